# Optimizing an MI355X kernel written in HIP

```python
import jax, jax.numpy as jnp
from jax import lax
import numpy as np

D_MODEL = 1024
BATCH = 16
SEQ = 2048
DEPTH = 1

PLE_DIM = 256
FOX_HEADS = 8
FOX_HEAD_DIM = 64
Q_BLOCK = 128
RET_HEADS = 4
RET_KEY_DIM = 64
RET_VAL_DIM = 128
RET_CHUNK = 128
ROPE_BASE = 10000.0
N_BRANCHES = 2
BRANCH_WIDTH = 512
N_EXPERTS = 32
TOP_K = 4
EXPERT_FF = 1024
SWIGLU_LIMIT = 7.0
SWIGLU_ALPHA = 1.702
MOE_BLOCK = 128
EPS = 1e-6

FOX_W = FOX_HEADS * FOX_HEAD_DIM
RET_QK_W = RET_HEADS * RET_KEY_DIM
RET_V_W = RET_HEADS * RET_VAL_DIM
IN_SPLITS = list(np.cumsum([FOX_W, FOX_W, FOX_W, FOX_HEADS, RET_QK_W, RET_QK_W, RET_V_W]))
IN_WIDTH = 3 * FOX_W + FOX_HEADS + 2 * RET_QK_W + 2 * RET_V_W

kernel_name = "fox_retnet_gated_moe_ple_block"


def rms_norm(x, g):
    x32 = x.astype(jnp.float32)
    y = x32 * lax.rsqrt(jnp.mean(x32 * x32, axis=-1, keepdims=True) + EPS)
    return (y * g.astype(jnp.float32)).astype(x.dtype)


def rotary(x, pos):
    half = x.shape[-1] // 2
    inv = ROPE_BASE ** (-jnp.arange(half, dtype=jnp.float32) / half)
    ang = pos.astype(jnp.float32)[:, None] * inv[None, :]
    cos = jnp.cos(ang)[None, :, None, :]
    sin = jnp.sin(ang)[None, :, None, :]
    x32 = x.astype(jnp.float32)
    x1, x2 = x32[..., :half], x32[..., half:]
    return jnp.concatenate([x1 * cos - x2 * sin, x2 * cos + x1 * sin], axis=-1).astype(x.dtype)


def fox_attention(q, k, v, log_f):
    B, S, H, d = q.shape
    scale = d ** -0.5
    qh = q.transpose(0, 2, 1, 3)
    kh = k.transpose(0, 2, 1, 3)
    vh = v.transpose(0, 2, 1, 3)
    c = jnp.cumsum(log_f, axis=1).transpose(0, 2, 1)
    outs = []
    for blk in range(S // Q_BLOCK):
        q0, q1 = blk * Q_BLOCK, (blk + 1) * Q_BLOCK
        qb, kb, vb = qh[:, :, q0:q1], kh[:, :, :q1], vh[:, :, :q1]
        logits = (jnp.einsum('bhqd,bhkd->bhqk', qb, kb).astype(jnp.float32) * scale
                  + c[:, :, q0:q1, None] - c[:, :, None, :q1])
        qpos = jnp.arange(q0, q1)
        kpos = jnp.arange(q1)
        logits = jnp.where(kpos[None, :] <= qpos[:, None], logits, -jnp.inf)
        probs = jax.nn.softmax(logits, axis=-1).astype(vb.dtype)
        outs.append(jnp.einsum('bhqk,bhkd->bhqd', probs, vb))
    o = jnp.concatenate(outs, axis=2)
    return o.transpose(0, 2, 1, 3).reshape(B, S, H * d)


def retention(q, k, v):
    B, S, H, dk = q.shape
    dv = v.shape[-1]
    C = RET_CHUNK
    NC = S // C
    lg = jnp.log1p(-jnp.exp2(-5.0 - jnp.arange(H, dtype=jnp.float32)))
    i = jnp.arange(C, dtype=jnp.float32)
    diff = i[:, None] - i[None, :]
    inner_decay = jnp.where(diff >= 0, jnp.exp(jnp.maximum(diff, 0.0)[None] * lg[:, None, None]), 0.0)
    q_decay = jnp.exp((i + 1.0)[None, :] * lg[:, None])
    k_decay = jnp.exp((C - 1.0 - i)[None, :] * lg[:, None])
    chunk_decay = jnp.exp(C * lg)

    def to_chunks(t):
        return t.reshape(B, NC, C, H, t.shape[-1]).transpose(1, 0, 3, 2, 4)

    def step(state, inp):
        qi, ki, vi = inp
        qi32, ki32, vi32 = qi.astype(jnp.float32), ki.astype(jnp.float32), vi.astype(jnp.float32)
        scores = jnp.einsum('bhid,bhjd->bhij', qi32, ki32) * inner_decay[None]
        o_intra = jnp.einsum('bhij,bhjv->bhiv', scores, vi32)
        o_inter = jnp.einsum('bhid,bhdv->bhiv', qi32, state) * q_decay[None, :, :, None]
        new_state = (state * chunk_decay[None, :, None, None]
                     + jnp.einsum('bhjd,bhjv->bhdv', ki32 * k_decay[None, :, :, None], vi32))
        return new_state, o_intra + o_inter

    init = jnp.zeros((B, H, dk, dv), jnp.float32)
    _, oc = lax.scan(step, init, (to_chunks(q), to_chunks(k), to_chunks(v)))
    return oc.transpose(1, 0, 3, 2, 4).reshape(B, S, H, dv)


def mixer_block(h, mix_norm, w_in, b_forget, w_branch, w_merge_gate, b_merge_gate, w_out):
    B, S, D = h.shape
    xn = rms_norm(h, mix_norm)
    u = xn @ w_in
    fq, fk, fv, ff, rq, rk, rv, rg = jnp.split(u, IN_SPLITS, axis=-1)
    log_f = jax.nn.log_sigmoid((ff + b_forget).astype(jnp.float32))
    fox = fox_attention(fq.reshape(B, S, FOX_HEADS, FOX_HEAD_DIM),
                        fk.reshape(B, S, FOX_HEADS, FOX_HEAD_DIM),
                        fv.reshape(B, S, FOX_HEADS, FOX_HEAD_DIM), log_f)
    pos = jnp.arange(S)
    rq = rotary(rq.reshape(B, S, RET_HEADS, RET_KEY_DIM), pos)
    rk = rotary(rk.reshape(B, S, RET_HEADS, RET_KEY_DIM), pos) * (RET_KEY_DIM ** -0.5)
    ro = retention(rq, rk, rv.reshape(B, S, RET_HEADS, RET_VAL_DIM))
    ro = ro * lax.rsqrt(jnp.mean(ro * ro, axis=-1, keepdims=True) + EPS)
    ro = ro.reshape(B, S, RET_V_W).astype(h.dtype) * jax.nn.silu(rg)
    branches = jnp.stack([fox, ro], axis=2)
    proj = jnp.einsum('bsgc,gcd->bsgd', branches, w_branch)
    gates = jax.nn.sigmoid(xn @ w_merge_gate + b_merge_gate).reshape(B, S, N_BRANCHES, D)
    merged = jnp.sum(gates * proj, axis=2)
    return merged @ w_out


def moe_block(hn, w_router, b_router, w_gate_up, b_gate_up, w_down, b_down):
    B, S, D = hn.shape
    N = B * S
    A = N * TOP_K
    xf = hn.reshape(N, D)
    logits = (xf @ w_router + b_router).astype(jnp.float32)
    top_val, top_idx = lax.top_k(logits, TOP_K)
    top_w = jax.nn.softmax(top_val, axis=-1)
    flat_e = top_idx.reshape(A).astype(jnp.int32)
    flat_w = top_w.reshape(A)
    flat_tok = jnp.arange(A, dtype=jnp.int32) // TOP_K
    order = jnp.argsort(flat_e, stable=True)
    sorted_e, sorted_tok, sorted_w = flat_e[order], flat_tok[order], flat_w[order]
    counts = jnp.bincount(flat_e, length=N_EXPERTS)
    group_start = jnp.cumsum(counts) - counts
    padded = (counts + MOE_BLOCK - 1) // MOE_BLOCK * MOE_BLOCK
    pad_end = jnp.cumsum(padded)
    pad_start = pad_end - padded
    dest = pad_start[sorted_e] + jnp.arange(A, dtype=jnp.int32) - group_start[sorted_e]
    n_blocks = -(-(A + N_EXPERTS * (MOE_BLOCK - 1)) // MOE_BLOCK)
    P = n_blocks * MOE_BLOCK
    buf_tok = jnp.full((P,), N, jnp.int32).at[dest].set(sorted_tok)
    buf_w = jnp.zeros((P,), jnp.float32).at[dest].set(sorted_w)
    x_pad = jnp.concatenate([xf, jnp.zeros((1, D), xf.dtype)], axis=0)
    x_buf = x_pad[buf_tok].reshape(n_blocks, MOE_BLOCK, D)
    block_start = jnp.arange(n_blocks, dtype=jnp.int32) * MOE_BLOCK
    block_e = jnp.minimum(jnp.sum(block_start[:, None] >= pad_end[None, :], axis=1), N_EXPERTS - 1)

    def expert_block(args):
        xb, e = args
        gu = xb @ w_gate_up[e] + b_gate_up[e]
        glu = jnp.minimum(gu[:, ::2], SWIGLU_LIMIT)
        lin = jnp.clip(gu[:, 1::2], -SWIGLU_LIMIT, SWIGLU_LIMIT)
        act = glu * jax.nn.sigmoid(SWIGLU_ALPHA * glu) * (lin + 1.0)
        return act @ w_down[e] + b_down[e]

    y_buf = lax.map(expert_block, (x_buf, block_e)).reshape(P, D)
    y = y_buf * buf_w[:, None].astype(y_buf.dtype)
    out = jax.ops.segment_sum(y, buf_tok, num_segments=N + 1)[:N]
    return out.reshape(B, S, D)


def setup_inputs(seed: int = 0) -> dict:
    key = jax.random.key(seed)
    ks = jax.random.split(key, 20)
    f32 = jnp.float32
    L, D = DEPTH, D_MODEL

    def nrm(k, shape, fan_in):
        return jax.random.normal(k, shape, f32) * (fan_in ** -0.5)

    def gain(k, shape):
        return 1.0 + 0.01 * jax.random.normal(k, shape, f32)

    return {
        "x": jax.random.normal(ks[0], (BATCH, SEQ, D), f32),
        "p": jax.random.normal(ks[1], (L, BATCH, SEQ, PLE_DIM), f32),
        "mix_norm": gain(ks[2], (L, D)),
        "w_in": nrm(ks[3], (L, D, IN_WIDTH), D),
        "b_forget": jax.random.uniform(ks[4], (L, FOX_HEADS), f32, minval=1.0, maxval=5.0),
        "w_branch": nrm(ks[5], (L, N_BRANCHES, BRANCH_WIDTH, D), BRANCH_WIDTH),
        "w_merge_gate": nrm(ks[6], (L, D, N_BRANCHES * D), D),
        "b_merge_gate": 0.01 * jax.random.normal(ks[7], (L, N_BRANCHES * D), f32),
        "w_out": nrm(ks[8], (L, D, D), D),
        "ffn_norm": gain(ks[9], (L, D)),
        "w_router": nrm(ks[10], (L, D, N_EXPERTS), D),
        "b_router": 0.01 * jax.random.normal(ks[11], (L, N_EXPERTS), f32),
        "w_gate_up": nrm(ks[12], (L, N_EXPERTS, D, 2 * EXPERT_FF), D),
        "b_gate_up": 0.01 * jax.random.normal(ks[13], (L, N_EXPERTS, 2 * EXPERT_FF), f32),
        "w_down": nrm(ks[14], (L, N_EXPERTS, EXPERT_FF, D), EXPERT_FF),
        "b_down": 0.01 * jax.random.normal(ks[15], (L, N_EXPERTS, D), f32),
        "ple_norm": gain(ks[16], (L, D)),
        "w_ple_gate": nrm(ks[17], (L, D, D), D),
        "w_ple_proj": nrm(ks[18], (L, PLE_DIM, D), PLE_DIM),
        "final_norm": gain(ks[19], (D,)),
    }


def reference(x, p, mix_norm, w_in, b_forget, w_branch, w_merge_gate, b_merge_gate, w_out,
              ffn_norm, w_router, b_router, w_gate_up, b_gate_up, w_down, b_down,
              ple_norm, w_ple_gate, w_ple_proj, final_norm):
    h = x
    for i in range(DEPTH):
        h = h + mixer_block(h, mix_norm[i], w_in[i], b_forget[i], w_branch[i],
                            w_merge_gate[i], b_merge_gate[i], w_out[i])
        h = h + moe_block(rms_norm(h, ffn_norm[i]), w_router[i], b_router[i],
                          w_gate_up[i], b_gate_up[i], w_down[i], b_down[i])
        ple_gate = jax.nn.sigmoid(rms_norm(h, ple_norm[i]) @ w_ple_gate[i])
        h = h + ple_gate * (p[i] @ w_ple_proj[i])
    return rms_norm(h, final_norm)
```

```cpp
#include <hip/hip_runtime.h>
#include <cstdio>
#include <cstdint>
#include <cstring>
#include <cmath>
__device__ __forceinline__ int lane_now() { int l; asm volatile("v_mbcnt_lo_u32_b32 %0, -1, 0\n\tv_mbcnt_hi_u32_b32 %0, -1, %0" : "=v"(l)); return l; }
namespace pg8 {
#define PG8_LAS __attribute__((address_space(3)))
typedef unsigned short bf16_t;
typedef short bf16x8 __attribute__((ext_vector_type(8)));
typedef float f32x4 __attribute__((ext_vector_type(4)));
typedef float f32x2 __attribute__((ext_vector_type(2)));
typedef unsigned u32x4 __attribute__((ext_vector_type(4)));
typedef unsigned u32x2 __attribute__((ext_vector_type(2)));
constexpr int BM = 256, BK = 64, HALF = 128, HTB = HALF * BK * 2  , STAGE_BYTES = 8 * HTB, NXCD = 8, WGM = 16;

__host__ __device__ __forceinline__ int lds_byte(int r, int c) { const int st = (r >> 4) * 2 + (c >> 5), rr = r & 15, cc = c & 31, ob = rr * 64 + cc * 2; return st * 1024 + (ob ^ (((ob >> 9) & 1) << 5)); }
__host__ __device__ __forceinline__ void stage_rc(int b, int& R, int& C) { const int st = b / 1024, sb = b % 1024, swz = sb ^ (((sb >> 9) & 1) << 5); R = (st >> 1) * 16 + swz / 64; C = (st & 1) * 32 + (swz % 64) / 2; }
__host__ __device__ __forceinline__ int perm32(int rho) { const int n = rho >> 4, i = rho & 15; return 8 * (i >> 2) + 4 * n + (i & 3); }

struct Unit { int pm, pn; const char* A; const char* B; int e, rtl; };
struct Gemm { int lda, ldb, K; };

struct DenseOrder {
    int nM, nN, nwg, G, c; const char* A; const char* B; size_t tsA, tsB;
    __device__ __forceinline__ void init(int nM_, int nN_, int G_, int c_, const void* A_, size_t tsA_, const void* B_, size_t tsB_) { nM = nM_; nN = nN_; nwg = nM * nN; G = G_; c = c_; A = (const char*)A_; B = (const char*)B_; tsA = tsA_; tsB = tsB_; }
    __device__ __forceinline__ bool tile(int i, int& pm, int& pn) const {
        const long L = (long)i * G + c; if (L >= nwg) return false;
        int wgid = (int)L; { const int q = nwg / NXCD, r = nwg % NXCD, xcd = wgid % NXCD, off = wgid / NXCD; wgid = (xcd < r ? xcd * (q + 1) : r * (q + 1) + (xcd - r) * q) + off; }
        const int nig = WGM * nN, gid = wgid / nig, fm = gid * WGM, gsz = (nM - fm) < WGM ? (nM - fm) : WGM;
        pm = fm + ((wgid % nig) % gsz); pn = (wgid % nig) / gsz; return true;
    }
    __device__ __forceinline__ bool next(int i, Unit& u) const { if (!tile(i, u.pm, u.pn)) return false; u.A = A + (size_t)u.pm * tsA; u.B = B + (size_t)u.pn * tsB; u.e = 0; u.rtl = 0; return true; }
    __device__ __forceinline__ const PG8_LAS unsigned char* table(int) const { return nullptr; }
};

__device__ __forceinline__ unsigned cvt_pk_bf16(float lo, float hi) { unsigned r; asm volatile("s_nop 0\n\tv_cvt_pk_bf16_f32 %0, %1, %2" : "=v"(r) : "v"(lo), "v"(hi)); return r; }
__device__ __forceinline__ float bflo(unsigned w) { return __uint_as_float(w << 16); }
__device__ __forceinline__ float bfhi(unsigned w) { return __uint_as_float(w & 0xffff0000u); }
__device__ __forceinline__ float fsigmoid(float x) { return __builtin_amdgcn_rcpf(1.0f + __builtin_amdgcn_exp2f(-1.4426950408889634f * x)); }

__device__ __forceinline__ const char* uni_ptr(const char* p) { const unsigned long long v = (unsigned long long)p; const unsigned lo = __builtin_amdgcn_readfirstlane((unsigned)v), hi = __builtin_amdgcn_readfirstlane((unsigned)(v >> 32)); return (const char*)(((unsigned long long)hi << 32) | lo); }
__device__ __forceinline__ void uni_unit(Unit& u) { u.pm = __builtin_amdgcn_readfirstlane(u.pm); u.pn = __builtin_amdgcn_readfirstlane(u.pn); u.e = __builtin_amdgcn_readfirstlane(u.e); u.rtl = __builtin_amdgcn_readfirstlane(u.rtl); u.A = uni_ptr(u.A); u.B = uni_ptr(u.B); }
struct NoHook { static constexpr bool ON = false; static constexpr int AT = -1; template <class A> __device__ __forceinline__ void operator()(A&, const Unit&, int, int, int, int) const {} };
template <class Epi, class Sched, bool ALIGN_EPI, bool GATHER, int ES = 2, class Hook = NoHook>
__device__ __forceinline__ void gemm_phase(PG8_LAS unsigned char* lds, const Gemm g, const Sched& S, const Epi& E, int wave, const Hook& H = Hook()) {
    int tid = wave * 64 + lane_now(); asm volatile("" : "+v"(tid));
    const int wid = __builtin_amdgcn_readfirstlane(tid >> 6), lane = tid & 63, wr = wid >> 2, wc = wid & 3, fr = lane & 15, fq = lane >> 4;
    const int K = g.K, nt = K * ES / (BK * 2);
    unsigned voffA[2], voffB[2];
#pragma unroll
    for (int i = 0; i < 2; ++i) { int R, C; stage_rc(tid * 16 + i * 8192, R, C); const int Rb = Epi::PERM ? ((R & ~31) + perm32(R & 31)) : R;
        voffA[i] = (unsigned)(R * g.lda * ES + C * 2); voffB[i] = (unsigned)(Rb * g.ldb * ES + C * 2); }
    const size_t kstep = (size_t)(BK * 2);
    const size_t hstepA = GATHER ? (size_t)0 : (size_t)HALF * g.lda * ES;
    const size_t hstepB = (size_t)HALF * g.ldb * ES;
    const unsigned ldsw = (unsigned)wid * 1024u;
    const int aoff = lds_byte(wr * 64 + fr, fq * 8), boff = lds_byte(wc * 32 + fr, fq * 8);
    unsigned vA[2][2], nvA[2][2];
#define PG8_ROWS(dst, uidx) do { int t_ = wave * 64 + lane_now(); asm volatile("" : "+v"(t_)); int R0_, C0_; stage_rc(t_ * 16, R0_, C0_); \
        const PG8_LAS unsigned char* _t = S.table(uidx) + (unsigned)R0_ * 4u; const unsigned c2_ = (unsigned)C0_ * 2u; _Pragma("unroll") for (int h = 0; h < 2; ++h) _Pragma("unroll") for (int i = 0; i < 2; ++i) \
        dst[h][i] = *(const PG8_LAS unsigned*)(_t + h * 512 + i * 256) + c2_; } while (0)
#define PG8_SA(b, h) (((b) * 2 + (h)) * HTB)
#define PG8_SB(b, h) ((4 + (b) * 2 + (h)) * HTB)
#define PG8_STAGE(bufoff, gbase, voff) do { const char* _gb = (const char*)(gbase); asm volatile("" : "+s"(_gb));     \
        _Pragma("unroll") for (int _i = 0; _i < 2; ++_i) { const unsigned _la = (unsigned)__builtin_amdgcn_readfirstlane((int)(unsigned)(uintptr_t)(lds + (bufoff) + ldsw + _i * 8192)); \
            asm volatile("s_mov_b32 m0, %2\n\ts_nop 0\n\tglobal_load_lds_dwordx4 %0, %1" :: "v"((voff)[_i]), "s"(_gb), "s"(_la) : "memory", "m0"); } } while (0)
#define PG8_STB(b, h, ptr) PG8_STAGE(PG8_SB(b, h), (ptr) + (h) * hstepB, voffB)
#define PG8_STA(b, h, ptr, nx) do { if constexpr (GATHER) { unsigned _v[2]; _v[0] = (nx) ? nvA[h][0] : vA[h][0]; _v[1] = (nx) ? nvA[h][1] : vA[h][1]; PG8_STAGE(PG8_SA(b, h), (ptr), _v); } \
        else { PG8_STAGE(PG8_SA(b, h), (ptr) + (h) * hstepA, voffA); } } while (0)
#define PG8_LDA(dst, b, h) do { _Pragma("unroll") for (int m = 0; m < 4; ++m) _Pragma("unroll") for (int k = 0; k < 2; ++k) dst[m][k] = *(const PG8_LAS bf16x8*)(lds + PG8_SA(b, h) + aoff + m * 2048 + k * 1024); } while (0)
#define PG8_LDB(dst, b, h) do { _Pragma("unroll") for (int n = 0; n < 2; ++n) _Pragma("unroll") for (int k = 0; k < 2; ++k) dst[n][k] = *(const PG8_LAS bf16x8*)(lds + PG8_SB(b, h) + boff + n * 2048 + k * 1024); } while (0)
#define PG8_MMA(ai, bj, At, Bt, Z) do { const f32x4 z4_ = {0.f, 0.f, 0.f, 0.f}; __builtin_amdgcn_s_setprio(1); _Pragma("unroll") for (int m = 0; m < 4; ++m) _Pragma("unroll") for (int n = 0; n < 2; ++n) { \
        if constexpr (ES == 2) { acc[ai][bj][m][n] = __builtin_amdgcn_mfma_f32_16x16x32_bf16(Bt[n][0], At[m][0], (Z) ? z4_ : acc[ai][bj][m][n], 0, 0, 0); acc[ai][bj][m][n] = __builtin_amdgcn_mfma_f32_16x16x32_bf16(Bt[n][1], At[m][1], acc[ai][bj][m][n], 0, 0, 0); } \
        else { typedef int v8i_ __attribute__((ext_vector_type(8))); const u32x4 b0_ = __builtin_bit_cast(u32x4, Bt[n][0]), b1_ = __builtin_bit_cast(u32x4, Bt[n][1]), a0_ = __builtin_bit_cast(u32x4, At[m][0]), a1_ = __builtin_bit_cast(u32x4, At[m][1]); \
            const v8i_ bv_ = {(int)b0_[0], (int)b0_[1], (int)b0_[2], (int)b0_[3], (int)b1_[0], (int)b1_[1], (int)b1_[2], (int)b1_[3]}, av_ = {(int)a0_[0], (int)a0_[1], (int)a0_[2], (int)a0_[3], (int)a1_[0], (int)a1_[1], (int)a1_[2], (int)a1_[3]}; \
            acc[ai][bj][m][n] = __builtin_amdgcn_mfma_scale_f32_16x16x128_f8f6f4(bv_, av_, (Z) ? z4_ : acc[ai][bj][m][n], 0, 0, 0, 0, 0, 0); } }     \
        __builtin_amdgcn_s_setprio(0); \
        _Pragma("unroll") for (int m = 0; m < 4; ++m) asm volatile("" : "+v"(acc[ai][bj][m][0]), "+v"(acc[ai][bj][m][1]));     \
        } while (0)
#define PG8_WAIT_V(n) asm volatile("s_waitcnt vmcnt(" #n ")" ::: "memory")
#define PG8_WAIT_L(n) asm volatile("s_waitcnt lgkmcnt(" #n ")" ::: "memory")
#define PG8_BAR __builtin_amdgcn_s_barrier()
#define PG8_SCHED __builtin_amdgcn_sched_barrier(0)
    Unit cur, nxt; int ui = 0;
    if (!S.next(0, cur)) return;
    uni_unit(cur);
    f32x4 acc[2][2][4][2];
    bf16x8 At[4][2], B0[2][2], B1[2][2];
    const char* cA = cur.A; const char* cB = cur.B;
    if constexpr (GATHER) { PG8_ROWS(vA, 0); }
    PG8_STB(0, 0, cB); PG8_STB(0, 1, cB); PG8_STA(0, 0, cA, false); PG8_STA(0, 1, cA, false);
    if (wr == 1) PG8_BAR;
    PG8_WAIT_V(2); PG8_BAR;
    PG8_STB(1, 0, cB + kstep); PG8_STA(1, 0, cA + kstep, false); PG8_STB(1, 1, cB + kstep);
    PG8_WAIT_V(6); PG8_BAR;
    for (;;) {
        const bool has_next = S.next(ui + 1, nxt);
        if (has_next) uni_unit(nxt);
        const char* nA = has_next ? nxt.A : cA; const char* nB = has_next ? nxt.B : cB;
#define PG8_KPAIR(t, LAST, ZERO) do { \
            const char* a1 = cA + (size_t)((t) + 1) * kstep; \
            const char* a2 = (LAST) ? nA : cA + (size_t)((t) + 2) * kstep; const char* b2 = (LAST) ? nB : cB + (size_t)((t) + 2) * kstep; \
            const char* a3 = a2 + kstep; const char* b3 = b2 + kstep; \
              \
            PG8_LDB(B0, 0, 0); PG8_LDB(B1, 0, 1); PG8_SCHED; PG8_LDA(At, 0, 0); PG8_STA(1, 1, a1, false); \
            PG8_WAIT_V(8); PG8_WAIT_L(0); PG8_BAR; PG8_MMA(0, 0, At, B0, ZERO); PG8_MMA(0, 1, At, B1, ZERO); PG8_BAR; PG8_SCHED; \
              \
            PG8_LDA(At, 0, 1); PG8_STB(0, 0, b2); PG8_STB(0, 1, b2); PG8_STA(0, 0, a2, LAST); \
            PG8_WAIT_V(8); PG8_WAIT_L(0); PG8_BAR; PG8_MMA(1, 0, At, B0, ZERO); PG8_MMA(1, 1, At, B1, ZERO); PG8_BAR; PG8_SCHED; \
              \
            PG8_LDB(B0, 1, 0); PG8_LDB(B1, 1, 1); PG8_SCHED; PG8_LDA(At, 1, 0); PG8_STA(0, 1, a2, LAST); \
            PG8_WAIT_V(8); PG8_WAIT_L(0); PG8_BAR; PG8_MMA(0, 0, At, B0, false); PG8_MMA(0, 1, At, B1, false); PG8_BAR; PG8_SCHED; \
              \
            PG8_LDA(At, 1, 1); PG8_STB(1, 0, b3); PG8_STB(1, 1, b3); PG8_STA(1, 0, a3, LAST); \
            PG8_WAIT_V(8); PG8_WAIT_L(0); PG8_BAR; PG8_MMA(1, 0, At, B0, false); PG8_MMA(1, 1, At, B1, false); PG8_BAR; PG8_SCHED; } while (0)
        PG8_KPAIR(0, false, true);
        _Pragma("nounroll") for (int t = 2; t < nt - 2; t += 2) { PG8_KPAIR(t, false, false); if constexpr (Hook::ON) { if (t == Hook::AT) H(acc, cur, wr, wc, fr, fq); } }
        if constexpr (GATHER) {
            if (has_next) { PG8_ROWS(nvA, ui + 1); }
            else {
#pragma unroll
                for (int h = 0; h < 2; ++h)
#pragma unroll
                    for (int i = 0; i < 2; ++i) nvA[h][i] = vA[h][i]; }
        }
        PG8_KPAIR(nt - 2, true, false);
#undef PG8_KPAIR
        if constexpr (ALIGN_EPI) { if (wr == 0) PG8_BAR; }
        E(acc, cur, wr, wc, fr, fq);
        if (!has_next) break;
        cur = nxt; cA = nA; cB = nB; ++ui;
        if constexpr (GATHER) {
#pragma unroll
            for (int h = 0; h < 2; ++h)
#pragma unroll
                for (int i = 0; i < 2; ++i) vA[h][i] = nvA[h][i];
        }
        if constexpr (ALIGN_EPI) { if (wr == 1) PG8_BAR; }
    }
    PG8_WAIT_V(0);
    if constexpr (!ALIGN_EPI) { if (wr == 0) PG8_BAR; }
    PG8_BAR;
#undef PG8_SA
#undef PG8_SB
#undef PG8_STAGE
#undef PG8_STB
#undef PG8_ROWS
#undef PG8_STA
#undef PG8_LDA
#undef PG8_LDB
#undef PG8_MMA
#undef PG8_WAIT_V
#undef PG8_WAIT_L
#undef PG8_BAR
#undef PG8_SCHED
}
}

constexpr int NWAVES = 8;
constexpr int NT = 32768, DM = 1024, SEQ = 2048, NBATCH = 16, INW = 3080, NE = 32, PLE = 256;
constexpr float EPS = 1e-6f;
constexpr float LOG2E = 1.4426950408889634f;
constexpr float C2 = 0.125f * 1.4426950408889634f;
constexpr int N1 = 5120;
constexpr int MAXRT = 576;
constexpr int MAXUNITS = 24;

constexpr size_t MiB = 1u << 20;
constexpr size_t WS_CTL = 0, CTL_ZERO_BYTES = 1 * MiB;
constexpr size_t WS_TOK = 2 * MiB;
constexpr size_t WS_RSOF = 6 * MiB;
constexpr size_t WS_TOPE = 10 * MiB;
constexpr size_t WS_TOPW = 10 * MiB + 512 * 1024;
constexpr size_t WS_POS = 11 * MiB;
constexpr size_t WS_LOGF = 12 * MiB;
constexpr size_t WS_CUM = 13 * MiB;
constexpr size_t WS_ROT = 14 * MiB;
constexpr size_t WS_RSTD2 = 14 * MiB + 512 * 1024;
constexpr size_t WS_WRT = 15 * MiB;
constexpr size_t WS_W1T = 16 * MiB;
constexpr size_t WS_WBT = 26 * MiB;
constexpr size_t WS_WOT = 28 * MiB;
constexpr size_t WS_WPGT = 30 * MiB;
constexpr size_t WS_WPPT = 32 * MiB;
constexpr size_t WS_WGUT = 34 * MiB;
constexpr size_t WS_WDT = 162 * MiB;
constexpr size_t WS_HB = 226 * MiB;
constexpr size_t WS_PB = 291 * MiB;
constexpr size_t WS_Z = 307 * MiB;
constexpr size_t WS_XN = WS_Z, WS_FQ = WS_Z + 64 * MiB, WS_FK = WS_Z + 96 * MiB, WS_FV = WS_Z + 128 * MiB, WS_RQ = WS_Z + 160 * MiB, WS_RK = WS_Z + 176 * MiB;
constexpr size_t WS_RV = WS_Z + 192 * MiB, WS_RGS = WS_Z + 224 * MiB, WS_GATES = WS_Z + 256 * MiB, WS_BR = WS_Z + 384 * MiB, WS_MERGED = WS_Z + 448 * MiB;
constexpr size_t WS_RKT = WS_Z + 512 * MiB;
constexpr size_t WS_XN8 = WS_Z + 528 * MiB;
constexpr size_t WS_WG8T = WS_W1T + 4 * MiB;
constexpr size_t WS_H2B = WS_Z + 448 * MiB;
constexpr size_t WS_MO = WS_Z + 512 * MiB;
constexpr size_t WS_ACT = WS_Z, WS_Y = WS_Z + 144 * MiB;
constexpr size_t WS_HB2 = WS_Z, WS_PJ = WS_Z + 384 * MiB, WS_G8 = WS_Z + 160 * MiB;
constexpr size_t WS_END = WS_Z + 576 * MiB;
constexpr int CW_BAR = 4096;
constexpr int CW_CNT = 8192;
constexpr int CW_QUEUE = 8256;
constexpr int CW_SSQ = 16384;
static_assert((CW_SSQ + NT) * 4 <= (int)CTL_ZERO_BYTES, "CTL words inside the memset region");

constexpr int RING_OFF = 0, RING_BYTES = 131072;
constexpr int TAB_OFF = RING_BYTES;
constexpr int SCH_OFF = TAB_OFF + MAXUNITS * 1024;
constexpr int SCH_CNT = SCH_OFF, SCH_P = SCH_OFF + 128, SCH_RT2E = SCH_OFF + 128 + 160;
constexpr int MISC_OFF = SCH_RT2E + MAXRT * 4;
constexpr int LDS_BYTES = 163840;
static_assert(MISC_OFF + 256 <= LDS_BYTES && (MISC_OFF % 16) == 0, "LDS map");

#define GAS __attribute__((address_space(1)))
#define LAS __attribute__((address_space(3)))
typedef unsigned short bf16;
typedef unsigned v4u __attribute__((ext_vector_type(4)));
typedef unsigned v2u __attribute__((ext_vector_type(2)));
typedef float f32x4 __attribute__((ext_vector_type(4)));
typedef short bf16x8 __attribute__((ext_vector_type(8)));
typedef GAS unsigned gu32;
#define RLX_AGENT __ATOMIC_RELAXED, __HIP_MEMORY_SCOPE_AGENT
#define LDS_WAIT() asm volatile("s_waitcnt lgkmcnt(0)" ::: "memory")
#define VM_WAIT() asm volatile("s_waitcnt vmcnt(0)" ::: "memory")
__device__ __forceinline__ unsigned f2bf(float f) { unsigned u = __builtin_bit_cast(unsigned, f); return (u + 0x7fffu + ((u >> 16) & 1u)) >> 16; }
__device__ __forceinline__ unsigned pk2(float lo, float hi) { return f2bf(lo) | (f2bf(hi) << 16); }
using pg8::bflo; using pg8::bfhi; using pg8::fsigmoid; using pg8::cvt_pk_bf16;
constexpr float WSCALE = 32.f;
constexpr float YSCALE = 8.f;
__device__ __forceinline__ float clamp_f8(float v) { return fminf(fmaxf(v, -448.f), 448.f); }
__device__ __forceinline__ v2u pack8_fp8(const f32x4 a, const f32x4 b) {
    int w0 = 0, w1 = 0;
    w0 = __builtin_amdgcn_cvt_pk_fp8_f32(clamp_f8(a[0]), clamp_f8(a[1]), w0, false); w0 = __builtin_amdgcn_cvt_pk_fp8_f32(clamp_f8(a[2]), clamp_f8(a[3]), w0, true);
    w1 = __builtin_amdgcn_cvt_pk_fp8_f32(clamp_f8(b[0]), clamp_f8(b[1]), w1, false); w1 = __builtin_amdgcn_cvt_pk_fp8_f32(clamp_f8(b[2]), clamp_f8(b[3]), w1, true);
    return (v2u){(unsigned)w0, (unsigned)w1}; }
#define DPP_F(v, ctrl) __int_as_float(__builtin_amdgcn_update_dpp(0, __float_as_int(v), (ctrl), 0xF, 0xF, false))
__device__ __forceinline__ float wave_sum(float v) {
    v += DPP_F(v, 0xB1); v += DPP_F(v, 0x4E); v += DPP_F(v, 0x141); v += DPP_F(v, 0x140);
    const int b = __float_as_int(v);
    return (__int_as_float(__builtin_amdgcn_readlane(b, 0)) + __int_as_float(__builtin_amdgcn_readlane(b, 16))) + (__int_as_float(__builtin_amdgcn_readlane(b, 32)) + __int_as_float(__builtin_amdgcn_readlane(b, 48)));
}
__device__ __forceinline__ float xor32_sum(float v) { auto rr = __builtin_amdgcn_permlane32_swap(__float_as_uint(v), __float_as_uint(v), false, false); return __uint_as_float(rr[0]) + __uint_as_float(rr[1]); }
__device__ __forceinline__ float xor16_sum(float v) { auto rr = __builtin_amdgcn_permlane16_swap(__float_as_uint(v), __float_as_uint(v), false, false); return __uint_as_float(rr[0]) + __uint_as_float(rr[1]); }

#define XB_TMO      128
#define XB_XCNT(j)  (256  + 64 * (j))
#define XB_XSUB(j)  (1280 + 64 * (j))
#define XB_XGEN(j)  (2304 + 64 * (j))
#define XB_TOP      3328
#define XB_TOPGEN   3392
#define XCD_BAR_WORDS 3456
#define XB_SPIN_CAP (1u << 20)

__device__ __forceinline__ unsigned xb_ld(unsigned* p)              { return __hip_atomic_load(p, __ATOMIC_RELAXED, __HIP_MEMORY_SCOPE_AGENT); }
__device__ __forceinline__ unsigned xb_add(unsigned* p, unsigned v) { return __hip_atomic_fetch_add(p, v, __ATOMIC_RELAXED, __HIP_MEMORY_SCOPE_AGENT); }
__device__ __forceinline__ unsigned xb_xcc_id() { return (unsigned)__builtin_amdgcn_s_getreg((3 << 11) | 20) & 0xFu; }
#define XB_SPIN(cond, bar) do { unsigned _sp = 0; while (cond) { __builtin_amdgcn_s_sleep(1); \
    if ((++_sp & 255u) == 0u) { if (xb_ld(&(bar)[XB_TMO])) break; if (_sp > XB_SPIN_CAP) { atomicAdd(&(bar)[XB_TMO], 1u); break; } } } } while (0)

struct XcdBarrier {
    unsigned* bar; unsigned x;
    volatile LAS unsigned* st;
};
__device__ __forceinline__ XcdBarrier xcd_barrier_post(unsigned* bar, volatile LAS unsigned* st, int tid) {
    XcdBarrier b; b.bar = bar; b.x = xb_xcc_id(); b.st = st;
    if (tid == 0) (void)xb_add(&bar[XB_XCNT(b.x)], 1u);
    return b;
}
__device__ __forceinline__ void xcd_barrier_complete(unsigned* bar, unsigned x, unsigned& nloc, unsigned& nx) {
    const unsigned G = gridDim.x * gridDim.y * gridDim.z;
    unsigned sum, cnt, mine, sp = 0u;
    for (;;) {
        sum = 0u; cnt = 0u; mine = 0u;
#pragma unroll
        for (unsigned j = 0; j < 16; ++j) { const unsigned c = xb_ld(&bar[XB_XCNT(j)]); sum += c; cnt += (c > 0u) ? 1u : 0u; mine = (j == x) ? c : mine; }
        if (sum == G) break;
        __builtin_amdgcn_s_sleep(1);
        if ((++sp & 255u) == 0u) { if (xb_ld(&bar[XB_TMO])) break; if (sp > XB_SPIN_CAP) { atomicAdd(&bar[XB_TMO], 1u); break; } }
    }
    nloc = mine > 0u ? mine : 1u; nx = cnt > 0u ? cnt : 1u;
}
__device__ __forceinline__ void xcd_barrier(const XcdBarrier& b, int tid) {
    asm volatile("s_waitcnt vmcnt(0)" ::: "memory");
    __syncthreads();
    if (tid == 0) {
        unsigned* bar = b.bar;
        __builtin_amdgcn_s_waitcnt(0);
        unsigned nloc = b.st[0], nx = b.st[1];
        if (nloc == 0u) { xcd_barrier_complete(bar, b.x, nloc, nx); b.st[0] = nloc; b.st[1] = nx; }
        const unsigned old = xb_add(&bar[XB_XSUB(b.x)], 1u);
        const unsigned gen = old / nloc;
        if (old + 1u == (gen + 1u) * nloc) {
            __builtin_amdgcn_fence(__ATOMIC_RELEASE, "agent");
            asm volatile("s_waitcnt vmcnt(0)" ::: "memory");
            const unsigned og = xb_add(&bar[XB_TOP], 1u);
            const unsigned tg = og / nx;
            if (og + 1u == (tg + 1u) * nx) xb_add(&bar[XB_TOPGEN], 1u);
            else XB_SPIN(xb_ld(&bar[XB_TOPGEN]) == tg, bar);
            __builtin_amdgcn_fence(__ATOMIC_ACQUIRE, "agent");
            xb_add(&bar[XB_XGEN(b.x)], 1u);
            asm volatile("s_waitcnt vmcnt(0)" ::: "memory");
        } else {
            XB_SPIN(xb_ld(&bar[XB_XGEN(b.x)]) == gen, bar);
            __builtin_amdgcn_fence(__ATOMIC_ACQUIRE, "agent");
            asm volatile("s_waitcnt vmcnt(0)" ::: "memory");
        }
    }
    __syncthreads();
}

struct Args { const float* in[20]; float* out; unsigned char* ws; int ph_lo, ph_hi, rep_phase, rep_mode; };
struct Frame {
    LAS unsigned char* lds;
    volatile LAS unsigned* MISC;
    int tid, lane, wave;
    int vcu, G;
    const __attribute__((address_space(4))) Args* ap;
};
#define REARGS() do { F.ap = (const __attribute__((address_space(4))) Args*)__builtin_amdgcn_kernarg_segment_ptr(); asm volatile("" : "+s"(F.ap)); } while (0)
#define WSP(T, off) ((T*)(F.ap->ws + (off)))

#include <hip/hip_bf16.h>
namespace attn_body {
using bf16=__hip_bfloat16;
using bf16x8=__attribute__((ext_vector_type(8)))short;
using s16x4=__attribute__((ext_vector_type(4)))short;
using f32x16=__attribute__((ext_vector_type(16)))float;
using u32x4=__attribute__((ext_vector_type(4)))unsigned;
constexpr int BATCH=16,NHEAD=8,SEQ=2048,D=64,DM=NHEAD*D,OPITCH=1024;
constexpr int NW=8,QBLK=32,QB=QBLK*NW,KVBLK=64,NQB=SEQ/QB;
constexpr int ATTN_PITCH=DM, ATTN_UNIT_ROWS=QB;
__device__ __forceinline__ int crow(int r,int hi){return (r&3)+8*(r>>2)+4*hi;}
#define SBAR() __builtin_amdgcn_sched_barrier(0)
__device__ __forceinline__ void cmask(f32x16&p0,f32x16&p1,int jb,int qrel,int hi){
  const float NEG=-INFINITY; int kb=64*jb+4*hi;
  #pragma unroll
  for(int r=0;r<16;++r){int kv=kb+(r&3)+8*(r>>2); if(kv>qrel)p0[r]=NEG; if(kv+32>qrel)p1[r]=NEG;}
}

constexpr int NSLOT=3, SLOTB=8192;
constexpr int LDS_K=0, LDS_V=NSLOT*SLOTB, LDS_WS=2*NSLOT*SLOTB, LDS_OST=LDS_WS+NW*64*4, LDS_KB=LDS_OST+NW*4096, LDS_BYTES=LDS_KB+SEQ*16;
constexpr float C2=0.125f*1.4426950408889634f;
__device__ __forceinline__ void glds16(const void*gsrc,unsigned lds_dst){unsigned keep;
  asm volatile("s_mov_b32 %0, m0\n\ts_mov_b32 m0, %2\n\ts_nop 0\n\tglobal_load_lds_dwordx4 %1, off\n\ts_mov_b32 m0, %0":"=&s"(keep):"v"(gsrc),"s"(lds_dst):"memory");}
__device__ __forceinline__ float max3f(float a,float b,float c){float r;asm("v_max3_f32 %0, %1, %2, %3":"=v"(r):"v"(a),"v"(b),"v"(c));return r;}
__device__ __forceinline__ float max2f(float a,float b){float r;asm("v_max_f32_e32 %0, %1, %2":"=v"(r):"v"(a),"v"(b));return r;}
__device__ __forceinline__ float fadd_s(float a,float b){float r;asm("v_add_f32_e32 %0, %1, %2":"=v"(r):"v"(a),"v"(b));return r;}
__device__ __forceinline__ float fsub_s(float a,float b){float r;asm("v_sub_f32_e32 %0, %1, %2":"=v"(r):"v"(a),"v"(b));return r;}
typedef float f32x2_t __attribute__((ext_vector_type(2))); typedef __bf16 bf16x2_t __attribute__((ext_vector_type(2)));
__device__ __forceinline__ unsigned cvtpk_s(float lo,float hi){f32x2_t v={lo,hi};bf16x2_t b=__builtin_convertvector(v,bf16x2_t);return __builtin_bit_cast(unsigned,b);}
#define WAIT_BAR(N) asm volatile("s_waitcnt vmcnt(" #N ") lgkmcnt(0)\n\ts_barrier":::"memory")

__device__ __forceinline__ void qkt(f32x16&p0,f32x16&p1,const char*Kslot,const bf16x8*qr,const bf16x8 qx,const bf16x8 kb0,const bf16x8 kb1,int r32,int hi){
  const f32x16 zc=f32x16{};
  const char*kb=Kslot+hi*1024+r32*16;
  #pragma unroll
  for(int d0=0;d0<4;++d0){
    const bf16x8 b0=*reinterpret_cast<const bf16x8*>(kb+d0*2048);
    const bf16x8 b1=*reinterpret_cast<const bf16x8*>(kb+d0*2048+512);
    if(d0==0){p0=__builtin_amdgcn_mfma_f32_32x32x16_bf16(b0,qr[0],zc,0,0,0);p1=__builtin_amdgcn_mfma_f32_32x32x16_bf16(b1,qr[0],zc,0,0,0);}
    else{p0=__builtin_amdgcn_mfma_f32_32x32x16_bf16(b0,qr[d0],p0,0,0,0);p1=__builtin_amdgcn_mfma_f32_32x32x16_bf16(b1,qr[d0],p1,0,0,0);}}
  p0=__builtin_amdgcn_mfma_f32_32x32x16_bf16(kb0,qx,p0,0,0,0);p1=__builtin_amdgcn_mfma_f32_32x32x16_bf16(kb1,qx,p1,0,0,0);
}
typedef __attribute__((address_space(3))) const char* lds_cptr;
typedef short v4i16_t __attribute__((ext_vector_type(4)));
__device__ __forceinline__ void kload8(bf16x8*kf,lds_cptr kp){
  kf[0]=*(const __attribute__((address_space(3))) bf16x8*)(kp);      kf[1]=*(const __attribute__((address_space(3))) bf16x8*)(kp+512);
  kf[2]=*(const __attribute__((address_space(3))) bf16x8*)(kp+2048); kf[3]=*(const __attribute__((address_space(3))) bf16x8*)(kp+2560);
  kf[4]=*(const __attribute__((address_space(3))) bf16x8*)(kp+4096); kf[5]=*(const __attribute__((address_space(3))) bf16x8*)(kp+4608);
  kf[6]=*(const __attribute__((address_space(3))) bf16x8*)(kp+6144); kf[7]=*(const __attribute__((address_space(3))) bf16x8*)(kp+6656);
}
__device__ __forceinline__ void kload2(bf16x8*kf,lds_cptr kp,int j){ kf[2*j]=*(const __attribute__((address_space(3))) bf16x8*)(kp+j*2048); kf[2*j+1]=*(const __attribute__((address_space(3))) bf16x8*)(kp+j*2048+512); }
__device__ __forceinline__ s16x4 vtr(lds_cptr p){ return __builtin_bit_cast(s16x4,__builtin_amdgcn_ds_read_tr16_b64_v4i16((__attribute__((address_space(3))) v4i16_t*)p)); }
__device__ __forceinline__ float rowmax(const f32x16&p0,const f32x16&p1){
  float a=max3f(p0[0],p0[1],p1[0]),b=max3f(p0[2],p0[3],p1[1]);a=max3f(a,p1[2],p1[3]);
  #pragma unroll
  for(int r=4;r<16;r+=4){a=max3f(a,p0[r],p0[r+1]);b=max3f(b,p0[r+2],p0[r+3]);a=max3f(a,p1[r],p1[r+1]);b=max3f(b,p1[r+2],p1[r+3]);}
  const float m=max2f(a,b);
  auto rr=__builtin_amdgcn_permlane32_swap(__float_as_uint(m),__float_as_uint(m),false,false);
  return max2f(__uint_as_float(rr[0]),__uint_as_float(rr[1]));
}
__device__ __forceinline__ void pv(f32x16*o,int vb,bf16x8 pa0,bf16x8 pa1,bf16x8 pa2,bf16x8 pa3){
  #pragma unroll
  for(int d0=0;d0<2;++d0){s16x4 lo[4],hi[4];
    #pragma unroll
    for(int ks=0;ks<4;++ks){
      asm volatile("ds_read_b64_tr_b16 %0,%1 offset:%c2":"=&v"(lo[ks]):"v"(vb),"i"(d0*4096+ks*1024):"memory");
      asm volatile("ds_read_b64_tr_b16 %0,%1 offset:%c2":"=&v"(hi[ks]):"v"(vb),"i"(d0*4096+ks*1024+512):"memory");}
    asm volatile("s_waitcnt lgkmcnt(0)":::"memory");SBAR();
    #define PK(k) (bf16x8){lo[k][0],lo[k][1],lo[k][2],lo[k][3],hi[k][0],hi[k][1],hi[k][2],hi[k][3]}
    o[d0]=__builtin_amdgcn_mfma_f32_32x32x16_bf16(pa0,PK(0),o[d0],0,0,0);
    o[d0]=__builtin_amdgcn_mfma_f32_32x32x16_bf16(pa1,PK(1),o[d0],0,0,0);
    o[d0]=__builtin_amdgcn_mfma_f32_32x32x16_bf16(pa2,PK(2),o[d0],0,0,0);
    o[d0]=__builtin_amdgcn_mfma_f32_32x32x16_bf16(pa3,PK(3),o[d0],0,0,0);
    #undef PK
  }
}

__device__ __forceinline__ void split3(float v,unsigned&a,unsigned&b,unsigned&c){ a=cvtpk_s(v,0.f)&0xffffu; const float r1=v-__uint_as_float(a<<16); b=cvtpk_s(r1,0.f)&0xffffu; const float r2=r1-__uint_as_float(b<<16); c=cvtpk_s(r2,0.f)&0xffffu; }
__device__ __forceinline__ bf16x8 make_qx(float m,int hi){ unsigned a,b,c; split3(m,a,b,c); u32x4 w={0x3F803F80u,0x3F80u|(a<<16),b|(c<<16),0u}; if(hi)w=(u32x4){0u,0u,0u,0u}; return __builtin_bit_cast(bf16x8,w); }
#ifndef ATTN_STORE16
#define ATTN_STORE16(p,v) (*(u32x4*)(p)=(v))
#endif
template<int THRL> __device__ __forceinline__ void attn_unit(int b,int h,int qb,const bf16*Q,const bf16*__restrict__ K,const bf16*__restrict__ V,bf16*O,const float*__restrict__ cum,char*shm,int wave){
  int tid=wave*64+lane_now(); asm volatile("":"+v"(tid));
  const int lane=tid&63,r32=lane&31,hi=lane>>5; const int wid=__builtin_amdgcn_readfirstlane(tid>>6);
  const long rowbase=(long)b*SEQ; const int q0=qb*QB;
  const bf16*Qw=Q+(rowbase+q0+wid*QBLK)*DM+h*D;
  const bf16*Kh=K+rowbase*DM+h*D,*Vh=V+rowbase*DM+h*D;
  const unsigned lds0=(unsigned)(uintptr_t)shm;
  float*wsf=(float*)(shm+LDS_WS)+wid*64;
  const bf16*ksrc=Kh+(long)lane*DM+wid*8;
  const bf16*vsrc=Vh+(long)(16*(wid&3)+(lane>>2))*DM+(wid>>2)*32+(lane&3)*8;
  const unsigned kdst=lds0+LDS_K+wid*1024, vdst=lds0+LDS_V+wid*1024;
  #define DMA_K(t,slot) glds16(ksrc+(long)(t)*KVBLK*DM,(unsigned)__builtin_amdgcn_readfirstlane(kdst+(slot)))
  #define DMA_V(t,slot) glds16(vsrc+(long)(t)*KVBLK*DM,(unsigned)__builtin_amdgcn_readfirstlane(vdst+(slot)))
  const int vb0=(int)(lds0+LDS_V)+((lane>>4)&1)*32+(lane&3)*8+(4*hi+((lane&15)>>2))*64;
  const char*Kbase=shm+LDS_K; bf16x8 kf[8];
  const lds_cptr shm3=(lds_cptr)shm; const lds_cptr kp0=shm3+LDS_K+hi*1024+r32*16; const lds_cptr vp0=shm3+LDS_V+((lane>>4)&1)*32+(lane&3)*8+(4*hi+((lane&15)>>2))*64;
  const int NT=(q0+QB)/KVBLK;
  const lds_cptr kbp=shm3+LDS_KB+r32*16;
  DMA_K(0,0);DMA_V(0,0);DMA_K(1,SLOTB);
  { const float cref=cum[q0+QB-1];
    for(int kv=tid;kv<q0+QB;kv+=NW*64){ unsigned a,bb,c; split3((cref-cum[kv])*1.4426950408889634f,a,bb,c);
      *(__attribute__((address_space(3))) u32x4*)((__attribute__((address_space(3))) char*)shm3+LDS_KB+kv*16)=(u32x4){a|(bb<<16),c|0xBF800000u,0xBF80BF80u,0u}; } }
  bf16x8 qr[4];
  #pragma unroll
  for(int d0=0;d0<4;++d0)qr[d0]=*reinterpret_cast<const bf16x8*>(&Qw[(long)r32*DM+d0*16+hi*8]);
  float mhat=0.f,l_reg=0.f;f32x16 o[2];o[0]=f32x16{};o[1]=f32x16{};bf16x8 qx=make_qx(0.f,hi);const f32x16 zc=f32x16{};
  const int qrel=wid*QBLK+r32;
  #define CMASK(P0,P1,t) do{int jb_=(t)-(NT-4); if(jb_>=0)cmask(P0,P1,jb_,qrel,hi);}while(0)
  bool resc=false;
  #define START(P0,P1) do{ const float rm=rowmax(P0,P1); resc=false; \
    { const float dl=rm; mhat=fadd_s(mhat,dl); \
      _Pragma("unroll") for(int r=0;r<16;++r){P0[r]=fsub_s(P0[r],dl);P1[r]=fsub_s(P1[r],dl);} \
      qx=make_qx(mhat,hi); } \
    _Pragma("unroll") for(int r=0;r<16;++r)P0[r]=__builtin_amdgcn_exp2f(P0[r]); }while(0)
  #define RESC() do{ if(resc){ asm volatile("s_waitcnt lgkmcnt(0)":::"memory"); \
      _Pragma("unroll") for(int d_=0;d_<2;++d_) _Pragma("unroll") for(int r=0;r<16;++r)o[d_][r]*=wsf[crow(r,hi)]; } }while(0)
  f32x16 pA0,pA1,pB0,pB1;
  int sl_prev=0,sl_cur=0,sl_next=SLOTB;
  #define ROT() do{sl_prev=sl_cur;sl_cur=sl_next;sl_next=(sl_next==(NSLOT-1)*SLOTB)?0:sl_next+SLOTB;}while(0)
  DMA_K(2,2*SLOTB);
  WAIT_BAR(3);
  qkt(pA0,pA1,Kbase,qr,qx,*(const __attribute__((address_space(3))) bf16x8*)(kbp),*(const __attribute__((address_space(3))) bf16x8*)(kbp+512),r32,hi);asm volatile("s_nop 15\n\ts_nop 7":"+v"(pA0),"+v"(pA1));CMASK(pA0,pA1,0);
  START(pA0,pA1);
  _Pragma("unroll") for(int r=0;r<16;++r)pA1[r]=__builtin_amdgcn_exp2f(pA1[r]);
  WAIT_BAR(0);
  DMA_K(3,0);DMA_V(1,SLOTB);
  ROT();
  kload8(kf,kp0+sl_cur);
  WAIT_BAR(2);
  s16x4 vlo[8],vhi[8]; u32x4 pw0,pw1,pw2,pw3;
  #define PKW(P,B) cvtpk_s(P[B],P[B+1])
  #define PAF(k) __builtin_bit_cast(bf16x8,pw##k)
  #define VFR(i) (bf16x8){vlo[i][0],vlo[i][1],vlo[i][2],vlo[i][3],vhi[i][0],vhi[i][1],vhi[i][2],vhi[i][3]}
  #define PIN(x) asm volatile("":"+v"(x))
  #define MX3(a,b,c) __builtin_fmaxf(__builtin_fmaxf((a),(b)),(c))
  #define GAPA(MF,A0,A1,A2,A3,W0,W1,PW) do{ MF; sacc+=A0; sacc+=A1; sacc+=A2; sacc+=A3; PIN(sacc); W0; W1; PIN(PW); SBAR(); }while(0)
  #define EX(v) __builtin_amdgcn_exp2f(v)
  #define GAPB(MF,X,B) do{ MF; X[B]=EX(X[B]); X[B+1]=EX(X[B+1]); X[B+2]=EX(X[B+2]); X[B+3]=EX(X[B+3]); PIN(X); SBAR(); }while(0)
  #define VRD(i) do{ vlo[i]=vtr(vp_+(((i)>>2)*4096+((i)&3)*1024)); vhi[i]=vtr(vp_+(((i)>>2)*4096+((i)&3)*1024+512)); }while(0)
  #define KRD(G,j) do{ if(G){ kload2(kf,kp0+sl_next,j); SBAR(); } }while(0)
  #define STEP(C0,C1,P0,P1,t,GK,GV,GL) do{ SBAR(); \
    const lds_cptr vp_=vp0+sl_prev; \
    const bf16x8 kb0_=*(const __attribute__((address_space(3))) bf16x8*)(kbp+(t)*1024), kb1_=*(const __attribute__((address_space(3))) bf16x8*)(kbp+(t)*1024+512); \
    VRD(0); SBAR(); float sacc=(P0[0]+P0[1]); \
    GAPA(C0=__builtin_amdgcn_mfma_f32_32x32x16_bf16(kf[0],qr[0],zc,0,0,0), P0[2],P0[3],P0[4],P0[5],     pw0[0]=PKW(P0,0), pw0[1]=PKW(P0,2), pw0); \
    VRD(4); SBAR(); GAPA(C1=__builtin_amdgcn_mfma_f32_32x32x16_bf16(kf[1],qr[0],zc,0,0,0), P0[6],P0[7],P0[8],P0[9],     pw0[2]=PKW(P0,4), pw0[3]=PKW(P0,6), pw0); \
    VRD(1); SBAR(); GAPA(C0=__builtin_amdgcn_mfma_f32_32x32x16_bf16(kf[2],qr[1],C0,0,0,0),   P0[10],P0[11],P0[12],P0[13], pw1[0]=PKW(P0,8), pw1[1]=PKW(P0,10), pw1); \
    VRD(5); SBAR(); GAPA(C1=__builtin_amdgcn_mfma_f32_32x32x16_bf16(kf[3],qr[1],C1,0,0,0),   P0[14],P0[15],P1[0],P1[1],   pw1[2]=PKW(P0,12),pw1[3]=PKW(P0,14), pw1); \
    VRD(2); SBAR(); GAPA(C0=__builtin_amdgcn_mfma_f32_32x32x16_bf16(kf[4],qr[2],C0,0,0,0),   P1[2],P1[3],P1[4],P1[5],     pw2[0]=PKW(P1,0), pw2[1]=PKW(P1,2), pw2); \
    VRD(6); SBAR(); GAPA(C1=__builtin_amdgcn_mfma_f32_32x32x16_bf16(kf[5],qr[2],C1,0,0,0),   P1[6],P1[7],P1[8],P1[9],     pw2[2]=PKW(P1,4), pw2[3]=PKW(P1,6), pw2); \
    VRD(3); SBAR(); GAPA(C0=__builtin_amdgcn_mfma_f32_32x32x16_bf16(kf[6],qr[3],C0,0,0,0),   P1[10],P1[11],P1[12],P1[13], pw3[0]=PKW(P1,8), pw3[1]=PKW(P1,10), pw3); \
    VRD(7); SBAR(); GAPA(C1=__builtin_amdgcn_mfma_f32_32x32x16_bf16(kf[7],qr[3],C1,0,0,0),   P1[14],P1[15],0.f,0.f,       pw3[2]=PKW(P1,12),pw3[3]=PKW(P1,14), pw3); \
    C0=__builtin_amdgcn_mfma_f32_32x32x16_bf16(kb0_,qx,C0,0,0,0); C1=__builtin_amdgcn_mfma_f32_32x32x16_bf16(kb1_,qx,C1,0,0,0); SBAR(); \
    l_reg+=sacc; \
    if(GK){DMA_K((t)+3,sl_cur);} if(GV){DMA_V((t)+1,sl_next);} \
    CMASK(C0,C1,t); \
    { float a=MX3(C0[0],C0[1],C1[0]),b=MX3(C0[2],C0[3],C1[1]); a=MX3(a,C1[2],C1[3]); \
      _Pragma("unroll") for(int r=4;r<16;r+=4){a=MX3(a,C0[r],C0[r+1]);b=MX3(b,C0[r+2],C0[r+3]);a=MX3(a,C1[r],C1[r+1]);b=MX3(b,C1[r+2],C1[r+3]);} \
      float rm=__builtin_fmaxf(a,b); { auto rr=__builtin_amdgcn_permlane32_swap(__float_as_uint(rm),__float_as_uint(rm),false,false); rm=__builtin_fmaxf(__uint_as_float(rr[0]),__uint_as_float(rr[1])); } \
      resc=false; \
      if(__builtin_expect(__any(rm>(float)THRL),0)){ const float dl=__builtin_fmaxf(rm,0.f); mhat+=dl; \
        _Pragma("unroll") for(int r=0;r<16;++r){C0[r]-=dl;C1[r]-=dl;} \
        qx=make_qx(mhat,hi); \
        const float f=__builtin_amdgcn_exp2f(-dl); l_reg*=f; if(hi==0)wsf[r32]=f; resc=true; } } \
    SBAR(); \
    GAPB(o[0]=__builtin_amdgcn_mfma_f32_32x32x16_bf16(PAF(0),VFR(0),o[0],0,0,0), C0,0); \
    GAPB(o[1]=__builtin_amdgcn_mfma_f32_32x32x16_bf16(PAF(0),VFR(4),o[1],0,0,0), C0,4); \
    KRD(GL,0); GAPB(o[0]=__builtin_amdgcn_mfma_f32_32x32x16_bf16(PAF(1),VFR(1),o[0],0,0,0), C0,8); \
    KRD(GL,1); GAPB(o[1]=__builtin_amdgcn_mfma_f32_32x32x16_bf16(PAF(1),VFR(5),o[1],0,0,0), C0,12); \
    KRD(GL,2); GAPB(o[0]=__builtin_amdgcn_mfma_f32_32x32x16_bf16(PAF(2),VFR(2),o[0],0,0,0), C1,0); \
    KRD(GL,3); GAPB(o[1]=__builtin_amdgcn_mfma_f32_32x32x16_bf16(PAF(2),VFR(6),o[1],0,0,0), C1,4); \
    GAPB(o[0]=__builtin_amdgcn_mfma_f32_32x32x16_bf16(PAF(3),VFR(3),o[0],0,0,0), C1,8); \
    GAPB(o[1]=__builtin_amdgcn_mfma_f32_32x32x16_bf16(PAF(3),VFR(7),o[1],0,0,0), C1,12); \
    }while(0)
  int t=1;
  #undef CMASK
  #define CMASK(P0,P1,t) do{}while(0)
  for(;t+5<NT;t+=2){
    STEP(pB0,pB1,pA0,pA1,t,true,true,true);     WAIT_BAR(2); RESC(); ROT();
    STEP(pA0,pA1,pB0,pB1,t+1,true,true,true);   WAIT_BAR(2); RESC(); ROT();
  }
  #undef CMASK
  #define CMASK(P0,P1,t) do{int jb_=(t)-(NT-4); if(jb_>=0)cmask(P0,P1,jb_,qrel,hi);}while(0)
  #define ENDW(tt) do{ if((tt)+3<NT){WAIT_BAR(2);} else if((tt)+2<NT){WAIT_BAR(1);} else {WAIT_BAR(0);} }while(0)
  for(;t+1<NT;t+=2){
    STEP(pB0,pB1,pA0,pA1,t,(t+3<NT),(t+1<NT),(t+1<NT));       ENDW(t);   RESC(); ROT();
    STEP(pA0,pA1,pB0,pB1,t+1,(t+4<NT),(t+2<NT),(t+2<NT));     ENDW(t+1); RESC(); ROT();
  }
  STEP(pB0,pB1,pA0,pA1,NT-1,false,false,false); RESC();
  { float sacc=pB0[0]+pB0[1]; _Pragma("unroll") for(int r=2;r<16;++r)sacc+=pB0[r]; _Pragma("unroll") for(int r=0;r<16;++r)sacc+=pB1[r]; l_reg+=sacc;
    pw0=(u32x4){PKW(pB0,0),PKW(pB0,2),PKW(pB0,4),PKW(pB0,6)};pw1=(u32x4){PKW(pB0,8),PKW(pB0,10),PKW(pB0,12),PKW(pB0,14)};pw2=(u32x4){PKW(pB1,0),PKW(pB1,2),PKW(pB1,4),PKW(pB1,6)};pw3=(u32x4){PKW(pB1,8),PKW(pB1,10),PKW(pB1,12),PKW(pB1,14)};
    SBAR(); pv(o,vb0+sl_cur,PAF(0),PAF(1),PAF(2),PAF(3)); }
  #undef PKW
  #undef PAF
  #undef VFR
  #undef PIN
  #undef MX3
  #undef GAPA
  #undef GAPB
  #undef EX
  #undef VRD
  #undef KRD
  #undef STEP
  #undef ENDW
  {auto rr=__builtin_amdgcn_permlane32_swap(__float_as_uint(l_reg),__float_as_uint(l_reg),false,false);l_reg=__uint_as_float(rr[0])+__uint_as_float(rr[1]);}
  if(hi==0)wsf[32+r32]=l_reg;asm volatile("s_waitcnt lgkmcnt(0)":::"memory");
  float rli[16];
  #pragma unroll
  for(int r=0;r<16;++r)rli[r]=__builtin_amdgcn_rcpf(wsf[32+crow(r,hi)]);
  bf16*Ow=O+(rowbase+q0+wid*QBLK)*OPITCH+h*D;
  { bf16*stg=(bf16*)(shm+LDS_OST)+wid*2048;
    #pragma unroll
    for(int r=0;r<16;++r){const int orow=crow(r,hi);
      #pragma unroll
      for(int d0=0;d0<2;++d0)stg[orow*64+d0*32+r32]=__float2bfloat16(o[d0][r]*rli[r]);}
    asm volatile("s_waitcnt lgkmcnt(0)":::"memory");
    #pragma unroll
    for(int i=0;i<4;++i){const int row=i*8+(lane>>3),ch=lane&7; const u32x4 v=*(const u32x4*)(stg+row*64+ch*8); ATTN_STORE16(Ow+(long)row*OPITCH+ch*8,v);} }
  asm volatile("s_waitcnt lgkmcnt(0)\n\ts_barrier":::"memory");
  #undef DMA_K
  #undef DMA_V
  #undef CMASK
  #undef START
  #undef RESC
  #undef ROT
}
constexpr int ATTN_LDS_BYTES=LDS_BYTES;
#undef SBAR
#undef WAIT_BAR
}

namespace ret_body {
constexpr int VT_P = 272, KT_P = 272, ST_P = 144, PW_P = 272;
constexpr int KC_P = 144;
constexpr int L_VT = 0, L_KT = L_VT + 128 * VT_P, L_ST = L_KT + 64 * KT_P, L_PW = L_ST + 128 * ST_P, PW_BYTES = 16 * PW_P, L_KC = L_PW + 8 * PW_BYTES, LDS_BYTES = L_KC + 128 * KC_P;
typedef short bf16x8 __attribute__((ext_vector_type(8)));
typedef float f32x4 __attribute__((ext_vector_type(4)));
#define dpp_f(v, ctrl) __int_as_float(__builtin_amdgcn_update_dpp(0, __float_as_int(v), (ctrl), 0xF, 0xF, false))
#define RB_MFMA(a, b, c) __builtin_amdgcn_mfma_f32_16x16x32_bf16(__builtin_bit_cast(bf16x8, a), __builtin_bit_cast(bf16x8, b), c, 0, 0, 0)
__device__ __forceinline__ void ret_unit(LAS unsigned char* L, int b, int h, const bf16* RQ, const bf16* RK, const bf16* RVT, const bf16* RKT, const bf16* RGS, bf16* BR, int wave, int c0 = 0, int c1 = SEQ / 128, int pf0 = 0) {
    int tid = wave * 64 + lane_now(); asm volatile("" : "+v"(tid));
    const int lane = tid & 63, w = __builtin_amdgcn_readfirstlane(tid >> 6), r = lane & 15, q = lane >> 4;
    const float lg2 = log1pf(-exp2f(-5.f - (float)h)) * LOG2E;
    const float cd = __builtin_amdgcn_exp2f(128.f * lg2);
    unsigned z0 = 0u; asm volatile("" : "+v"(z0));
    f32x4 S[4];
#pragma unroll
    for (int i = 0; i < 4; ++i) { const float zf = __uint_as_float(z0); S[i] = (f32x4){zf, zf, zf, zf}; }
    for (int i = tid * 16; i < 128 * ST_P; i += NWAVES * 64 * 16) *(LAS v4u*)(L + L_ST + i) = (v4u){z0, z0, z0, z0};
    LAS unsigned char* Pw = L + L_PW + w * PW_BYTES;
    v4u pv[4], pkt[2], pkc[2], pq[2];
    const int t16 = tid & 15, trow = tid >> 4;
#define RB_LOAD(cc) do { const size_t r0_ = (size_t)b * SEQ + (size_t)(cc) * 128; const size_t it_ = (size_t)((b * 4 + h) * 16 + (cc)); \
        _Pragma("unroll") for (int j = 0; j < 4; ++j) pv[j] = *(const v4u*)(RVT + it_ * 16384 + (size_t)(32 * j + trow) * 128 + 8 * t16); \
        _Pragma("unroll") for (int j = 0; j < 2; ++j) pkt[j] = *(const v4u*)(RKT + it_ * 8192 + (size_t)(32 * j + trow) * 128 + 8 * t16); \
        _Pragma("unroll") for (int j = 0; j < 2; ++j) pkc[j] = *(const v4u*)(RK + (r0_ + 64 * j + (tid >> 3)) * 256 + h * 64 + 8 * (tid & 7)); \
        _Pragma("unroll") for (int ks = 0; ks < 2; ++ks) pq[ks] = *(const v4u*)(RQ + (r0_ + 16 * w + r) * 256 + h * 64 + 32 * ks + 8 * q); } while (0)
    RB_LOAD(0);
    for (int c = 0; c < c1; ++c) {
        const int pf = pf0 | ((c < c0) ? 3 : 0);
        const size_t row0 = (size_t)b * SEQ + (size_t)c * 128;
        float lg2c = lg2; asm volatile("" : "+v"(lg2c));
        if (!(pf & 8)) {
#pragma unroll
        for (int j = 0; j < 4; ++j) *(LAS v4u*)(L + L_VT + (32 * j + trow) * VT_P + 16 * t16) = pv[j];
#pragma unroll
        for (int j = 0; j < 2; ++j) *(LAS v4u*)(L + L_KT + (32 * j + trow) * KT_P + 16 * t16) = pkt[j];
        if (!(pf & 2)) {
#pragma unroll
        for (int j = 0; j < 2; ++j) *(LAS v4u*)(L + L_KC + (64 * j + (tid >> 3)) * KC_P + 16 * (tid & 7)) = pkc[j];
        }
        }
        v4u qf[2]; qf[0] = pq[0]; qf[1] = pq[1];
        __syncthreads();
        const float fdec = __builtin_amdgcn_exp2f((float)(16 * w + 4 * q - r) * lg2c);
        const float g1 = __builtin_amdgcn_exp2f(lg2c), g2 = g1 * g1, g3 = g2 * g1; float gm16[8];
        { const float gi = __builtin_amdgcn_exp2f(-16.f * lg2c); gm16[0] = 1.f;
#pragma unroll
          for (int j = 1; j < 8; ++j) gm16[j] = gm16[j - 1] * gi; }
        if (!(pf & 2)) {
#pragma unroll
        for (int jh = 0; jh < 2; ++jh) {
        v4u kk0[4], kk1[4];
#pragma unroll
        for (int jj = 0; jj < 4; ++jj) { const int jb = 4 * jh + jj; if (jb <= w) { kk0[jj] = *(const LAS v4u*)(L + L_KC + (16 * jb + r) * KC_P + 16 * q); kk1[jj] = *(const LAS v4u*)(L + L_KC + (16 * jb + r) * KC_P + 64 + 16 * q); } }
        __builtin_amdgcn_sched_barrier(0);
#pragma unroll
        for (int jj = 0; jj < 4; ++jj) { const int jb = 4 * jh + jj;
            if (jb <= w) {
                const v4u k0 = kk0[jj], k1 = kk1[jj];
                f32x4 acc = (f32x4){0.f, 0.f, 0.f, 0.f};
                acc = RB_MFMA(qf[0], k0, acc); acc = RB_MFMA(qf[1], k1, acc);
                const float f0 = fdec * gm16[jb];
                acc[0] *= f0; acc[1] *= f0 * g1; acc[2] *= f0 * g2; acc[3] *= f0 * g3;
                if (jb == w) {
#pragma unroll
                    for (int e = 0; e < 4; ++e) acc[e] = (4 * q - r + e >= 0) ? acc[e] : 0.f; }
                const unsigned p01 = cvt_pk_bf16(acc[0], acc[1]), p23 = cvt_pk_bf16(acc[2], acc[3]);
                LAS unsigned char* pp = Pw + (4 * q) * PW_P + (16 * jb + r) * 2;
                *(LAS unsigned short*)(pp) = (unsigned short)p01; *(LAS unsigned short*)(pp + PW_P) = (unsigned short)(p01 >> 16);
                *(LAS unsigned short*)(pp + 2 * PW_P) = (unsigned short)p23; *(LAS unsigned short*)(pp + 3 * PW_P) = (unsigned short)(p23 >> 16);
            } else if (jb == w + 1 && (w & 1) == 0) {
                LAS unsigned char* pp = Pw + (4 * q) * PW_P + (16 * jb + r) * 2;
                *(LAS unsigned short*)(pp) = 0; *(LAS unsigned short*)(pp + PW_P) = 0; *(LAS unsigned short*)(pp + 2 * PW_P) = 0; *(LAS unsigned short*)(pp + 3 * PW_P) = 0;
            }
        }
        __builtin_amdgcn_sched_barrier(0); }
        }
        LDS_WAIT(); asm volatile("" ::: "memory");
        if (c + 1 < c1) RB_LOAD(c + 1);
        if (!(pf & 2)) {
        v4u pg[4];
        { const size_t grow_ = row0 + 16 * w + (lane >> 4);
#pragma unroll
          for (int i = 0; i < 4; ++i) pg[i] = *(const v4u*)(RGS + (grow_ + 4 * i) * 512 + h * 128 + 8 * (lane & 15)); }
        f32x4 oi[8];
#pragma unroll
        for (int d = 0; d < 8; ++d) oi[d] = (f32x4){0.f, 0.f, 0.f, 0.f};
#pragma unroll
        for (int ks = 0; ks < 4; ++ks) {
            if (2 * ks <= w && !(pf & 2)) { const v4u pa = *(const LAS v4u*)(Pw + r * PW_P + (32 * ks + 8 * q) * 2); v4u vb[8];
#pragma unroll
                for (int d = 0; d < 8; ++d) vb[d] = *(const LAS v4u*)(L + L_VT + (16 * d + r) * VT_P + (32 * ks + 8 * q) * 2);
                __builtin_amdgcn_sched_barrier(0);
#pragma unroll
                for (int d = 0; d < 8; ++d) oi[d] = RB_MFMA(pa, vb[d], oi[d]);
                __builtin_amdgcn_sched_barrier(0); }
        }
        { const float rfq = __builtin_amdgcn_exp2f((float)(16 * w + r + 1) * lg2);
#pragma unroll
          for (int ks = 0; ks < 2; ++ks) { v4u sb[8], qs;
#pragma unroll
            for (int wd = 0; wd < 4; ++wd) qs[wd] = cvt_pk_bf16(bflo(qf[ks][wd]) * rfq, bfhi(qf[ks][wd]) * rfq);
#pragma unroll
            for (int d = 0; d < 8; ++d) sb[d] = *(const LAS v4u*)(L + L_ST + (16 * d + r) * ST_P + (32 * ks + 8 * q) * 2);
            __builtin_amdgcn_sched_barrier(0);
#pragma unroll
            for (int d = 0; d < 8; ++d) oi[d] = RB_MFMA(qs, sb[d], oi[d]);
            __builtin_amdgcn_sched_barrier(0); } }
        float ss[4];
#pragma unroll
        for (int e = 0; e < 4; ++e) ss[e] = 0.f;
#pragma unroll
        for (int d = 0; d < 8; ++d)
#pragma unroll
            for (int e = 0; e < 4; ++e) ss[e] += oi[d][e] * oi[d][e];
#pragma unroll
        for (int e = 0; e < 4; ++e) { float s = ss[e]; s += dpp_f(s, 0xB1); s += dpp_f(s, 0x4E); s += dpp_f(s, 0x141); s += dpp_f(s, 0x140); ss[e] = 1.f / sqrtf(s * (1.f / 128.f) + EPS); }
#pragma unroll
        for (int d = 0; d < 8; ++d) { const unsigned p01 = cvt_pk_bf16(oi[d][0] * ss[0], oi[d][1] * ss[1]), p23 = cvt_pk_bf16(oi[d][2] * ss[2], oi[d][3] * ss[3]);
            LAS unsigned char* pp = Pw + (4 * q) * PW_P + (16 * d + r) * 2;
            *(LAS unsigned short*)(pp) = (unsigned short)p01; *(LAS unsigned short*)(pp + PW_P) = (unsigned short)(p01 >> 16);
            *(LAS unsigned short*)(pp + 2 * PW_P) = (unsigned short)p23; *(LAS unsigned short*)(pp + 3 * PW_P) = (unsigned short)(p23 >> 16); }
        LDS_WAIT(); asm volatile("" ::: "memory");
        { const int orow = lane >> 4, oc = lane & 15; const size_t grow = row0 + 16 * w + orow;
#pragma unroll
          for (int i = 0; i < 4; ++i) { const v4u ov = *(const LAS v4u*)(Pw + (orow + 4 * i) * PW_P + 16 * oc); const v4u gv = pg[i];
              v4u o;
#pragma unroll
              for (int wd = 0; wd < 4; ++wd) o[wd] = cvt_pk_bf16(bflo(ov[wd]) * bflo(gv[wd]), bfhi(ov[wd]) * bfhi(gv[wd]));
              if (!(pf & 1)) *(v4u*)(BR + (grow + 4 * i) * 1024 + 512 + h * 128 + 8 * oc) = o; } }
        }
        if (!(pf & 2)) __syncthreads();
#pragma unroll
        for (int i = 0; i < 4; ++i) S[i] = S[i] * cd;
        if (!(pf & 4))
#pragma unroll
        for (int ks = 0; ks < 4; ++ks) { const v4u vb = *(const LAS v4u*)(L + L_VT + (16 * w + r) * VT_P + (32 * ks + 8 * q) * 2); v4u ka[4];
#pragma unroll
            for (int i = 0; i < 4; ++i) ka[i] = *(const LAS v4u*)(L + L_KT + (16 * i + r) * KT_P + (32 * ks + 8 * q) * 2);
            __builtin_amdgcn_sched_barrier(0);
#pragma unroll
            for (int i = 0; i < 4; ++i) S[i] = RB_MFMA(ka[i], vb, S[i]);
            __builtin_amdgcn_sched_barrier(0); }
#pragma unroll
        for (int i = 0; i < 4; ++i) { v2u sv; sv.x = cvt_pk_bf16(S[i][0], S[i][1]); sv.y = cvt_pk_bf16(S[i][2], S[i][3]); *(LAS v2u*)(L + L_ST + (16 * w + r) * ST_P + (16 * i + 4 * q) * 2) = sv; }
        __syncthreads();
    }
}
#undef RB_MFMA
#undef dpp_f
#undef RB_LOAD
}

struct TrItem { const float* src; bf16* dst; int ldw, K, base, mul, gu, f8; };
__device__ __forceinline__ int tr_row(const TrItem& t, int n) { if (t.gu) { const int a = t.base + (n >> 1), b = n & 1; return 256 * (a >> 7) + 128 * b + (a & 127); } return t.base + t.mul * n; }
__device__ __forceinline__ void tr_load(const TrItem& t, f32x4 (&v)[8], int lane) {
    const float* p = t.src + (size_t)(lane >> 3) * t.ldw + 4 * (lane & 7);
#pragma unroll
    for (int i = 0; i < 8; ++i) v[i] = *(const GAS f32x4*)(p + (size_t)(8 * i) * t.ldw);
}
__device__ __forceinline__ void tr_store(const TrItem& t, const f32x4 (&v)[8], LAS float* scr, int lane) {
    { LAS float* w = scr + (lane >> 3) * 33 + 4 * (lane & 7);
#pragma unroll
      for (int i = 0; i < 8; ++i) { w[(8 * i) * 33 + 0] = v[i][0]; w[(8 * i) * 33 + 1] = v[i][1]; w[(8 * i) * 33 + 2] = v[i][2]; w[(8 * i) * 33 + 3] = v[i][3]; } }
    LDS_WAIT(); asm volatile("" ::: "memory");
    const int c = lane & 7;
#pragma unroll
    for (int j = 0; j < 4; ++j) { const int n = (lane >> 3) + 8 * j; const LAS float* s = scr + (8 * c) * 33 + n;
        if (t.f8) { const f32x4 a = {s[0 * 33] * WSCALE, s[1 * 33] * WSCALE, s[2 * 33] * WSCALE, s[3 * 33] * WSCALE}, b = {s[4 * 33] * WSCALE, s[5 * 33] * WSCALE, s[6 * 33] * WSCALE, s[7 * 33] * WSCALE};
            *(GAS v2u*)((unsigned char*)t.dst + (size_t)tr_row(t, n) * t.K + 8 * c) = pack8_fp8(a, b); }
        else { v4u o; o.x = cvt_pk_bf16(s[0 * 33], s[1 * 33]); o.y = cvt_pk_bf16(s[2 * 33], s[3 * 33]); o.z = cvt_pk_bf16(s[4 * 33], s[5 * 33]); o.w = cvt_pk_bf16(s[6 * 33], s[7 * 33]);
            *(GAS v4u*)(t.dst + (size_t)tr_row(t, n) * t.K + 8 * c) = o; } }
    LDS_WAIT(); asm volatile("" ::: "memory");
}
__device__ __forceinline__ void tr_store2(const TrItem& t0, const f32x4 (&v0)[8], const TrItem& t1, const f32x4 (&v1)[8], LAS float* s0, LAS float* s1, int lane) {
    { LAS float* w0 = s0 + (lane >> 3) * 33 + 4 * (lane & 7); LAS float* w1 = s1 + (lane >> 3) * 33 + 4 * (lane & 7);
#pragma unroll
      for (int i = 0; i < 8; ++i) { w0[(8 * i) * 33 + 0] = v0[i][0]; w0[(8 * i) * 33 + 1] = v0[i][1]; w0[(8 * i) * 33 + 2] = v0[i][2]; w0[(8 * i) * 33 + 3] = v0[i][3];
                                    w1[(8 * i) * 33 + 0] = v1[i][0]; w1[(8 * i) * 33 + 1] = v1[i][1]; w1[(8 * i) * 33 + 2] = v1[i][2]; w1[(8 * i) * 33 + 3] = v1[i][3]; } }
    LDS_WAIT(); asm volatile("" ::: "memory");
    const int c = lane & 7;
#pragma unroll
    for (int u = 0; u < 2; ++u) { const TrItem& t = u ? t1 : t0; const LAS float* sb = u ? s1 : s0;
#pragma unroll
        for (int j = 0; j < 4; ++j) { const int n = (lane >> 3) + 8 * j; const LAS float* s = sb + (8 * c) * 33 + n;
            if (t.f8 == 1) { const f32x4 a = {s[0 * 33] * WSCALE, s[1 * 33] * WSCALE, s[2 * 33] * WSCALE, s[3 * 33] * WSCALE}, b = {s[4 * 33] * WSCALE, s[5 * 33] * WSCALE, s[6 * 33] * WSCALE, s[7 * 33] * WSCALE};
                *(GAS v2u*)((unsigned char*)t.dst + (size_t)tr_row(t, n) * t.K + 8 * c) = pack8_fp8(a, b); }
            else { v4u o; o.x = cvt_pk_bf16(s[0 * 33], s[1 * 33]); o.y = cvt_pk_bf16(s[2 * 33], s[3 * 33]); o.z = cvt_pk_bf16(s[4 * 33], s[5 * 33]); o.w = cvt_pk_bf16(s[6 * 33], s[7 * 33]);
                *(GAS v4u*)(t.dst + (size_t)tr_row(t, n) * t.K + 8 * c) = o; } } }
    LDS_WAIT(); asm volatile("" ::: "memory");
}
constexpr int TR_IN = 96 * 16, TR_MG = 64 * 16, TR_BR = 2 * 32 * 8, TR_O = 32 * 16, TR_PG = 32 * 16, TR_PP = 32 * 4, TR_GU = 32 * 64 * 16, TR_DN = 32 * 32 * 16;
constexpr int TR_ITEMS = TR_IN + TR_MG + TR_BR + TR_O + TR_PG + TR_PP + TR_GU + TR_DN;
__device__ __forceinline__ TrItem tr_decode(Frame& F, int it) {
    TrItem t; t.mul = 1; t.gu = 0; t.f8 = 0; int r = it;
    if (r < TR_GU) { const int e = r >> 10, rr = r & 1023, kb = rr >> 6, blk = rr & 63;
        t.src = (F.ap->in[12]) + (size_t)e * 1024 * 2048 + (size_t)(64 * kb) * 2048 + 32 * blk; t.ldw = 2048; t.dst = (bf16*)(WSP(unsigned char, WS_WGUT) + (size_t)e * 2048 * 1024 + 64 * kb); t.K = 1024; t.base = 16 * blk; t.gu = 1; t.f8 = 1; return t; } r -= TR_GU;
    if (r < TR_DN) { const int e = r >> 9, rr = r & 511, kb = rr >> 5, blk = rr & 31;
        t.src = (F.ap->in[14]) + (size_t)e * 1024 * 1024 + (size_t)(64 * kb) * 1024 + 32 * blk; t.ldw = 1024; t.dst = (bf16*)(WSP(unsigned char, WS_WDT) + (size_t)e * 1024 * 1024 + 64 * kb); t.K = 1024; t.base = 32 * blk; t.f8 = 1; return t; } r -= TR_DN;
    if (r < TR_IN) { const int kb = r / 96, blk = r % 96; int s0;
        if (blk < 32) { s0 = 32 * blk; t.base = 32 * blk; t.f8 = 1; }
        else if (blk < 48) { s0 = 32 * blk; t.base = 32 * (blk - 32); }
        else if (blk < 64) { s0 = 2056 + 32 * (blk - 48); t.base = 1024 + 32 * (blk - 48); }
        else if (blk < 80) { s0 = 2568 + 32 * (blk - 64); t.base = 1536 + 32 * (blk - 64); }
        else { const int hb = (blk - 80) & 7, head = hb >> 1, half = hb & 1, isk = (blk >= 88); s0 = (isk ? 1800 : 1544) + head * 64 + half * 32; t.base = (isk ? 768 : 512) + head * 64 + half; t.mul = 2; }
        t.src = (F.ap->in[3]) + (size_t)(64 * kb) * INW + s0; t.ldw = INW; t.dst = t.f8 ? (bf16*)(WSP(unsigned char, WS_WG8T) + 64 * kb) : WSP(bf16, WS_W1T) + 64 * kb; t.K = 1024; return t; } r -= TR_IN;
    if (r < TR_MG) { const int kb = r >> 6, blk = r & 63; t.src = (F.ap->in[6]) + (size_t)(64 * kb) * 2048 + 32 * blk; t.ldw = 2048; t.dst = (bf16*)(WSP(unsigned char, WS_WG8T) + 64 * kb); t.K = 1024; t.base = 1024 + 32 * blk; t.f8 = 1; return t; } r -= TR_MG;
    if (r < TR_BR) { const int gsel = r >> 8, rr = r & 255, kb = rr >> 5, blk = rr & 31;
        t.src = (F.ap->in[5]) + (size_t)gsel * 512 * 1024 + (size_t)(64 * kb) * 1024 + 32 * blk; t.ldw = 1024; t.dst = WSP(bf16, WS_WBT) + gsel * 512 + 64 * kb; t.K = 1024; t.base = 32 * blk; return t; } r -= TR_BR;
    if (r < TR_O) { const int kb = r >> 5, blk = r & 31; t.src = (F.ap->in[8]) + (size_t)(64 * kb) * 1024 + 32 * blk; t.ldw = 1024; t.dst = WSP(bf16, WS_WOT) + 64 * kb; t.K = 1024; t.base = 32 * blk; return t; } r -= TR_O;
    if (r < TR_PG) { const int kb = r >> 5, blk = r & 31; t.src = (F.ap->in[17]) + (size_t)(64 * kb) * 1024 + 32 * blk; t.ldw = 1024; t.dst = (bf16*)(WSP(unsigned char, WS_WPGT) + 64 * kb); t.K = 1024; t.base = 32 * blk; t.f8 = 1; return t; } r -= TR_PG;
    { const int kb = r >> 5, blk = r & 31; t.src = (F.ap->in[18]) + (size_t)(64 * kb) * 1024 + 32 * blk; t.ldw = 1024; t.dst = WSP(bf16, WS_WPPT) + 64 * kb; t.K = 256; t.base = 32 * blk; return t; }
}

__device__ __forceinline__ void p0_row(Frame& F, int m, f32x4 (&v)[4], LAS const float* WFt, int lane) {
    float s = 0.f;
#pragma unroll
    for (int j = 0; j < 4; ++j) s += (v[j].x * v[j].x + v[j].y * v[j].y) + (v[j].z * v[j].z + v[j].w * v[j].w);
    const float rstd = 1.f / sqrtf(wave_sum(s) * (1.f / DM) + EPS);
    GAS unsigned long long* o8 = (GAS unsigned long long*)(WSP(bf16, WS_XN) + (size_t)m * DM) + lane;
    GAS int* q8 = (GAS int*)(WSP(unsigned char, WS_XN8) + (size_t)m * DM) + lane;
#pragma unroll
    for (int j = 0; j < 4; ++j) { const f32x4 g = ((const GAS f32x4*)(F.ap->in[2]))[lane + 64 * j]; v[j] = v[j] * rstd * g;
        o8[64 * j] = (unsigned long long)cvt_pk_bf16(v[j].x, v[j].y) | ((unsigned long long)cvt_pk_bf16(v[j].z, v[j].w) << 32);
        { int w = 0; w = __builtin_amdgcn_cvt_pk_fp8_f32(clamp_f8(v[j].x), clamp_f8(v[j].y), w, false); w = __builtin_amdgcn_cvt_pk_fp8_f32(clamp_f8(v[j].z), clamp_f8(v[j].w), w, true); q8[64 * j] = w; } }
    float fa[8];
#pragma unroll
    for (int c = 0; c < 8; ++c) { float a = 0.f;
#pragma unroll
        for (int j = 0; j < 4; ++j) { const f32x4 w = *(const LAS f32x4*)(WFt + c * 1024 + 256 * j + 4 * lane); a += (v[j].x * w.x + v[j].y * w.y) + (v[j].z * w.z + v[j].w * w.w); }
        fa[c] = wave_sum(a); }
    float z = fa[0];
#pragma unroll
    for (int c = 1; c < 8; ++c) z = (lane == c) ? fa[c] : z;
    if (lane < 8) { z += (F.ap->in[4])[lane]; WSP(float, WS_LOGF)[(size_t)m * 8 + lane] = fminf(z, 0.f) - log1pf(expf(-fabsf(z))); }
}
__device__ __forceinline__ void p0_prologue(Frame& F) {
    LAS float* WFt = (LAS float*)(F.lds + RING_OFF);
    for (int idx = F.tid; idx < 8192; idx += NWAVES * 64) { const int k = idx >> 3, c = idx & 7; WFt[c * 1024 + k] = (F.ap->in[3])[(size_t)k * INW + 1536 + c]; }
    __syncthreads();
    const int gw = F.vcu * NWAVES + F.wave, NGW = F.G * NWAVES, lane = F.lane;
#ifndef P0_REP_ROWS
#define P0_REP_ROWS 1
#endif
#ifndef P0_REP_TR
#define P0_REP_TR 1
#endif
#ifndef P0_REP_ROWS
#define P0_REP_ROWS 1
#endif
#ifndef P0_REP_TR
#define P0_REP_TR 1
#endif
    for (int rep_ = 0; rep_ < P0_REP_ROWS; ++rep_)
    { f32x4 va[4], vb[4]; int m = gw;
      if (m < NT) {
#pragma unroll
          for (int j = 0; j < 4; ++j) va[j] = ((const GAS f32x4*)((F.ap->in[0]) + (size_t)m * DM))[lane + 64 * j]; }
      for (; m < NT; m += NGW) { const int m2 = m + NGW;
          if (m2 < NT) {
#pragma unroll
              for (int j = 0; j < 4; ++j) vb[j] = ((const GAS f32x4*)((F.ap->in[0]) + (size_t)m2 * DM))[lane + 64 * j]; }
          __builtin_amdgcn_sched_barrier(0);
          p0_row(F, m, va, WFt, lane);
          __builtin_amdgcn_sched_barrier(0);
#pragma unroll
          for (int j = 0; j < 4; ++j) va[j] = vb[j];
      } }
    __syncthreads();
    for (int rep_ = 0; rep_ < P0_REP_TR; ++rep_)
    { LAS float* scr = (LAS float*)(F.lds + RING_OFF + F.wave * 8704);
      constexpr int TR_P0_END = TR_GU + TR_DN + TR_IN + TR_MG;
      int it = TR_GU + TR_DN + gw; f32x4 cur[8], nxt[8]; TrItem tc, tn;
      if (it < TR_P0_END) { tc = tr_decode(F, it); tr_load(tc, cur, lane); }
      while (it < TR_P0_END) {
          const int itn = it + NGW; const bool hn = itn < TR_P0_END;
          if (hn) { tn = tr_decode(F, itn); tr_load(tn, nxt, lane); }
          tr_store(tc, cur, scr, lane);
          if (hn) { tc = tn;
#pragma unroll
              for (int i = 0; i < 8; ++i) cur[i] = nxt[i]; }
          it = itn;
      } }
    const int gt = F.vcu * (NWAVES * 64) + F.tid, NGT = F.G * NWAVES * 64;
    { float* rot = WSP(float, WS_ROT);
      for (int i = gt; i < SEQ * 32; i += NGT) { const int pos = i >> 5, j = i & 31;
          const float inv = powf(10000.f, -(float)j / 32.f); const float ang = (float)pos * inv;
          double rev = (double)ang * 0.15915494309189535; rev -= floor(rev); const float fr = (float)rev;
          rot[i] = __builtin_amdgcn_cosf(fr); rot[SEQ * 32 + i] = __builtin_amdgcn_sinf(fr); } }
    { bf16* wrt = WSP(bf16, WS_WRT);
      for (int i = gt; i < 1024 * 32; i += NGT) { const int k = i >> 5, n = i & 31; const float v = (F.ap->in[10])[i]; const unsigned hi = f2bf(v); const float rem = v - __uint_as_float(hi << 16);
          wrt[n * 1024 + k] = (bf16)hi; wrt[32768 + n * 1024 + k] = (bf16)f2bf(rem); } }
    if (gt < 64) { GAS v4u* z = (GAS v4u*)(WSP(unsigned char, WS_HB) + (size_t)NT * DM); z[gt] = (v4u){0u, 0u, 0u, 0u}; }
}

constexpr int CONV_ITEMS = 64, CONV_TR_ITEMS = TR_ITEMS - TR_IN - TR_MG, CONV_TR_CHUNKS = CONV_TR_ITEMS / CONV_ITEMS, CONV_PB_CHUNKS = NT * PLE / 4 / 16384, CONV_CHUNKS = CONV_TR_CHUNKS + CONV_PB_CHUNKS;
static_assert(CONV_TR_ITEMS % CONV_ITEMS == 0 && (TR_GU + TR_DN) % CONV_ITEMS == 0 && (NT * PLE / 4) % 16384 == 0, "whole chunks");
__device__ __forceinline__ TrItem conv_decode(Frame& F, int ci) { return tr_decode(F, ci < TR_GU + TR_DN ? ci : ci + TR_IN + TR_MG); }
__device__ __forceinline__ void conv_chunk(Frame& F, int c) {
    int lane = lane_now(); asm volatile("" : "+v"(lane));
    if (c >= CONV_TR_CHUNKS) {
        const int j = c - CONV_TR_CHUNKS, t = F.wave * 64 + lane;
        const GAS f32x4* ps = (const GAS f32x4*)(F.ap->in[1]) + (size_t)j * 16384 + t; GAS unsigned long long* pd = (GAS unsigned long long*)WSP(bf16, WS_PB) + (size_t)j * 16384 + t;
        for (int b = 0; b < 4; ++b) { f32x4 v[8];
#pragma unroll
            for (int u = 0; u < 8; ++u) v[u] = ps[b * 4096 + u * 512];
#pragma unroll
            for (int u = 0; u < 8; ++u) pd[b * 4096 + u * 512] = (unsigned long long)cvt_pk_bf16(v[u].x, v[u].y) | ((unsigned long long)cvt_pk_bf16(v[u].z, v[u].w) << 32); }
        return; }
    LAS float* scr = (LAS float*)(F.lds + RING_OFF + F.wave * 17408); LAS float* scr1 = scr + 2176;
    static_assert(NWAVES * 17408 <= SCH_OFF - RING_OFF, "conversion scratch inside ring + table region");
    const int base = c * CONV_ITEMS + F.wave;
    f32x4 a0[8], a1[8], b0[8], b1[8], c0[8], c1[8]; TrItem ta0, ta1, tb0, tb1, tc0, tc1;
    constexpr int NPAIR = CONV_ITEMS / NWAVES / 2;
    ta0 = conv_decode(F, base); ta1 = conv_decode(F, base + NWAVES); tr_load(ta0, a0, lane); tr_load(ta1, a1, lane);
    tb0 = conv_decode(F, base + 2 * NWAVES); tb1 = conv_decode(F, base + 3 * NWAVES); tr_load(tb0, b0, lane); tr_load(tb1, b1, lane);
    tc0 = tb0; tc1 = tb1;
#pragma unroll
    for (int i = 0; i < 8; ++i) { c0[i] = b0[i]; c1[i] = b1[i]; }
    for (int k = 0; k < NPAIR; ++k) {
        if (k + 2 < NPAIR) { tc0 = conv_decode(F, base + NWAVES * (2 * k + 4)); tc1 = conv_decode(F, base + NWAVES * (2 * k + 5)); tr_load(tc0, c0, lane); tr_load(tc1, c1, lane); }
        __builtin_amdgcn_sched_barrier(0);
        tr_store2(ta0, a0, ta1, a1, scr, scr1, lane);
        __builtin_amdgcn_sched_barrier(0);
        ta0 = tb0; ta1 = tb1; tb0 = tc0; tb1 = tc1;
#pragma unroll
        for (int i = 0; i < 8; ++i) { a0[i] = b0[i]; a1[i] = b1[i]; b0[i] = c0[i]; b1[i] = c1[i]; }
    }
}

__device__ __forceinline__ void cum_scan(Frame& F, int bh) {
    const float* lf = WSP(float, WS_LOGF); float* cum = WSP(float, WS_CUM);
    const int b = bh >> 3, h = bh & 7, t0 = 4 * F.tid;
    double a0 = lf[((size_t)(b * SEQ + t0 + 0)) * 8 + h], a1 = lf[((size_t)(b * SEQ + t0 + 1)) * 8 + h], a2 = lf[((size_t)(b * SEQ + t0 + 2)) * 8 + h], a3 = lf[((size_t)(b * SEQ + t0 + 3)) * 8 + h];
    a1 += a0; a2 += a1; a3 += a2;
    LAS double* tot = (LAS double*)(F.lds + RING_OFF);
    tot[F.tid] = a3;
    __syncthreads();
    double ex = 0.0;
    for (int j = 0; j < 63; ++j) { const double v = tot[F.wave * 64 + j]; ex += (j < F.lane) ? v : 0.0; }
    if (F.lane == 63) tot[512 + F.wave] = ex + a3;
    __syncthreads();
    for (int w = 0; w < F.wave; ++w) ex += tot[512 + w];
    *(GAS f32x4*)(cum + (size_t)bh * SEQ + t0) = (f32x4){(float)(ex + a0), (float)(ex + a1), (float)(ex + a2), (float)(ex + a3)};
    __syncthreads();
}

typedef pg8::f32x4 (&AccRef)[2][2][4][2];
using pg8::Unit;
__device__ __forceinline__ v4u pack8(const f32x4 a, const f32x4 b) { v4u w; w.x = cvt_pk_bf16(a[0], a[1]); w.y = cvt_pk_bf16(a[2], a[3]); w.z = cvt_pk_bf16(b[0], b[1]); w.w = cvt_pk_bf16(b[2], b[3]); return w; }
__device__ __forceinline__ void unpack8(const v4u w, f32x4& a, f32x4& b) { a = (f32x4){bflo(w.x), bfhi(w.x), bflo(w.y), bfhi(w.y)}; b = (f32x4){bflo(w.z), bfhi(w.z), bflo(w.w), bfhi(w.w)}; }

__device__ __forceinline__ void tstore32(LAS unsigned char* scr, const v4u wa, const v4u wb, int fr, int fq, bf16* dst, int cstride) {
    LAS unsigned short* s2 = (LAS unsigned short*)scr;
#pragma unroll
    for (int e2 = 0; e2 < 4; ++e2) { const int col = 8 * fq + 2 * e2;
        s2[col * 40 + fr] = (unsigned short)(wa[e2] & 0xffffu); s2[(col + 1) * 40 + fr] = (unsigned short)(wa[e2] >> 16);
        s2[col * 40 + 16 + fr] = (unsigned short)(wb[e2] & 0xffffu); s2[(col + 1) * 40 + 16 + fr] = (unsigned short)(wb[e2] >> 16); }
    asm volatile("" ::: "memory");
    const int lane = fr + 16 * fq, cl = lane >> 1, part = lane & 1;
    const v4u r0 = *(const LAS v4u*)(scr + cl * 80 + part * 32), r1 = *(const LAS v4u*)(scr + cl * 80 + part * 32 + 16);
    asm volatile("" ::: "memory");
    bf16* d = dst + (size_t)cl * cstride + part * 16;
    *(v4u*)d = r0; *(v4u*)(d + 8) = r1;
}
struct EpiIn {
    static constexpr bool PERM = true;
    bf16 *FQ, *FK, *FV, *RQ, *RK, *RV, *RGS; const float* rot; bf16* RKT; LAS unsigned char* scr; int skip;
    __device__ __forceinline__ void operator()(const pg8::f32x4 (&acc)[2][2][4][2], const Unit& u, int wr, int wc, int fr, int fq) const {
        if (skip == 1) return;
        asm volatile("" : "+v"(fr), "+v"(fq));
        const int pn = u.pn; bf16* base; int ldc, colt, mode = 0; float sc = 1.f;
        if (skip) { const int cls = pn < 6 ? 1 : pn < 8 ? 2 : pn < 10 ? 4 : 8; if (skip & (cls << 1)) return; }
        if (pn < 2) { base = FQ; ldc = 512; colt = pn * 256; sc = C2; }
        else if (pn < 4) { base = FK; ldc = 512; colt = (pn - 2) * 256; }
        else if (pn < 6) { base = FV; ldc = 512; colt = (pn - 4) * 256; }
        else if (pn == 6) { base = RQ; ldc = 256; colt = 0; mode = 1; }
        else if (pn == 7) { base = RK; ldc = 256; colt = 0; mode = 1; sc = 0.125f; }
        else if (pn < 10) { base = RV; ldc = 512; colt = (pn - 8) * 256; mode = 4; }
        else { base = RGS; ldc = 512; colt = (pn - 10) * 256; mode = 2; }
        const int row0 = u.pm * 256 + wr * 64 + fr, col0 = colt + wc * 32 + 8 * fq;
        LAS unsigned char* ws = scr + (wr * 4 + wc) * 3072;
        if (mode == 1) {
            f32x4 cs[2][4], sn[2][4]; const int j = (col0 & 63) >> 1;
#pragma unroll
            for (int ai = 0; ai < 2; ++ai)
#pragma unroll
                for (int m = 0; m < 4; ++m) { const int pos = (row0 + ai * 128 + m * 16) & (SEQ - 1); cs[ai][m] = *(const f32x4*)(rot + pos * 32 + j); sn[ai][m] = *(const f32x4*)(rot + SEQ * 32 + pos * 32 + j); }
            __builtin_amdgcn_sched_barrier(0);
            float lg2b[2] = {0.f, 0.f};
            if (pn == 7) { lg2b[0] = log1pf(-exp2f(-5.f - (float)(wc >> 1))) * LOG2E; lg2b[1] = log1pf(-exp2f(-5.f - (float)((wc >> 1) + 2))) * LOG2E; }
#pragma unroll
            for (int ai = 0; ai < 2; ++ai)
#pragma unroll
                for (int mh = 0; mh < 2; ++mh)
#pragma unroll
                    for (int bj = 0; bj < 2; ++bj) { const int c = col0 + bj * 128; v4u wt[2];
#pragma unroll
                        for (int mm = 0; mm < 2; ++mm) { const int m = 2 * mh + mm, row = row0 + ai * 128 + m * 16; const f32x4 a = acc[ai][bj][m][0], b = acc[ai][bj][m][1], cv = cs[ai][m], sv = sn[ai][m];
                            const f32x4 v0 = {(a[0] * cv[0] - a[1] * sv[0]) * sc, (a[1] * cv[0] + a[0] * sv[0]) * sc, (a[2] * cv[1] - a[3] * sv[1]) * sc, (a[3] * cv[1] + a[2] * sv[1]) * sc};
                            const f32x4 v1 = {(b[0] * cv[2] - b[1] * sv[2]) * sc, (b[1] * cv[2] + b[0] * sv[2]) * sc, (b[2] * cv[3] - b[3] * sv[3]) * sc, (b[3] * cv[3] + b[2] * sv[3]) * sc};
                            *(v4u*)(base + (size_t)row * ldc + c) = pack8(v0, v1);
                            if (pn == 7) { const float dk = __builtin_amdgcn_exp2f((float)(127 - (row & 127)) * lg2b[bj]); wt[mm] = pack8(v0 * dk, v1 * dk); } }
                        if (pn == 7) {
                            const int rowb = u.pm * 256 + ai * 128 + wr * 64 + mh * 32, cb = wc * 32 + bj * 128;
                            tstore32(ws, wt[0], wt[1], fr, fq, RKT + ((size_t)((rowb >> 11) * 4 + (cb >> 6)) * 16 + ((rowb >> 7) & 15)) * 8192 + (size_t)(cb & 63) * 128 + (rowb & 127), 128); } }
            return; }
        if (mode == 4) {
#pragma unroll
            for (int ai = 0; ai < 2; ++ai)
#pragma unroll
                for (int mh = 0; mh < 2; ++mh)
#pragma unroll
                    for (int bj = 0; bj < 2; ++bj) { const int rowb = u.pm * 256 + ai * 128 + wr * 64 + mh * 32, cb = colt + wc * 32 + bj * 128;
                        tstore32(ws, pack8(acc[ai][bj][2 * mh][0], acc[ai][bj][2 * mh][1]), pack8(acc[ai][bj][2 * mh + 1][0], acc[ai][bj][2 * mh + 1][1]), fr, fq,
                                 RV + ((size_t)((rowb >> 11) * 4 + (cb >> 7)) * 16 + ((rowb >> 7) & 15)) * 16384 + (size_t)(cb & 127) * 128 + (rowb & 127), 128); }
            return; }
#pragma unroll
        for (int ai = 0; ai < 2; ++ai)
#pragma unroll
            for (int m = 0; m < 4; ++m) { const int row = row0 + ai * 128 + m * 16;
#pragma unroll
                for (int bj = 0; bj < 2; ++bj) { const int c = col0 + bj * 128; f32x4 v0 = acc[ai][bj][m][0], v1 = acc[ai][bj][m][1];
                    if (mode == 0) { v0 = v0 * sc; v1 = v1 * sc; }
                    else {
#pragma unroll
                        for (int e = 0; e < 4; ++e) { v0[e] = v0[e] * fsigmoid(v0[e]); v1[e] = v1[e] * fsigmoid(v1[e]); } }
                    *(v4u*)(base + (size_t)row * ldc + c) = pack8(v0, v1); } }
    }
};
__device__ __forceinline__ void u8x8_to_f32(const v2u w, f32x4& a, f32x4& b) {
    a = (f32x4){(float)(w.x & 255u), (float)((w.x >> 8) & 255u), (float)((w.x >> 16) & 255u), (float)(w.x >> 24)}; b = (f32x4){(float)(w.y & 255u), (float)((w.y >> 8) & 255u), (float)((w.y >> 16) & 255u), (float)(w.y >> 24)}; }
struct EpiGate {
    static constexpr bool PERM = true;
    unsigned char* GATES; const float* bmg; bf16 *FQ, *FK; int skip;
    __device__ __forceinline__ void operator()(const pg8::f32x4 (&acc)[2][2][4][2], const Unit& u, int wr, int wc, int fr, int fq) const {
        if (skip & 33) return;
        { const int l_ = lane_now(); fr = l_ & 15; fq = (l_ >> 4) & 3; }
        if (u.pn < 4) {
            bf16* base = u.pn < 2 ? FQ : FK; const float sc = (u.pn < 2 ? C2 : 1.f) * (1.f / WSCALE);
            const int r0 = u.pm * 256 + wr * 64 + fr, c0 = (u.pn & 1) * 256 + wc * 32 + 8 * fq;
#pragma unroll
            for (int ai = 0; ai < 2; ++ai)
#pragma unroll
                for (int m = 0; m < 4; ++m)
#pragma unroll
                    for (int bj = 0; bj < 2; ++bj) *(v4u*)(base + (size_t)(r0 + ai * 128 + m * 16) * 512 + c0 + bj * 128) = pack8(acc[ai][bj][m][0] * sc, acc[ai][bj][m][1] * sc);
            return; }
        float ck = -LOG2E / WSCALE, cb = -LOG2E, c254 = 254.f; asm volatile("" : "+s"(ck), "+s"(cb), "+s"(c254));
        typedef float f2 __attribute__((ext_vector_type(2)));
        const int row0 = u.pm * 256 + wr * 64 + fr, col0 = (u.pn - 4) * 256 + wc * 32 + 8 * fq;
        f32x4 bb[2][2];
#pragma unroll
        for (int bj = 0; bj < 2; ++bj) { bb[bj][0] = *(const f32x4*)(bmg + col0 + bj * 128) * cb; bb[bj][1] = *(const f32x4*)(bmg + col0 + bj * 128 + 4) * cb; }
#pragma unroll
        for (int ai = 0; ai < 2; ++ai)
#pragma unroll
            for (int m = 0; m < 4; ++m) { unsigned char* rowp = GATES + (size_t)(row0 + ai * 128 + m * 16) * 2048 + col0;
#pragma unroll
                for (int bj = 0; bj < 2; ++bj) { v2u w;
#pragma unroll
                    for (int n = 0; n < 2; ++n) { const f32x4 a = acc[ai][bj][m][n], b = bb[bj][n]; unsigned b4 = 0u;
#pragma unroll
                        for (int hh = 0; hh < 2; ++hh) { const f2 t = (f2){a[2 * hh], a[2 * hh + 1]} * ck + (f2){b[2 * hh], b[2 * hh + 1]};
                            f2 ex; ex.x = __builtin_amdgcn_exp2f(t.x); ex.y = __builtin_amdgcn_exp2f(t.y); const f2 den = ex + 1.0f;
                            f2 rc; rc.x = __builtin_amdgcn_rcpf(den.x); rc.y = __builtin_amdgcn_rcpf(den.y); const f2 x = rc * c254 + 0.5f;
                            if (hh == 0) { b4 = __builtin_amdgcn_cvt_pk_u8_f32(x.x, 0, b4); b4 = __builtin_amdgcn_cvt_pk_u8_f32(x.y, 1, b4); }
                            else { b4 = __builtin_amdgcn_cvt_pk_u8_f32(x.x, 2, b4); b4 = __builtin_amdgcn_cvt_pk_u8_f32(x.y, 3, b4); } }
                        if (n == 0) w.x = b4; else w.y = b4; }
                    *(v2u*)(rowp + bj * 128) = w; } }
    }
};
struct HookMerge {
    static constexpr bool ON = true; static constexpr int AT = 6;
    const unsigned char* GATES;
    __device__ __forceinline__ void operator()(pg8::f32x4 (&acc)[2][2][4][2], const Unit& u, int wr, int wc, int fr, int fq) const {
        asm volatile("" : "+v"(fr), "+v"(fq));
        const int row0 = u.pm * 256 + wr * 64 + fr, col0 = u.pn * 256 + wc * 32 + 8 * fq;
        v2u ga[2][4][2], gb[2][4][2];
#pragma unroll
        for (int ai = 0; ai < 2; ++ai)
#pragma unroll
            for (int m = 0; m < 4; ++m) { const unsigned char* gp = GATES + (size_t)(row0 + ai * 128 + m * 16) * 2048 + col0;
#pragma unroll
                for (int bj = 0; bj < 2; ++bj) { ga[ai][m][bj] = *(const v2u*)(gp + bj * 128); gb[ai][m][bj] = *(const v2u*)(gp + 1024 + bj * 128); } }
        __builtin_amdgcn_sched_barrier(0);
#pragma unroll
        for (int ai = 0; ai < 2; ++ai)
#pragma unroll
            for (int m = 0; m < 4; ++m)
#pragma unroll
                for (int bj = 0; bj < 2; ++bj) { f32x4 a0, a1, b0, b1; u8x8_to_f32(ga[ai][m][bj], a0, a1); u8x8_to_f32(gb[ai][m][bj], b0, b1);
#pragma unroll
                    for (int e2 = 0; e2 < 4; ++e2) { acc[ai][bj][m][0][e2] *= a0[e2] * __builtin_amdgcn_rcpf(fmaxf(b0[e2], 1e-30f)); acc[ai][bj][m][1][e2] *= a1[e2] * __builtin_amdgcn_rcpf(fmaxf(b1[e2], 1e-30f)); } }
        __builtin_amdgcn_sched_barrier(0);
    }
};
struct EpiMerge {
    static constexpr bool PERM = true;
    const unsigned char* GATES; bf16* MERGED;
    __device__ __forceinline__ void operator()(const pg8::f32x4 (&acc)[2][2][4][2], const Unit& u, int wr, int wc, int fr, int fq) const {
        asm volatile("" : "+v"(fr), "+v"(fq));
        const int row0 = u.pm * 256 + wr * 64 + fr, col0 = u.pn * 256 + wc * 32 + 8 * fq;
        v2u gg[2][4][2];
#pragma unroll
        for (int ai = 0; ai < 2; ++ai)
#pragma unroll
            for (int m = 0; m < 4; ++m)
#pragma unroll
                for (int bj = 0; bj < 2; ++bj) gg[ai][m][bj] = *(const v2u*)(GATES + (size_t)(row0 + ai * 128 + m * 16) * 2048 + 1024 + col0 + bj * 128);
        __builtin_amdgcn_sched_barrier(0);
#pragma unroll
        for (int ai = 0; ai < 2; ++ai)
#pragma unroll
            for (int m = 0; m < 4; ++m)
#pragma unroll
                for (int bj = 0; bj < 2; ++bj) { f32x4 g0, g1; u8x8_to_f32(gg[ai][m][bj], g0, g1);
#pragma unroll
                    for (int e2 = 0; e2 < 4; ++e2) { g0[e2] = fmaxf(g0[e2], 1e-30f) * (1.f / 254.f); g1[e2] = fmaxf(g1[e2], 1e-30f) * (1.f / 254.f); }
                    *(v4u*)(MERGED + (size_t)(row0 + ai * 128 + m * 16) * 1024 + col0 + bj * 128) = pack8(acc[ai][bj][m][0] * g0, acc[ai][bj][m][1] * g1); }
    }
};
struct EpiMO {
    static constexpr bool PERM = true;
    bf16* MO;
    __device__ __forceinline__ void operator()(const pg8::f32x4 (&acc)[2][2][4][2], const Unit& u, int wr, int wc, int fr, int fq) const {
        asm volatile("" : "+v"(fr), "+v"(fq));
        const int row0 = u.pm * 256 + wr * 64 + fr, col0 = u.pn * 256 + wc * 32 + 8 * fq;
#pragma unroll
        for (int ai = 0; ai < 2; ++ai)
#pragma unroll
            for (int m = 0; m < 4; ++m) { bf16* rowp = MO + (size_t)(row0 + ai * 128 + m * 16) * 1024 + col0;
#pragma unroll
                for (int bj = 0; bj < 2; ++bj) *(v4u*)(rowp + bj * 128) = pack8(acc[ai][bj][m][0], acc[ai][bj][m][1]); }
    }
};
struct EpiGU {
    static constexpr bool PERM = true;
    const float* bgu; const float* rsof; unsigned char* ACT;
    __device__ __forceinline__ void operator()(const pg8::f32x4 (&acc)[2][2][4][2], const Unit& u, int wr, int wc, int fr, int fq) const {
        { const int l_ = lane_now(); fr = l_ & 15; fq = (l_ >> 4) & 3; }
        float c7 = 7.f, cm7 = -7.f, ck = -1.702f * 1.4426950408889634f; asm volatile("" : "+s"(c7), "+s"(cm7), "+s"(ck));
        const int j0 = u.pn * 128 + wc * 32 + 8 * fq;
        const float* bb = bgu + (size_t)u.e * 2048 + 2 * j0;
        const f32x4 q0 = *(const f32x4*)(bb), q1 = *(const f32x4*)(bb + 4), q2 = *(const f32x4*)(bb + 8), q3 = *(const f32x4*)(bb + 12);
        const f32x4 bg0 = {q0[0], q0[2], q1[0], q1[2]}, bl0 = {q0[1], q0[3], q1[1], q1[3]}, bg1 = {q2[0], q2[2], q3[0], q3[2]}, bl1 = {q2[1], q2[3], q3[1], q3[3]};
        const int rl0 = wr * 64 + fr;
        float rsv[2][4];
#pragma unroll
        for (int ai = 0; ai < 2; ++ai)
#pragma unroll
            for (int m = 0; m < 4; ++m) rsv[ai][m] = rsof[(size_t)u.e * NT + u.rtl * 256 + rl0 + ai * 128 + m * 16];
        __builtin_amdgcn_sched_barrier(0);
#pragma unroll
        for (int ai = 0; ai < 2; ++ai)
#pragma unroll
            for (int m = 0; m < 4; ++m) { const int rl = rl0 + ai * 128 + m * 16; const float rs = rsv[ai][m] * (1.f / WSCALE);
                int wpk[2];
#pragma unroll
                for (int n = 0; n < 2; ++n) { const f32x4 ga = acc[ai][0][m][n], la = acc[ai][1][m][n]; const f32x4 bgv = n ? bg1 : bg0, blv = n ? bl1 : bl0; int w = 0;
#pragma unroll
                    for (int hh = 0; hh < 2; ++hh) { typedef float f2 __attribute__((ext_vector_type(2)));
                        f2 g = (f2){ga[2 * hh], ga[2 * hh + 1]} * rs + (f2){bgv[2 * hh], bgv[2 * hh + 1]}, l = (f2){la[2 * hh], la[2 * hh + 1]} * rs + (f2){blv[2 * hh], blv[2 * hh + 1]};
                        f2 a, b; a.x = fminf(g.x, c7); a.y = fminf(g.y, c7); b.x = __builtin_amdgcn_fmed3f(l.x, cm7, c7); b.y = __builtin_amdgcn_fmed3f(l.y, cm7, c7);
                        const f2 t = a * ck; f2 ex; ex.x = __builtin_amdgcn_exp2f(t.x); ex.y = __builtin_amdgcn_exp2f(t.y);
                        const f2 den = ex + 1.0f; f2 rc; rc.x = __builtin_amdgcn_rcpf(den.x); rc.y = __builtin_amdgcn_rcpf(den.y);
                        const f2 o = (a * rc) * (b + 1.0f);
                        if (hh == 0) w = __builtin_amdgcn_cvt_pk_fp8_f32(o.x, o.y, w, false); else w = __builtin_amdgcn_cvt_pk_fp8_f32(o.x, o.y, w, true); }
                    wpk[n] = w; }
                *(v2u*)(ACT + ((size_t)u.pm * 256 + rl) * 1024 + j0) = (v2u){(unsigned)wpk[0], (unsigned)wpk[1]}; }
    }
};
struct EpiDN {
    static constexpr bool PERM = true;
    const float* bdn; unsigned char* Y;
    __device__ __forceinline__ void operator()(const pg8::f32x4 (&acc)[2][2][4][2], const Unit& u, int wr, int wc, int fr, int fq) const {
        asm volatile("" : "+v"(fr), "+v"(fq));
        const int col0 = u.pn * 256 + wc * 32 + 8 * fq; const float* bb = bdn + (size_t)u.e * 1024 + col0;
        f32x4 bv[2][2];
#pragma unroll
        for (int bj = 0; bj < 2; ++bj) { bv[bj][0] = *(const f32x4*)(bb + bj * 128) * YSCALE; bv[bj][1] = *(const f32x4*)(bb + bj * 128 + 4) * YSCALE; }
        const int rl0 = wr * 64 + fr;
#pragma unroll
        for (int ai = 0; ai < 2; ++ai)
#pragma unroll
            for (int m = 0; m < 4; ++m) { unsigned char* rowp = Y + ((size_t)u.pm * 256 + rl0 + ai * 128 + m * 16) * 1024 + col0;
#pragma unroll
                for (int bj = 0; bj < 2; ++bj) *(v2u*)(rowp + bj * 128) = pack8_fp8(acc[ai][bj][m][0] * (YSCALE / WSCALE) + bv[bj][0], acc[ai][bj][m][1] * (YSCALE / WSCALE) + bv[bj][1]); }
    }
};
struct EpiPJ {
    static constexpr bool PERM = false;
    bf16* PJ;
    __device__ __forceinline__ void operator()(const pg8::f32x4 (&acc)[2][2][4][2], const Unit& u, int wr, int wc, int fr, int fq) const {
        asm volatile("" : "+v"(fr), "+v"(fq));
        const int row0 = u.pm * 256 + wr * 64 + fr, col0 = u.pn * 256 + wc * 32 + 4 * fq;
#pragma unroll
        for (int ai = 0; ai < 2; ++ai)
#pragma unroll
            for (int m = 0; m < 4; ++m) { const size_t off = (size_t)(row0 + ai * 128 + m * 16) * 1024 + col0;
#pragma unroll
                for (int bj = 0; bj < 2; ++bj)
#pragma unroll
                    for (int n = 0; n < 2; ++n) { const f32x4 v = acc[ai][bj][m][n]; v2u w; w.x = cvt_pk_bf16(v[0], v[1]); w.y = cvt_pk_bf16(v[2], v[3]); *(v2u*)(PJ + off + bj * 128 + n * 16) = w; } }
    }
};
struct EpiPG {
    static constexpr bool PERM = true;
    unsigned char* G8; const float* rstd2;
    __device__ __forceinline__ void operator()(const pg8::f32x4 (&acc)[2][2][4][2], const Unit& u, int wr, int wc, int fr, int fq) const {
        { const int l_ = lane_now(); fr = l_ & 15; fq = (l_ >> 4) & 3; }
        float ck = -LOG2E / WSCALE, c254 = 254.f; asm volatile("" : "+s"(ck), "+s"(c254));
        typedef float f2 __attribute__((ext_vector_type(2)));
        const int row0 = u.pm * 256 + wr * 64 + fr, col0 = u.pn * 256 + wc * 32 + 8 * fq;
        float rsv[2][4];
#pragma unroll
        for (int ai = 0; ai < 2; ++ai)
#pragma unroll
            for (int m = 0; m < 4; ++m) rsv[ai][m] = rstd2[row0 + ai * 128 + m * 16];
        __builtin_amdgcn_sched_barrier(0);
#pragma unroll
        for (int ai = 0; ai < 2; ++ai)
#pragma unroll
            for (int m = 0; m < 4; ++m) { const float rs = rsv[ai][m] * ck; unsigned char* rowp = G8 + (size_t)(row0 + ai * 128 + m * 16) * 1024 + col0;
#pragma unroll
                for (int bj = 0; bj < 2; ++bj) { v2u w;
#pragma unroll
                    for (int n = 0; n < 2; ++n) { const f32x4 a = acc[ai][bj][m][n]; unsigned b4 = 0u;
#pragma unroll
                        for (int hh = 0; hh < 2; ++hh) { const f2 t = (f2){a[2 * hh], a[2 * hh + 1]} * rs;
                            f2 ex; ex.x = __builtin_amdgcn_exp2f(t.x); ex.y = __builtin_amdgcn_exp2f(t.y); const f2 den = ex + 1.0f;
                            f2 rc; rc.x = __builtin_amdgcn_rcpf(den.x); rc.y = __builtin_amdgcn_rcpf(den.y); const f2 x = rc * c254 + 0.5f;
                            if (hh == 0) { b4 = __builtin_amdgcn_cvt_pk_u8_f32(x.x, 0, b4); b4 = __builtin_amdgcn_cvt_pk_u8_f32(x.y, 1, b4); }
                            else { b4 = __builtin_amdgcn_cvt_pk_u8_f32(x.x, 2, b4); b4 = __builtin_amdgcn_cvt_pk_u8_f32(x.y, 3, b4); } }
                        if (n == 0) w.x = b4; else w.y = b4; }
                    *(v2u*)(rowp + bj * 128) = w; } }
    }
};

__device__ __forceinline__ int moe_setup(Frame& F) {
    LAS int* cnt = (LAS int*)(F.lds + SCH_CNT); LAS int* P = (LAS int*)(F.lds + SCH_P); LAS int* rt2e = (LAS int*)(F.lds + SCH_RT2E);
    if (F.tid < NE) cnt[F.tid] = (int)__hip_atomic_load(((gu32*)(F.ap->ws + WS_CTL)) + CW_CNT + F.tid, RLX_AGENT);
    __syncthreads();
    if (F.tid == 0) { int s = 0; for (int e = 0; e < NE; ++e) { P[e] = s; s += (cnt[e] + 255) >> 8; } P[NE] = s; }
    __syncthreads();
    const int RT = __builtin_amdgcn_readfirstlane(P[NE]);
    for (int t = F.tid; t < RT && t < MAXRT; t += NWAVES * 64) { int e = 0;
#pragma unroll
        for (int k = 1; k <= NE; ++k) e += (P[k] <= t) ? 1 : 0;
        rt2e[t] = e; }
    __syncthreads();
    return RT < MAXRT ? RT : MAXRT;
}
struct MoeOrder {
    pg8::DenseOrder d; LAS const int* P; LAS const int* rt2e; LAS const unsigned* tab;
    const char* Abase; size_t tsA; const char* Bbase; size_t estride, tsB; bool gather;
    __device__ __forceinline__ bool next(int i, Unit& u) const {
        if (!d.tile(i, u.pm, u.pn)) return false;
        const int e = __builtin_amdgcn_readfirstlane(rt2e[u.pm]); u.e = e; u.rtl = u.pm - __builtin_amdgcn_readfirstlane(P[e]);
        u.A = gather ? Abase : Abase + (size_t)u.pm * tsA; u.B = Bbase + (size_t)e * estride + (size_t)u.pn * tsB; return true;
    }
    __device__ __forceinline__ const LAS unsigned char* table(int ui) const { return (const LAS unsigned char*)tab + ui * 1024; }
};

__device__ __forceinline__ void router_pass(Frame& F) {
    LAS float* L = (LAS float*)(F.lds + RING_OFF + F.wave * 2304);
    LAS int* hist = (LAS int*)(F.lds + RING_OFF + 32768); LAS int* hbase = hist + 32;
    if (F.tid < 64) hist[F.tid] = 0;
    __syncthreads();
    const float* X = (F.ap->in[0]); const bf16* MO = WSP(bf16, WS_MO); bf16* MOw = WSP(bf16, WS_MO); unsigned char* HB = WSP(unsigned char, WS_HB); const bf16* wrt = WSP(bf16, WS_WRT);
    const int lane = F.lane, r = lane & 15, q = lane >> 4, tok0 = (int)blockIdx.x * 128 + F.wave * 16, token = tok0 + r;
    pg8::f32x4 acc0 = {0.f, 0.f, 0.f, 0.f}, acc1 = {0.f, 0.f, 0.f, 0.f}; float ss = 0.f;
    const float* hrow = X + (size_t)token * DM + q * 8; const bf16* morow = MO + (size_t)token * DM + q * 8; const bf16* b0p = wrt + (size_t)r * 1024 + q * 8;
    f32x4 xa[2][2][2], ga[2][2][2]; v4u ma[2][2], wa[2][2][4];
#define RT_LOAD(buf, grp) do { _Pragma("unroll") for (int s_ = 0; s_ < 2; ++s_) { const int kk_ = (grp) * 2 + s_; \
        xa[buf][s_][0] = *(const f32x4*)(hrow + kk_ * 32); xa[buf][s_][1] = *(const f32x4*)(hrow + kk_ * 32 + 4); ma[buf][s_] = *(const v4u*)(morow + kk_ * 32); \
        ga[buf][s_][0] = *(const f32x4*)((F.ap->in[9]) + kk_ * 32 + q * 8); ga[buf][s_][1] = *(const f32x4*)((F.ap->in[9]) + kk_ * 32 + q * 8 + 4); \
        wa[buf][s_][0] = *(const v4u*)(b0p + kk_ * 32); wa[buf][s_][1] = *(const v4u*)(b0p + 16 * 1024 + kk_ * 32); wa[buf][s_][2] = *(const v4u*)(b0p + 32768 + kk_ * 32); wa[buf][s_][3] = *(const v4u*)(b0p + 32768 + 16 * 1024 + kk_ * 32); } } while (0)
#define RT_STEP(buf, grp) do { _Pragma("unroll") for (int s_ = 0; s_ < 2; ++s_) { const int kk_ = (grp) * 2 + s_; \
        f32x4 h0 = xa[buf][s_][0], h1 = xa[buf][s_][1]; { f32x4 m0, m1; unpack8(ma[buf][s_], m0, m1); h0 = h0 + m0; h1 = h1 + m1; } \
        ss += (h0[0] * h0[0] + h0[1] * h0[1]) + (h0[2] * h0[2] + h0[3] * h0[3]) + (h1[0] * h1[0] + h1[1] * h1[1]) + (h1[2] * h1[2] + h1[3] * h1[3]); \
        const f32x4 x0 = h0 * ga[buf][s_][0], x1 = h1 * ga[buf][s_][1]; \
        const v4u hi = pack8(x0, x1); f32x4 y0, y1; unpack8(hi, y0, y1); const v4u lo = pack8(x0 - y0, x1 - y1); \
        *(v2u*)(HB + (size_t)token * DM + kk_ * 32 + q * 8) = pack8_fp8(x0, x1); *(v4u*)(MOw + (size_t)token * DM + q * 8 + kk_ * 32) = pack8(h0, h1);     \
        const bf16x8 ah = __builtin_bit_cast(bf16x8, hi), al = __builtin_bit_cast(bf16x8, lo); \
        acc0 = __builtin_amdgcn_mfma_f32_16x16x32_bf16(ah, __builtin_bit_cast(bf16x8, wa[buf][s_][0]), acc0, 0, 0, 0); acc0 = __builtin_amdgcn_mfma_f32_16x16x32_bf16(al, __builtin_bit_cast(bf16x8, wa[buf][s_][0]), acc0, 0, 0, 0); \
        acc0 = __builtin_amdgcn_mfma_f32_16x16x32_bf16(ah, __builtin_bit_cast(bf16x8, wa[buf][s_][2]), acc0, 0, 0, 0); \
        acc1 = __builtin_amdgcn_mfma_f32_16x16x32_bf16(ah, __builtin_bit_cast(bf16x8, wa[buf][s_][1]), acc1, 0, 0, 0); acc1 = __builtin_amdgcn_mfma_f32_16x16x32_bf16(al, __builtin_bit_cast(bf16x8, wa[buf][s_][1]), acc1, 0, 0, 0); \
        acc1 = __builtin_amdgcn_mfma_f32_16x16x32_bf16(ah, __builtin_bit_cast(bf16x8, wa[buf][s_][3]), acc1, 0, 0, 0); } } while (0)
    RT_LOAD(0, 0);
#pragma unroll
    for (int gp = 0; gp < 16; gp += 2) {
        RT_LOAD(1, gp + 1); __builtin_amdgcn_sched_barrier(0); RT_STEP(0, gp); __builtin_amdgcn_sched_barrier(0);
        if (gp + 2 < 16) RT_LOAD(0, gp + 2);
        __builtin_amdgcn_sched_barrier(0); RT_STEP(1, gp + 1); __builtin_amdgcn_sched_barrier(0);
    }
#undef RT_LOAD
#undef RT_STEP
    ss = xor16_sum(ss); ss = xor32_sum(ss);
    const float rstd = 1.f / sqrtf(ss * (1.f / DM) + EPS);
#pragma unroll
    for (int i = 0; i < 4; ++i) { L[(4 * q + i) * 33 + r] = acc0[i]; L[(4 * q + i) * 33 + 16 + r] = acc1[i]; }
    LDS_WAIT(); asm volatile("" ::: "memory");
    int te0 = 0, te1 = 0, te2 = 0, te3 = 0, rk0 = 0, rk1 = 0, rk2 = 0, rk3 = 0; float w0 = 0.f, w1 = 0.f, w2 = 0.f, w3 = 0.f;
    if (lane < 16) {
        float v[32];
#pragma unroll
        for (int e = 0; e < 32; ++e) v[e] = L[lane * 33 + e] * rstd + (F.ap->in[11])[e];
        float tv[4]; int te[4];
#pragma unroll
        for (int k = 0; k < 4; ++k) { float best = v[0]; int bi = 0;
#pragma unroll
            for (int e = 1; e < 32; ++e) if (v[e] > best) { best = v[e]; bi = e; }
            tv[k] = best; te[k] = bi;
#pragma unroll
            for (int e = 0; e < 32; ++e) v[e] = (e == bi) ? -INFINITY : v[e]; }
        const float e1 = expf(tv[1] - tv[0]), e2 = expf(tv[2] - tv[0]), e3 = expf(tv[3] - tv[0]), inv = 1.f / (1.f + e1 + e2 + e3);
        w0 = inv; w1 = e1 * inv; w2 = e2 * inv; w3 = e3 * inv; te0 = te[0]; te1 = te[1]; te2 = te[2]; te3 = te[3];
        rk0 = __hip_atomic_fetch_add(hist + te0, 1, __ATOMIC_RELAXED, __HIP_MEMORY_SCOPE_WORKGROUP); rk1 = __hip_atomic_fetch_add(hist + te1, 1, __ATOMIC_RELAXED, __HIP_MEMORY_SCOPE_WORKGROUP);
        rk2 = __hip_atomic_fetch_add(hist + te2, 1, __ATOMIC_RELAXED, __HIP_MEMORY_SCOPE_WORKGROUP); rk3 = __hip_atomic_fetch_add(hist + te3, 1, __ATOMIC_RELAXED, __HIP_MEMORY_SCOPE_WORKGROUP);
    }
    __syncthreads();
    if (F.tid < NE) hbase[F.tid] = (int)__hip_atomic_fetch_add(((gu32*)(F.ap->ws + WS_CTL)) + CW_CNT + F.tid, (unsigned)hist[F.tid], RLX_AGENT);
    __syncthreads();
    if (lane < 16) {
        int* TOK = WSP(int, WS_TOK); float* RSOF = WSP(float, WS_RSOF); int* TOPE = WSP(int, WS_TOPE); float* TOPW = WSP(float, WS_TOPW); int* POS = WSP(int, WS_POS);
        const int p0 = hbase[te0] + rk0, p1 = hbase[te1] + rk1, p2 = hbase[te2] + rk2, p3 = hbase[te3] + rk3;
        TOK[(size_t)te0 * NT + p0] = token; TOK[(size_t)te1 * NT + p1] = token; TOK[(size_t)te2 * NT + p2] = token; TOK[(size_t)te3 * NT + p3] = token;
        RSOF[(size_t)te0 * NT + p0] = rstd; RSOF[(size_t)te1 * NT + p1] = rstd; RSOF[(size_t)te2 * NT + p2] = rstd; RSOF[(size_t)te3 * NT + p3] = rstd;
        *(int4*)(TOPE + (size_t)token * 4) = make_int4(te0, te1, te2, te3); *(float4*)(TOPW + (size_t)token * 4) = make_float4(w0, w1, w2, w3); *(int4*)(POS + (size_t)token * 4) = make_int4(p0, p1, p2, p3);
    }
    __syncthreads();
}
__device__ __forceinline__ void combine_pass(Frame& F) {
    LAS const int* P = (LAS const int*)(F.lds + SCH_P);
    const unsigned char* Y = WSP(unsigned char, WS_Y); const bf16* MO = WSP(bf16, WS_MO); unsigned char* HB2 = WSP(unsigned char, WS_HB2); float* RSTD2 = WSP(float, WS_RSTD2); bf16* H2B = WSP(bf16, WS_H2B);
    const int* TOPE = WSP(int, WS_TOPE); const float* TOPW = WSP(float, WS_TOPW); const int* POS = WSP(int, WS_POS);
    const int lane = F.lane, tok0 = (int)blockIdx.x * 128 + F.wave * 16;
    int4 te_n[2], tp_n[2]; float4 tw_n[2], tw_c[2]; v4u mc[2][2], mn[2][2]; v2u yc[2][4][2], yn[2][4][2];
#define CB_ROUTE(i) do { _Pragma("unroll") for (int t_ = 0; t_ < 2; ++t_) { te_n[t_] = *(const int4*)(TOPE + (size_t)(tok0 + (i) + t_) * 4); tw_n[t_] = *(const float4*)(TOPW + (size_t)(tok0 + (i) + t_) * 4); tp_n[t_] = *(const int4*)(POS + (size_t)(tok0 + (i) + t_) * 4); } } while (0)
#define CB_DATA(dm, dy, i) do { _Pragma("unroll") for (int t_ = 0; t_ < 2; ++t_) { \
        const size_t s0_ = (size_t)(P[te_n[t_].x] * 256 + tp_n[t_].x) * DM, s1_ = (size_t)(P[te_n[t_].y] * 256 + tp_n[t_].y) * DM, s2_ = (size_t)(P[te_n[t_].z] * 256 + tp_n[t_].z) * DM, s3_ = (size_t)(P[te_n[t_].w] * 256 + tp_n[t_].w) * DM; \
        _Pragma("unroll") for (int j = 0; j < 2; ++j) { const int c = 8 * lane + 512 * j; dm[t_][j] = *(const v4u*)(MO + (size_t)(tok0 + (i) + t_) * DM + c); \
            dy[t_][0][j] = *(const v2u*)(Y + s0_ + c); dy[t_][1][j] = *(const v2u*)(Y + s1_ + c); dy[t_][2][j] = *(const v2u*)(Y + s2_ + c); dy[t_][3][j] = *(const v2u*)(Y + s3_ + c); } } } while (0)
    CB_ROUTE(0); CB_DATA(mc, yc, 0); tw_c[0] = tw_n[0]; tw_c[1] = tw_n[1]; CB_ROUTE(2);
    for (int i = 0; i < 16; i += 2) {
        const float4 tw_x0 = tw_n[0], tw_x1 = tw_n[1];
        if (i + 2 < 16) CB_DATA(mn, yn, i + 2);
        if (i + 4 < 16) CB_ROUTE(i + 4);
        __builtin_amdgcn_sched_barrier(0);
#pragma unroll
        for (int t = 0; t < 2; ++t) { const int token = tok0 + i + t; f32x4 v[2][2]; float ss = 0.f; const float4 tw = tw_c[t] * (1.f / YSCALE);
#pragma unroll
            for (int j = 0; j < 2; ++j) { f32x4 a, b; unpack8(mc[t][j], a, b);
#pragma unroll
                for (int k = 0; k < 4; ++k) { const v2u y = yc[t][k][j]; const float w = k == 0 ? tw.x : k == 1 ? tw.y : k == 2 ? tw.z : tw.w;
                    const auto p0 = __builtin_amdgcn_cvt_pk_f32_fp8((int)y.x, false), p1 = __builtin_amdgcn_cvt_pk_f32_fp8((int)y.x, true), p2 = __builtin_amdgcn_cvt_pk_f32_fp8((int)y.y, false), p3 = __builtin_amdgcn_cvt_pk_f32_fp8((int)y.y, true);
                    a += w * (f32x4){p0[0], p0[1], p1[0], p1[1]}; b += w * (f32x4){p2[0], p2[1], p3[0], p3[1]}; }
                v[j][0] = a; v[j][1] = b;
                ss += ((a.x * a.x + a.y * a.y) + (a.z * a.z + a.w * a.w)) + ((b.x * b.x + b.y * b.y) + (b.z * b.z + b.w * b.w)); }
            const float rstd = 1.f / sqrtf(wave_sum(ss) * (1.f / DM) + EPS);
#pragma unroll
            for (int j = 0; j < 2; ++j) { const int c = 8 * lane + 512 * j; *(v4u*)(H2B + (size_t)token * DM + c) = pack8(v[j][0], v[j][1]);
                const f32x4 g0 = *(const f32x4*)((F.ap->in[16]) + c), g1 = *(const f32x4*)((F.ap->in[16]) + c + 4);
                *(v2u*)(HB2 + (size_t)token * DM + c) = pack8_fp8(v[j][0] * g0, v[j][1] * g1); }
            if (lane == 0) RSTD2[token] = rstd; }
        __builtin_amdgcn_sched_barrier(0);
#pragma unroll
        for (int t = 0; t < 2; ++t)
#pragma unroll
            for (int j = 0; j < 2; ++j) { mc[t][j] = mn[t][j];
#pragma unroll
                for (int k = 0; k < 4; ++k) yc[t][k][j] = yn[t][k][j]; }
        tw_c[0] = tw_x0; tw_c[1] = tw_x1;
    }
#undef CB_ROUTE
#undef CB_DATA
}
__device__ __forceinline__ void final_pass(Frame& F) {
    const bf16* PJ = WSP(bf16, WS_PJ); const bf16* H2B = WSP(bf16, WS_H2B); const unsigned char* G8 = WSP(unsigned char, WS_G8); const int lane = F.lane, tok0 = (int)blockIdx.x * 128 + F.wave * 16;
    v4u hc[2][2], hn[2][2], pc[2][2], pn[2][2]; v2u gc[2][2], gn[2][2];
#define FP_LOAD(hd, pd, gd, i) do { _Pragma("unroll") for (int t_ = 0; t_ < 2; ++t_) _Pragma("unroll") for (int j = 0; j < 2; ++j) { const size_t o_ = (size_t)(tok0 + (i) + t_) * DM + 8 * lane + 512 * j; \
        hd[t_][j] = *(const v4u*)(H2B + o_); pd[t_][j] = *(const v4u*)(PJ + o_); gd[t_][j] = *(const v2u*)(G8 + o_); } } while (0)
    FP_LOAD(hc, pc, gc, 0);
    for (int i = 0; i < 16; i += 2) {
        if (i + 2 < 16) FP_LOAD(hn, pn, gn, i + 2);
        __builtin_amdgcn_sched_barrier(0);
#pragma unroll
        for (int t = 0; t < 2; ++t) { f32x4 v[2][2]; float ss = 0.f;
#pragma unroll
            for (int j = 0; j < 2; ++j) { f32x4 a, b, pa, pb; unpack8(hc[t][j], a, b); unpack8(pc[t][j], pa, pb); const unsigned g0 = gc[t][j].x, g1 = gc[t][j].y;
                const f32x4 ga = {(float)(g0 & 255u), (float)((g0 >> 8) & 255u), (float)((g0 >> 16) & 255u), (float)(g0 >> 24)}, gb = {(float)(g1 & 255u), (float)((g1 >> 8) & 255u), (float)((g1 >> 16) & 255u), (float)(g1 >> 24)};
                a += (ga * (1.f / 254.f)) * pa; b += (gb * (1.f / 254.f)) * pb; v[j][0] = a; v[j][1] = b;
                ss += ((a.x * a.x + a.y * a.y) + (a.z * a.z + a.w * a.w)) + ((b.x * b.x + b.y * b.y) + (b.z * b.z + b.w * b.w)); }
            const float rstd = 1.f / sqrtf(wave_sum(ss) * (1.f / DM) + EPS); float* hr = (F.ap->out) + (size_t)(tok0 + i + t) * DM;
#pragma unroll
            for (int j = 0; j < 2; ++j) { const int c = 8 * lane + 512 * j; const f32x4 g0 = *(const f32x4*)((F.ap->in[19]) + c), g1 = *(const f32x4*)((F.ap->in[19]) + c + 4);
                *(f32x4*)(hr + c) = v[j][0] * rstd * g0; *(f32x4*)(hr + c + 4) = v[j][1] * rstd * g1; } }
        __builtin_amdgcn_sched_barrier(0);
#pragma unroll
        for (int t = 0; t < 2; ++t)
#pragma unroll
            for (int j = 0; j < 2; ++j) { hc[t][j] = hn[t][j]; pc[t][j] = pn[t][j]; gc[t][j] = gn[t][j]; }
    }
#undef FP_LOAD
}

struct PnOffOrder { pg8::DenseOrder d; int off;
    __device__ __forceinline__ bool next(int i, pg8::Unit& u) const { if (!d.next(i, u)) return false; u.pn += off; return true; }
    __device__ __forceinline__ const LAS unsigned char* table(int) const { return nullptr; } };
struct StrideOrder { int start, stride, n; const char* A; const char* B; size_t tsA, tsB;
    __device__ __forceinline__ bool next(int i, pg8::Unit& u) const { const int idx = start + i * stride; if (idx >= n) return false; u.pm = idx >> 2; u.pn = idx & 3; u.A = A + (size_t)u.pm * tsA; u.B = B + (size_t)u.pn * tsB; u.e = 0; u.rtl = 0; return true; }
    __device__ __forceinline__ const LAS unsigned char* table(int) const { return nullptr; } };
constexpr int N_PHASES = 11;

__global__ void __launch_bounds__(NWAVES * 64, 2) fwd(Args args) {
    extern __shared__ __attribute__((aligned(16))) unsigned char lds[];
    Frame F;
    F.lds = (LAS unsigned char*)lds;
    F.MISC = (volatile LAS unsigned*)(F.lds + MISC_OFF);
    F.tid = threadIdx.x; F.lane = F.tid & 63; F.wave = __builtin_amdgcn_readfirstlane(F.tid >> 6);
    F.G = gridDim.x; { const int bx = blockIdx.x; F.vcu = (F.G % 8 == 0) ? (bx % 8) * (F.G / 8) + bx / 8 : bx; }
    REARGS();
    for (int u = F.tid; u < 64; u += NWAVES * 64) ((LAS unsigned*)(F.lds + MISC_OFF))[u] = 0u;
    __syncthreads();
    const bool one = (F.ap->ph_hi - F.ap->ph_lo) > 1;
    XcdBarrier bar; bar.bar = (unsigned*)(((gu32*)(F.ap->ws + WS_CTL)) + CW_BAR); bar.x = 0; bar.st = nullptr;
    if (one) bar = xcd_barrier_post((unsigned*)(((gu32*)(F.ap->ws + WS_CTL)) + CW_BAR), F.MISC + 8, F.tid);
#ifdef ONLY_PHASE
    constexpr int lo = ONLY_PHASE, hi = ONLY_PHASE + 1;
#else
    const int lo = F.ap->ph_lo, hi = F.ap->ph_hi;
#endif
    int cid = (int)blockIdx.x;
#define IN(k) (lo <= (k) && (k) < hi)
#define RELANE() do { int l_ = lane_now(); asm volatile("" : "+v"(l_)); F.lane = l_; F.tid = F.wave * 64 + l_; REARGS(); asm volatile("" : "+s"(cid)); } while (0)
#define GBAR() do { RELANE(); xcd_barrier(bar, F.tid); } while (0)
#define SEAM(k) do { if (IN(k) && IN((k) + 1)) GBAR(); } while (0)
    const int rep_phase = F.ap->rep_phase, rep_mode = F.ap->rep_mode;
#define NREP(k) (((k) == rep_phase) ? 2 : 1)
    LAS unsigned char* ring = F.lds + RING_OFF;

    for (int rep = 0; rep < NREP(0); ++rep) { if (rep) GBAR(); if (IN(0)) { RELANE(); p0_prologue(F); } } SEAM(0);
    for (int rep = 0; rep < NREP(1); ++rep) { if (rep) GBAR(); if (IN(1)) { RELANE();
        if (cid < NBATCH * 8) cum_scan(F, cid);
        { pg8::Gemm g{1024, 1024, 1024}; PnOffOrder S; S.off = 4; S.d.init(NT / 256, 8, F.G, cid, WSP(bf16, WS_XN), (size_t)256 * 1024 * 2, WSP(bf16, WS_W1T), (size_t)256 * 1024 * 2);
          EpiIn E{WSP(bf16, WS_FQ), WSP(bf16, WS_FK), WSP(bf16, WS_FV), WSP(bf16, WS_RQ), WSP(bf16, WS_RK), WSP(bf16, WS_RV), WSP(bf16, WS_RGS), WSP(float, WS_ROT), WSP(bf16, WS_RKT), F.lds + TAB_OFF, (rep == 1 && rep_mode >= 7) ? (rep_mode == 7 ? 1 : rep_mode - 64) : 0};
          pg8::gemm_phase<EpiIn, PnOffOrder, true, false>(ring, g, S, E, F.wave); }
        { RELANE();
          pg8::Gemm g{1024, 1024, 1024}; pg8::DenseOrder S; S.init(NT / 256, 12, F.G, cid, WSP(unsigned char, WS_XN8), (size_t)256 * 1024, WSP(unsigned char, WS_WG8T), (size_t)256 * 1024);
          EpiGate E{WSP(unsigned char, WS_GATES), (F.ap->in[7]), WSP(bf16, WS_FQ), WSP(bf16, WS_FK), (rep == 1 && rep_mode >= 7) ? (rep_mode == 7 ? 1 : rep_mode - 64) : 0};
          pg8::gemm_phase<EpiGate, pg8::DenseOrder, true, false, 1>(ring, g, S, E, F.wave); }
    } } SEAM(1);
    for (int rep = 0; rep < NREP(2); ++rep) { if (rep) GBAR(); if (IN(2)) { RELANE();
        { static_assert(ret_body::LDS_BYTES <= RING_BYTES && attn_body::ATTN_LDS_BYTES <= RING_BYTES, "phase scratch inside the ring");
          volatile LAS int* qn = (volatile LAS int*)(F.MISC + 16);
          const attn_body::bf16* Q = (const attn_body::bf16*)WSP(bf16, WS_FQ); const attn_body::bf16* K = (const attn_body::bf16*)WSP(bf16, WS_FK); const attn_body::bf16* V = (const attn_body::bf16*)WSP(bf16, WS_FV);
          attn_body::bf16* O = (attn_body::bf16*)WSP(bf16, WS_BR);
          if (lane_now() + F.wave * 64 == 0) qn[0] = (int)__hip_atomic_fetch_add(((gu32*)(F.ap->ws + WS_CTL)) + CW_QUEUE + 64 * rep, 1u, RLX_AGENT);
          __syncthreads();
          for (int n = 0;; ++n) {
              const int item = __builtin_amdgcn_readfirstlane(qn[n & 1]);
              if (item >= 128 + 1024 + CONV_CHUNKS) break;
              int nxt_item = 0;
              if (lane_now() + F.wave * 64 == 0) nxt_item = (int)__hip_atomic_fetch_add(((gu32*)(F.ap->ws + WS_CTL)) + CW_QUEUE + 64 * rep, 1u, RLX_AGENT);
              if (item < 128) { const int bh4 = item & 63, second = (item < 64);
                  ret_body::ret_unit(ring, bh4 >> 2, bh4 & 3, WSP(bf16, WS_RQ), WSP(bf16, WS_RK), WSP(bf16, WS_RV), WSP(bf16, WS_RKT), WSP(bf16, WS_RGS), WSP(bf16, WS_BR), F.wave, second ? 8 : 0, second ? 16 : 8, 0); }
              else { const int r = item - 128, cb = (int)(((long)r * CONV_CHUNKS) / (1024 + CONV_CHUNKS)), cn = (int)(((long)(r + 1) * CONV_CHUNKS) / (1024 + CONV_CHUNKS));
                  if (cn > cb) { RELANE(); conv_chunk(F, cb); }
                  else { const int k = r - cb, qb = 7 - (k >> 7), bh = k & 127;
                      attn_body::attn_unit<8>(bh >> 3, bh & 7, qb, Q, K, V, O, WSP(float, WS_CUM) + (size_t)bh * SEQ, (char*)lds + RING_OFF, F.wave); } }
              if (lane_now() + F.wave * 64 == 0) qn[(n + 1) & 1] = nxt_item;
              __syncthreads();
          } }
    } } SEAM(2);
    for (int rep = 0; rep < NREP(3); ++rep) { if (rep) GBAR(); if (IN(3)) { RELANE();
        pg8::Gemm g{1024, 1024, 1024}; pg8::DenseOrder S; S.init(NT / 256, 4, F.G, cid, WSP(bf16, WS_BR), (size_t)256 * 1024 * 2, WSP(bf16, WS_WBT), (size_t)256 * 1024 * 2);
        EpiMerge E{WSP(unsigned char, WS_GATES), WSP(bf16, WS_MERGED)}; HookMerge H{WSP(unsigned char, WS_GATES)};
        pg8::gemm_phase<EpiMerge, pg8::DenseOrder, true, false, 2, HookMerge>(ring, g, S, E, F.wave, H);
    } } SEAM(3);
    for (int rep = 0; rep < NREP(4); ++rep) { if (rep) GBAR(); if (IN(4)) { RELANE();
        pg8::Gemm g{1024, 1024, 1024}; pg8::DenseOrder S; S.init(NT / 256, 4, F.G, cid, WSP(bf16, WS_MERGED), (size_t)256 * 1024 * 2, WSP(bf16, WS_WOT), (size_t)256 * 1024 * 2);
        EpiMO E{WSP(bf16, WS_MO)}; pg8::gemm_phase<EpiMO, pg8::DenseOrder, true, false>(ring, g, S, E, F.wave);
    } } SEAM(4);
    for (int rep = 0; rep < NREP(5); ++rep) { if (rep) GBAR(); if (IN(5)) { RELANE(); router_pass(F); } } SEAM(5);
    for (int rep = 0; rep < NREP(6); ++rep) { if (rep) GBAR(); if (IN(6)) { RELANE();
        const int RT = moe_setup(F);
        MoeOrder S; S.d.init(RT, 8, F.G, cid, nullptr, 0, nullptr, 0); S.P = (LAS const int*)(F.lds + SCH_P); S.rt2e = (LAS const int*)(F.lds + SCH_RT2E); S.tab = (LAS const unsigned*)(F.lds + TAB_OFF);
        S.Abase = (const char*)WSP(unsigned char, WS_HB); S.tsA = 0; S.Bbase = (const char*)WSP(unsigned char, WS_WGUT); S.estride = (size_t)2048 * 1024; S.tsB = (size_t)256 * 1024; S.gather = true;
        { LAS const int* cnt = (LAS const int*)(F.lds + SCH_CNT); LAS unsigned* tab = (LAS unsigned*)(F.lds + TAB_OFF); const int* TOK = WSP(int, WS_TOK);
          int tokv[MAXUNITS / 2];
#pragma unroll
          for (int j = 0; j < MAXUNITS / 2; ++j) { const int ui = 2 * j + (F.tid >> 8), r = F.tid & 255; int pm, pn; tokv[j] = -1;
              if (S.d.tile(ui, pm, pn)) { const int e = S.rt2e[pm], pos = (pm - S.P[e]) * 256 + r; tokv[j] = pos < cnt[e] ? TOK[(size_t)e * NT + pos] : NT; } }
#pragma unroll
          for (int j = 0; j < MAXUNITS / 2; ++j) { const int ui = 2 * j + (F.tid >> 8), r = F.tid & 255; if (tokv[j] >= 0) tab[ui * 256 + r] = (unsigned)tokv[j] * 1024u; }
          __syncthreads(); }
        pg8::Gemm g{1024, 1024, 1024};
        EpiGU E{(F.ap->in[13]), WSP(float, WS_RSOF), WSP(unsigned char, WS_ACT)}; pg8::gemm_phase<EpiGU, MoeOrder, true, true, 1>(ring, g, S, E, F.wave);
    } } SEAM(6);
    for (int rep = 0; rep < NREP(7); ++rep) { if (rep) GBAR(); if (IN(7)) { RELANE();
        const int RT = moe_setup(F);
        MoeOrder S; S.d.init(RT, 4, F.G, cid, nullptr, 0, nullptr, 0); S.P = (LAS const int*)(F.lds + SCH_P); S.rt2e = (LAS const int*)(F.lds + SCH_RT2E); S.tab = (LAS const unsigned*)(F.lds + TAB_OFF);
        S.Abase = (const char*)WSP(unsigned char, WS_ACT); S.tsA = (size_t)256 * 1024; S.Bbase = (const char*)WSP(unsigned char, WS_WDT); S.estride = (size_t)1024 * 1024; S.tsB = (size_t)256 * 1024; S.gather = false;
        pg8::Gemm g{1024, 1024, 1024};
        EpiDN E{(F.ap->in[15]), WSP(unsigned char, WS_Y)}; pg8::gemm_phase<EpiDN, MoeOrder, true, false, 1>(ring, g, S, E, F.wave);
        { const int rem = (RT * 4) % F.G, nidle = F.G - rem; const bool tail = 2 * nidle >= F.G;
          if (!tail || cid >= rem) { RELANE(); pg8::Gemm g2{256, 256, 256}; StrideOrder S2; S2.start = tail ? cid - rem : cid; S2.stride = tail ? nidle : F.G; S2.n = (NT / 256) * 4; S2.A = (const char*)WSP(bf16, WS_PB); S2.tsA = (size_t)256 * 256 * 2; S2.B = (const char*)WSP(bf16, WS_WPPT); S2.tsB = (size_t)256 * 256 * 2;
              EpiPJ E2{WSP(bf16, WS_PJ)}; pg8::gemm_phase<EpiPJ, StrideOrder, true, false>(ring, g2, S2, E2, F.wave); } }
    } } SEAM(7);
    for (int rep = 0; rep < NREP(8); ++rep) { if (rep) GBAR(); if (IN(8)) { RELANE(); (void)moe_setup(F); combine_pass(F); } } SEAM(8);
    for (int rep = 0; rep < NREP(9); ++rep) { if (rep) GBAR(); if (IN(9)) { RELANE();
        { pg8::Gemm g{1024, 1024, 1024}; pg8::DenseOrder S; S.init(NT / 256, 4, F.G, cid, WSP(unsigned char, WS_HB2), (size_t)256 * 1024, WSP(unsigned char, WS_WPGT), (size_t)256 * 1024);
          EpiPG E{WSP(unsigned char, WS_G8), WSP(float, WS_RSTD2)}; pg8::gemm_phase<EpiPG, pg8::DenseOrder, true, false, 1>(ring, g, S, E, F.wave); }
    } } SEAM(9);
    if (IN(10)) { RELANE(); final_pass(F); }
#undef IN
#undef SEAM
}

extern "C" void kernel_launch(void* const* d_in, const int* in_sizes, int n_in, void* d_out, int out_size, void* d_ws, size_t ws_size, hipStream_t stream) {
    static int grid = 0;
    if (grid == 0) {
        if (n_in != 20 || in_sizes[0] != NT * DM || out_size != NT * DM || ws_size < WS_END) { fprintf(stderr, "kernel_launch: unexpected shapes / workspace (%zu < %zu); nothing launched\n", ws_size, (size_t)WS_END); grid = -1; return; }
        int dev = 0, cus = 0, per_cu = 0;
        if (hipGetDevice(&dev) != hipSuccess || hipDeviceGetAttribute(&cus, hipDeviceAttributeMultiprocessorCount, dev) != hipSuccess) { grid = -1; return; }
        if (hipFuncSetAttribute((const void*)fwd, hipFuncAttributeMaxDynamicSharedMemorySize, LDS_BYTES) != hipSuccess) { fprintf(stderr, "kernel_launch: hipFuncSetAttribute failed\n"); grid = -1; return; }
        if (hipOccupancyMaxActiveBlocksPerMultiprocessor(&per_cu, (const void*)fwd, NWAVES * 64, LDS_BYTES) != hipSuccess || per_cu < 1) { fprintf(stderr, "kernel_launch: occupancy query reports %d workgroups per CU\n", per_cu); }
        (void)hipGetLastError();
        grid = cus;
        if (grid != 256) { fprintf(stderr, "kernel_launch: built for 256 CUs, found %d; nothing launched\n", cus); grid = -1; return; }
    }
    if (grid < 0) return;
    if (hipMemsetAsync((char*)d_ws + WS_CTL, 0, CTL_ZERO_BYTES, stream) != hipSuccess) return;
    Args a; memset(&a, 0, sizeof a);
    for (int i = 0; i < 20; ++i) a.in[i] = (const float*)d_in[i];
    a.out = (float*)d_out; a.ws = (unsigned char*)d_ws;
#ifndef MK_SPLIT
    a.ph_lo = 0; a.ph_hi = N_PHASES;
#ifdef PROBE_PHASE
    a.rep_phase = PROBE_PHASE; a.rep_mode = PROBE_MODE;
#else
    a.rep_phase = -1; a.rep_mode = 0;
#endif
    hipLaunchKernelGGL(fwd, dim3(grid), dim3(NWAVES * 64), LDS_BYTES, stream, a);
#else
    for (int ph = 0; ph < N_PHASES; ++ph) { a.ph_lo = ph; a.ph_hi = ph + 1; hipLaunchKernelGGL(fwd, dim3(grid), dim3(NWAVES * 64), LDS_BYTES, stream, a); }
#endif
}
```

```cpp
#include <hip/hip_runtime.h>
#include <cstdio>
#include <cstdint>
#include <cstring>
#include <cmath>
__device__ __forceinline__ int lane_now() { int l; asm volatile("v_mbcnt_lo_u32_b32 %0, -1, 0\n\tv_mbcnt_hi_u32_b32 %0, -1, %0" : "=v"(l)); return l; }
namespace pg8 {
#define PG8_LAS __attribute__((address_space(3)))
typedef unsigned short bf16_t;
typedef short bf16x8 __attribute__((ext_vector_type(8)));
typedef float f32x4 __attribute__((ext_vector_type(4)));
typedef float f32x2 __attribute__((ext_vector_type(2)));
typedef unsigned u32x4 __attribute__((ext_vector_type(4)));
typedef unsigned u32x2 __attribute__((ext_vector_type(2)));
constexpr int BM = 256, BK = 64, HALF = 128, HTB = HALF * BK * 2  , STAGE_BYTES = 8 * HTB, NXCD = 8, WGM = 4;

__host__ __device__ __forceinline__ int lds_byte(int r, int c) { const int st = (r >> 4) * 2 + (c >> 5), rr = r & 15, cc = c & 31, ob = rr * 64 + cc * 2; return st * 1024 + (ob ^ (((ob >> 9) & 1) << 5)); }
__host__ __device__ __forceinline__ void stage_rc(int b, int& R, int& C) { const int st = b / 1024, sb = b % 1024, swz = sb ^ (((sb >> 9) & 1) << 5); R = (st >> 1) * 16 + swz / 64; C = (st & 1) * 32 + (swz % 64) / 2; }
__host__ __device__ __forceinline__ int perm32(int rho) { const int n = rho >> 4, i = rho & 15; return 8 * (i >> 2) + 4 * n + (i & 3); }

struct Unit { int pm, pn; const char* A; const char* B; int e, rtl; };
struct Gemm { int lda, ldb, K; };

struct DenseOrder {
    int nM, nN, nwg, G, c; const char* A; const char* B; size_t tsA, tsB;
    __device__ __forceinline__ void init(int nM_, int nN_, int G_, int c_, const void* A_, size_t tsA_, const void* B_, size_t tsB_) { nM = nM_; nN = nN_; nwg = nM * nN; G = G_; c = c_; A = (const char*)A_; B = (const char*)B_; tsA = tsA_; tsB = tsB_; }
    __device__ __forceinline__ bool tile(int i, int& pm, int& pn) const {
        const long L = (long)i * G + c; if (L >= nwg) return false;
        int wgid = (int)L; { const int q = nwg / NXCD, r = nwg % NXCD, xcd = wgid % NXCD, off = wgid / NXCD; wgid = (xcd < r ? xcd * (q + 1) : r * (q + 1) + (xcd - r) * q) + off; }
        const int nig = WGM * nN, gid = wgid / nig, fm = gid * WGM, gsz = (nM - fm) < WGM ? (nM - fm) : WGM;
        pm = fm + ((wgid % nig) % gsz); pn = (wgid % nig) / gsz; return true;
    }
    __device__ __forceinline__ bool next(int i, Unit& u) const { if (!tile(i, u.pm, u.pn)) return false; u.A = A + (size_t)u.pm * tsA; u.B = B + (size_t)u.pn * tsB; u.e = 0; u.rtl = 0; return true; }
    __device__ __forceinline__ const PG8_LAS unsigned char* table(int) const { return nullptr; }
};

__device__ __forceinline__ unsigned cvt_pk_bf16(float lo, float hi) { unsigned r; asm volatile("s_nop 0\n\tv_cvt_pk_bf16_f32 %0, %1, %2" : "=v"(r) : "v"(lo), "v"(hi)); return r; }
__device__ __forceinline__ float bflo(unsigned w) { return __uint_as_float(w << 16); }
__device__ __forceinline__ float bfhi(unsigned w) { return __uint_as_float(w & 0xffff0000u); }
__device__ __forceinline__ float fsigmoid(float x) { return __builtin_amdgcn_rcpf(1.0f + __builtin_amdgcn_exp2f(-1.4426950408889634f * x)); }

__device__ __forceinline__ const char* uni_ptr(const char* p) { const unsigned long long v = (unsigned long long)p; const unsigned lo = __builtin_amdgcn_readfirstlane((unsigned)v), hi = __builtin_amdgcn_readfirstlane((unsigned)(v >> 32)); return (const char*)(((unsigned long long)hi << 32) | lo); }
__device__ __forceinline__ void uni_unit(Unit& u) { u.pm = __builtin_amdgcn_readfirstlane(u.pm); u.pn = __builtin_amdgcn_readfirstlane(u.pn); u.e = __builtin_amdgcn_readfirstlane(u.e); u.rtl = __builtin_amdgcn_readfirstlane(u.rtl); u.A = uni_ptr(u.A); u.B = uni_ptr(u.B); }
struct NoHook { static constexpr bool ON = false; static constexpr int AT = -1; template <class A> __device__ __forceinline__ void operator()(A&, const Unit&, int, int, int, int) const {} };
template <class Epi, class Sched, bool ALIGN_EPI, bool GATHER, int ES = 2, class Hook = NoHook>
__device__ __forceinline__ void gemm_phase(PG8_LAS unsigned char* lds, const Gemm g, const Sched& S, const Epi& E, int wave, const Hook& H = Hook()) {
    int tid = wave * 64 + lane_now(); asm volatile("" : "+v"(tid));
    const int wid = __builtin_amdgcn_readfirstlane(tid >> 6), lane = tid & 63, wr = wid >> 2, wc = wid & 3, fr = lane & 15, fq = lane >> 4;
    const int K = g.K, nt = K * ES / (BK * 2);
    unsigned voffA[2], voffB[2];
#pragma unroll
    for (int i = 0; i < 2; ++i) { int R, C; stage_rc(tid * 16 + i * 8192, R, C); const int Rb = Epi::PERM ? ((R & ~31) + perm32(R & 31)) : R;
        voffA[i] = (unsigned)(R * g.lda * ES + C * 2); voffB[i] = (unsigned)(Rb * g.ldb * ES + C * 2); }
    const size_t kstep = (size_t)(BK * 2);
    const size_t hstepA = GATHER ? (size_t)0 : (size_t)HALF * g.lda * ES;
    const size_t hstepB = (size_t)HALF * g.ldb * ES;
    const unsigned ldsw = (unsigned)wid * 1024u;
    const int aoff = lds_byte(wr * 64 + fr, fq * 8), boff = lds_byte(wc * 32 + fr, fq * 8);
    unsigned vA[2][2], nvA[2][2];
#define PG8_ROWS(dst, uidx) do { int t_ = wave * 64 + lane_now(); asm volatile("" : "+v"(t_)); int R0_, C0_; stage_rc(t_ * 16, R0_, C0_); \
        const PG8_LAS unsigned char* _t = S.table(uidx) + (unsigned)R0_ * 4u; const unsigned c2_ = (unsigned)C0_ * 2u; _Pragma("unroll") for (int h = 0; h < 2; ++h) _Pragma("unroll") for (int i = 0; i < 2; ++i) \
        dst[h][i] = *(const PG8_LAS unsigned*)(_t + h * 512 + i * 256) + c2_; } while (0)
#define PG8_SA(b, h) (((b) * 2 + (h)) * HTB)
#define PG8_SB(b, h) ((4 + (b) * 2 + (h)) * HTB)
#define PG8_STAGE(bufoff, gbase, voff) do { const char* _gb = (const char*)(gbase); asm volatile("" : "+s"(_gb));     \
        _Pragma("unroll") for (int _i = 0; _i < 2; ++_i) { const unsigned _la = (unsigned)__builtin_amdgcn_readfirstlane((int)(unsigned)(uintptr_t)(lds + (bufoff) + ldsw + _i * 8192)); \
            asm volatile("s_mov_b32 m0, %2\n\ts_nop 0\n\tglobal_load_lds_dwordx4 %0, %1" :: "v"((voff)[_i]), "s"(_gb), "s"(_la) : "memory", "m0"); } } while (0)
#define PG8_STB(b, h, ptr) PG8_STAGE(PG8_SB(b, h), (ptr) + (h) * hstepB, voffB)
#define PG8_STA(b, h, ptr, nx) do { if constexpr (GATHER) { unsigned _v[2]; _v[0] = (nx) ? nvA[h][0] : vA[h][0]; _v[1] = (nx) ? nvA[h][1] : vA[h][1]; PG8_STAGE(PG8_SA(b, h), (ptr), _v); } \
        else { PG8_STAGE(PG8_SA(b, h), (ptr) + (h) * hstepA, voffA); } } while (0)
#define PG8_LDA(dst, b, h) do { _Pragma("unroll") for (int m = 0; m < 4; ++m) _Pragma("unroll") for (int k = 0; k < 2; ++k) dst[m][k] = *(const PG8_LAS bf16x8*)(lds + PG8_SA(b, h) + aoff + m * 2048 + k * 1024); } while (0)
#define PG8_LDB(dst, b, h) do { _Pragma("unroll") for (int n = 0; n < 2; ++n) _Pragma("unroll") for (int k = 0; k < 2; ++k) dst[n][k] = *(const PG8_LAS bf16x8*)(lds + PG8_SB(b, h) + boff + n * 2048 + k * 1024); } while (0)
#define PG8_MMA(ai, bj, At, Bt, Z) do { const f32x4 z4_ = {0.f, 0.f, 0.f, 0.f}; __builtin_amdgcn_s_setprio(1); _Pragma("unroll") for (int m = 0; m < 4; ++m) _Pragma("unroll") for (int n = 0; n < 2; ++n) { \
        if constexpr (ES == 2) { acc[ai][bj][m][n] = __builtin_amdgcn_mfma_f32_16x16x32_bf16(Bt[n][0], At[m][0], (Z) ? z4_ : acc[ai][bj][m][n], 0, 0, 0); acc[ai][bj][m][n] = __builtin_amdgcn_mfma_f32_16x16x32_bf16(Bt[n][1], At[m][1], acc[ai][bj][m][n], 0, 0, 0); } \
        else { typedef int v8i_ __attribute__((ext_vector_type(8))); const u32x4 b0_ = __builtin_bit_cast(u32x4, Bt[n][0]), b1_ = __builtin_bit_cast(u32x4, Bt[n][1]), a0_ = __builtin_bit_cast(u32x4, At[m][0]), a1_ = __builtin_bit_cast(u32x4, At[m][1]); \
            const v8i_ bv_ = {(int)b0_[0], (int)b0_[1], (int)b0_[2], (int)b0_[3], (int)b1_[0], (int)b1_[1], (int)b1_[2], (int)b1_[3]}, av_ = {(int)a0_[0], (int)a0_[1], (int)a0_[2], (int)a0_[3], (int)a1_[0], (int)a1_[1], (int)a1_[2], (int)a1_[3]}; \
            acc[ai][bj][m][n] = __builtin_amdgcn_mfma_scale_f32_16x16x128_f8f6f4(bv_, av_, (Z) ? z4_ : acc[ai][bj][m][n], 0, 0, 0, 0, 0, 0); } }     \
        __builtin_amdgcn_s_setprio(0); \
        _Pragma("unroll") for (int m = 0; m < 4; ++m) asm volatile("" : "+v"(acc[ai][bj][m][0]), "+v"(acc[ai][bj][m][1]));     \
        } while (0)
#define PG8_WAIT_V(n) asm volatile("s_waitcnt vmcnt(" #n ")" ::: "memory")
#define PG8_WAIT_L(n) asm volatile("s_waitcnt lgkmcnt(" #n ")" ::: "memory")
#define PG8_BAR __builtin_amdgcn_s_barrier()
#define PG8_SCHED __builtin_amdgcn_sched_barrier(0)
    Unit cur, nxt; int ui = 0;
    if (!S.next(0, cur)) return;
    uni_unit(cur);
    f32x4 acc[2][2][4][2];
    bf16x8 At[4][2], B0[2][2], B1[2][2];
    const char* cA = cur.A; const char* cB = cur.B;
    if constexpr (GATHER) { PG8_ROWS(vA, 0); }
    PG8_STB(0, 0, cB); PG8_STB(0, 1, cB); PG8_STA(0, 0, cA, false); PG8_STA(0, 1, cA, false);
    if (wr == 1) PG8_BAR;
    PG8_WAIT_V(2); PG8_BAR;
    PG8_STB(1, 0, cB + kstep); PG8_STA(1, 0, cA + kstep, false); PG8_STB(1, 1, cB + kstep);
    PG8_WAIT_V(6); PG8_BAR;
    for (;;) {
        const bool has_next = S.next(ui + 1, nxt);
        if (has_next) uni_unit(nxt);
        const char* nA = has_next ? nxt.A : cA; const char* nB = has_next ? nxt.B : cB;
#define PG8_KPAIR(t, LAST, ZERO) do { \
            const char* a1 = cA + (size_t)((t) + 1) * kstep; \
            const char* a2 = (LAST) ? nA : cA + (size_t)((t) + 2) * kstep; const char* b2 = (LAST) ? nB : cB + (size_t)((t) + 2) * kstep; \
            const char* a3 = a2 + kstep; const char* b3 = b2 + kstep; \
              \
            PG8_LDB(B0, 0, 0); PG8_LDB(B1, 0, 1); PG8_SCHED; PG8_LDA(At, 0, 0); PG8_STA(1, 1, a1, false); \
            PG8_WAIT_V(8); PG8_WAIT_L(0); PG8_BAR; PG8_MMA(0, 0, At, B0, ZERO); PG8_MMA(0, 1, At, B1, ZERO); PG8_BAR; PG8_SCHED; \
              \
            PG8_LDA(At, 0, 1); PG8_STB(0, 0, b2); PG8_STB(0, 1, b2); PG8_STA(0, 0, a2, LAST); \
            PG8_WAIT_V(8); PG8_WAIT_L(0); PG8_BAR; PG8_MMA(1, 0, At, B0, ZERO); PG8_MMA(1, 1, At, B1, ZERO); PG8_BAR; PG8_SCHED; \
              \
            PG8_LDB(B0, 1, 0); PG8_LDB(B1, 1, 1); PG8_SCHED; PG8_LDA(At, 1, 0); PG8_STA(0, 1, a2, LAST); \
            PG8_WAIT_V(8); PG8_WAIT_L(0); PG8_BAR; PG8_MMA(0, 0, At, B0, false); PG8_MMA(0, 1, At, B1, false); PG8_BAR; PG8_SCHED; \
              \
            PG8_LDA(At, 1, 1); PG8_STB(1, 0, b3); PG8_STB(1, 1, b3); PG8_STA(1, 0, a3, LAST); \
            PG8_WAIT_V(8); PG8_WAIT_L(0); PG8_BAR; PG8_MMA(1, 0, At, B0, false); PG8_MMA(1, 1, At, B1, false); PG8_BAR; PG8_SCHED; } while (0)
        PG8_KPAIR(0, false, true);
        _Pragma("nounroll") for (int t = 2; t < nt - 2; t += 2) { PG8_KPAIR(t, false, false); if constexpr (Hook::ON) { if (t == Hook::AT) H(acc, cur, wr, wc, fr, fq); } }
        if constexpr (GATHER) {
            if (has_next) { PG8_ROWS(nvA, ui + 1); }
            else {
#pragma unroll
                for (int h = 0; h < 2; ++h)
#pragma unroll
                    for (int i = 0; i < 2; ++i) nvA[h][i] = vA[h][i]; }
        }
        PG8_KPAIR(nt - 2, true, false);
#undef PG8_KPAIR
        if constexpr (ALIGN_EPI) { if (wr == 0) PG8_BAR; }
        E(acc, cur, wr, wc, fr, fq);
        if (!has_next) break;
        cur = nxt; cA = nA; cB = nB; ++ui;
        if constexpr (GATHER) {
#pragma unroll
            for (int h = 0; h < 2; ++h)
#pragma unroll
                for (int i = 0; i < 2; ++i) vA[h][i] = nvA[h][i];
        }
        if constexpr (ALIGN_EPI) { if (wr == 1) PG8_BAR; }
    }
    PG8_WAIT_V(0);
    if constexpr (!ALIGN_EPI) { if (wr == 0) PG8_BAR; }
    PG8_BAR;
#undef PG8_SA
#undef PG8_SB
#undef PG8_STAGE
#undef PG8_STB
#undef PG8_ROWS
#undef PG8_STA
#undef PG8_LDA
#undef PG8_LDB
#undef PG8_MMA
#undef PG8_WAIT_V
#undef PG8_WAIT_L
#undef PG8_BAR
#undef PG8_SCHED
}
}

constexpr int NWAVES = 8;
constexpr int NT = 32768, DM = 1024, SEQ = 2048, NBATCH = 16, INW = 3080, NE = 32, PLE = 256;
constexpr float EPS = 1e-6f;
constexpr float LOG2E = 1.4426950408889634f;
constexpr float C2 = 0.125f * 1.4426950408889634f;
constexpr int N1 = 5120;
constexpr int MAXRT = 576;
constexpr int MAXUNITS = 24;

constexpr size_t MiB = 1u << 20;
constexpr size_t WS_CTL = 0, CTL_ZERO_BYTES = 1 * MiB;
constexpr size_t WS_TOK = 2 * MiB;
constexpr size_t WS_RSOF = 6 * MiB;
constexpr size_t WS_TOPE = 10 * MiB;
constexpr size_t WS_TOPW = 10 * MiB + 512 * 1024;
constexpr size_t WS_POS = 11 * MiB;
constexpr size_t WS_LOGF = 12 * MiB;
constexpr size_t WS_CUM = 13 * MiB;
constexpr size_t WS_ROT = 14 * MiB;
constexpr size_t WS_RSTD2 = 14 * MiB + 512 * 1024;
constexpr size_t WS_WRT = 15 * MiB;
constexpr size_t WS_W1T = 16 * MiB;
constexpr size_t WS_WBT = 26 * MiB;
constexpr size_t WS_WOT = 28 * MiB;
constexpr size_t WS_WPGT = 30 * MiB;
constexpr size_t WS_WPPT = 32 * MiB;
constexpr size_t WS_WGUT = 34 * MiB;
constexpr size_t WS_WDT = 162 * MiB;
constexpr size_t WS_HB = 226 * MiB;
constexpr size_t WS_PB = 291 * MiB;
constexpr size_t WS_Z = 307 * MiB;
constexpr size_t WS_XN = WS_Z, WS_FQ = WS_Z + 64 * MiB, WS_FK = WS_Z + 96 * MiB, WS_FV = WS_Z + 128 * MiB, WS_RQ = WS_Z + 160 * MiB, WS_RK = WS_Z + 176 * MiB;
constexpr size_t WS_RV = WS_Z + 192 * MiB, WS_RGS = WS_Z + 224 * MiB, WS_GATES = WS_Z + 256 * MiB, WS_BR = WS_Z + 384 * MiB, WS_MERGED = WS_Z + 448 * MiB;
constexpr size_t WS_RKT = WS_Z + 512 * MiB;
constexpr size_t WS_XN8 = WS_Z + 528 * MiB;
constexpr size_t WS_WG8T = WS_W1T + 4 * MiB;
constexpr size_t WS_H2B = WS_Z + 448 * MiB;
constexpr size_t WS_MO = WS_Z + 512 * MiB;
constexpr size_t WS_ACT = WS_Z, WS_Y = WS_Z + 144 * MiB;
constexpr size_t WS_HB2 = WS_Z, WS_PJ = WS_Z + 384 * MiB, WS_G8 = WS_Z + 160 * MiB;
constexpr size_t WS_END = WS_Z + 576 * MiB;
constexpr int CW_BAR = 4096;
constexpr int CW_CNT = 8192;
constexpr int CW_QUEUE = 8256;
constexpr int CW_SSQ = 16384;
static_assert((CW_SSQ + NT) * 4 <= (int)CTL_ZERO_BYTES, "CTL words inside the memset region");

constexpr int RING_OFF = 0, RING_BYTES = 131072;
constexpr int TAB_OFF = RING_BYTES;
constexpr int SCH_OFF = TAB_OFF + MAXUNITS * 1024;
constexpr int SCH_CNT = SCH_OFF, SCH_P = SCH_OFF + 128, SCH_RT2E = SCH_OFF + 128 + 160;
constexpr int MISC_OFF = SCH_RT2E + MAXRT * 4;
constexpr int LDS_BYTES = 163840;
static_assert(MISC_OFF + 256 <= LDS_BYTES && (MISC_OFF % 16) == 0, "LDS map");

#define GAS __attribute__((address_space(1)))
#define LAS __attribute__((address_space(3)))
typedef unsigned short bf16;
typedef unsigned v4u __attribute__((ext_vector_type(4)));
typedef unsigned v2u __attribute__((ext_vector_type(2)));
typedef float f32x4 __attribute__((ext_vector_type(4)));
typedef short bf16x8 __attribute__((ext_vector_type(8)));
typedef GAS unsigned gu32;
#define RLX_AGENT __ATOMIC_RELAXED, __HIP_MEMORY_SCOPE_AGENT
#define LDS_WAIT() asm volatile("s_waitcnt lgkmcnt(0)" ::: "memory")
#define VM_WAIT() asm volatile("s_waitcnt vmcnt(0)" ::: "memory")
__device__ __forceinline__ unsigned f2bf(float f) { unsigned u = __builtin_bit_cast(unsigned, f); return (u + 0x7fffu + ((u >> 16) & 1u)) >> 16; }
__device__ __forceinline__ unsigned pk2(float lo, float hi) { return f2bf(lo) | (f2bf(hi) << 16); }
using pg8::bflo; using pg8::bfhi; using pg8::fsigmoid; using pg8::cvt_pk_bf16;
constexpr float WSCALE = 32.f;
constexpr float YSCALE = 8.f;
__device__ __forceinline__ float clamp_f8(float v) { return fminf(fmaxf(v, -448.f), 448.f); }
__device__ __forceinline__ v2u pack8_fp8(const f32x4 a, const f32x4 b) {
    int w0 = 0, w1 = 0;
    w0 = __builtin_amdgcn_cvt_pk_fp8_f32(clamp_f8(a[0]), clamp_f8(a[1]), w0, false); w0 = __builtin_amdgcn_cvt_pk_fp8_f32(clamp_f8(a[2]), clamp_f8(a[3]), w0, true);
    w1 = __builtin_amdgcn_cvt_pk_fp8_f32(clamp_f8(b[0]), clamp_f8(b[1]), w1, false); w1 = __builtin_amdgcn_cvt_pk_fp8_f32(clamp_f8(b[2]), clamp_f8(b[3]), w1, true);
    return (v2u){(unsigned)w0, (unsigned)w1}; }
#define DPP_F(v, ctrl) __int_as_float(__builtin_amdgcn_update_dpp(0, __float_as_int(v), (ctrl), 0xF, 0xF, false))
__device__ __forceinline__ float wave_sum(float v) {
    v += DPP_F(v, 0xB1); v += DPP_F(v, 0x4E); v += DPP_F(v, 0x141); v += DPP_F(v, 0x140);
    const int b = __float_as_int(v);
    return (__int_as_float(__builtin_amdgcn_readlane(b, 0)) + __int_as_float(__builtin_amdgcn_readlane(b, 16))) + (__int_as_float(__builtin_amdgcn_readlane(b, 32)) + __int_as_float(__builtin_amdgcn_readlane(b, 48)));
}
__device__ __forceinline__ float xor32_sum(float v) { auto rr = __builtin_amdgcn_permlane32_swap(__float_as_uint(v), __float_as_uint(v), false, false); return __uint_as_float(rr[0]) + __uint_as_float(rr[1]); }
__device__ __forceinline__ float xor16_sum(float v) { auto rr = __builtin_amdgcn_permlane16_swap(__float_as_uint(v), __float_as_uint(v), false, false); return __uint_as_float(rr[0]) + __uint_as_float(rr[1]); }

#define XB_TMO      128
#define XB_XCNT(j)  (256  + 64 * (j))
#define XB_XSUB(j)  (1280 + 64 * (j))
#define XB_XGEN(j)  (2304 + 64 * (j))
#define XB_TOP      3328
#define XB_TOPGEN   3392
#define XCD_BAR_WORDS 3456
#define XB_SPIN_CAP (1u << 20)

__device__ __forceinline__ unsigned xb_ld(unsigned* p)              { return __hip_atomic_load(p, __ATOMIC_RELAXED, __HIP_MEMORY_SCOPE_AGENT); }
__device__ __forceinline__ unsigned xb_add(unsigned* p, unsigned v) { return __hip_atomic_fetch_add(p, v, __ATOMIC_RELAXED, __HIP_MEMORY_SCOPE_AGENT); }
__device__ __forceinline__ unsigned xb_xcc_id() { return (unsigned)__builtin_amdgcn_s_getreg((3 << 11) | 20) & 0xFu; }
#define XB_SPIN(cond, bar) do { unsigned _sp = 0; while (cond) { __builtin_amdgcn_s_sleep(1); \
    if ((++_sp & 255u) == 0u) { if (xb_ld(&(bar)[XB_TMO])) break; if (_sp > XB_SPIN_CAP) { atomicAdd(&(bar)[XB_TMO], 1u); break; } } } } while (0)

struct XcdBarrier {
    unsigned* bar; unsigned x;
    volatile LAS unsigned* st;
};
__device__ __forceinline__ XcdBarrier xcd_barrier_post(unsigned* bar, volatile LAS unsigned* st, int tid) {
    XcdBarrier b; b.bar = bar; b.x = xb_xcc_id(); b.st = st;
    if (tid == 0) (void)xb_add(&bar[XB_XCNT(b.x)], 1u);
    return b;
}
__device__ __forceinline__ void xcd_barrier_complete(unsigned* bar, unsigned x, unsigned& nloc, unsigned& nx) {
    const unsigned G = gridDim.x * gridDim.y * gridDim.z;
    unsigned sum, cnt, mine, sp = 0u;
    for (;;) {
        sum = 0u; cnt = 0u; mine = 0u;
#pragma unroll
        for (unsigned j = 0; j < 16; ++j) { const unsigned c = xb_ld(&bar[XB_XCNT(j)]); sum += c; cnt += (c > 0u) ? 1u : 0u; mine = (j == x) ? c : mine; }
        if (sum == G) break;
        __builtin_amdgcn_s_sleep(1);
        if ((++sp & 255u) == 0u) { if (xb_ld(&bar[XB_TMO])) break; if (sp > XB_SPIN_CAP) { atomicAdd(&bar[XB_TMO], 1u); break; } }
    }
    nloc = mine > 0u ? mine : 1u; nx = cnt > 0u ? cnt : 1u;
}
__device__ __forceinline__ void xcd_barrier(const XcdBarrier& b, int tid) {
    asm volatile("s_waitcnt vmcnt(0)" ::: "memory");
    __syncthreads();
    if (tid == 0) {
        unsigned* bar = b.bar;
        __builtin_amdgcn_s_waitcnt(0);
        unsigned nloc = b.st[0], nx = b.st[1];
        if (nloc == 0u) { xcd_barrier_complete(bar, b.x, nloc, nx); b.st[0] = nloc; b.st[1] = nx; }
        const unsigned old = xb_add(&bar[XB_XSUB(b.x)], 1u);
        const unsigned gen = old / nloc;
        if (old + 1u == (gen + 1u) * nloc) {
            __builtin_amdgcn_fence(__ATOMIC_RELEASE, "agent");
            asm volatile("s_waitcnt vmcnt(0)" ::: "memory");
            const unsigned og = xb_add(&bar[XB_TOP], 1u);
            const unsigned tg = og / nx;
            if (og + 1u == (tg + 1u) * nx) xb_add(&bar[XB_TOPGEN], 1u);
            else XB_SPIN(xb_ld(&bar[XB_TOPGEN]) == tg, bar);
            __builtin_amdgcn_fence(__ATOMIC_ACQUIRE, "agent");
            xb_add(&bar[XB_XGEN(b.x)], 1u);
            asm volatile("s_waitcnt vmcnt(0)" ::: "memory");
        } else {
            XB_SPIN(xb_ld(&bar[XB_XGEN(b.x)]) == gen, bar);
            __builtin_amdgcn_fence(__ATOMIC_ACQUIRE, "agent");
            asm volatile("s_waitcnt vmcnt(0)" ::: "memory");
        }
    }
    __syncthreads();
}

struct Args { const float* in[20]; float* out; unsigned char* ws; int ph_lo, ph_hi, rep_phase, rep_mode; };
struct Frame {
    LAS unsigned char* lds;
    volatile LAS unsigned* MISC;
    int tid, lane, wave;
    int vcu, G;
    const __attribute__((address_space(4))) Args* ap;
};
#define REARGS() do { F.ap = (const __attribute__((address_space(4))) Args*)__builtin_amdgcn_kernarg_segment_ptr(); asm volatile("" : "+s"(F.ap)); } while (0)
#define WSP(T, off) ((T*)(F.ap->ws + (off)))

#include <hip/hip_bf16.h>
namespace attn_body {
using bf16=__hip_bfloat16;
using bf16x8=__attribute__((ext_vector_type(8)))short;
using s16x4=__attribute__((ext_vector_type(4)))short;
using f32x16=__attribute__((ext_vector_type(16)))float;
using u32x4=__attribute__((ext_vector_type(4)))unsigned;
constexpr int BATCH=16,NHEAD=8,SEQ=2048,D=64,DM=NHEAD*D,OPITCH=1024;
constexpr int NW=8,QBLK=32,QB=QBLK*NW,KVBLK=64,NQB=SEQ/QB;
constexpr int ATTN_PITCH=DM, ATTN_UNIT_ROWS=QB;
__device__ __forceinline__ int crow(int r,int hi){return (r&3)+8*(r>>2)+4*hi;}
#define SBAR() __builtin_amdgcn_sched_barrier(0)
__device__ __forceinline__ void cmask(f32x16&p0,f32x16&p1,int jb,int qrel,int hi){
  const float NEG=-INFINITY; int kb=64*jb+4*hi;
  #pragma unroll
  for(int r=0;r<16;++r){int kv=kb+(r&3)+8*(r>>2); if(kv>qrel)p0[r]=NEG; if(kv+32>qrel)p1[r]=NEG;}
}

constexpr int NSLOT=3, SLOTB=8192;
constexpr int LDS_K=0, LDS_V=NSLOT*SLOTB, LDS_WS=2*NSLOT*SLOTB, LDS_OST=LDS_WS+NW*64*4, LDS_KB=LDS_OST+NW*4096, LDS_BYTES=LDS_KB+SEQ*16;
constexpr float C2=0.125f*1.4426950408889634f;
__device__ __forceinline__ void glds16(const void*gsrc,unsigned lds_dst){unsigned keep;
  asm volatile("s_mov_b32 %0, m0\n\ts_mov_b32 m0, %2\n\ts_nop 0\n\tglobal_load_lds_dwordx4 %1, off\n\ts_mov_b32 m0, %0":"=&s"(keep):"v"(gsrc),"s"(lds_dst):"memory");}
__device__ __forceinline__ float max3f(float a,float b,float c){float r;asm("v_max3_f32 %0, %1, %2, %3":"=v"(r):"v"(a),"v"(b),"v"(c));return r;}
__device__ __forceinline__ float max2f(float a,float b){float r;asm("v_max_f32_e32 %0, %1, %2":"=v"(r):"v"(a),"v"(b));return r;}
__device__ __forceinline__ float fadd_s(float a,float b){float r;asm("v_add_f32_e32 %0, %1, %2":"=v"(r):"v"(a),"v"(b));return r;}
__device__ __forceinline__ float fsub_s(float a,float b){float r;asm("v_sub_f32_e32 %0, %1, %2":"=v"(r):"v"(a),"v"(b));return r;}
typedef float f32x2_t __attribute__((ext_vector_type(2))); typedef __bf16 bf16x2_t __attribute__((ext_vector_type(2)));
__device__ __forceinline__ unsigned cvtpk_s(float lo,float hi){f32x2_t v={lo,hi};bf16x2_t b=__builtin_convertvector(v,bf16x2_t);return __builtin_bit_cast(unsigned,b);}
#define WAIT_BAR(N) asm volatile("s_waitcnt vmcnt(" #N ") lgkmcnt(0)\n\ts_barrier":::"memory")

__device__ __forceinline__ void qkt(f32x16&p0,f32x16&p1,const char*Kslot,const bf16x8*qr,const bf16x8 qx,const bf16x8 kb0,const bf16x8 kb1,int r32,int hi){
  const f32x16 zc=f32x16{};
  const char*kb=Kslot+hi*1024+r32*16;
  #pragma unroll
  for(int d0=0;d0<4;++d0){
    const bf16x8 b0=*reinterpret_cast<const bf16x8*>(kb+d0*2048);
    const bf16x8 b1=*reinterpret_cast<const bf16x8*>(kb+d0*2048+512);
    if(d0==0){p0=__builtin_amdgcn_mfma_f32_32x32x16_bf16(b0,qr[0],zc,0,0,0);p1=__builtin_amdgcn_mfma_f32_32x32x16_bf16(b1,qr[0],zc,0,0,0);}
    else{p0=__builtin_amdgcn_mfma_f32_32x32x16_bf16(b0,qr[d0],p0,0,0,0);p1=__builtin_amdgcn_mfma_f32_32x32x16_bf16(b1,qr[d0],p1,0,0,0);}}
  p0=__builtin_amdgcn_mfma_f32_32x32x16_bf16(kb0,qx,p0,0,0,0);p1=__builtin_amdgcn_mfma_f32_32x32x16_bf16(kb1,qx,p1,0,0,0);
}
typedef __attribute__((address_space(3))) const char* lds_cptr;
typedef short v4i16_t __attribute__((ext_vector_type(4)));
__device__ __forceinline__ void kload8(bf16x8*kf,lds_cptr kp){
  kf[0]=*(const __attribute__((address_space(3))) bf16x8*)(kp);      kf[1]=*(const __attribute__((address_space(3))) bf16x8*)(kp+512);
  kf[2]=*(const __attribute__((address_space(3))) bf16x8*)(kp+2048); kf[3]=*(const __attribute__((address_space(3))) bf16x8*)(kp+2560);
  kf[4]=*(const __attribute__((address_space(3))) bf16x8*)(kp+4096); kf[5]=*(const __attribute__((address_space(3))) bf16x8*)(kp+4608);
  kf[6]=*(const __attribute__((address_space(3))) bf16x8*)(kp+6144); kf[7]=*(const __attribute__((address_space(3))) bf16x8*)(kp+6656);
}
__device__ __forceinline__ void kload2(bf16x8*kf,lds_cptr kp,int j){ kf[2*j]=*(const __attribute__((address_space(3))) bf16x8*)(kp+j*2048); kf[2*j+1]=*(const __attribute__((address_space(3))) bf16x8*)(kp+j*2048+512); }
__device__ __forceinline__ s16x4 vtr(lds_cptr p){ return __builtin_bit_cast(s16x4,__builtin_amdgcn_ds_read_tr16_b64_v4i16((__attribute__((address_space(3))) v4i16_t*)p)); }
__device__ __forceinline__ float rowmax(const f32x16&p0,const f32x16&p1){
  float a=max3f(p0[0],p0[1],p1[0]),b=max3f(p0[2],p0[3],p1[1]);a=max3f(a,p1[2],p1[3]);
  #pragma unroll
  for(int r=4;r<16;r+=4){a=max3f(a,p0[r],p0[r+1]);b=max3f(b,p0[r+2],p0[r+3]);a=max3f(a,p1[r],p1[r+1]);b=max3f(b,p1[r+2],p1[r+3]);}
  const float m=max2f(a,b);
  auto rr=__builtin_amdgcn_permlane32_swap(__float_as_uint(m),__float_as_uint(m),false,false);
  return max2f(__uint_as_float(rr[0]),__uint_as_float(rr[1]));
}
__device__ __forceinline__ void pv(f32x16*o,int vb,bf16x8 pa0,bf16x8 pa1,bf16x8 pa2,bf16x8 pa3){
  #pragma unroll
  for(int d0=0;d0<2;++d0){s16x4 lo[4],hi[4];
    #pragma unroll
    for(int ks=0;ks<4;++ks){
      asm volatile("ds_read_b64_tr_b16 %0,%1 offset:%c2":"=&v"(lo[ks]):"v"(vb),"i"(d0*4096+ks*1024):"memory");
      asm volatile("ds_read_b64_tr_b16 %0,%1 offset:%c2":"=&v"(hi[ks]):"v"(vb),"i"(d0*4096+ks*1024+512):"memory");}
    asm volatile("s_waitcnt lgkmcnt(0)":::"memory");SBAR();
    #define PK(k) (bf16x8){lo[k][0],lo[k][1],lo[k][2],lo[k][3],hi[k][0],hi[k][1],hi[k][2],hi[k][3]}
    o[d0]=__builtin_amdgcn_mfma_f32_32x32x16_bf16(pa0,PK(0),o[d0],0,0,0);
    o[d0]=__builtin_amdgcn_mfma_f32_32x32x16_bf16(pa1,PK(1),o[d0],0,0,0);
    o[d0]=__builtin_amdgcn_mfma_f32_32x32x16_bf16(pa2,PK(2),o[d0],0,0,0);
    o[d0]=__builtin_amdgcn_mfma_f32_32x32x16_bf16(pa3,PK(3),o[d0],0,0,0);
    #undef PK
  }
}

__device__ __forceinline__ void split3(float v,unsigned&a,unsigned&b,unsigned&c){ a=cvtpk_s(v,0.f)&0xffffu; const float r1=v-__uint_as_float(a<<16); b=cvtpk_s(r1,0.f)&0xffffu; const float r2=r1-__uint_as_float(b<<16); c=cvtpk_s(r2,0.f)&0xffffu; }
__device__ __forceinline__ bf16x8 make_qx(float m,int hi){ unsigned a,b,c; split3(m,a,b,c); u32x4 w={0x3F803F80u,0x3F80u|(a<<16),b|(c<<16),0u}; if(hi)w=(u32x4){0u,0u,0u,0u}; return __builtin_bit_cast(bf16x8,w); }
#ifndef ATTN_STORE16
#define ATTN_STORE16(p,v) (*(u32x4*)(p)=(v))
#endif
template<int THRL> __device__ __forceinline__ void attn_unit(int b,int h,int qb,const bf16*Q,const bf16*__restrict__ K,const bf16*__restrict__ V,bf16*O,const float*__restrict__ cum,char*shm,int wave){
  int tid=wave*64+lane_now(); asm volatile("":"+v"(tid));
  const int lane=tid&63,r32=lane&31,hi=lane>>5; const int wid=__builtin_amdgcn_readfirstlane(tid>>6);
  const long rowbase=(long)b*SEQ; const int q0=qb*QB;
  const bf16*Qw=Q+(rowbase+q0+wid*QBLK)*DM+h*D;
  const bf16*Kh=K+rowbase*DM+h*D,*Vh=V+rowbase*DM+h*D;
  const unsigned lds0=(unsigned)(uintptr_t)shm;
  float*wsf=(float*)(shm+LDS_WS)+wid*64;
  const bf16*ksrc=Kh+(long)lane*DM+wid*8;
  const bf16*vsrc=Vh+(long)(16*(wid&3)+(lane>>2))*DM+(wid>>2)*32+(lane&3)*8;
  const unsigned kdst=lds0+LDS_K+wid*1024, vdst=lds0+LDS_V+wid*1024;
  #define DMA_K(t,slot) glds16(ksrc+(long)(t)*KVBLK*DM,(unsigned)__builtin_amdgcn_readfirstlane(kdst+(slot)))
  #define DMA_V(t,slot) glds16(vsrc+(long)(t)*KVBLK*DM,(unsigned)__builtin_amdgcn_readfirstlane(vdst+(slot)))
  const int vb0=(int)(lds0+LDS_V)+((lane>>4)&1)*32+(lane&3)*8+(4*hi+((lane&15)>>2))*64;
  const char*Kbase=shm+LDS_K; bf16x8 kf[8];
  const lds_cptr shm3=(lds_cptr)shm; const lds_cptr kp0=shm3+LDS_K+hi*1024+r32*16; const lds_cptr vp0=shm3+LDS_V+((lane>>4)&1)*32+(lane&3)*8+(4*hi+((lane&15)>>2))*64;
  const int NT=(q0+QB)/KVBLK;
  const lds_cptr kbp=shm3+LDS_KB+r32*16;
  DMA_K(0,0);DMA_V(0,0);DMA_K(1,SLOTB);
  { const float cref=cum[q0+QB-1];
    for(int kv=tid;kv<q0+QB;kv+=NW*64){ unsigned a,bb,c; split3((cref-cum[kv])*1.4426950408889634f,a,bb,c);
      *(__attribute__((address_space(3))) u32x4*)((__attribute__((address_space(3))) char*)shm3+LDS_KB+kv*16)=(u32x4){a|(bb<<16),c|0xBF800000u,0xBF80BF80u,0u}; } }
  bf16x8 qr[4];
  #pragma unroll
  for(int d0=0;d0<4;++d0)qr[d0]=*reinterpret_cast<const bf16x8*>(&Qw[(long)r32*DM+d0*16+hi*8]);
  float mhat=0.f,l_reg=0.f;f32x16 o[2];o[0]=f32x16{};o[1]=f32x16{};bf16x8 qx=make_qx(0.f,hi);const f32x16 zc=f32x16{};
  const int qrel=wid*QBLK+r32;
  #define CMASK(P0,P1,t) do{int jb_=(t)-(NT-4); if(jb_>=0)cmask(P0,P1,jb_,qrel,hi);}while(0)
  bool resc=false;
  #define START(P0,P1) do{ const float rm=rowmax(P0,P1); resc=false; \
    { const float dl=rm; mhat=fadd_s(mhat,dl); \
      _Pragma("unroll") for(int r=0;r<16;++r){P0[r]=fsub_s(P0[r],dl);P1[r]=fsub_s(P1[r],dl);} \
      qx=make_qx(mhat,hi); } \
    _Pragma("unroll") for(int r=0;r<16;++r)P0[r]=__builtin_amdgcn_exp2f(P0[r]); }while(0)
  #define RESC() do{ if(resc){ asm volatile("s_waitcnt lgkmcnt(0)":::"memory"); \
      _Pragma("unroll") for(int d_=0;d_<2;++d_) _Pragma("unroll") for(int r=0;r<16;++r)o[d_][r]*=wsf[crow(r,hi)]; } }while(0)
  f32x16 pA0,pA1,pB0,pB1;
  int sl_prev=0,sl_cur=0,sl_next=SLOTB;
  #define ROT() do{sl_prev=sl_cur;sl_cur=sl_next;sl_next=(sl_next==(NSLOT-1)*SLOTB)?0:sl_next+SLOTB;}while(0)
  DMA_K(2,2*SLOTB);
  WAIT_BAR(3);
  qkt(pA0,pA1,Kbase,qr,qx,*(const __attribute__((address_space(3))) bf16x8*)(kbp),*(const __attribute__((address_space(3))) bf16x8*)(kbp+512),r32,hi);asm volatile("s_nop 15\n\ts_nop 7":"+v"(pA0),"+v"(pA1));CMASK(pA0,pA1,0);
  START(pA0,pA1);
  _Pragma("unroll") for(int r=0;r<16;++r)pA1[r]=__builtin_amdgcn_exp2f(pA1[r]);
  WAIT_BAR(0);
  DMA_K(3,0);DMA_V(1,SLOTB);
  ROT();
  kload8(kf,kp0+sl_cur);
  WAIT_BAR(2);
  s16x4 vlo[8],vhi[8]; u32x4 pw0,pw1,pw2,pw3;
  #define PKW(P,B) cvtpk_s(P[B],P[B+1])
  #define PAF(k) __builtin_bit_cast(bf16x8,pw##k)
  #define VFR(i) (bf16x8){vlo[i][0],vlo[i][1],vlo[i][2],vlo[i][3],vhi[i][0],vhi[i][1],vhi[i][2],vhi[i][3]}
  #define PIN(x) asm volatile("":"+v"(x))
  #define MX3(a,b,c) __builtin_fmaxf(__builtin_fmaxf((a),(b)),(c))
  #define GAPA(MF,A0,A1,A2,A3,W0,W1,PW) do{ MF; sacc+=A0; sacc+=A1; sacc+=A2; sacc+=A3; PIN(sacc); W0; W1; PIN(PW); SBAR(); }while(0)
  #define EX(v) __builtin_amdgcn_exp2f(v)
  #define GAPB(MF,X,B) do{ MF; X[B]=EX(X[B]); X[B+1]=EX(X[B+1]); X[B+2]=EX(X[B+2]); X[B+3]=EX(X[B+3]); PIN(X); SBAR(); }while(0)
  #define VRD(i) do{ vlo[i]=vtr(vp_+(((i)>>2)*4096+((i)&3)*1024)); vhi[i]=vtr(vp_+(((i)>>2)*4096+((i)&3)*1024+512)); }while(0)
  #define KRD(G,j) do{ if(G){ kload2(kf,kp0+sl_next,j); SBAR(); } }while(0)
  #define STEP(C0,C1,P0,P1,t,GK,GV,GL) do{ SBAR(); \
    const lds_cptr vp_=vp0+sl_prev; \
    const bf16x8 kb0_=*(const __attribute__((address_space(3))) bf16x8*)(kbp+(t)*1024), kb1_=*(const __attribute__((address_space(3))) bf16x8*)(kbp+(t)*1024+512); \
    VRD(0); SBAR(); float sacc=(P0[0]+P0[1]); \
    GAPA(C0=__builtin_amdgcn_mfma_f32_32x32x16_bf16(kf[0],qr[0],zc,0,0,0), P0[2],P0[3],P0[4],P0[5],     pw0[0]=PKW(P0,0), pw0[1]=PKW(P0,2), pw0); \
    VRD(4); SBAR(); GAPA(C1=__builtin_amdgcn_mfma_f32_32x32x16_bf16(kf[1],qr[0],zc,0,0,0), P0[6],P0[7],P0[8],P0[9],     pw0[2]=PKW(P0,4), pw0[3]=PKW(P0,6), pw0); \
    VRD(1); SBAR(); GAPA(C0=__builtin_amdgcn_mfma_f32_32x32x16_bf16(kf[2],qr[1],C0,0,0,0),   P0[10],P0[11],P0[12],P0[13], pw1[0]=PKW(P0,8), pw1[1]=PKW(P0,10), pw1); \
    VRD(5); SBAR(); GAPA(C1=__builtin_amdgcn_mfma_f32_32x32x16_bf16(kf[3],qr[1],C1,0,0,0),   P0[14],P0[15],P1[0],P1[1],   pw1[2]=PKW(P0,12),pw1[3]=PKW(P0,14), pw1); \
    VRD(2); SBAR(); GAPA(C0=__builtin_amdgcn_mfma_f32_32x32x16_bf16(kf[4],qr[2],C0,0,0,0),   P1[2],P1[3],P1[4],P1[5],     pw2[0]=PKW(P1,0), pw2[1]=PKW(P1,2), pw2); \
    VRD(6); SBAR(); GAPA(C1=__builtin_amdgcn_mfma_f32_32x32x16_bf16(kf[5],qr[2],C1,0,0,0),   P1[6],P1[7],P1[8],P1[9],     pw2[2]=PKW(P1,4), pw2[3]=PKW(P1,6), pw2); \
    VRD(3); SBAR(); GAPA(C0=__builtin_amdgcn_mfma_f32_32x32x16_bf16(kf[6],qr[3],C0,0,0,0),   P1[10],P1[11],P1[12],P1[13], pw3[0]=PKW(P1,8), pw3[1]=PKW(P1,10), pw3); \
    VRD(7); SBAR(); GAPA(C1=__builtin_amdgcn_mfma_f32_32x32x16_bf16(kf[7],qr[3],C1,0,0,0),   P1[14],P1[15],0.f,0.f,       pw3[2]=PKW(P1,12),pw3[3]=PKW(P1,14), pw3); \
    C0=__builtin_amdgcn_mfma_f32_32x32x16_bf16(kb0_,qx,C0,0,0,0); C1=__builtin_amdgcn_mfma_f32_32x32x16_bf16(kb1_,qx,C1,0,0,0); SBAR(); \
    l_reg+=sacc; \
    if(GK){DMA_K((t)+3,sl_cur);} if(GV){DMA_V((t)+1,sl_next);} \
    CMASK(C0,C1,t); \
    { float a=MX3(C0[0],C0[1],C1[0]),b=MX3(C0[2],C0[3],C1[1]); a=MX3(a,C1[2],C1[3]); \
      _Pragma("unroll") for(int r=4;r<16;r+=4){a=MX3(a,C0[r],C0[r+1]);b=MX3(b,C0[r+2],C0[r+3]);a=MX3(a,C1[r],C1[r+1]);b=MX3(b,C1[r+2],C1[r+3]);} \
      float rm=__builtin_fmaxf(a,b); { auto rr=__builtin_amdgcn_permlane32_swap(__float_as_uint(rm),__float_as_uint(rm),false,false); rm=__builtin_fmaxf(__uint_as_float(rr[0]),__uint_as_float(rr[1])); } \
      resc=false; \
      if(__builtin_expect(__any(rm>(float)THRL),0)){ const float dl=__builtin_fmaxf(rm,0.f); mhat+=dl; \
        _Pragma("unroll") for(int r=0;r<16;++r){C0[r]-=dl;C1[r]-=dl;} \
        qx=make_qx(mhat,hi); \
        const float f=__builtin_amdgcn_exp2f(-dl); l_reg*=f; if(hi==0)wsf[r32]=f; resc=true; } } \
    SBAR(); \
    GAPB(o[0]=__builtin_amdgcn_mfma_f32_32x32x16_bf16(PAF(0),VFR(0),o[0],0,0,0), C0,0); \
    GAPB(o[1]=__builtin_amdgcn_mfma_f32_32x32x16_bf16(PAF(0),VFR(4),o[1],0,0,0), C0,4); \
    KRD(GL,0); GAPB(o[0]=__builtin_amdgcn_mfma_f32_32x32x16_bf16(PAF(1),VFR(1),o[0],0,0,0), C0,8); \
    KRD(GL,1); GAPB(o[1]=__builtin_amdgcn_mfma_f32_32x32x16_bf16(PAF(1),VFR(5),o[1],0,0,0), C0,12); \
    KRD(GL,2); GAPB(o[0]=__builtin_amdgcn_mfma_f32_32x32x16_bf16(PAF(2),VFR(2),o[0],0,0,0), C1,0); \
    KRD(GL,3); GAPB(o[1]=__builtin_amdgcn_mfma_f32_32x32x16_bf16(PAF(2),VFR(6),o[1],0,0,0), C1,4); \
    GAPB(o[0]=__builtin_amdgcn_mfma_f32_32x32x16_bf16(PAF(3),VFR(3),o[0],0,0,0), C1,8); \
    GAPB(o[1]=__builtin_amdgcn_mfma_f32_32x32x16_bf16(PAF(3),VFR(7),o[1],0,0,0), C1,12); \
    }while(0)
  int t=1;
  #undef CMASK
  #define CMASK(P0,P1,t) do{}while(0)
  for(;t+5<NT;t+=2){
    STEP(pB0,pB1,pA0,pA1,t,true,true,true);     WAIT_BAR(2); RESC(); ROT();
    STEP(pA0,pA1,pB0,pB1,t+1,true,true,true);   WAIT_BAR(2); RESC(); ROT();
  }
  #undef CMASK
  #define CMASK(P0,P1,t) do{int jb_=(t)-(NT-4); if(jb_>=0)cmask(P0,P1,jb_,qrel,hi);}while(0)
  #define ENDW(tt) do{ if((tt)+3<NT){WAIT_BAR(2);} else if((tt)+2<NT){WAIT_BAR(1);} else {WAIT_BAR(0);} }while(0)
  for(;t+1<NT;t+=2){
    STEP(pB0,pB1,pA0,pA1,t,(t+3<NT),(t+1<NT),(t+1<NT));       ENDW(t);   RESC(); ROT();
    STEP(pA0,pA1,pB0,pB1,t+1,(t+4<NT),(t+2<NT),(t+2<NT));     ENDW(t+1); RESC(); ROT();
  }
  STEP(pB0,pB1,pA0,pA1,NT-1,false,false,false); RESC();
  { float sacc=pB0[0]+pB0[1]; _Pragma("unroll") for(int r=2;r<16;++r)sacc+=pB0[r]; _Pragma("unroll") for(int r=0;r<16;++r)sacc+=pB1[r]; l_reg+=sacc;
    pw0=(u32x4){PKW(pB0,0),PKW(pB0,2),PKW(pB0,4),PKW(pB0,6)};pw1=(u32x4){PKW(pB0,8),PKW(pB0,10),PKW(pB0,12),PKW(pB0,14)};pw2=(u32x4){PKW(pB1,0),PKW(pB1,2),PKW(pB1,4),PKW(pB1,6)};pw3=(u32x4){PKW(pB1,8),PKW(pB1,10),PKW(pB1,12),PKW(pB1,14)};
    SBAR(); pv(o,vb0+sl_cur,PAF(0),PAF(1),PAF(2),PAF(3)); }
  #undef PKW
  #undef PAF
  #undef VFR
  #undef PIN
  #undef MX3
  #undef GAPA
  #undef GAPB
  #undef EX
  #undef VRD
  #undef KRD
  #undef STEP
  #undef ENDW
  {auto rr=__builtin_amdgcn_permlane32_swap(__float_as_uint(l_reg),__float_as_uint(l_reg),false,false);l_reg=__uint_as_float(rr[0])+__uint_as_float(rr[1]);}
  if(hi==0)wsf[32+r32]=l_reg;asm volatile("s_waitcnt lgkmcnt(0)":::"memory");
  float rli[16];
  #pragma unroll
  for(int r=0;r<16;++r)rli[r]=__builtin_amdgcn_rcpf(wsf[32+crow(r,hi)]);
  bf16*Ow=O+(rowbase+q0+wid*QBLK)*OPITCH+h*D;
  { bf16*stg=(bf16*)(shm+LDS_OST)+wid*2048;
    #pragma unroll
    for(int r=0;r<16;++r){const int orow=crow(r,hi);
      #pragma unroll
      for(int d0=0;d0<2;++d0)stg[orow*64+d0*32+r32]=__float2bfloat16(o[d0][r]*rli[r]);}
    asm volatile("s_waitcnt lgkmcnt(0)":::"memory");
    #pragma unroll
    for(int i=0;i<4;++i){const int row=i*8+(lane>>3),ch=lane&7; const u32x4 v=*(const u32x4*)(stg+row*64+ch*8); ATTN_STORE16(Ow+(long)row*OPITCH+ch*8,v);} }
  asm volatile("s_waitcnt lgkmcnt(0)\n\ts_barrier":::"memory");
  #undef DMA_K
  #undef DMA_V
  #undef CMASK
  #undef START
  #undef RESC
  #undef ROT
}
constexpr int ATTN_LDS_BYTES=LDS_BYTES;
#undef SBAR
#undef WAIT_BAR
}

namespace ret_body {
constexpr int VT_P = 272, KT_P = 272, ST_P = 144, PW_P = 272;
constexpr int KC_P = 144;
constexpr int L_VT = 0, L_KT = L_VT + 128 * VT_P, L_ST = L_KT + 64 * KT_P, L_PW = L_ST + 128 * ST_P, PW_BYTES = 16 * PW_P, L_KC = L_PW + 8 * PW_BYTES, LDS_BYTES = L_KC + 128 * KC_P;
typedef short bf16x8 __attribute__((ext_vector_type(8)));
typedef float f32x4 __attribute__((ext_vector_type(4)));
#define dpp_f(v, ctrl) __int_as_float(__builtin_amdgcn_update_dpp(0, __float_as_int(v), (ctrl), 0xF, 0xF, false))
#define RB_MFMA(a, b, c) __builtin_amdgcn_mfma_f32_16x16x32_bf16(__builtin_bit_cast(bf16x8, a), __builtin_bit_cast(bf16x8, b), c, 0, 0, 0)
__device__ __forceinline__ void ret_unit(LAS unsigned char* L, int b, int h, const bf16* RQ, const bf16* RK, const bf16* RVT, const bf16* RKT, const bf16* RGS, bf16* BR, int wave, int c0 = 0, int c1 = SEQ / 128, int pf0 = 0) {
    int tid = wave * 64 + lane_now(); asm volatile("" : "+v"(tid));
    const int lane = tid & 63, w = __builtin_amdgcn_readfirstlane(tid >> 6), r = lane & 15, q = lane >> 4;
    const float lg2 = log1pf(-exp2f(-5.f - (float)h)) * LOG2E;
    const float cd = __builtin_amdgcn_exp2f(128.f * lg2);
    unsigned z0 = 0u; asm volatile("" : "+v"(z0));
    f32x4 S[4];
#pragma unroll
    for (int i = 0; i < 4; ++i) { const float zf = __uint_as_float(z0); S[i] = (f32x4){zf, zf, zf, zf}; }
    for (int i = tid * 16; i < 128 * ST_P; i += NWAVES * 64 * 16) *(LAS v4u*)(L + L_ST + i) = (v4u){z0, z0, z0, z0};
    LAS unsigned char* Pw = L + L_PW + w * PW_BYTES;
    v4u pv[4], pkt[2], pkc[2], pq[2];
    const int t16 = tid & 15, trow = tid >> 4;
#define RB_LOAD(cc) do { const size_t r0_ = (size_t)b * SEQ + (size_t)(cc) * 128; const size_t it_ = (size_t)((b * 4 + h) * 16 + (cc)); \
        _Pragma("unroll") for (int j = 0; j < 4; ++j) pv[j] = *(const v4u*)(RVT + it_ * 16384 + (size_t)(32 * j + trow) * 128 + 8 * t16); \
        _Pragma("unroll") for (int j = 0; j < 2; ++j) pkt[j] = *(const v4u*)(RKT + it_ * 8192 + (size_t)(32 * j + trow) * 128 + 8 * t16); \
        _Pragma("unroll") for (int j = 0; j < 2; ++j) pkc[j] = *(const v4u*)(RK + (r0_ + 64 * j + (tid >> 3)) * 256 + h * 64 + 8 * (tid & 7)); \
        _Pragma("unroll") for (int ks = 0; ks < 2; ++ks) pq[ks] = *(const v4u*)(RQ + (r0_ + 16 * w + r) * 256 + h * 64 + 32 * ks + 8 * q); } while (0)
    RB_LOAD(0);
    for (int c = 0; c < c1; ++c) {
        const int pf = pf0 | ((c < c0) ? 3 : 0);
        const size_t row0 = (size_t)b * SEQ + (size_t)c * 128;
        float lg2c = lg2; asm volatile("" : "+v"(lg2c));
        if (!(pf & 8)) {
#pragma unroll
        for (int j = 0; j < 4; ++j) *(LAS v4u*)(L + L_VT + (32 * j + trow) * VT_P + 16 * t16) = pv[j];
#pragma unroll
        for (int j = 0; j < 2; ++j) *(LAS v4u*)(L + L_KT + (32 * j + trow) * KT_P + 16 * t16) = pkt[j];
        if (!(pf & 2)) {
#pragma unroll
        for (int j = 0; j < 2; ++j) *(LAS v4u*)(L + L_KC + (64 * j + (tid >> 3)) * KC_P + 16 * (tid & 7)) = pkc[j];
        }
        }
        v4u qf[2]; qf[0] = pq[0]; qf[1] = pq[1];
        __syncthreads();
        const float fdec = __builtin_amdgcn_exp2f((float)(16 * w + 4 * q - r) * lg2c);
        const float g1 = __builtin_amdgcn_exp2f(lg2c), g2 = g1 * g1, g3 = g2 * g1; float gm16[8];
        { const float gi = __builtin_amdgcn_exp2f(-16.f * lg2c); gm16[0] = 1.f;
#pragma unroll
          for (int j = 1; j < 8; ++j) gm16[j] = gm16[j - 1] * gi; }
        if (!(pf & 2)) {
#pragma unroll
        for (int jh = 0; jh < 2; ++jh) {
        v4u kk0[4], kk1[4];
#pragma unroll
        for (int jj = 0; jj < 4; ++jj) { const int jb = 4 * jh + jj; if (jb <= w) { kk0[jj] = *(const LAS v4u*)(L + L_KC + (16 * jb + r) * KC_P + 16 * q); kk1[jj] = *(const LAS v4u*)(L + L_KC + (16 * jb + r) * KC_P + 64 + 16 * q); } }
        __builtin_amdgcn_sched_barrier(0);
#pragma unroll
        for (int jj = 0; jj < 4; ++jj) { const int jb = 4 * jh + jj;
            if (jb <= w) {
                const v4u k0 = kk0[jj], k1 = kk1[jj];
                f32x4 acc = (f32x4){0.f, 0.f, 0.f, 0.f};
                acc = RB_MFMA(qf[0], k0, acc); acc = RB_MFMA(qf[1], k1, acc);
                const float f0 = fdec * gm16[jb];
                acc[0] *= f0; acc[1] *= f0 * g1; acc[2] *= f0 * g2; acc[3] *= f0 * g3;
                if (jb == w) {
#pragma unroll
                    for (int e = 0; e < 4; ++e) acc[e] = (4 * q - r + e >= 0) ? acc[e] : 0.f; }
                const unsigned p01 = cvt_pk_bf16(acc[0], acc[1]), p23 = cvt_pk_bf16(acc[2], acc[3]);
                LAS unsigned char* pp = Pw + (4 * q) * PW_P + (16 * jb + r) * 2;
                *(LAS unsigned short*)(pp) = (unsigned short)p01; *(LAS unsigned short*)(pp + PW_P) = (unsigned short)(p01 >> 16);
                *(LAS unsigned short*)(pp + 2 * PW_P) = (unsigned short)p23; *(LAS unsigned short*)(pp + 3 * PW_P) = (unsigned short)(p23 >> 16);
            } else if (jb == w + 1 && (w & 1) == 0) {
                LAS unsigned char* pp = Pw + (4 * q) * PW_P + (16 * jb + r) * 2;
                *(LAS unsigned short*)(pp) = 0; *(LAS unsigned short*)(pp + PW_P) = 0; *(LAS unsigned short*)(pp + 2 * PW_P) = 0; *(LAS unsigned short*)(pp + 3 * PW_P) = 0;
            }
        }
        __builtin_amdgcn_sched_barrier(0); }
        }
        LDS_WAIT(); asm volatile("" ::: "memory");
        if (c + 1 < c1) RB_LOAD(c + 1);
        if (!(pf & 2)) {
        v4u pg[4];
        { const size_t grow_ = row0 + 16 * w + (lane >> 4);
#pragma unroll
          for (int i = 0; i < 4; ++i) pg[i] = *(const v4u*)(RGS + (grow_ + 4 * i) * 512 + h * 128 + 8 * (lane & 15)); }
        f32x4 oi[8];
#pragma unroll
        for (int d = 0; d < 8; ++d) oi[d] = (f32x4){0.f, 0.f, 0.f, 0.f};
#pragma unroll
        for (int ks = 0; ks < 4; ++ks) {
            if (2 * ks <= w && !(pf & 2)) { const v4u pa = *(const LAS v4u*)(Pw + r * PW_P + (32 * ks + 8 * q) * 2); v4u vb[8];
#pragma unroll
                for (int d = 0; d < 8; ++d) vb[d] = *(const LAS v4u*)(L + L_VT + (16 * d + r) * VT_P + (32 * ks + 8 * q) * 2);
                __builtin_amdgcn_sched_barrier(0);
#pragma unroll
                for (int d = 0; d < 8; ++d) oi[d] = RB_MFMA(pa, vb[d], oi[d]);
                __builtin_amdgcn_sched_barrier(0); }
        }
        { const float rfq = __builtin_amdgcn_exp2f((float)(16 * w + r + 1) * lg2);
#pragma unroll
          for (int ks = 0; ks < 2; ++ks) { v4u sb[8], qs;
#pragma unroll
            for (int wd = 0; wd < 4; ++wd) qs[wd] = cvt_pk_bf16(bflo(qf[ks][wd]) * rfq, bfhi(qf[ks][wd]) * rfq);
#pragma unroll
            for (int d = 0; d < 8; ++d) sb[d] = *(const LAS v4u*)(L + L_ST + (16 * d + r) * ST_P + (32 * ks + 8 * q) * 2);
            __builtin_amdgcn_sched_barrier(0);
#pragma unroll
            for (int d = 0; d < 8; ++d) oi[d] = RB_MFMA(qs, sb[d], oi[d]);
            __builtin_amdgcn_sched_barrier(0); } }
        float ss[4];
#pragma unroll
        for (int e = 0; e < 4; ++e) ss[e] = 0.f;
#pragma unroll
        for (int d = 0; d < 8; ++d)
#pragma unroll
            for (int e = 0; e < 4; ++e) ss[e] += oi[d][e] * oi[d][e];
#pragma unroll
        for (int e = 0; e < 4; ++e) { float s = ss[e]; s += dpp_f(s, 0xB1); s += dpp_f(s, 0x4E); s += dpp_f(s, 0x141); s += dpp_f(s, 0x140); ss[e] = 1.f / sqrtf(s * (1.f / 128.f) + EPS); }
#pragma unroll
        for (int d = 0; d < 8; ++d) { const unsigned p01 = cvt_pk_bf16(oi[d][0] * ss[0], oi[d][1] * ss[1]), p23 = cvt_pk_bf16(oi[d][2] * ss[2], oi[d][3] * ss[3]);
            LAS unsigned char* pp = Pw + (4 * q) * PW_P + (16 * d + r) * 2;
            *(LAS unsigned short*)(pp) = (unsigned short)p01; *(LAS unsigned short*)(pp + PW_P) = (unsigned short)(p01 >> 16);
            *(LAS unsigned short*)(pp + 2 * PW_P) = (unsigned short)p23; *(LAS unsigned short*)(pp + 3 * PW_P) = (unsigned short)(p23 >> 16); }
        LDS_WAIT(); asm volatile("" ::: "memory");
        { const int orow = lane >> 4, oc = lane & 15; const size_t grow = row0 + 16 * w + orow;
#pragma unroll
          for (int i = 0; i < 4; ++i) { const v4u ov = *(const LAS v4u*)(Pw + (orow + 4 * i) * PW_P + 16 * oc); const v4u gv = pg[i];
              v4u o;
#pragma unroll
              for (int wd = 0; wd < 4; ++wd) o[wd] = cvt_pk_bf16(bflo(ov[wd]) * bflo(gv[wd]), bfhi(ov[wd]) * bfhi(gv[wd]));
              if (!(pf & 1)) *(v4u*)(BR + (grow + 4 * i) * 1024 + 512 + h * 128 + 8 * oc) = o; } }
        }
        if (!(pf & 2)) __syncthreads();
#pragma unroll
        for (int i = 0; i < 4; ++i) S[i] = S[i] * cd;
        if (!(pf & 4))
#pragma unroll
        for (int ks = 0; ks < 4; ++ks) { const v4u vb = *(const LAS v4u*)(L + L_VT + (16 * w + r) * VT_P + (32 * ks + 8 * q) * 2); v4u ka[4];
#pragma unroll
            for (int i = 0; i < 4; ++i) ka[i] = *(const LAS v4u*)(L + L_KT + (16 * i + r) * KT_P + (32 * ks + 8 * q) * 2);
            __builtin_amdgcn_sched_barrier(0);
#pragma unroll
            for (int i = 0; i < 4; ++i) S[i] = RB_MFMA(ka[i], vb, S[i]);
            __builtin_amdgcn_sched_barrier(0); }
#pragma unroll
        for (int i = 0; i < 4; ++i) { v2u sv; sv.x = cvt_pk_bf16(S[i][0], S[i][1]); sv.y = cvt_pk_bf16(S[i][2], S[i][3]); *(LAS v2u*)(L + L_ST + (16 * w + r) * ST_P + (16 * i + 4 * q) * 2) = sv; }
        __syncthreads();
    }
}
#undef RB_MFMA
#undef dpp_f
#undef RB_LOAD
}

struct TrItem { const float* src; bf16* dst; int ldw, K, base, mul, gu, f8; };
__device__ __forceinline__ int tr_row(const TrItem& t, int n) { if (t.gu) { const int a = t.base + (n >> 1), b = n & 1; return 256 * (a >> 7) + 128 * b + (a & 127); } return t.base + t.mul * n; }
__device__ __forceinline__ void tr_load(const TrItem& t, f32x4 (&v)[8], int lane) {
    const float* p = t.src + (size_t)(lane >> 3) * t.ldw + 4 * (lane & 7);
#pragma unroll
    for (int i = 0; i < 8; ++i) v[i] = *(const GAS f32x4*)(p + (size_t)(8 * i) * t.ldw);
}
__device__ __forceinline__ void tr_store(const TrItem& t, const f32x4 (&v)[8], LAS float* scr, int lane) {
    { LAS float* w = scr + (lane >> 3) * 33 + 4 * (lane & 7);
#pragma unroll
      for (int i = 0; i < 8; ++i) { w[(8 * i) * 33 + 0] = v[i][0]; w[(8 * i) * 33 + 1] = v[i][1]; w[(8 * i) * 33 + 2] = v[i][2]; w[(8 * i) * 33 + 3] = v[i][3]; } }
    LDS_WAIT(); asm volatile("" ::: "memory");
    const int c = lane & 7;
#pragma unroll
    for (int j = 0; j < 4; ++j) { const int n = (lane >> 3) + 8 * j; const LAS float* s = scr + (8 * c) * 33 + n;
        if (t.f8) { const f32x4 a = {s[0 * 33] * WSCALE, s[1 * 33] * WSCALE, s[2 * 33] * WSCALE, s[3 * 33] * WSCALE}, b = {s[4 * 33] * WSCALE, s[5 * 33] * WSCALE, s[6 * 33] * WSCALE, s[7 * 33] * WSCALE};
            *(GAS v2u*)((unsigned char*)t.dst + (size_t)tr_row(t, n) * t.K + 8 * c) = pack8_fp8(a, b); }
        else { v4u o; o.x = cvt_pk_bf16(s[0 * 33], s[1 * 33]); o.y = cvt_pk_bf16(s[2 * 33], s[3 * 33]); o.z = cvt_pk_bf16(s[4 * 33], s[5 * 33]); o.w = cvt_pk_bf16(s[6 * 33], s[7 * 33]);
            *(GAS v4u*)(t.dst + (size_t)tr_row(t, n) * t.K + 8 * c) = o; } }
    LDS_WAIT(); asm volatile("" ::: "memory");
}
__device__ __forceinline__ void tr_store2(const TrItem& t0, const f32x4 (&v0)[8], const TrItem& t1, const f32x4 (&v1)[8], LAS float* s0, LAS float* s1, int lane) {
    { LAS float* w0 = s0 + (lane >> 3) * 33 + 4 * (lane & 7); LAS float* w1 = s1 + (lane >> 3) * 33 + 4 * (lane & 7);
#pragma unroll
      for (int i = 0; i < 8; ++i) { w0[(8 * i) * 33 + 0] = v0[i][0]; w0[(8 * i) * 33 + 1] = v0[i][1]; w0[(8 * i) * 33 + 2] = v0[i][2]; w0[(8 * i) * 33 + 3] = v0[i][3];
                                    w1[(8 * i) * 33 + 0] = v1[i][0]; w1[(8 * i) * 33 + 1] = v1[i][1]; w1[(8 * i) * 33 + 2] = v1[i][2]; w1[(8 * i) * 33 + 3] = v1[i][3]; } }
    LDS_WAIT(); asm volatile("" ::: "memory");
    const int c = lane & 7;
#pragma unroll
    for (int u = 0; u < 2; ++u) { const TrItem& t = u ? t1 : t0; const LAS float* sb = u ? s1 : s0;
#pragma unroll
        for (int j = 0; j < 4; ++j) { const int n = (lane >> 3) + 8 * j; const LAS float* s = sb + (8 * c) * 33 + n;
            if (t.f8 == 1) { const f32x4 a = {s[0 * 33] * WSCALE, s[1 * 33] * WSCALE, s[2 * 33] * WSCALE, s[3 * 33] * WSCALE}, b = {s[4 * 33] * WSCALE, s[5 * 33] * WSCALE, s[6 * 33] * WSCALE, s[7 * 33] * WSCALE};
                *(GAS v2u*)((unsigned char*)t.dst + (size_t)tr_row(t, n) * t.K + 8 * c) = pack8_fp8(a, b); }
            else { v4u o; o.x = cvt_pk_bf16(s[0 * 33], s[1 * 33]); o.y = cvt_pk_bf16(s[2 * 33], s[3 * 33]); o.z = cvt_pk_bf16(s[4 * 33], s[5 * 33]); o.w = cvt_pk_bf16(s[6 * 33], s[7 * 33]);
                *(GAS v4u*)(t.dst + (size_t)tr_row(t, n) * t.K + 8 * c) = o; } } }
    LDS_WAIT(); asm volatile("" ::: "memory");
}
constexpr int TR_IN = 96 * 16, TR_MG = 64 * 16, TR_BR = 2 * 32 * 8, TR_O = 32 * 16, TR_PG = 32 * 16, TR_PP = 32 * 4, TR_GU = 32 * 64 * 16, TR_DN = 32 * 32 * 16;
constexpr int TR_ITEMS = TR_IN + TR_MG + TR_BR + TR_O + TR_PG + TR_PP + TR_GU + TR_DN;
__device__ __forceinline__ TrItem tr_decode(Frame& F, int it) {
    TrItem t; t.mul = 1; t.gu = 0; t.f8 = 0; int r = it;
    if (r < TR_GU) { const int e = r >> 10, rr = r & 1023, kb = rr >> 6, blk = rr & 63;
        t.src = (F.ap->in[12]) + (size_t)e * 1024 * 2048 + (size_t)(64 * kb) * 2048 + 32 * blk; t.ldw = 2048; t.dst = (bf16*)(WSP(unsigned char, WS_WGUT) + (size_t)e * 2048 * 1024 + 64 * kb); t.K = 1024; t.base = 16 * blk; t.gu = 1; t.f8 = 1; return t; } r -= TR_GU;
    if (r < TR_DN) { const int e = r >> 9, rr = r & 511, kb = rr >> 5, blk = rr & 31;
        t.src = (F.ap->in[14]) + (size_t)e * 1024 * 1024 + (size_t)(64 * kb) * 1024 + 32 * blk; t.ldw = 1024; t.dst = (bf16*)(WSP(unsigned char, WS_WDT) + (size_t)e * 1024 * 1024 + 64 * kb); t.K = 1024; t.base = 32 * blk; t.f8 = 1; return t; } r -= TR_DN;
    if (r < TR_IN) { const int kb = r / 96, blk = r % 96; int s0;
        if (blk < 32) { s0 = 32 * blk; t.base = 32 * blk; t.f8 = 1; }
        else if (blk < 48) { s0 = 32 * blk; t.base = 32 * (blk - 32); }
        else if (blk < 64) { s0 = 2056 + 32 * (blk - 48); t.base = 1024 + 32 * (blk - 48); }
        else if (blk < 80) { s0 = 2568 + 32 * (blk - 64); t.base = 1536 + 32 * (blk - 64); }
        else { const int hb = (blk - 80) & 7, head = hb >> 1, half = hb & 1, isk = (blk >= 88); s0 = (isk ? 1800 : 1544) + head * 64 + half * 32; t.base = (isk ? 768 : 512) + head * 64 + half; t.mul = 2; }
        t.src = (F.ap->in[3]) + (size_t)(64 * kb) * INW + s0; t.ldw = INW; t.dst = t.f8 ? (bf16*)(WSP(unsigned char, WS_WG8T) + 64 * kb) : WSP(bf16, WS_W1T) + 64 * kb; t.K = 1024; return t; } r -= TR_IN;
    if (r < TR_MG) { const int kb = r >> 6, blk = r & 63; t.src = (F.ap->in[6]) + (size_t)(64 * kb) * 2048 + 32 * blk; t.ldw = 2048; t.dst = (bf16*)(WSP(unsigned char, WS_WG8T) + 64 * kb); t.K = 1024; t.base = 1024 + 32 * blk; t.f8 = 1; return t; } r -= TR_MG;
    if (r < TR_BR) { const int gsel = r >> 8, rr = r & 255, kb = rr >> 5, blk = rr & 31;
        t.src = (F.ap->in[5]) + (size_t)gsel * 512 * 1024 + (size_t)(64 * kb) * 1024 + 32 * blk; t.ldw = 1024; t.dst = WSP(bf16, WS_WBT) + gsel * 512 + 64 * kb; t.K = 1024; t.base = 32 * blk; return t; } r -= TR_BR;
    if (r < TR_O) { const int kb = r >> 5, blk = r & 31; t.src = (F.ap->in[8]) + (size_t)(64 * kb) * 1024 + 32 * blk; t.ldw = 1024; t.dst = WSP(bf16, WS_WOT) + 64 * kb; t.K = 1024; t.base = 32 * blk; return t; } r -= TR_O;
    if (r < TR_PG) { const int kb = r >> 5, blk = r & 31; t.src = (F.ap->in[17]) + (size_t)(64 * kb) * 1024 + 32 * blk; t.ldw = 1024; t.dst = (bf16*)(WSP(unsigned char, WS_WPGT) + 64 * kb); t.K = 1024; t.base = 32 * blk; t.f8 = 1; return t; } r -= TR_PG;
    { const int kb = r >> 5, blk = r & 31; t.src = (F.ap->in[18]) + (size_t)(64 * kb) * 1024 + 32 * blk; t.ldw = 1024; t.dst = WSP(bf16, WS_WPPT) + 64 * kb; t.K = 256; t.base = 32 * blk; return t; }
}

__device__ __forceinline__ void p0_row(Frame& F, int m, f32x4 (&v)[4], LAS const float* WFt, int lane) {
    float s = 0.f;
#pragma unroll
    for (int j = 0; j < 4; ++j) s += (v[j].x * v[j].x + v[j].y * v[j].y) + (v[j].z * v[j].z + v[j].w * v[j].w);
    const float rstd = 1.f / sqrtf(wave_sum(s) * (1.f / DM) + EPS);
    GAS unsigned long long* o8 = (GAS unsigned long long*)(WSP(bf16, WS_XN) + (size_t)m * DM) + lane;
    GAS int* q8 = (GAS int*)(WSP(unsigned char, WS_XN8) + (size_t)m * DM) + lane;
#pragma unroll
    for (int j = 0; j < 4; ++j) { const f32x4 g = ((const GAS f32x4*)(F.ap->in[2]))[lane + 64 * j]; v[j] = v[j] * rstd * g;
        o8[64 * j] = (unsigned long long)cvt_pk_bf16(v[j].x, v[j].y) | ((unsigned long long)cvt_pk_bf16(v[j].z, v[j].w) << 32);
        { int w = 0; w = __builtin_amdgcn_cvt_pk_fp8_f32(clamp_f8(v[j].x), clamp_f8(v[j].y), w, false); w = __builtin_amdgcn_cvt_pk_fp8_f32(clamp_f8(v[j].z), clamp_f8(v[j].w), w, true); q8[64 * j] = w; } }
    float fa[8];
#pragma unroll
    for (int c = 0; c < 8; ++c) { float a = 0.f;
#pragma unroll
        for (int j = 0; j < 4; ++j) { const f32x4 w = *(const LAS f32x4*)(WFt + c * 1024 + 256 * j + 4 * lane); a += (v[j].x * w.x + v[j].y * w.y) + (v[j].z * w.z + v[j].w * w.w); }
        fa[c] = wave_sum(a); }
    float z = fa[0];
#pragma unroll
    for (int c = 1; c < 8; ++c) z = (lane == c) ? fa[c] : z;
    if (lane < 8) { z += (F.ap->in[4])[lane]; WSP(float, WS_LOGF)[(size_t)m * 8 + lane] = fminf(z, 0.f) - log1pf(expf(-fabsf(z))); }
}
__device__ __forceinline__ void p0_prologue(Frame& F) {
    LAS float* WFt = (LAS float*)(F.lds + RING_OFF);
    for (int idx = F.tid; idx < 8192; idx += NWAVES * 64) { const int k = idx >> 3, c = idx & 7; WFt[c * 1024 + k] = (F.ap->in[3])[(size_t)k * INW + 1536 + c]; }
    __syncthreads();
    const int gw = F.vcu * NWAVES + F.wave, NGW = F.G * NWAVES, lane = F.lane;
#ifndef P0_REP_ROWS
#define P0_REP_ROWS 1
#endif
#ifndef P0_REP_TR
#define P0_REP_TR 1
#endif
#ifndef P0_REP_ROWS
#define P0_REP_ROWS 1
#endif
#ifndef P0_REP_TR
#define P0_REP_TR 1
#endif
    for (int rep_ = 0; rep_ < P0_REP_ROWS; ++rep_)
    { f32x4 va[4], vb[4]; int m = gw;
      if (m < NT) {
#pragma unroll
          for (int j = 0; j < 4; ++j) va[j] = ((const GAS f32x4*)((F.ap->in[0]) + (size_t)m * DM))[lane + 64 * j]; }
      for (; m < NT; m += NGW) { const int m2 = m + NGW;
          if (m2 < NT) {
#pragma unroll
              for (int j = 0; j < 4; ++j) vb[j] = ((const GAS f32x4*)((F.ap->in[0]) + (size_t)m2 * DM))[lane + 64 * j]; }
          __builtin_amdgcn_sched_barrier(0);
          p0_row(F, m, va, WFt, lane);
          __builtin_amdgcn_sched_barrier(0);
#pragma unroll
          for (int j = 0; j < 4; ++j) va[j] = vb[j];
      } }
    __syncthreads();
    for (int rep_ = 0; rep_ < P0_REP_TR; ++rep_)
    { LAS float* scr = (LAS float*)(F.lds + RING_OFF + F.wave * 8704);
      constexpr int TR_P0_END = TR_GU + TR_DN + TR_IN + TR_MG;
      int it = TR_GU + TR_DN + gw; f32x4 cur[8], nxt[8]; TrItem tc, tn;
      if (it < TR_P0_END) { tc = tr_decode(F, it); tr_load(tc, cur, lane); }
      while (it < TR_P0_END) {
          const int itn = it + NGW; const bool hn = itn < TR_P0_END;
          if (hn) { tn = tr_decode(F, itn); tr_load(tn, nxt, lane); }
          tr_store(tc, cur, scr, lane);
          if (hn) { tc = tn;
#pragma unroll
              for (int i = 0; i < 8; ++i) cur[i] = nxt[i]; }
          it = itn;
      } }
    const int gt = F.vcu * (NWAVES * 64) + F.tid, NGT = F.G * NWAVES * 64;
    { float* rot = WSP(float, WS_ROT);
      for (int i = gt; i < SEQ * 32; i += NGT) { const int pos = i >> 5, j = i & 31;
          const float inv = powf(10000.f, -(float)j / 32.f); const float ang = (float)pos * inv;
          double rev = (double)ang * 0.15915494309189535; rev -= floor(rev); const float fr = (float)rev;
          rot[i] = __builtin_amdgcn_cosf(fr); rot[SEQ * 32 + i] = __builtin_amdgcn_sinf(fr); } }
    { bf16* wrt = WSP(bf16, WS_WRT);
      for (int i = gt; i < 1024 * 32; i += NGT) { const int k = i >> 5, n = i & 31; const float v = (F.ap->in[10])[i]; const unsigned hi = f2bf(v); const float rem = v - __uint_as_float(hi << 16);
          wrt[n * 1024 + k] = (bf16)hi; wrt[32768 + n * 1024 + k] = (bf16)f2bf(rem); } }
    if (gt < 64) { GAS v4u* z = (GAS v4u*)(WSP(unsigned char, WS_HB) + (size_t)NT * DM); z[gt] = (v4u){0u, 0u, 0u, 0u}; }
}

constexpr int CONV_ITEMS = 64, CONV_TR_ITEMS = TR_ITEMS - TR_IN - TR_MG, CONV_TR_CHUNKS = CONV_TR_ITEMS / CONV_ITEMS, CONV_PB_CHUNKS = NT * PLE / 4 / 16384, CONV_CHUNKS = CONV_TR_CHUNKS + CONV_PB_CHUNKS;
static_assert(CONV_TR_ITEMS % CONV_ITEMS == 0 && (TR_GU + TR_DN) % CONV_ITEMS == 0 && (NT * PLE / 4) % 16384 == 0, "whole chunks");
__device__ __forceinline__ TrItem conv_decode(Frame& F, int ci) { return tr_decode(F, ci < TR_GU + TR_DN ? ci : ci + TR_IN + TR_MG); }
__device__ __forceinline__ void conv_chunk(Frame& F, int c) {
    int lane = lane_now(); asm volatile("" : "+v"(lane));
    if (c >= CONV_TR_CHUNKS) {
        const int j = c - CONV_TR_CHUNKS, t = F.wave * 64 + lane;
        const GAS f32x4* ps = (const GAS f32x4*)(F.ap->in[1]) + (size_t)j * 16384 + t; GAS unsigned long long* pd = (GAS unsigned long long*)WSP(bf16, WS_PB) + (size_t)j * 16384 + t;
        for (int b = 0; b < 4; ++b) { f32x4 v[8];
#pragma unroll
            for (int u = 0; u < 8; ++u) v[u] = ps[b * 4096 + u * 512];
#pragma unroll
            for (int u = 0; u < 8; ++u) pd[b * 4096 + u * 512] = (unsigned long long)cvt_pk_bf16(v[u].x, v[u].y) | ((unsigned long long)cvt_pk_bf16(v[u].z, v[u].w) << 32); }
        return; }
    LAS float* scr = (LAS float*)(F.lds + RING_OFF + F.wave * 17408); LAS float* scr1 = scr + 2176;
    static_assert(NWAVES * 17408 <= SCH_OFF - RING_OFF, "conversion scratch inside ring + table region");
    const int base = c * CONV_ITEMS + F.wave;
    f32x4 a0[8], a1[8], b0[8], b1[8], c0[8], c1[8]; TrItem ta0, ta1, tb0, tb1, tc0, tc1;
    constexpr int NPAIR = CONV_ITEMS / NWAVES / 2;
    ta0 = conv_decode(F, base); ta1 = conv_decode(F, base + NWAVES); tr_load(ta0, a0, lane); tr_load(ta1, a1, lane);
    tb0 = conv_decode(F, base + 2 * NWAVES); tb1 = conv_decode(F, base + 3 * NWAVES); tr_load(tb0, b0, lane); tr_load(tb1, b1, lane);
    tc0 = tb0; tc1 = tb1;
#pragma unroll
    for (int i = 0; i < 8; ++i) { c0[i] = b0[i]; c1[i] = b1[i]; }
    for (int k = 0; k < NPAIR; ++k) {
        if (k + 2 < NPAIR) { tc0 = conv_decode(F, base + NWAVES * (2 * k + 4)); tc1 = conv_decode(F, base + NWAVES * (2 * k + 5)); tr_load(tc0, c0, lane); tr_load(tc1, c1, lane); }
        __builtin_amdgcn_sched_barrier(0);
        tr_store2(ta0, a0, ta1, a1, scr, scr1, lane);
        __builtin_amdgcn_sched_barrier(0);
        ta0 = tb0; ta1 = tb1; tb0 = tc0; tb1 = tc1;
#pragma unroll
        for (int i = 0; i < 8; ++i) { a0[i] = b0[i]; a1[i] = b1[i]; b0[i] = c0[i]; b1[i] = c1[i]; }
    }
}

__device__ __forceinline__ void cum_scan(Frame& F, int bh) {
    const float* lf = WSP(float, WS_LOGF); float* cum = WSP(float, WS_CUM);
    const int b = bh >> 3, h = bh & 7, t0 = 4 * F.tid;
    double a0 = lf[((size_t)(b * SEQ + t0 + 0)) * 8 + h], a1 = lf[((size_t)(b * SEQ + t0 + 1)) * 8 + h], a2 = lf[((size_t)(b * SEQ + t0 + 2)) * 8 + h], a3 = lf[((size_t)(b * SEQ + t0 + 3)) * 8 + h];
    a1 += a0; a2 += a1; a3 += a2;
    LAS double* tot = (LAS double*)(F.lds + RING_OFF);
    tot[F.tid] = a3;
    __syncthreads();
    double ex = 0.0;
    for (int j = 0; j < 63; ++j) { const double v = tot[F.wave * 64 + j]; ex += (j < F.lane) ? v : 0.0; }
    if (F.lane == 63) tot[512 + F.wave] = ex + a3;
    __syncthreads();
    for (int w = 0; w < F.wave; ++w) ex += tot[512 + w];
    *(GAS f32x4*)(cum + (size_t)bh * SEQ + t0) = (f32x4){(float)(ex + a0), (float)(ex + a1), (float)(ex + a2), (float)(ex + a3)};
    __syncthreads();
}

typedef pg8::f32x4 (&AccRef)[2][2][4][2];
using pg8::Unit;
__device__ __forceinline__ v4u pack8(const f32x4 a, const f32x4 b) { v4u w; w.x = cvt_pk_bf16(a[0], a[1]); w.y = cvt_pk_bf16(a[2], a[3]); w.z = cvt_pk_bf16(b[0], b[1]); w.w = cvt_pk_bf16(b[2], b[3]); return w; }
__device__ __forceinline__ void unpack8(const v4u w, f32x4& a, f32x4& b) { a = (f32x4){bflo(w.x), bfhi(w.x), bflo(w.y), bfhi(w.y)}; b = (f32x4){bflo(w.z), bfhi(w.z), bflo(w.w), bfhi(w.w)}; }

__device__ __forceinline__ void tstore32(LAS unsigned char* scr, const v4u wa, const v4u wb, int fr, int fq, bf16* dst, int cstride) {
    LAS unsigned short* s2 = (LAS unsigned short*)scr;
#pragma unroll
    for (int e2 = 0; e2 < 4; ++e2) { const int col = 8 * fq + 2 * e2;
        s2[col * 40 + fr] = (unsigned short)(wa[e2] & 0xffffu); s2[(col + 1) * 40 + fr] = (unsigned short)(wa[e2] >> 16);
        s2[col * 40 + 16 + fr] = (unsigned short)(wb[e2] & 0xffffu); s2[(col + 1) * 40 + 16 + fr] = (unsigned short)(wb[e2] >> 16); }
    asm volatile("" ::: "memory");
    const int lane = fr + 16 * fq, cl = lane >> 1, part = lane & 1;
    const v4u r0 = *(const LAS v4u*)(scr + cl * 80 + part * 32), r1 = *(const LAS v4u*)(scr + cl * 80 + part * 32 + 16);
    asm volatile("" ::: "memory");
    bf16* d = dst + (size_t)cl * cstride + part * 16;
    *(v4u*)d = r0; *(v4u*)(d + 8) = r1;
}
struct EpiIn {
    static constexpr bool PERM = true;
    bf16 *FQ, *FK, *FV, *RQ, *RK, *RV, *RGS; const float* rot; bf16* RKT; LAS unsigned char* scr; int skip;
    __device__ __forceinline__ void operator()(const pg8::f32x4 (&acc)[2][2][4][2], const Unit& u, int wr, int wc, int fr, int fq) const {
        if (skip == 1) return;
        asm volatile("" : "+v"(fr), "+v"(fq));
        const int pn = u.pn; bf16* base; int ldc, colt, mode = 0; float sc = 1.f;
        if (skip) { const int cls = pn < 6 ? 1 : pn < 8 ? 2 : pn < 10 ? 4 : 8; if (skip & (cls << 1)) return; }
        if (pn < 2) { base = FQ; ldc = 512; colt = pn * 256; sc = C2; }
        else if (pn < 4) { base = FK; ldc = 512; colt = (pn - 2) * 256; }
        else if (pn < 6) { base = FV; ldc = 512; colt = (pn - 4) * 256; }
        else if (pn == 6) { base = RQ; ldc = 256; colt = 0; mode = 1; }
        else if (pn == 7) { base = RK; ldc = 256; colt = 0; mode = 1; sc = 0.125f; }
        else if (pn < 10) { base = RV; ldc = 512; colt = (pn - 8) * 256; mode = 4; }
        else { base = RGS; ldc = 512; colt = (pn - 10) * 256; mode = 2; }
        const int row0 = u.pm * 256 + wr * 64 + fr, col0 = colt + wc * 32 + 8 * fq;
        LAS unsigned char* ws = scr + (wr * 4 + wc) * 3072;
        if (mode == 1) {
            f32x4 cs[2][4], sn[2][4]; const int j = (col0 & 63) >> 1;
#pragma unroll
            for (int ai = 0; ai < 2; ++ai)
#pragma unroll
                for (int m = 0; m < 4; ++m) { const int pos = (row0 + ai * 128 + m * 16) & (SEQ - 1); cs[ai][m] = *(const f32x4*)(rot + pos * 32 + j); sn[ai][m] = *(const f32x4*)(rot + SEQ * 32 + pos * 32 + j); }
            __builtin_amdgcn_sched_barrier(0);
            float lg2b[2] = {0.f, 0.f};
            if (pn == 7) { lg2b[0] = log1pf(-exp2f(-5.f - (float)(wc >> 1))) * LOG2E; lg2b[1] = log1pf(-exp2f(-5.f - (float)((wc >> 1) + 2))) * LOG2E; }
#pragma unroll
            for (int ai = 0; ai < 2; ++ai)
#pragma unroll
                for (int mh = 0; mh < 2; ++mh)
#pragma unroll
                    for (int bj = 0; bj < 2; ++bj) { const int c = col0 + bj * 128; v4u wt[2];
#pragma unroll
                        for (int mm = 0; mm < 2; ++mm) { const int m = 2 * mh + mm, row = row0 + ai * 128 + m * 16; const f32x4 a = acc[ai][bj][m][0], b = acc[ai][bj][m][1], cv = cs[ai][m], sv = sn[ai][m];
                            const f32x4 v0 = {(a[0] * cv[0] - a[1] * sv[0]) * sc, (a[1] * cv[0] + a[0] * sv[0]) * sc, (a[2] * cv[1] - a[3] * sv[1]) * sc, (a[3] * cv[1] + a[2] * sv[1]) * sc};
                            const f32x4 v1 = {(b[0] * cv[2] - b[1] * sv[2]) * sc, (b[1] * cv[2] + b[0] * sv[2]) * sc, (b[2] * cv[3] - b[3] * sv[3]) * sc, (b[3] * cv[3] + b[2] * sv[3]) * sc};
                            *(v4u*)(base + (size_t)row * ldc + c) = pack8(v0, v1);
                            if (pn == 7) { const float dk = __builtin_amdgcn_exp2f((float)(127 - (row & 127)) * lg2b[bj]); wt[mm] = pack8(v0 * dk, v1 * dk); } }
                        if (pn == 7) {
                            const int rowb = u.pm * 256 + ai * 128 + wr * 64 + mh * 32, cb = wc * 32 + bj * 128;
                            tstore32(ws, wt[0], wt[1], fr, fq, RKT + ((size_t)((rowb >> 11) * 4 + (cb >> 6)) * 16 + ((rowb >> 7) & 15)) * 8192 + (size_t)(cb & 63) * 128 + (rowb & 127), 128); } }
            return; }
        if (mode == 4) {
#pragma unroll
            for (int ai = 0; ai < 2; ++ai)
#pragma unroll
                for (int mh = 0; mh < 2; ++mh)
#pragma unroll
                    for (int bj = 0; bj < 2; ++bj) { const int rowb = u.pm * 256 + ai * 128 + wr * 64 + mh * 32, cb = colt + wc * 32 + bj * 128;
                        tstore32(ws, pack8(acc[ai][bj][2 * mh][0], acc[ai][bj][2 * mh][1]), pack8(acc[ai][bj][2 * mh + 1][0], acc[ai][bj][2 * mh + 1][1]), fr, fq,
                                 RV + ((size_t)((rowb >> 11) * 4 + (cb >> 7)) * 16 + ((rowb >> 7) & 15)) * 16384 + (size_t)(cb & 127) * 128 + (rowb & 127), 128); }
            return; }
#pragma unroll
        for (int ai = 0; ai < 2; ++ai)
#pragma unroll
            for (int m = 0; m < 4; ++m) { const int row = row0 + ai * 128 + m * 16;
#pragma unroll
                for (int bj = 0; bj < 2; ++bj) { const int c = col0 + bj * 128; f32x4 v0 = acc[ai][bj][m][0], v1 = acc[ai][bj][m][1];
                    if (mode == 0) { v0 = v0 * sc; v1 = v1 * sc; }
                    else {
#pragma unroll
                        for (int e = 0; e < 4; ++e) { v0[e] = v0[e] * fsigmoid(v0[e]); v1[e] = v1[e] * fsigmoid(v1[e]); } }
                    *(v4u*)(base + (size_t)row * ldc + c) = pack8(v0, v1); } }
    }
};
__device__ __forceinline__ void u8x8_to_f32(const v2u w, f32x4& a, f32x4& b) {
    a = (f32x4){(float)(w.x & 255u), (float)((w.x >> 8) & 255u), (float)((w.x >> 16) & 255u), (float)(w.x >> 24)}; b = (f32x4){(float)(w.y & 255u), (float)((w.y >> 8) & 255u), (float)((w.y >> 16) & 255u), (float)(w.y >> 24)}; }
struct EpiGate {
    static constexpr bool PERM = true;
    unsigned char* GATES; const float* bmg; bf16 *FQ, *FK; int skip;
    __device__ __forceinline__ void operator()(const pg8::f32x4 (&acc)[2][2][4][2], const Unit& u, int wr, int wc, int fr, int fq) const {
        if (skip & 33) return;
        { const int l_ = lane_now(); fr = l_ & 15; fq = (l_ >> 4) & 3; }
        if (u.pn < 4) {
            bf16* base = u.pn < 2 ? FQ : FK; const float sc = (u.pn < 2 ? C2 : 1.f) * (1.f / WSCALE);
            const int r0 = u.pm * 256 + wr * 64 + fr, c0 = (u.pn & 1) * 256 + wc * 32 + 8 * fq;
#pragma unroll
            for (int ai = 0; ai < 2; ++ai)
#pragma unroll
                for (int m = 0; m < 4; ++m)
#pragma unroll
                    for (int bj = 0; bj < 2; ++bj) *(v4u*)(base + (size_t)(r0 + ai * 128 + m * 16) * 512 + c0 + bj * 128) = pack8(acc[ai][bj][m][0] * sc, acc[ai][bj][m][1] * sc);
            return; }
        float ck = -LOG2E / WSCALE, cb = -LOG2E, c254 = 254.f; asm volatile("" : "+s"(ck), "+s"(cb), "+s"(c254));
        typedef float f2 __attribute__((ext_vector_type(2)));
        const int row0 = u.pm * 256 + wr * 64 + fr, col0 = (u.pn - 4) * 256 + wc * 32 + 8 * fq;
        f32x4 bb[2][2];
#pragma unroll
        for (int bj = 0; bj < 2; ++bj) { bb[bj][0] = *(const f32x4*)(bmg + col0 + bj * 128) * cb; bb[bj][1] = *(const f32x4*)(bmg + col0 + bj * 128 + 4) * cb; }
#pragma unroll
        for (int ai = 0; ai < 2; ++ai)
#pragma unroll
            for (int m = 0; m < 4; ++m) { unsigned char* rowp = GATES + (size_t)(row0 + ai * 128 + m * 16) * 2048 + col0;
#pragma unroll
                for (int bj = 0; bj < 2; ++bj) { v2u w;
#pragma unroll
                    for (int n = 0; n < 2; ++n) { const f32x4 a = acc[ai][bj][m][n], b = bb[bj][n]; unsigned b4 = 0u;
#pragma unroll
                        for (int hh = 0; hh < 2; ++hh) { const f2 t = (f2){a[2 * hh], a[2 * hh + 1]} * ck + (f2){b[2 * hh], b[2 * hh + 1]};
                            f2 ex; ex.x = __builtin_amdgcn_exp2f(t.x); ex.y = __builtin_amdgcn_exp2f(t.y); const f2 den = ex + 1.0f;
                            f2 rc; rc.x = __builtin_amdgcn_rcpf(den.x); rc.y = __builtin_amdgcn_rcpf(den.y); const f2 x = rc * c254 + 0.5f;
                            if (hh == 0) { b4 = __builtin_amdgcn_cvt_pk_u8_f32(x.x, 0, b4); b4 = __builtin_amdgcn_cvt_pk_u8_f32(x.y, 1, b4); }
                            else { b4 = __builtin_amdgcn_cvt_pk_u8_f32(x.x, 2, b4); b4 = __builtin_amdgcn_cvt_pk_u8_f32(x.y, 3, b4); } }
                        if (n == 0) w.x = b4; else w.y = b4; }
                    *(v2u*)(rowp + bj * 128) = w; } }
    }
};
struct HookMerge {
    static constexpr bool ON = true; static constexpr int AT = 6;
    const unsigned char* GATES;
    __device__ __forceinline__ void operator()(pg8::f32x4 (&acc)[2][2][4][2], const Unit& u, int wr, int wc, int fr, int fq) const {
        asm volatile("" : "+v"(fr), "+v"(fq));
        const int row0 = u.pm * 256 + wr * 64 + fr, col0 = u.pn * 256 + wc * 32 + 8 * fq;
        v2u ga[2][4][2], gb[2][4][2];
#pragma unroll
        for (int ai = 0; ai < 2; ++ai)
#pragma unroll
            for (int m = 0; m < 4; ++m) { const unsigned char* gp = GATES + (size_t)(row0 + ai * 128 + m * 16) * 2048 + col0;
#pragma unroll
                for (int bj = 0; bj < 2; ++bj) { ga[ai][m][bj] = *(const v2u*)(gp + bj * 128); gb[ai][m][bj] = *(const v2u*)(gp + 1024 + bj * 128); } }
        __builtin_amdgcn_sched_barrier(0);
#pragma unroll
        for (int ai = 0; ai < 2; ++ai)
#pragma unroll
            for (int m = 0; m < 4; ++m)
#pragma unroll
                for (int bj = 0; bj < 2; ++bj) { f32x4 a0, a1, b0, b1; u8x8_to_f32(ga[ai][m][bj], a0, a1); u8x8_to_f32(gb[ai][m][bj], b0, b1);
#pragma unroll
                    for (int e2 = 0; e2 < 4; ++e2) { acc[ai][bj][m][0][e2] *= a0[e2] * __builtin_amdgcn_rcpf(fmaxf(b0[e2], 1e-30f)); acc[ai][bj][m][1][e2] *= a1[e2] * __builtin_amdgcn_rcpf(fmaxf(b1[e2], 1e-30f)); } }
        __builtin_amdgcn_sched_barrier(0);
    }
};
struct EpiMerge {
    static constexpr bool PERM = true;
    const unsigned char* GATES; bf16* MERGED;
    __device__ __forceinline__ void operator()(const pg8::f32x4 (&acc)[2][2][4][2], const Unit& u, int wr, int wc, int fr, int fq) const {
        asm volatile("" : "+v"(fr), "+v"(fq));
        const int row0 = u.pm * 256 + wr * 64 + fr, col0 = u.pn * 256 + wc * 32 + 8 * fq;
        v2u gg[2][4][2];
#pragma unroll
        for (int ai = 0; ai < 2; ++ai)
#pragma unroll
            for (int m = 0; m < 4; ++m)
#pragma unroll
                for (int bj = 0; bj < 2; ++bj) gg[ai][m][bj] = *(const v2u*)(GATES + (size_t)(row0 + ai * 128 + m * 16) * 2048 + 1024 + col0 + bj * 128);
        __builtin_amdgcn_sched_barrier(0);
#pragma unroll
        for (int ai = 0; ai < 2; ++ai)
#pragma unroll
            for (int m = 0; m < 4; ++m)
#pragma unroll
                for (int bj = 0; bj < 2; ++bj) { f32x4 g0, g1; u8x8_to_f32(gg[ai][m][bj], g0, g1);
#pragma unroll
                    for (int e2 = 0; e2 < 4; ++e2) { g0[e2] = fmaxf(g0[e2], 1e-30f) * (1.f / 254.f); g1[e2] = fmaxf(g1[e2], 1e-30f) * (1.f / 254.f); }
                    *(v4u*)(MERGED + (size_t)(row0 + ai * 128 + m * 16) * 1024 + col0 + bj * 128) = pack8(acc[ai][bj][m][0] * g0, acc[ai][bj][m][1] * g1); }
    }
};
struct EpiMO {
    static constexpr bool PERM = true;
    bf16* MO;
    __device__ __forceinline__ void operator()(const pg8::f32x4 (&acc)[2][2][4][2], const Unit& u, int wr, int wc, int fr, int fq) const {
        asm volatile("" : "+v"(fr), "+v"(fq));
        const int row0 = u.pm * 256 + wr * 64 + fr, col0 = u.pn * 256 + wc * 32 + 8 * fq;
#pragma unroll
        for (int ai = 0; ai < 2; ++ai)
#pragma unroll
            for (int m = 0; m < 4; ++m) { bf16* rowp = MO + (size_t)(row0 + ai * 128 + m * 16) * 1024 + col0;
#pragma unroll
                for (int bj = 0; bj < 2; ++bj) *(v4u*)(rowp + bj * 128) = pack8(acc[ai][bj][m][0], acc[ai][bj][m][1]); }
    }
};
struct EpiGU {
    static constexpr bool PERM = true;
    const float* bgu; const float* rsof; unsigned char* ACT;
    __device__ __forceinline__ void operator()(const pg8::f32x4 (&acc)[2][2][4][2], const Unit& u, int wr, int wc, int fr, int fq) const {
        { const int l_ = lane_now(); fr = l_ & 15; fq = (l_ >> 4) & 3; }
        float c7 = 7.f, cm7 = -7.f, ck = -1.702f * 1.4426950408889634f; asm volatile("" : "+s"(c7), "+s"(cm7), "+s"(ck));
        const int j0 = u.pn * 128 + wc * 32 + 8 * fq;
        const float* bb = bgu + (size_t)u.e * 2048 + 2 * j0;
        const f32x4 q0 = *(const f32x4*)(bb), q1 = *(const f32x4*)(bb + 4), q2 = *(const f32x4*)(bb + 8), q3 = *(const f32x4*)(bb + 12);
        const f32x4 bg0 = {q0[0], q0[2], q1[0], q1[2]}, bl0 = {q0[1], q0[3], q1[1], q1[3]}, bg1 = {q2[0], q2[2], q3[0], q3[2]}, bl1 = {q2[1], q2[3], q3[1], q3[3]};
        const int rl0 = wr * 64 + fr;
        float rsv[2][4];
#pragma unroll
        for (int ai = 0; ai < 2; ++ai)
#pragma unroll
            for (int m = 0; m < 4; ++m) rsv[ai][m] = rsof[(size_t)u.e * NT + u.rtl * 256 + rl0 + ai * 128 + m * 16];
        __builtin_amdgcn_sched_barrier(0);
#pragma unroll
        for (int ai = 0; ai < 2; ++ai)
#pragma unroll
            for (int m = 0; m < 4; ++m) { const int rl = rl0 + ai * 128 + m * 16; const float rs = rsv[ai][m] * (1.f / WSCALE);
                int wpk[2];
#pragma unroll
                for (int n = 0; n < 2; ++n) { const f32x4 ga = acc[ai][0][m][n], la = acc[ai][1][m][n]; const f32x4 bgv = n ? bg1 : bg0, blv = n ? bl1 : bl0; int w = 0;
#pragma unroll
                    for (int hh = 0; hh < 2; ++hh) { typedef float f2 __attribute__((ext_vector_type(2)));
                        f2 g = (f2){ga[2 * hh], ga[2 * hh + 1]} * rs + (f2){bgv[2 * hh], bgv[2 * hh + 1]}, l = (f2){la[2 * hh], la[2 * hh + 1]} * rs + (f2){blv[2 * hh], blv[2 * hh + 1]};
                        f2 a, b; a.x = fminf(g.x, c7); a.y = fminf(g.y, c7); b.x = __builtin_amdgcn_fmed3f(l.x, cm7, c7); b.y = __builtin_amdgcn_fmed3f(l.y, cm7, c7);
                        const f2 t = a * ck; f2 ex; ex.x = __builtin_amdgcn_exp2f(t.x); ex.y = __builtin_amdgcn_exp2f(t.y);
                        const f2 den = ex + 1.0f; f2 rc; rc.x = __builtin_amdgcn_rcpf(den.x); rc.y = __builtin_amdgcn_rcpf(den.y);
                        const f2 o = (a * rc) * (b + 1.0f);
                        if (hh == 0) w = __builtin_amdgcn_cvt_pk_fp8_f32(o.x, o.y, w, false); else w = __builtin_amdgcn_cvt_pk_fp8_f32(o.x, o.y, w, true); }
                    wpk[n] = w; }
                *(v2u*)(ACT + ((size_t)u.pm * 256 + rl) * 1024 + j0) = (v2u){(unsigned)wpk[0], (unsigned)wpk[1]}; }
    }
};
struct EpiDN {
    static constexpr bool PERM = true;
    const float* bdn; unsigned char* Y;
    __device__ __forceinline__ void operator()(const pg8::f32x4 (&acc)[2][2][4][2], const Unit& u, int wr, int wc, int fr, int fq) const {
        asm volatile("" : "+v"(fr), "+v"(fq));
        const int col0 = u.pn * 256 + wc * 32 + 8 * fq; const float* bb = bdn + (size_t)u.e * 1024 + col0;
        f32x4 bv[2][2];
#pragma unroll
        for (int bj = 0; bj < 2; ++bj) { bv[bj][0] = *(const f32x4*)(bb + bj * 128) * YSCALE; bv[bj][1] = *(const f32x4*)(bb + bj * 128 + 4) * YSCALE; }
        const int rl0 = wr * 64 + fr;
#pragma unroll
        for (int ai = 0; ai < 2; ++ai)
#pragma unroll
            for (int m = 0; m < 4; ++m) { unsigned char* rowp = Y + ((size_t)u.pm * 256 + rl0 + ai * 128 + m * 16) * 1024 + col0;
#pragma unroll
                for (int bj = 0; bj < 2; ++bj) *(v2u*)(rowp + bj * 128) = pack8_fp8(acc[ai][bj][m][0] * (YSCALE / WSCALE) + bv[bj][0], acc[ai][bj][m][1] * (YSCALE / WSCALE) + bv[bj][1]); }
    }
};
struct EpiPJ {
    static constexpr bool PERM = false;
    bf16* PJ;
    __device__ __forceinline__ void operator()(const pg8::f32x4 (&acc)[2][2][4][2], const Unit& u, int wr, int wc, int fr, int fq) const {
        asm volatile("" : "+v"(fr), "+v"(fq));
        const int row0 = u.pm * 256 + wr * 64 + fr, col0 = u.pn * 256 + wc * 32 + 4 * fq;
#pragma unroll
        for (int ai = 0; ai < 2; ++ai)
#pragma unroll
            for (int m = 0; m < 4; ++m) { const size_t off = (size_t)(row0 + ai * 128 + m * 16) * 1024 + col0;
#pragma unroll
                for (int bj = 0; bj < 2; ++bj)
#pragma unroll
                    for (int n = 0; n < 2; ++n) { const f32x4 v = acc[ai][bj][m][n]; v2u w; w.x = cvt_pk_bf16(v[0], v[1]); w.y = cvt_pk_bf16(v[2], v[3]); *(v2u*)(PJ + off + bj * 128 + n * 16) = w; } }
    }
};
struct EpiPG {
    static constexpr bool PERM = true;
    unsigned char* G8; const float* rstd2;
    __device__ __forceinline__ void operator()(const pg8::f32x4 (&acc)[2][2][4][2], const Unit& u, int wr, int wc, int fr, int fq) const {
        { const int l_ = lane_now(); fr = l_ & 15; fq = (l_ >> 4) & 3; }
        float ck = -LOG2E / WSCALE, c254 = 254.f; asm volatile("" : "+s"(ck), "+s"(c254));
        typedef float f2 __attribute__((ext_vector_type(2)));
        const int row0 = u.pm * 256 + wr * 64 + fr, col0 = u.pn * 256 + wc * 32 + 8 * fq;
        float rsv[2][4];
#pragma unroll
        for (int ai = 0; ai < 2; ++ai)
#pragma unroll
            for (int m = 0; m < 4; ++m) rsv[ai][m] = rstd2[row0 + ai * 128 + m * 16];
        __builtin_amdgcn_sched_barrier(0);
#pragma unroll
        for (int ai = 0; ai < 2; ++ai)
#pragma unroll
            for (int m = 0; m < 4; ++m) { const float rs = rsv[ai][m] * ck; unsigned char* rowp = G8 + (size_t)(row0 + ai * 128 + m * 16) * 1024 + col0;
#pragma unroll
                for (int bj = 0; bj < 2; ++bj) { v2u w;
#pragma unroll
                    for (int n = 0; n < 2; ++n) { const f32x4 a = acc[ai][bj][m][n]; unsigned b4 = 0u;
#pragma unroll
                        for (int hh = 0; hh < 2; ++hh) { const f2 t = (f2){a[2 * hh], a[2 * hh + 1]} * rs;
                            f2 ex; ex.x = __builtin_amdgcn_exp2f(t.x); ex.y = __builtin_amdgcn_exp2f(t.y); const f2 den = ex + 1.0f;
                            f2 rc; rc.x = __builtin_amdgcn_rcpf(den.x); rc.y = __builtin_amdgcn_rcpf(den.y); const f2 x = rc * c254 + 0.5f;
                            if (hh == 0) { b4 = __builtin_amdgcn_cvt_pk_u8_f32(x.x, 0, b4); b4 = __builtin_amdgcn_cvt_pk_u8_f32(x.y, 1, b4); }
                            else { b4 = __builtin_amdgcn_cvt_pk_u8_f32(x.x, 2, b4); b4 = __builtin_amdgcn_cvt_pk_u8_f32(x.y, 3, b4); } }
                        if (n == 0) w.x = b4; else w.y = b4; }
                    *(v2u*)(rowp + bj * 128) = w; } }
    }
};

__device__ __forceinline__ int moe_setup(Frame& F) {
    LAS int* cnt = (LAS int*)(F.lds + SCH_CNT); LAS int* P = (LAS int*)(F.lds + SCH_P); LAS int* rt2e = (LAS int*)(F.lds + SCH_RT2E);
    if (F.tid < NE) cnt[F.tid] = (int)__hip_atomic_load(((gu32*)(F.ap->ws + WS_CTL)) + CW_CNT + F.tid, RLX_AGENT);
    __syncthreads();
    if (F.tid == 0) { int s = 0; for (int e = 0; e < NE; ++e) { P[e] = s; s += (cnt[e] + 255) >> 8; } P[NE] = s; }
    __syncthreads();
    const int RT = __builtin_amdgcn_readfirstlane(P[NE]);
    for (int t = F.tid; t < RT && t < MAXRT; t += NWAVES * 64) { int e = 0;
#pragma unroll
        for (int k = 1; k <= NE; ++k) e += (P[k] <= t) ? 1 : 0;
        rt2e[t] = e; }
    __syncthreads();
    return RT < MAXRT ? RT : MAXRT;
}
struct MoeOrder {
    pg8::DenseOrder d; LAS const int* P; LAS const int* rt2e; LAS const unsigned* tab;
    const char* Abase; size_t tsA; const char* Bbase; size_t estride, tsB; bool gather;
    __device__ __forceinline__ bool next(int i, Unit& u) const {
        if (!d.tile(i, u.pm, u.pn)) return false;
        const int e = __builtin_amdgcn_readfirstlane(rt2e[u.pm]); u.e = e; u.rtl = u.pm - __builtin_amdgcn_readfirstlane(P[e]);
        u.A = gather ? Abase : Abase + (size_t)u.pm * tsA; u.B = Bbase + (size_t)e * estride + (size_t)u.pn * tsB; return true;
    }
    __device__ __forceinline__ const LAS unsigned char* table(int ui) const { return (const LAS unsigned char*)tab + ui * 1024; }
};

__device__ __forceinline__ void router_pass(Frame& F) {
    LAS float* L = (LAS float*)(F.lds + RING_OFF + F.wave * 2304);
    LAS int* hist = (LAS int*)(F.lds + RING_OFF + 32768); LAS int* hbase = hist + 32;
    if (F.tid < 64) hist[F.tid] = 0;
    __syncthreads();
    const float* X = (F.ap->in[0]); const bf16* MO = WSP(bf16, WS_MO); bf16* MOw = WSP(bf16, WS_MO); unsigned char* HB = WSP(unsigned char, WS_HB); const bf16* wrt = WSP(bf16, WS_WRT);
    const int lane = F.lane, r = lane & 15, q = lane >> 4, tok0 = (int)blockIdx.x * 128 + F.wave * 16, token = tok0 + r;
    pg8::f32x4 acc0 = {0.f, 0.f, 0.f, 0.f}, acc1 = {0.f, 0.f, 0.f, 0.f}; float ss = 0.f;
    const float* hrow = X + (size_t)token * DM + q * 8; const bf16* morow = MO + (size_t)token * DM + q * 8; const bf16* b0p = wrt + (size_t)r * 1024 + q * 8;
    f32x4 xa[2][2][2], ga[2][2][2]; v4u ma[2][2], wa[2][2][4];
#define RT_LOAD(buf, grp) do { _Pragma("unroll") for (int s_ = 0; s_ < 2; ++s_) { const int kk_ = (grp) * 2 + s_; \
        xa[buf][s_][0] = *(const f32x4*)(hrow + kk_ * 32); xa[buf][s_][1] = *(const f32x4*)(hrow + kk_ * 32 + 4); ma[buf][s_] = *(const v4u*)(morow + kk_ * 32); \
        ga[buf][s_][0] = *(const f32x4*)((F.ap->in[9]) + kk_ * 32 + q * 8); ga[buf][s_][1] = *(const f32x4*)((F.ap->in[9]) + kk_ * 32 + q * 8 + 4); \
        wa[buf][s_][0] = *(const v4u*)(b0p + kk_ * 32); wa[buf][s_][1] = *(const v4u*)(b0p + 16 * 1024 + kk_ * 32); wa[buf][s_][2] = *(const v4u*)(b0p + 32768 + kk_ * 32); wa[buf][s_][3] = *(const v4u*)(b0p + 32768 + 16 * 1024 + kk_ * 32); } } while (0)
#define RT_STEP(buf, grp) do { _Pragma("unroll") for (int s_ = 0; s_ < 2; ++s_) { const int kk_ = (grp) * 2 + s_; \
        f32x4 h0 = xa[buf][s_][0], h1 = xa[buf][s_][1]; { f32x4 m0, m1; unpack8(ma[buf][s_], m0, m1); h0 = h0 + m0; h1 = h1 + m1; } \
        ss += (h0[0] * h0[0] + h0[1] * h0[1]) + (h0[2] * h0[2] + h0[3] * h0[3]) + (h1[0] * h1[0] + h1[1] * h1[1]) + (h1[2] * h1[2] + h1[3] * h1[3]); \
        const f32x4 x0 = h0 * ga[buf][s_][0], x1 = h1 * ga[buf][s_][1]; \
        const v4u hi = pack8(x0, x1); f32x4 y0, y1; unpack8(hi, y0, y1); const v4u lo = pack8(x0 - y0, x1 - y1); \
        *(v2u*)(HB + (size_t)token * DM + kk_ * 32 + q * 8) = pack8_fp8(x0, x1); *(v4u*)(MOw + (size_t)token * DM + q * 8 + kk_ * 32) = pack8(h0, h1);     \
        const bf16x8 ah = __builtin_bit_cast(bf16x8, hi), al = __builtin_bit_cast(bf16x8, lo); \
        acc0 = __builtin_amdgcn_mfma_f32_16x16x32_bf16(ah, __builtin_bit_cast(bf16x8, wa[buf][s_][0]), acc0, 0, 0, 0); acc0 = __builtin_amdgcn_mfma_f32_16x16x32_bf16(al, __builtin_bit_cast(bf16x8, wa[buf][s_][0]), acc0, 0, 0, 0); \
        acc0 = __builtin_amdgcn_mfma_f32_16x16x32_bf16(ah, __builtin_bit_cast(bf16x8, wa[buf][s_][2]), acc0, 0, 0, 0); \
        acc1 = __builtin_amdgcn_mfma_f32_16x16x32_bf16(ah, __builtin_bit_cast(bf16x8, wa[buf][s_][1]), acc1, 0, 0, 0); acc1 = __builtin_amdgcn_mfma_f32_16x16x32_bf16(al, __builtin_bit_cast(bf16x8, wa[buf][s_][1]), acc1, 0, 0, 0); \
        acc1 = __builtin_amdgcn_mfma_f32_16x16x32_bf16(ah, __builtin_bit_cast(bf16x8, wa[buf][s_][3]), acc1, 0, 0, 0); } } while (0)
    RT_LOAD(0, 0);
#pragma unroll
    for (int gp = 0; gp < 16; gp += 2) {
        RT_LOAD(1, gp + 1); __builtin_amdgcn_sched_barrier(0); RT_STEP(0, gp); __builtin_amdgcn_sched_barrier(0);
        if (gp + 2 < 16) RT_LOAD(0, gp + 2);
        __builtin_amdgcn_sched_barrier(0); RT_STEP(1, gp + 1); __builtin_amdgcn_sched_barrier(0);
    }
#undef RT_LOAD
#undef RT_STEP
    ss = xor16_sum(ss); ss = xor32_sum(ss);
    const float rstd = 1.f / sqrtf(ss * (1.f / DM) + EPS);
#pragma unroll
    for (int i = 0; i < 4; ++i) { L[(4 * q + i) * 33 + r] = acc0[i]; L[(4 * q + i) * 33 + 16 + r] = acc1[i]; }
    LDS_WAIT(); asm volatile("" ::: "memory");
    int te0 = 0, te1 = 0, te2 = 0, te3 = 0, rk0 = 0, rk1 = 0, rk2 = 0, rk3 = 0; float w0 = 0.f, w1 = 0.f, w2 = 0.f, w3 = 0.f;
    if (lane < 16) {
        float v[32];
#pragma unroll
        for (int e = 0; e < 32; ++e) v[e] = L[lane * 33 + e] * rstd + (F.ap->in[11])[e];
        float tv[4]; int te[4];
#pragma unroll
        for (int k = 0; k < 4; ++k) { float best = v[0]; int bi = 0;
#pragma unroll
            for (int e = 1; e < 32; ++e) if (v[e] > best) { best = v[e]; bi = e; }
            tv[k] = best; te[k] = bi;
#pragma unroll
            for (int e = 0; e < 32; ++e) v[e] = (e == bi) ? -INFINITY : v[e]; }
        const float e1 = expf(tv[1] - tv[0]), e2 = expf(tv[2] - tv[0]), e3 = expf(tv[3] - tv[0]), inv = 1.f / (1.f + e1 + e2 + e3);
        w0 = inv; w1 = e1 * inv; w2 = e2 * inv; w3 = e3 * inv; te0 = te[0]; te1 = te[1]; te2 = te[2]; te3 = te[3];
        rk0 = __hip_atomic_fetch_add(hist + te0, 1, __ATOMIC_RELAXED, __HIP_MEMORY_SCOPE_WORKGROUP); rk1 = __hip_atomic_fetch_add(hist + te1, 1, __ATOMIC_RELAXED, __HIP_MEMORY_SCOPE_WORKGROUP);
        rk2 = __hip_atomic_fetch_add(hist + te2, 1, __ATOMIC_RELAXED, __HIP_MEMORY_SCOPE_WORKGROUP); rk3 = __hip_atomic_fetch_add(hist + te3, 1, __ATOMIC_RELAXED, __HIP_MEMORY_SCOPE_WORKGROUP);
    }
    __syncthreads();
    if (F.tid < NE) hbase[F.tid] = (int)__hip_atomic_fetch_add(((gu32*)(F.ap->ws + WS_CTL)) + CW_CNT + F.tid, (unsigned)hist[F.tid], RLX_AGENT);
    __syncthreads();
    if (lane < 16) {
        int* TOK = WSP(int, WS_TOK); float* RSOF = WSP(float, WS_RSOF); int* TOPE = WSP(int, WS_TOPE); float* TOPW = WSP(float, WS_TOPW); int* POS = WSP(int, WS_POS);
        const int p0 = hbase[te0] + rk0, p1 = hbase[te1] + rk1, p2 = hbase[te2] + rk2, p3 = hbase[te3] + rk3;
        TOK[(size_t)te0 * NT + p0] = token; TOK[(size_t)te1 * NT + p1] = token; TOK[(size_t)te2 * NT + p2] = token; TOK[(size_t)te3 * NT + p3] = token;
        RSOF[(size_t)te0 * NT + p0] = rstd; RSOF[(size_t)te1 * NT + p1] = rstd; RSOF[(size_t)te2 * NT + p2] = rstd; RSOF[(size_t)te3 * NT + p3] = rstd;
        *(int4*)(TOPE + (size_t)token * 4) = make_int4(te0, te1, te2, te3); *(float4*)(TOPW + (size_t)token * 4) = make_float4(w0, w1, w2, w3); *(int4*)(POS + (size_t)token * 4) = make_int4(p0, p1, p2, p3);
    }
    __syncthreads();
}
__device__ __forceinline__ void combine_pass(Frame& F) {
    LAS const int* P = (LAS const int*)(F.lds + SCH_P);
    const unsigned char* Y = WSP(unsigned char, WS_Y); const bf16* MO = WSP(bf16, WS_MO); unsigned char* HB2 = WSP(unsigned char, WS_HB2); float* RSTD2 = WSP(float, WS_RSTD2); bf16* H2B = WSP(bf16, WS_H2B);
    const int* TOPE = WSP(int, WS_TOPE); const float* TOPW = WSP(float, WS_TOPW); const int* POS = WSP(int, WS_POS);
    const int lane = F.lane, tok0 = (int)blockIdx.x * 128 + F.wave * 16;
    int4 te_n[2], tp_n[2]; float4 tw_n[2], tw_c[2]; v4u mc[2][2], mn[2][2]; v2u yc[2][4][2], yn[2][4][2];
#define CB_ROUTE(i) do { _Pragma("unroll") for (int t_ = 0; t_ < 2; ++t_) { te_n[t_] = *(const int4*)(TOPE + (size_t)(tok0 + (i) + t_) * 4); tw_n[t_] = *(const float4*)(TOPW + (size_t)(tok0 + (i) + t_) * 4); tp_n[t_] = *(const int4*)(POS + (size_t)(tok0 + (i) + t_) * 4); } } while (0)
#define CB_DATA(dm, dy, i) do { _Pragma("unroll") for (int t_ = 0; t_ < 2; ++t_) { \
        const size_t s0_ = (size_t)(P[te_n[t_].x] * 256 + tp_n[t_].x) * DM, s1_ = (size_t)(P[te_n[t_].y] * 256 + tp_n[t_].y) * DM, s2_ = (size_t)(P[te_n[t_].z] * 256 + tp_n[t_].z) * DM, s3_ = (size_t)(P[te_n[t_].w] * 256 + tp_n[t_].w) * DM; \
        _Pragma("unroll") for (int j = 0; j < 2; ++j) { const int c = 8 * lane + 512 * j; dm[t_][j] = *(const v4u*)(MO + (size_t)(tok0 + (i) + t_) * DM + c); \
            dy[t_][0][j] = *(const v2u*)(Y + s0_ + c); dy[t_][1][j] = *(const v2u*)(Y + s1_ + c); dy[t_][2][j] = *(const v2u*)(Y + s2_ + c); dy[t_][3][j] = *(const v2u*)(Y + s3_ + c); } } } while (0)
    CB_ROUTE(0); CB_DATA(mc, yc, 0); tw_c[0] = tw_n[0]; tw_c[1] = tw_n[1]; CB_ROUTE(2);
    for (int i = 0; i < 16; i += 2) {
        const float4 tw_x0 = tw_n[0], tw_x1 = tw_n[1];
        if (i + 2 < 16) CB_DATA(mn, yn, i + 2);
        if (i + 4 < 16) CB_ROUTE(i + 4);
        __builtin_amdgcn_sched_barrier(0);
#pragma unroll
        for (int t = 0; t < 2; ++t) { const int token = tok0 + i + t; f32x4 v[2][2]; float ss = 0.f; const float4 tw = tw_c[t] * (1.f / YSCALE);
#pragma unroll
            for (int j = 0; j < 2; ++j) { f32x4 a, b; unpack8(mc[t][j], a, b);
#pragma unroll
                for (int k = 0; k < 4; ++k) { const v2u y = yc[t][k][j]; const float w = k == 0 ? tw.x : k == 1 ? tw.y : k == 2 ? tw.z : tw.w;
                    const auto p0 = __builtin_amdgcn_cvt_pk_f32_fp8((int)y.x, false), p1 = __builtin_amdgcn_cvt_pk_f32_fp8((int)y.x, true), p2 = __builtin_amdgcn_cvt_pk_f32_fp8((int)y.y, false), p3 = __builtin_amdgcn_cvt_pk_f32_fp8((int)y.y, true);
                    a += w * (f32x4){p0[0], p0[1], p1[0], p1[1]}; b += w * (f32x4){p2[0], p2[1], p3[0], p3[1]}; }
                v[j][0] = a; v[j][1] = b;
                ss += ((a.x * a.x + a.y * a.y) + (a.z * a.z + a.w * a.w)) + ((b.x * b.x + b.y * b.y) + (b.z * b.z + b.w * b.w)); }
            const float rstd = 1.f / sqrtf(wave_sum(ss) * (1.f / DM) + EPS);
#pragma unroll
            for (int j = 0; j < 2; ++j) { const int c = 8 * lane + 512 * j; *(v4u*)(H2B + (size_t)token * DM + c) = pack8(v[j][0], v[j][1]);
                const f32x4 g0 = *(const f32x4*)((F.ap->in[16]) + c), g1 = *(const f32x4*)((F.ap->in[16]) + c + 4);
                *(v2u*)(HB2 + (size_t)token * DM + c) = pack8_fp8(v[j][0] * g0, v[j][1] * g1); }
            if (lane == 0) RSTD2[token] = rstd; }
        __builtin_amdgcn_sched_barrier(0);
#pragma unroll
        for (int t = 0; t < 2; ++t)
#pragma unroll
            for (int j = 0; j < 2; ++j) { mc[t][j] = mn[t][j];
#pragma unroll
                for (int k = 0; k < 4; ++k) yc[t][k][j] = yn[t][k][j]; }
        tw_c[0] = tw_x0; tw_c[1] = tw_x1;
    }
#undef CB_ROUTE
#undef CB_DATA
}
__device__ __forceinline__ void final_pass(Frame& F) {
    const bf16* PJ = WSP(bf16, WS_PJ); const bf16* H2B = WSP(bf16, WS_H2B); const unsigned char* G8 = WSP(unsigned char, WS_G8); const int lane = F.lane, tok0 = (int)blockIdx.x * 128 + F.wave * 16;
    v4u hc[2][2], hn[2][2], pc[2][2], pn[2][2]; v2u gc[2][2], gn[2][2];
#define FP_LOAD(hd, pd, gd, i) do { _Pragma("unroll") for (int t_ = 0; t_ < 2; ++t_) _Pragma("unroll") for (int j = 0; j < 2; ++j) { const size_t o_ = (size_t)(tok0 + (i) + t_) * DM + 8 * lane + 512 * j; \
        hd[t_][j] = *(const v4u*)(H2B + o_); pd[t_][j] = *(const v4u*)(PJ + o_); gd[t_][j] = *(const v2u*)(G8 + o_); } } while (0)
    FP_LOAD(hc, pc, gc, 0);
    for (int i = 0; i < 16; i += 2) {
        if (i + 2 < 16) FP_LOAD(hn, pn, gn, i + 2);
        __builtin_amdgcn_sched_barrier(0);
#pragma unroll
        for (int t = 0; t < 2; ++t) { f32x4 v[2][2]; float ss = 0.f;
#pragma unroll
            for (int j = 0; j < 2; ++j) { f32x4 a, b, pa, pb; unpack8(hc[t][j], a, b); unpack8(pc[t][j], pa, pb); const unsigned g0 = gc[t][j].x, g1 = gc[t][j].y;
                const f32x4 ga = {(float)(g0 & 255u), (float)((g0 >> 8) & 255u), (float)((g0 >> 16) & 255u), (float)(g0 >> 24)}, gb = {(float)(g1 & 255u), (float)((g1 >> 8) & 255u), (float)((g1 >> 16) & 255u), (float)(g1 >> 24)};
                a += (ga * (1.f / 254.f)) * pa; b += (gb * (1.f / 254.f)) * pb; v[j][0] = a; v[j][1] = b;
                ss += ((a.x * a.x + a.y * a.y) + (a.z * a.z + a.w * a.w)) + ((b.x * b.x + b.y * b.y) + (b.z * b.z + b.w * b.w)); }
            const float rstd = 1.f / sqrtf(wave_sum(ss) * (1.f / DM) + EPS); float* hr = (F.ap->out) + (size_t)(tok0 + i + t) * DM;
#pragma unroll
            for (int j = 0; j < 2; ++j) { const int c = 8 * lane + 512 * j; const f32x4 g0 = *(const f32x4*)((F.ap->in[19]) + c), g1 = *(const f32x4*)((F.ap->in[19]) + c + 4);
                *(f32x4*)(hr + c) = v[j][0] * rstd * g0; *(f32x4*)(hr + c + 4) = v[j][1] * rstd * g1; } }
        __builtin_amdgcn_sched_barrier(0);
#pragma unroll
        for (int t = 0; t < 2; ++t)
#pragma unroll
            for (int j = 0; j < 2; ++j) { hc[t][j] = hn[t][j]; pc[t][j] = pn[t][j]; gc[t][j] = gn[t][j]; }
    }
#undef FP_LOAD
}

struct PnOffOrder { pg8::DenseOrder d; int off;
    __device__ __forceinline__ bool next(int i, pg8::Unit& u) const { if (!d.next(i, u)) return false; u.pn += off; return true; }
    __device__ __forceinline__ const LAS unsigned char* table(int) const { return nullptr; } };
struct StrideOrder { int start, stride, n; const char* A; const char* B; size_t tsA, tsB;
    __device__ __forceinline__ bool next(int i, pg8::Unit& u) const { const int idx = start + i * stride; if (idx >= n) return false; u.pm = idx >> 2; u.pn = idx & 3; u.A = A + (size_t)u.pm * tsA; u.B = B + (size_t)u.pn * tsB; u.e = 0; u.rtl = 0; return true; }
    __device__ __forceinline__ const LAS unsigned char* table(int) const { return nullptr; } };
constexpr int N_PHASES = 11;

__global__ void __launch_bounds__(NWAVES * 64, 2) fwd(Args args) {
    extern __shared__ __attribute__((aligned(16))) unsigned char lds[];
    Frame F;
    F.lds = (LAS unsigned char*)lds;
    F.MISC = (volatile LAS unsigned*)(F.lds + MISC_OFF);
    F.tid = threadIdx.x; F.lane = F.tid & 63; F.wave = __builtin_amdgcn_readfirstlane(F.tid >> 6);
    F.G = gridDim.x; { const int bx = blockIdx.x; F.vcu = (F.G % 8 == 0) ? (bx % 8) * (F.G / 8) + bx / 8 : bx; }
    REARGS();
    for (int u = F.tid; u < 64; u += NWAVES * 64) ((LAS unsigned*)(F.lds + MISC_OFF))[u] = 0u;
    __syncthreads();
    const bool one = (F.ap->ph_hi - F.ap->ph_lo) > 1;
    XcdBarrier bar; bar.bar = (unsigned*)(((gu32*)(F.ap->ws + WS_CTL)) + CW_BAR); bar.x = 0; bar.st = nullptr;
    if (one) bar = xcd_barrier_post((unsigned*)(((gu32*)(F.ap->ws + WS_CTL)) + CW_BAR), F.MISC + 8, F.tid);
#ifdef ONLY_PHASE
    constexpr int lo = ONLY_PHASE, hi = ONLY_PHASE + 1;
#else
    const int lo = F.ap->ph_lo, hi = F.ap->ph_hi;
#endif
    int cid = (int)blockIdx.x;
#define IN(k) (lo <= (k) && (k) < hi)
#define RELANE() do { int l_ = lane_now(); asm volatile("" : "+v"(l_)); F.lane = l_; F.tid = F.wave * 64 + l_; REARGS(); asm volatile("" : "+s"(cid)); } while (0)
#define GBAR() do { RELANE(); xcd_barrier(bar, F.tid); } while (0)
#define SEAM(k) do { if (IN(k) && IN((k) + 1)) GBAR(); } while (0)
    const int rep_phase = F.ap->rep_phase, rep_mode = F.ap->rep_mode;
#define NREP(k) (((k) == rep_phase) ? 2 : 1)
    LAS unsigned char* ring = F.lds + RING_OFF;

    for (int rep = 0; rep < NREP(0); ++rep) { if (rep) GBAR(); if (IN(0)) { RELANE(); p0_prologue(F); } } SEAM(0);
    for (int rep = 0; rep < NREP(1); ++rep) { if (rep) GBAR(); if (IN(1)) { RELANE();
        if (cid < NBATCH * 8) cum_scan(F, cid);
        { pg8::Gemm g{1024, 1024, 1024}; PnOffOrder S; S.off = 4; S.d.init(NT / 256, 8, F.G, cid, WSP(bf16, WS_XN), (size_t)256 * 1024 * 2, WSP(bf16, WS_W1T), (size_t)256 * 1024 * 2);
          EpiIn E{WSP(bf16, WS_FQ), WSP(bf16, WS_FK), WSP(bf16, WS_FV), WSP(bf16, WS_RQ), WSP(bf16, WS_RK), WSP(bf16, WS_RV), WSP(bf16, WS_RGS), WSP(float, WS_ROT), WSP(bf16, WS_RKT), F.lds + TAB_OFF, (rep == 1 && rep_mode >= 7) ? (rep_mode == 7 ? 1 : rep_mode - 64) : 0};
          pg8::gemm_phase<EpiIn, PnOffOrder, true, false>(ring, g, S, E, F.wave); }
        { RELANE();
          pg8::Gemm g{1024, 1024, 1024}; pg8::DenseOrder S; S.init(NT / 256, 12, F.G, cid, WSP(unsigned char, WS_XN8), (size_t)256 * 1024, WSP(unsigned char, WS_WG8T), (size_t)256 * 1024);
          EpiGate E{WSP(unsigned char, WS_GATES), (F.ap->in[7]), WSP(bf16, WS_FQ), WSP(bf16, WS_FK), (rep == 1 && rep_mode >= 7) ? (rep_mode == 7 ? 1 : rep_mode - 64) : 0};
          pg8::gemm_phase<EpiGate, pg8::DenseOrder, true, false, 1>(ring, g, S, E, F.wave); }
    } } SEAM(1);
    for (int rep = 0; rep < NREP(2); ++rep) { if (rep) GBAR(); if (IN(2)) { RELANE();
        { static_assert(ret_body::LDS_BYTES <= RING_BYTES && attn_body::ATTN_LDS_BYTES <= RING_BYTES, "phase scratch inside the ring");
          volatile LAS int* qn = (volatile LAS int*)(F.MISC + 16);
          const attn_body::bf16* Q = (const attn_body::bf16*)WSP(bf16, WS_FQ); const attn_body::bf16* K = (const attn_body::bf16*)WSP(bf16, WS_FK); const attn_body::bf16* V = (const attn_body::bf16*)WSP(bf16, WS_FV);
          attn_body::bf16* O = (attn_body::bf16*)WSP(bf16, WS_BR);
          if (lane_now() + F.wave * 64 == 0) qn[0] = (int)__hip_atomic_fetch_add(((gu32*)(F.ap->ws + WS_CTL)) + CW_QUEUE + 64 * rep, 1u, RLX_AGENT);
          __syncthreads();
          for (int n = 0;; ++n) {
              const int item = __builtin_amdgcn_readfirstlane(qn[n & 1]);
              if (item >= 128 + 1024 + CONV_CHUNKS) break;
              int nxt_item = 0;
              if (lane_now() + F.wave * 64 == 0) nxt_item = (int)__hip_atomic_fetch_add(((gu32*)(F.ap->ws + WS_CTL)) + CW_QUEUE + 64 * rep, 1u, RLX_AGENT);
              if (item < 128) { const int bh4 = item & 63, second = (item < 64);
                  ret_body::ret_unit(ring, bh4 >> 2, bh4 & 3, WSP(bf16, WS_RQ), WSP(bf16, WS_RK), WSP(bf16, WS_RV), WSP(bf16, WS_RKT), WSP(bf16, WS_RGS), WSP(bf16, WS_BR), F.wave, second ? 8 : 0, second ? 16 : 8, 0); }
              else { const int r = item - 128, cb = (int)(((long)r * CONV_CHUNKS) / (1024 + CONV_CHUNKS)), cn = (int)(((long)(r + 1) * CONV_CHUNKS) / (1024 + CONV_CHUNKS));
                  if (cn > cb) { RELANE(); conv_chunk(F, cb); }
                  else { const int k = r - cb, qb = 7 - (k >> 7), bh = k & 127;
                      attn_body::attn_unit<8>(bh >> 3, bh & 7, qb, Q, K, V, O, WSP(float, WS_CUM) + (size_t)bh * SEQ, (char*)lds + RING_OFF, F.wave); } }
              if (lane_now() + F.wave * 64 == 0) qn[(n + 1) & 1] = nxt_item;
              __syncthreads();
          } }
    } } SEAM(2);
    for (int rep = 0; rep < NREP(3); ++rep) { if (rep) GBAR(); if (IN(3)) { RELANE();
        pg8::Gemm g{1024, 1024, 1024}; pg8::DenseOrder S; S.init(NT / 256, 4, F.G, cid, WSP(bf16, WS_BR), (size_t)256 * 1024 * 2, WSP(bf16, WS_WBT), (size_t)256 * 1024 * 2);
        EpiMerge E{WSP(unsigned char, WS_GATES), WSP(bf16, WS_MERGED)}; HookMerge H{WSP(unsigned char, WS_GATES)};
        pg8::gemm_phase<EpiMerge, pg8::DenseOrder, true, false, 2, HookMerge>(ring, g, S, E, F.wave, H);
    } } SEAM(3);
    for (int rep = 0; rep < NREP(4); ++rep) { if (rep) GBAR(); if (IN(4)) { RELANE();
        pg8::Gemm g{1024, 1024, 1024}; pg8::DenseOrder S; S.init(NT / 256, 4, F.G, cid, WSP(bf16, WS_MERGED), (size_t)256 * 1024 * 2, WSP(bf16, WS_WOT), (size_t)256 * 1024 * 2);
        EpiMO E{WSP(bf16, WS_MO)}; pg8::gemm_phase<EpiMO, pg8::DenseOrder, true, false>(ring, g, S, E, F.wave);
    } } SEAM(4);
    for (int rep = 0; rep < NREP(5); ++rep) { if (rep) GBAR(); if (IN(5)) { RELANE(); router_pass(F); } } SEAM(5);
    for (int rep = 0; rep < NREP(6); ++rep) { if (rep) GBAR(); if (IN(6)) { RELANE();
        const int RT = moe_setup(F);
        MoeOrder S; S.d.init(RT, 8, F.G, cid, nullptr, 0, nullptr, 0); S.P = (LAS const int*)(F.lds + SCH_P); S.rt2e = (LAS const int*)(F.lds + SCH_RT2E); S.tab = (LAS const unsigned*)(F.lds + TAB_OFF);
        S.Abase = (const char*)WSP(unsigned char, WS_HB); S.tsA = 0; S.Bbase = (const char*)WSP(unsigned char, WS_WGUT); S.estride = (size_t)2048 * 1024; S.tsB = (size_t)256 * 1024; S.gather = true;
        { LAS const int* cnt = (LAS const int*)(F.lds + SCH_CNT); LAS unsigned* tab = (LAS unsigned*)(F.lds + TAB_OFF); const int* TOK = WSP(int, WS_TOK);
          int tokv[MAXUNITS / 2];
#pragma unroll
          for (int j = 0; j < MAXUNITS / 2; ++j) { const int ui = 2 * j + (F.tid >> 8), r = F.tid & 255; int pm, pn; tokv[j] = -1;
              if (S.d.tile(ui, pm, pn)) { const int e = S.rt2e[pm], pos = (pm - S.P[e]) * 256 + r; tokv[j] = pos < cnt[e] ? TOK[(size_t)e * NT + pos] : NT; } }
#pragma unroll
          for (int j = 0; j < MAXUNITS / 2; ++j) { const int ui = 2 * j + (F.tid >> 8), r = F.tid & 255; if (tokv[j] >= 0) tab[ui * 256 + r] = (unsigned)tokv[j] * 1024u; }
          __syncthreads(); }
        pg8::Gemm g{1024, 1024, 1024};
        EpiGU E{(F.ap->in[13]), WSP(float, WS_RSOF), WSP(unsigned char, WS_ACT)}; pg8::gemm_phase<EpiGU, MoeOrder, true, true, 1>(ring, g, S, E, F.wave);
    } } SEAM(6);
    for (int rep = 0; rep < NREP(7); ++rep) { if (rep) GBAR(); if (IN(7)) { RELANE();
        const int RT = moe_setup(F);
        MoeOrder S; S.d.init(RT, 4, F.G, cid, nullptr, 0, nullptr, 0); S.P = (LAS const int*)(F.lds + SCH_P); S.rt2e = (LAS const int*)(F.lds + SCH_RT2E); S.tab = (LAS const unsigned*)(F.lds + TAB_OFF);
        S.Abase = (const char*)WSP(unsigned char, WS_ACT); S.tsA = (size_t)256 * 1024; S.Bbase = (const char*)WSP(unsigned char, WS_WDT); S.estride = (size_t)1024 * 1024; S.tsB = (size_t)256 * 1024; S.gather = false;
        pg8::Gemm g{1024, 1024, 1024};
        EpiDN E{(F.ap->in[15]), WSP(unsigned char, WS_Y)}; pg8::gemm_phase<EpiDN, MoeOrder, true, false, 1>(ring, g, S, E, F.wave);
        { const int rem = (RT * 4) % F.G, nidle = F.G - rem; const bool tail = 2 * nidle >= F.G;
          if (!tail || cid >= rem) { RELANE(); pg8::Gemm g2{256, 256, 256}; StrideOrder S2; S2.start = tail ? cid - rem : cid; S2.stride = tail ? nidle : F.G; S2.n = (NT / 256) * 4; S2.A = (const char*)WSP(bf16, WS_PB); S2.tsA = (size_t)256 * 256 * 2; S2.B = (const char*)WSP(bf16, WS_WPPT); S2.tsB = (size_t)256 * 256 * 2;
              EpiPJ E2{WSP(bf16, WS_PJ)}; pg8::gemm_phase<EpiPJ, StrideOrder, true, false>(ring, g2, S2, E2, F.wave); } }
    } } SEAM(7);
    for (int rep = 0; rep < NREP(8); ++rep) { if (rep) GBAR(); if (IN(8)) { RELANE(); (void)moe_setup(F); combine_pass(F); } } SEAM(8);
    for (int rep = 0; rep < NREP(9); ++rep) { if (rep) GBAR(); if (IN(9)) { RELANE();
        { pg8::Gemm g{1024, 1024, 1024}; pg8::DenseOrder S; S.init(NT / 256, 4, F.G, cid, WSP(unsigned char, WS_HB2), (size_t)256 * 1024, WSP(unsigned char, WS_WPGT), (size_t)256 * 1024);
          EpiPG E{WSP(unsigned char, WS_G8), WSP(float, WS_RSTD2)}; pg8::gemm_phase<EpiPG, pg8::DenseOrder, true, false, 1>(ring, g, S, E, F.wave); }
    } } SEAM(9);
    if (IN(10)) { RELANE(); final_pass(F); }
#undef IN
#undef SEAM
}

extern "C" void kernel_launch(void* const* d_in, const int* in_sizes, int n_in, void* d_out, int out_size, void* d_ws, size_t ws_size, hipStream_t stream) {
    static int grid = 0;
    if (grid == 0) {
        if (n_in != 20 || in_sizes[0] != NT * DM || out_size != NT * DM || ws_size < WS_END) { fprintf(stderr, "kernel_launch: unexpected shapes / workspace (%zu < %zu); nothing launched\n", ws_size, (size_t)WS_END); grid = -1; return; }
        int dev = 0, cus = 0, per_cu = 0;
        if (hipGetDevice(&dev) != hipSuccess || hipDeviceGetAttribute(&cus, hipDeviceAttributeMultiprocessorCount, dev) != hipSuccess) { grid = -1; return; }
        if (hipFuncSetAttribute((const void*)fwd, hipFuncAttributeMaxDynamicSharedMemorySize, LDS_BYTES) != hipSuccess) { fprintf(stderr, "kernel_launch: hipFuncSetAttribute failed\n"); grid = -1; return; }
        if (hipOccupancyMaxActiveBlocksPerMultiprocessor(&per_cu, (const void*)fwd, NWAVES * 64, LDS_BYTES) != hipSuccess || per_cu < 1) { fprintf(stderr, "kernel_launch: occupancy query reports %d workgroups per CU\n", per_cu); }
        (void)hipGetLastError();
        grid = cus;
        if (grid != 256) { fprintf(stderr, "kernel_launch: built for 256 CUs, found %d; nothing launched\n", cus); grid = -1; return; }
    }
    if (grid < 0) return;
    if (hipMemsetAsync((char*)d_ws + WS_CTL, 0, CTL_ZERO_BYTES, stream) != hipSuccess) return;
    Args a; memset(&a, 0, sizeof a);
    for (int i = 0; i < 20; ++i) a.in[i] = (const float*)d_in[i];
    a.out = (float*)d_out; a.ws = (unsigned char*)d_ws;
#ifndef MK_SPLIT
    a.ph_lo = 0; a.ph_hi = N_PHASES;
#ifdef PROBE_PHASE
    a.rep_phase = PROBE_PHASE; a.rep_mode = PROBE_MODE;
#else
    a.rep_phase = -1; a.rep_mode = 0;
#endif
    hipLaunchKernelGGL(fwd, dim3(grid), dim3(NWAVES * 64), LDS_BYTES, stream, a);
#else
    for (int ph = 0; ph < N_PHASES; ++ph) { a.ph_lo = ph; a.ph_hi = ph + 1; hipLaunchKernelGGL(fwd, dim3(grid), dim3(NWAVES * 64), LDS_BYTES, stream, a); }
#endif
}
```

```cpp
#include <hip/hip_runtime.h>
#include <cstdio>
#include <cstdint>
#include <cstring>
#include <cmath>
__device__ __forceinline__ int lane_now() { int l; asm volatile("v_mbcnt_lo_u32_b32 %0, -1, 0\n\tv_mbcnt_hi_u32_b32 %0, -1, %0" : "=v"(l)); return l; }
namespace pg8 {
#define PG8_LAS __attribute__((address_space(3)))
typedef unsigned short bf16_t;
typedef short bf16x8 __attribute__((ext_vector_type(8)));
typedef float f32x4 __attribute__((ext_vector_type(4)));
typedef float f32x2 __attribute__((ext_vector_type(2)));
typedef unsigned u32x4 __attribute__((ext_vector_type(4)));
typedef unsigned u32x2 __attribute__((ext_vector_type(2)));
constexpr int BM = 256, BK = 64, HALF = 128, HTB = HALF * BK * 2  , STAGE_BYTES = 8 * HTB, NXCD = 8, WGM = 8;

__host__ __device__ __forceinline__ int lds_byte(int r, int c) { const int st = (r >> 4) * 2 + (c >> 5), rr = r & 15, cc = c & 31, ob = rr * 64 + cc * 2; return st * 1024 + (ob ^ (((ob >> 9) & 1) << 5)); }
__host__ __device__ __forceinline__ void stage_rc(int b, int& R, int& C) { const int st = b / 1024, sb = b % 1024, swz = sb ^ (((sb >> 9) & 1) << 5); R = (st >> 1) * 16 + swz / 64; C = (st & 1) * 32 + (swz % 64) / 2; }
__host__ __device__ __forceinline__ int perm32(int rho) { const int n = rho >> 4, i = rho & 15; return 8 * (i >> 2) + 4 * n + (i & 3); }

struct Unit { int pm, pn; const char* A; const char* B; int e, rtl; };
struct Gemm { int lda, ldb, K; };

struct DenseOrder {
    int nM, nN, nwg, G, c; const char* A; const char* B; size_t tsA, tsB;
    __device__ __forceinline__ void init(int nM_, int nN_, int G_, int c_, const void* A_, size_t tsA_, const void* B_, size_t tsB_) { nM = nM_; nN = nN_; nwg = nM * nN; G = G_; c = c_; A = (const char*)A_; B = (const char*)B_; tsA = tsA_; tsB = tsB_; }
    __device__ __forceinline__ bool tile(int i, int& pm, int& pn) const {
        const long L = (long)i * G + c; if (L >= nwg) return false;
        int wgid = (int)L; { const int q = nwg / NXCD, r = nwg % NXCD, xcd = wgid % NXCD, off = wgid / NXCD; wgid = (xcd < r ? xcd * (q + 1) : r * (q + 1) + (xcd - r) * q) + off; }
        const int nig = WGM * nN, gid = wgid / nig, fm = gid * WGM, gsz = (nM - fm) < WGM ? (nM - fm) : WGM;
        pm = fm + ((wgid % nig) % gsz); pn = (wgid % nig) / gsz; return true;
    }
    __device__ __forceinline__ bool next(int i, Unit& u) const { if (!tile(i, u.pm, u.pn)) return false; u.A = A + (size_t)u.pm * tsA; u.B = B + (size_t)u.pn * tsB; u.e = 0; u.rtl = 0; return true; }
    __device__ __forceinline__ const PG8_LAS unsigned char* table(int) const { return nullptr; }
};

__device__ __forceinline__ unsigned cvt_pk_bf16(float lo, float hi) { unsigned r; asm volatile("s_nop 0\n\tv_cvt_pk_bf16_f32 %0, %1, %2" : "=v"(r) : "v"(lo), "v"(hi)); return r; }
__device__ __forceinline__ float bflo(unsigned w) { return __uint_as_float(w << 16); }
__device__ __forceinline__ float bfhi(unsigned w) { return __uint_as_float(w & 0xffff0000u); }
__device__ __forceinline__ float fsigmoid(float x) { return __builtin_amdgcn_rcpf(1.0f + __builtin_amdgcn_exp2f(-1.4426950408889634f * x)); }

__device__ __forceinline__ const char* uni_ptr(const char* p) { const unsigned long long v = (unsigned long long)p; const unsigned lo = __builtin_amdgcn_readfirstlane((unsigned)v), hi = __builtin_amdgcn_readfirstlane((unsigned)(v >> 32)); return (const char*)(((unsigned long long)hi << 32) | lo); }
__device__ __forceinline__ void uni_unit(Unit& u) { u.pm = __builtin_amdgcn_readfirstlane(u.pm); u.pn = __builtin_amdgcn_readfirstlane(u.pn); u.e = __builtin_amdgcn_readfirstlane(u.e); u.rtl = __builtin_amdgcn_readfirstlane(u.rtl); u.A = uni_ptr(u.A); u.B = uni_ptr(u.B); }
struct NoHook { static constexpr bool ON = false; static constexpr int AT = -1; template <class A> __device__ __forceinline__ void operator()(A&, const Unit&, int, int, int, int) const {} };
template <class Epi, class Sched, bool ALIGN_EPI, bool GATHER, int ES = 2, class Hook = NoHook>
__device__ __forceinline__ void gemm_phase(PG8_LAS unsigned char* lds, const Gemm g, const Sched& S, const Epi& E, int wave, const Hook& H = Hook()) {
    int tid = wave * 64 + lane_now(); asm volatile("" : "+v"(tid));
    const int wid = __builtin_amdgcn_readfirstlane(tid >> 6), lane = tid & 63, wr = wid >> 2, wc = wid & 3, fr = lane & 15, fq = lane >> 4;
    const int K = g.K, nt = K * ES / (BK * 2);
    unsigned voffA[2], voffB[2];
#pragma unroll
    for (int i = 0; i < 2; ++i) { int R, C; stage_rc(tid * 16 + i * 8192, R, C); const int Rb = Epi::PERM ? ((R & ~31) + perm32(R & 31)) : R;
        voffA[i] = (unsigned)(R * g.lda * ES + C * 2); voffB[i] = (unsigned)(Rb * g.ldb * ES + C * 2); }
    const size_t kstep = (size_t)(BK * 2);
    const size_t hstepA = GATHER ? (size_t)0 : (size_t)HALF * g.lda * ES;
    const size_t hstepB = (size_t)HALF * g.ldb * ES;
    const unsigned ldsw = (unsigned)wid * 1024u;
    const int aoff = lds_byte(wr * 64 + fr, fq * 8), boff = lds_byte(wc * 32 + fr, fq * 8);
    unsigned vA[2][2], nvA[2][2];
#define PG8_ROWS(dst, uidx) do { int t_ = wave * 64 + lane_now(); asm volatile("" : "+v"(t_)); int R0_, C0_; stage_rc(t_ * 16, R0_, C0_); \
        const PG8_LAS unsigned char* _t = S.table(uidx) + (unsigned)R0_ * 4u; const unsigned c2_ = (unsigned)C0_ * 2u; _Pragma("unroll") for (int h = 0; h < 2; ++h) _Pragma("unroll") for (int i = 0; i < 2; ++i) \
        dst[h][i] = *(const PG8_LAS unsigned*)(_t + h * 512 + i * 256) + c2_; } while (0)
#define PG8_SA(b, h) (((b) * 2 + (h)) * HTB)
#define PG8_SB(b, h) ((4 + (b) * 2 + (h)) * HTB)
#define PG8_STAGE(bufoff, gbase, voff) do { const char* _gb = (const char*)(gbase); asm volatile("" : "+s"(_gb));     \
        _Pragma("unroll") for (int _i = 0; _i < 2; ++_i) { const unsigned _la = (unsigned)__builtin_amdgcn_readfirstlane((int)(unsigned)(uintptr_t)(lds + (bufoff) + ldsw + _i * 8192)); \
            asm volatile("s_mov_b32 m0, %2\n\ts_nop 0\n\tglobal_load_lds_dwordx4 %0, %1" :: "v"((voff)[_i]), "s"(_gb), "s"(_la) : "memory", "m0"); } } while (0)
#define PG8_STB(b, h, ptr) PG8_STAGE(PG8_SB(b, h), (ptr) + (h) * hstepB, voffB)
#define PG8_STA(b, h, ptr, nx) do { if constexpr (GATHER) { unsigned _v[2]; _v[0] = (nx) ? nvA[h][0] : vA[h][0]; _v[1] = (nx) ? nvA[h][1] : vA[h][1]; PG8_STAGE(PG8_SA(b, h), (ptr), _v); } \
        else { PG8_STAGE(PG8_SA(b, h), (ptr) + (h) * hstepA, voffA); } } while (0)
#define PG8_LDA(dst, b, h) do { _Pragma("unroll") for (int m = 0; m < 4; ++m) _Pragma("unroll") for (int k = 0; k < 2; ++k) dst[m][k] = *(const PG8_LAS bf16x8*)(lds + PG8_SA(b, h) + aoff + m * 2048 + k * 1024); } while (0)
#define PG8_LDB(dst, b, h) do { _Pragma("unroll") for (int n = 0; n < 2; ++n) _Pragma("unroll") for (int k = 0; k < 2; ++k) dst[n][k] = *(const PG8_LAS bf16x8*)(lds + PG8_SB(b, h) + boff + n * 2048 + k * 1024); } while (0)
#define PG8_MMA(ai, bj, At, Bt, Z) do { const f32x4 z4_ = {0.f, 0.f, 0.f, 0.f}; __builtin_amdgcn_s_setprio(1); _Pragma("unroll") for (int m = 0; m < 4; ++m) _Pragma("unroll") for (int n = 0; n < 2; ++n) { \
        if constexpr (ES == 2) { acc[ai][bj][m][n] = __builtin_amdgcn_mfma_f32_16x16x32_bf16(Bt[n][0], At[m][0], (Z) ? z4_ : acc[ai][bj][m][n], 0, 0, 0); acc[ai][bj][m][n] = __builtin_amdgcn_mfma_f32_16x16x32_bf16(Bt[n][1], At[m][1], acc[ai][bj][m][n], 0, 0, 0); } \
        else { typedef int v8i_ __attribute__((ext_vector_type(8))); const u32x4 b0_ = __builtin_bit_cast(u32x4, Bt[n][0]), b1_ = __builtin_bit_cast(u32x4, Bt[n][1]), a0_ = __builtin_bit_cast(u32x4, At[m][0]), a1_ = __builtin_bit_cast(u32x4, At[m][1]); \
            const v8i_ bv_ = {(int)b0_[0], (int)b0_[1], (int)b0_[2], (int)b0_[3], (int)b1_[0], (int)b1_[1], (int)b1_[2], (int)b1_[3]}, av_ = {(int)a0_[0], (int)a0_[1], (int)a0_[2], (int)a0_[3], (int)a1_[0], (int)a1_[1], (int)a1_[2], (int)a1_[3]}; \
            acc[ai][bj][m][n] = __builtin_amdgcn_mfma_scale_f32_16x16x128_f8f6f4(bv_, av_, (Z) ? z4_ : acc[ai][bj][m][n], 0, 0, 0, 0, 0, 0); } }     \
        __builtin_amdgcn_s_setprio(0); \
        _Pragma("unroll") for (int m = 0; m < 4; ++m) asm volatile("" : "+v"(acc[ai][bj][m][0]), "+v"(acc[ai][bj][m][1]));     \
        } while (0)
#define PG8_WAIT_V(n) asm volatile("s_waitcnt vmcnt(" #n ")" ::: "memory")
#define PG8_WAIT_L(n) asm volatile("s_waitcnt lgkmcnt(" #n ")" ::: "memory")
#define PG8_BAR __builtin_amdgcn_s_barrier()
#define PG8_SCHED __builtin_amdgcn_sched_barrier(0)
    Unit cur, nxt; int ui = 0;
    if (!S.next(0, cur)) return;
    uni_unit(cur);
    f32x4 acc[2][2][4][2];
    bf16x8 At[4][2], B0[2][2], B1[2][2];
    const char* cA = cur.A; const char* cB = cur.B;
    if constexpr (GATHER) { PG8_ROWS(vA, 0); }
    PG8_STB(0, 0, cB); PG8_STB(0, 1, cB); PG8_STA(0, 0, cA, false); PG8_STA(0, 1, cA, false);
    if (wr == 1) PG8_BAR;
    PG8_WAIT_V(2); PG8_BAR;
    PG8_STB(1, 0, cB + kstep); PG8_STA(1, 0, cA + kstep, false); PG8_STB(1, 1, cB + kstep);
    PG8_WAIT_V(6); PG8_BAR;
    for (;;) {
        const bool has_next = S.next(ui + 1, nxt);
        if (has_next) uni_unit(nxt);
        const char* nA = has_next ? nxt.A : cA; const char* nB = has_next ? nxt.B : cB;
#define PG8_KPAIR(t, LAST, ZERO) do { \
            const char* a1 = cA + (size_t)((t) + 1) * kstep; \
            const char* a2 = (LAST) ? nA : cA + (size_t)((t) + 2) * kstep; const char* b2 = (LAST) ? nB : cB + (size_t)((t) + 2) * kstep; \
            const char* a3 = a2 + kstep; const char* b3 = b2 + kstep; \
              \
            PG8_LDB(B0, 0, 0); PG8_LDB(B1, 0, 1); PG8_SCHED; PG8_LDA(At, 0, 0); PG8_STA(1, 1, a1, false); \
            PG8_WAIT_V(8); PG8_WAIT_L(0); PG8_BAR; PG8_MMA(0, 0, At, B0, ZERO); PG8_MMA(0, 1, At, B1, ZERO); PG8_BAR; PG8_SCHED; \
              \
            PG8_LDA(At, 0, 1); PG8_STB(0, 0, b2); PG8_STB(0, 1, b2); PG8_STA(0, 0, a2, LAST); \
            PG8_WAIT_V(8); PG8_WAIT_L(0); PG8_BAR; PG8_MMA(1, 0, At, B0, ZERO); PG8_MMA(1, 1, At, B1, ZERO); PG8_BAR; PG8_SCHED; \
              \
            PG8_LDB(B0, 1, 0); PG8_LDB(B1, 1, 1); PG8_SCHED; PG8_LDA(At, 1, 0); PG8_STA(0, 1, a2, LAST); \
            PG8_WAIT_V(8); PG8_WAIT_L(0); PG8_BAR; PG8_MMA(0, 0, At, B0, false); PG8_MMA(0, 1, At, B1, false); PG8_BAR; PG8_SCHED; \
              \
            PG8_LDA(At, 1, 1); PG8_STB(1, 0, b3); PG8_STB(1, 1, b3); PG8_STA(1, 0, a3, LAST); \
            PG8_WAIT_V(8); PG8_WAIT_L(0); PG8_BAR; PG8_MMA(1, 0, At, B0, false); PG8_MMA(1, 1, At, B1, false); PG8_BAR; PG8_SCHED; } while (0)
        PG8_KPAIR(0, false, true);
        _Pragma("nounroll") for (int t = 2; t < nt - 2; t += 2) { PG8_KPAIR(t, false, false); if constexpr (Hook::ON) { if (t == Hook::AT) H(acc, cur, wr, wc, fr, fq); } }
        if constexpr (GATHER) {
            if (has_next) { PG8_ROWS(nvA, ui + 1); }
            else {
#pragma unroll
                for (int h = 0; h < 2; ++h)
#pragma unroll
                    for (int i = 0; i < 2; ++i) nvA[h][i] = vA[h][i]; }
        }
        PG8_KPAIR(nt - 2, true, false);
#undef PG8_KPAIR
        if constexpr (ALIGN_EPI) { if (wr == 0) PG8_BAR; }
        E(acc, cur, wr, wc, fr, fq);
        if (!has_next) break;
        cur = nxt; cA = nA; cB = nB; ++ui;
        if constexpr (GATHER) {
#pragma unroll
            for (int h = 0; h < 2; ++h)
#pragma unroll
                for (int i = 0; i < 2; ++i) vA[h][i] = nvA[h][i];
        }
        if constexpr (ALIGN_EPI) { if (wr == 1) PG8_BAR; }
    }
    PG8_WAIT_V(0);
    if constexpr (!ALIGN_EPI) { if (wr == 0) PG8_BAR; }
    PG8_BAR;
#undef PG8_SA
#undef PG8_SB
#undef PG8_STAGE
#undef PG8_STB
#undef PG8_ROWS
#undef PG8_STA
#undef PG8_LDA
#undef PG8_LDB
#undef PG8_MMA
#undef PG8_WAIT_V
#undef PG8_WAIT_L
#undef PG8_BAR
#undef PG8_SCHED
}
}

constexpr int NWAVES = 8;
constexpr int NT = 32768, DM = 1024, SEQ = 2048, NBATCH = 16, INW = 3080, NE = 32, PLE = 256;
constexpr float EPS = 1e-6f;
constexpr float LOG2E = 1.4426950408889634f;
constexpr float C2 = 0.125f * 1.4426950408889634f;
constexpr int N1 = 5120;
constexpr int MAXRT = 576;
constexpr int MAXUNITS = 24;

constexpr size_t MiB = 1u << 20;
constexpr size_t WS_CTL = 0, CTL_ZERO_BYTES = 1 * MiB;
constexpr size_t WS_TOK = 2 * MiB;
constexpr size_t WS_RSOF = 6 * MiB;
constexpr size_t WS_TOPE = 10 * MiB;
constexpr size_t WS_TOPW = 10 * MiB + 512 * 1024;
constexpr size_t WS_POS = 11 * MiB;
constexpr size_t WS_LOGF = 12 * MiB;
constexpr size_t WS_CUM = 13 * MiB;
constexpr size_t WS_ROT = 14 * MiB;
constexpr size_t WS_RSTD2 = 14 * MiB + 512 * 1024;
constexpr size_t WS_WRT = 15 * MiB;
constexpr size_t WS_W1T = 16 * MiB;
constexpr size_t WS_WBT = 26 * MiB;
constexpr size_t WS_WOT = 28 * MiB;
constexpr size_t WS_WPGT = 30 * MiB;
constexpr size_t WS_WPPT = 32 * MiB;
constexpr size_t WS_WGUT = 34 * MiB;
constexpr size_t WS_WDT = 162 * MiB;
constexpr size_t WS_HB = 226 * MiB;
constexpr size_t WS_PB = 291 * MiB;
constexpr size_t WS_Z = 307 * MiB;
constexpr size_t WS_XN = WS_Z, WS_FQ = WS_Z + 64 * MiB, WS_FK = WS_Z + 96 * MiB, WS_FV = WS_Z + 128 * MiB, WS_RQ = WS_Z + 160 * MiB, WS_RK = WS_Z + 176 * MiB;
constexpr size_t WS_RV = WS_Z + 192 * MiB, WS_RGS = WS_Z + 224 * MiB, WS_GATES = WS_Z + 256 * MiB, WS_BR = WS_Z + 384 * MiB, WS_MERGED = WS_Z + 448 * MiB;
constexpr size_t WS_RKT = WS_Z + 512 * MiB;
constexpr size_t WS_XN8 = WS_Z + 528 * MiB;
constexpr size_t WS_WG8T = WS_W1T + 4 * MiB;
constexpr size_t WS_H2B = WS_Z + 448 * MiB;
constexpr size_t WS_MO = WS_Z + 512 * MiB;
constexpr size_t WS_ACT = WS_Z, WS_Y = WS_Z + 144 * MiB;
constexpr size_t WS_HB2 = WS_Z, WS_PJ = WS_Z + 384 * MiB, WS_G8 = WS_Z + 160 * MiB;
constexpr size_t WS_END = WS_Z + 576 * MiB;
constexpr int CW_BAR = 4096;
constexpr int CW_CNT = 8192;
constexpr int CW_QUEUE = 8256;
constexpr int CW_SSQ = 16384;
static_assert((CW_SSQ + NT) * 4 <= (int)CTL_ZERO_BYTES, "CTL words inside the memset region");

constexpr int RING_OFF = 0, RING_BYTES = 131072;
constexpr int TAB_OFF = RING_BYTES;
constexpr int SCH_OFF = TAB_OFF + MAXUNITS * 1024;
constexpr int SCH_CNT = SCH_OFF, SCH_P = SCH_OFF + 128, SCH_RT2E = SCH_OFF + 128 + 160;
constexpr int MISC_OFF = SCH_RT2E + MAXRT * 4;
constexpr int LDS_BYTES = 163840;
static_assert(MISC_OFF + 256 <= LDS_BYTES && (MISC_OFF % 16) == 0, "LDS map");

#define GAS __attribute__((address_space(1)))
#define LAS __attribute__((address_space(3)))
typedef unsigned short bf16;
typedef unsigned v4u __attribute__((ext_vector_type(4)));
typedef unsigned v2u __attribute__((ext_vector_type(2)));
typedef float f32x4 __attribute__((ext_vector_type(4)));
typedef short bf16x8 __attribute__((ext_vector_type(8)));
typedef GAS unsigned gu32;
#define RLX_AGENT __ATOMIC_RELAXED, __HIP_MEMORY_SCOPE_AGENT
#define LDS_WAIT() asm volatile("s_waitcnt lgkmcnt(0)" ::: "memory")
#define VM_WAIT() asm volatile("s_waitcnt vmcnt(0)" ::: "memory")
__device__ __forceinline__ unsigned f2bf(float f) { unsigned u = __builtin_bit_cast(unsigned, f); return (u + 0x7fffu + ((u >> 16) & 1u)) >> 16; }
__device__ __forceinline__ unsigned pk2(float lo, float hi) { return f2bf(lo) | (f2bf(hi) << 16); }
using pg8::bflo; using pg8::bfhi; using pg8::fsigmoid; using pg8::cvt_pk_bf16;
constexpr float WSCALE = 32.f;
constexpr float YSCALE = 8.f;
__device__ __forceinline__ float clamp_f8(float v) { return fminf(fmaxf(v, -448.f), 448.f); }
__device__ __forceinline__ v2u pack8_fp8(const f32x4 a, const f32x4 b) {
    int w0 = 0, w1 = 0;
    w0 = __builtin_amdgcn_cvt_pk_fp8_f32(clamp_f8(a[0]), clamp_f8(a[1]), w0, false); w0 = __builtin_amdgcn_cvt_pk_fp8_f32(clamp_f8(a[2]), clamp_f8(a[3]), w0, true);
    w1 = __builtin_amdgcn_cvt_pk_fp8_f32(clamp_f8(b[0]), clamp_f8(b[1]), w1, false); w1 = __builtin_amdgcn_cvt_pk_fp8_f32(clamp_f8(b[2]), clamp_f8(b[3]), w1, true);
    return (v2u){(unsigned)w0, (unsigned)w1}; }
#define DPP_F(v, ctrl) __int_as_float(__builtin_amdgcn_update_dpp(0, __float_as_int(v), (ctrl), 0xF, 0xF, false))
__device__ __forceinline__ float wave_sum(float v) {
    v += DPP_F(v, 0xB1); v += DPP_F(v, 0x4E); v += DPP_F(v, 0x141); v += DPP_F(v, 0x140);
    const int b = __float_as_int(v);
    return (__int_as_float(__builtin_amdgcn_readlane(b, 0)) + __int_as_float(__builtin_amdgcn_readlane(b, 16))) + (__int_as_float(__builtin_amdgcn_readlane(b, 32)) + __int_as_float(__builtin_amdgcn_readlane(b, 48)));
}
__device__ __forceinline__ float xor32_sum(float v) { auto rr = __builtin_amdgcn_permlane32_swap(__float_as_uint(v), __float_as_uint(v), false, false); return __uint_as_float(rr[0]) + __uint_as_float(rr[1]); }
__device__ __forceinline__ float xor16_sum(float v) { auto rr = __builtin_amdgcn_permlane16_swap(__float_as_uint(v), __float_as_uint(v), false, false); return __uint_as_float(rr[0]) + __uint_as_float(rr[1]); }

#define XB_TMO      128
#define XB_XCNT(j)  (256  + 64 * (j))
#define XB_XSUB(j)  (1280 + 64 * (j))
#define XB_XGEN(j)  (2304 + 64 * (j))
#define XB_TOP      3328
#define XB_TOPGEN   3392
#define XCD_BAR_WORDS 3456
#define XB_SPIN_CAP (1u << 20)

__device__ __forceinline__ unsigned xb_ld(unsigned* p)              { return __hip_atomic_load(p, __ATOMIC_RELAXED, __HIP_MEMORY_SCOPE_AGENT); }
__device__ __forceinline__ unsigned xb_add(unsigned* p, unsigned v) { return __hip_atomic_fetch_add(p, v, __ATOMIC_RELAXED, __HIP_MEMORY_SCOPE_AGENT); }
__device__ __forceinline__ unsigned xb_xcc_id() { return (unsigned)__builtin_amdgcn_s_getreg((3 << 11) | 20) & 0xFu; }
#define XB_SPIN(cond, bar) do { unsigned _sp = 0; while (cond) { __builtin_amdgcn_s_sleep(1); \
    if ((++_sp & 255u) == 0u) { if (xb_ld(&(bar)[XB_TMO])) break; if (_sp > XB_SPIN_CAP) { atomicAdd(&(bar)[XB_TMO], 1u); break; } } } } while (0)

struct XcdBarrier {
    unsigned* bar; unsigned x;
    volatile LAS unsigned* st;
};
__device__ __forceinline__ XcdBarrier xcd_barrier_post(unsigned* bar, volatile LAS unsigned* st, int tid) {
    XcdBarrier b; b.bar = bar; b.x = xb_xcc_id(); b.st = st;
    if (tid == 0) (void)xb_add(&bar[XB_XCNT(b.x)], 1u);
    return b;
}
__device__ __forceinline__ void xcd_barrier_complete(unsigned* bar, unsigned x, unsigned& nloc, unsigned& nx) {
    const unsigned G = gridDim.x * gridDim.y * gridDim.z;
    unsigned sum, cnt, mine, sp = 0u;
    for (;;) {
        sum = 0u; cnt = 0u; mine = 0u;
#pragma unroll
        for (unsigned j = 0; j < 16; ++j) { const unsigned c = xb_ld(&bar[XB_XCNT(j)]); sum += c; cnt += (c > 0u) ? 1u : 0u; mine = (j == x) ? c : mine; }
        if (sum == G) break;
        __builtin_amdgcn_s_sleep(1);
        if ((++sp & 255u) == 0u) { if (xb_ld(&bar[XB_TMO])) break; if (sp > XB_SPIN_CAP) { atomicAdd(&bar[XB_TMO], 1u); break; } }
    }
    nloc = mine > 0u ? mine : 1u; nx = cnt > 0u ? cnt : 1u;
}
__device__ __forceinline__ void xcd_barrier(const XcdBarrier& b, int tid) {
    asm volatile("s_waitcnt vmcnt(0)" ::: "memory");
    __syncthreads();
    if (tid == 0) {
        unsigned* bar = b.bar;
        __builtin_amdgcn_s_waitcnt(0);
        unsigned nloc = b.st[0], nx = b.st[1];
        if (nloc == 0u) { xcd_barrier_complete(bar, b.x, nloc, nx); b.st[0] = nloc; b.st[1] = nx; }
        const unsigned old = xb_add(&bar[XB_XSUB(b.x)], 1u);
        const unsigned gen = old / nloc;
        if (old + 1u == (gen + 1u) * nloc) {
            __builtin_amdgcn_fence(__ATOMIC_RELEASE, "agent");
            asm volatile("s_waitcnt vmcnt(0)" ::: "memory");
            const unsigned og = xb_add(&bar[XB_TOP], 1u);
            const unsigned tg = og / nx;
            if (og + 1u == (tg + 1u) * nx) xb_add(&bar[XB_TOPGEN], 1u);
            else XB_SPIN(xb_ld(&bar[XB_TOPGEN]) == tg, bar);
            __builtin_amdgcn_fence(__ATOMIC_ACQUIRE, "agent");
            xb_add(&bar[XB_XGEN(b.x)], 1u);
            asm volatile("s_waitcnt vmcnt(0)" ::: "memory");
        } else {
            XB_SPIN(xb_ld(&bar[XB_XGEN(b.x)]) == gen, bar);
            __builtin_amdgcn_fence(__ATOMIC_ACQUIRE, "agent");
            asm volatile("s_waitcnt vmcnt(0)" ::: "memory");
        }
    }
    __syncthreads();
}

struct Args { const float* in[20]; float* out; unsigned char* ws; int ph_lo, ph_hi, rep_phase, rep_mode; };
struct Frame {
    LAS unsigned char* lds;
    volatile LAS unsigned* MISC;
    int tid, lane, wave;
    int vcu, G;
    const __attribute__((address_space(4))) Args* ap;
};
#define REARGS() do { F.ap = (const __attribute__((address_space(4))) Args*)__builtin_amdgcn_kernarg_segment_ptr(); asm volatile("" : "+s"(F.ap)); } while (0)
#define WSP(T, off) ((T*)(F.ap->ws + (off)))

#include <hip/hip_bf16.h>
namespace attn_body {
using bf16=__hip_bfloat16;
using bf16x8=__attribute__((ext_vector_type(8)))short;
using s16x4=__attribute__((ext_vector_type(4)))short;
using f32x16=__attribute__((ext_vector_type(16)))float;
using u32x4=__attribute__((ext_vector_type(4)))unsigned;
constexpr int BATCH=16,NHEAD=8,SEQ=2048,D=64,DM=NHEAD*D,OPITCH=1024;
constexpr int NW=8,QBLK=32,QB=QBLK*NW,KVBLK=64,NQB=SEQ/QB;
constexpr int ATTN_PITCH=DM, ATTN_UNIT_ROWS=QB;
__device__ __forceinline__ int crow(int r,int hi){return (r&3)+8*(r>>2)+4*hi;}
#define SBAR() __builtin_amdgcn_sched_barrier(0)
__device__ __forceinline__ void cmask(f32x16&p0,f32x16&p1,int jb,int qrel,int hi){
  const float NEG=-INFINITY; int kb=64*jb+4*hi;
  #pragma unroll
  for(int r=0;r<16;++r){int kv=kb+(r&3)+8*(r>>2); if(kv>qrel)p0[r]=NEG; if(kv+32>qrel)p1[r]=NEG;}
}

constexpr int NSLOT=3, SLOTB=8192;
constexpr int LDS_K=0, LDS_V=NSLOT*SLOTB, LDS_WS=2*NSLOT*SLOTB, LDS_OST=LDS_WS+NW*64*4, LDS_KB=LDS_OST+NW*4096, LDS_BYTES=LDS_KB+SEQ*16;
constexpr float C2=0.125f*1.4426950408889634f;
__device__ __forceinline__ void glds16(const void*gsrc,unsigned lds_dst){unsigned keep;
  asm volatile("s_mov_b32 %0, m0\n\ts_mov_b32 m0, %2\n\ts_nop 0\n\tglobal_load_lds_dwordx4 %1, off\n\ts_mov_b32 m0, %0":"=&s"(keep):"v"(gsrc),"s"(lds_dst):"memory");}
__device__ __forceinline__ float max3f(float a,float b,float c){float r;asm("v_max3_f32 %0, %1, %2, %3":"=v"(r):"v"(a),"v"(b),"v"(c));return r;}
__device__ __forceinline__ float max2f(float a,float b){float r;asm("v_max_f32_e32 %0, %1, %2":"=v"(r):"v"(a),"v"(b));return r;}
__device__ __forceinline__ float fadd_s(float a,float b){float r;asm("v_add_f32_e32 %0, %1, %2":"=v"(r):"v"(a),"v"(b));return r;}
__device__ __forceinline__ float fsub_s(float a,float b){float r;asm("v_sub_f32_e32 %0, %1, %2":"=v"(r):"v"(a),"v"(b));return r;}
typedef float f32x2_t __attribute__((ext_vector_type(2))); typedef __bf16 bf16x2_t __attribute__((ext_vector_type(2)));
__device__ __forceinline__ unsigned cvtpk_s(float lo,float hi){f32x2_t v={lo,hi};bf16x2_t b=__builtin_convertvector(v,bf16x2_t);return __builtin_bit_cast(unsigned,b);}
#define WAIT_BAR(N) asm volatile("s_waitcnt vmcnt(" #N ") lgkmcnt(0)\n\ts_barrier":::"memory")

__device__ __forceinline__ void qkt(f32x16&p0,f32x16&p1,const char*Kslot,const bf16x8*qr,const bf16x8 qx,const bf16x8 kb0,const bf16x8 kb1,int r32,int hi){
  const f32x16 zc=f32x16{};
  const char*kb=Kslot+hi*1024+r32*16;
  #pragma unroll
  for(int d0=0;d0<4;++d0){
    const bf16x8 b0=*reinterpret_cast<const bf16x8*>(kb+d0*2048);
    const bf16x8 b1=*reinterpret_cast<const bf16x8*>(kb+d0*2048+512);
    if(d0==0){p0=__builtin_amdgcn_mfma_f32_32x32x16_bf16(b0,qr[0],zc,0,0,0);p1=__builtin_amdgcn_mfma_f32_32x32x16_bf16(b1,qr[0],zc,0,0,0);}
    else{p0=__builtin_amdgcn_mfma_f32_32x32x16_bf16(b0,qr[d0],p0,0,0,0);p1=__builtin_amdgcn_mfma_f32_32x32x16_bf16(b1,qr[d0],p1,0,0,0);}}
  p0=__builtin_amdgcn_mfma_f32_32x32x16_bf16(kb0,qx,p0,0,0,0);p1=__builtin_amdgcn_mfma_f32_32x32x16_bf16(kb1,qx,p1,0,0,0);
}
typedef __attribute__((address_space(3))) const char* lds_cptr;
typedef short v4i16_t __attribute__((ext_vector_type(4)));
__device__ __forceinline__ void kload8(bf16x8*kf,lds_cptr kp){
  kf[0]=*(const __attribute__((address_space(3))) bf16x8*)(kp);      kf[1]=*(const __attribute__((address_space(3))) bf16x8*)(kp+512);
  kf[2]=*(const __attribute__((address_space(3))) bf16x8*)(kp+2048); kf[3]=*(const __attribute__((address_space(3))) bf16x8*)(kp+2560);
  kf[4]=*(const __attribute__((address_space(3))) bf16x8*)(kp+4096); kf[5]=*(const __attribute__((address_space(3))) bf16x8*)(kp+4608);
  kf[6]=*(const __attribute__((address_space(3))) bf16x8*)(kp+6144); kf[7]=*(const __attribute__((address_space(3))) bf16x8*)(kp+6656);
}
__device__ __forceinline__ void kload2(bf16x8*kf,lds_cptr kp,int j){ kf[2*j]=*(const __attribute__((address_space(3))) bf16x8*)(kp+j*2048); kf[2*j+1]=*(const __attribute__((address_space(3))) bf16x8*)(kp+j*2048+512); }
__device__ __forceinline__ s16x4 vtr(lds_cptr p){ return __builtin_bit_cast(s16x4,__builtin_amdgcn_ds_read_tr16_b64_v4i16((__attribute__((address_space(3))) v4i16_t*)p)); }
__device__ __forceinline__ float rowmax(const f32x16&p0,const f32x16&p1){
  float a=max3f(p0[0],p0[1],p1[0]),b=max3f(p0[2],p0[3],p1[1]);a=max3f(a,p1[2],p1[3]);
  #pragma unroll
  for(int r=4;r<16;r+=4){a=max3f(a,p0[r],p0[r+1]);b=max3f(b,p0[r+2],p0[r+3]);a=max3f(a,p1[r],p1[r+1]);b=max3f(b,p1[r+2],p1[r+3]);}
  const float m=max2f(a,b);
  auto rr=__builtin_amdgcn_permlane32_swap(__float_as_uint(m),__float_as_uint(m),false,false);
  return max2f(__uint_as_float(rr[0]),__uint_as_float(rr[1]));
}
__device__ __forceinline__ void pv(f32x16*o,int vb,bf16x8 pa0,bf16x8 pa1,bf16x8 pa2,bf16x8 pa3){
  #pragma unroll
  for(int d0=0;d0<2;++d0){s16x4 lo[4],hi[4];
    #pragma unroll
    for(int ks=0;ks<4;++ks){
      asm volatile("ds_read_b64_tr_b16 %0,%1 offset:%c2":"=&v"(lo[ks]):"v"(vb),"i"(d0*4096+ks*1024):"memory");
      asm volatile("ds_read_b64_tr_b16 %0,%1 offset:%c2":"=&v"(hi[ks]):"v"(vb),"i"(d0*4096+ks*1024+512):"memory");}
    asm volatile("s_waitcnt lgkmcnt(0)":::"memory");SBAR();
    #define PK(k) (bf16x8){lo[k][0],lo[k][1],lo[k][2],lo[k][3],hi[k][0],hi[k][1],hi[k][2],hi[k][3]}
    o[d0]=__builtin_amdgcn_mfma_f32_32x32x16_bf16(pa0,PK(0),o[d0],0,0,0);
    o[d0]=__builtin_amdgcn_mfma_f32_32x32x16_bf16(pa1,PK(1),o[d0],0,0,0);
    o[d0]=__builtin_amdgcn_mfma_f32_32x32x16_bf16(pa2,PK(2),o[d0],0,0,0);
    o[d0]=__builtin_amdgcn_mfma_f32_32x32x16_bf16(pa3,PK(3),o[d0],0,0,0);
    #undef PK
  }
}

__device__ __forceinline__ void split3(float v,unsigned&a,unsigned&b,unsigned&c){ a=cvtpk_s(v,0.f)&0xffffu; const float r1=v-__uint_as_float(a<<16); b=cvtpk_s(r1,0.f)&0xffffu; const float r2=r1-__uint_as_float(b<<16); c=cvtpk_s(r2,0.f)&0xffffu; }
__device__ __forceinline__ bf16x8 make_qx(float m,int hi){ unsigned a,b,c; split3(m,a,b,c); u32x4 w={0x3F803F80u,0x3F80u|(a<<16),b|(c<<16),0u}; if(hi)w=(u32x4){0u,0u,0u,0u}; return __builtin_bit_cast(bf16x8,w); }
#ifndef ATTN_STORE16
#define ATTN_STORE16(p,v) (*(u32x4*)(p)=(v))
#endif
template<int THRL> __device__ __forceinline__ void attn_unit(int b,int h,int qb,const bf16*Q,const bf16*__restrict__ K,const bf16*__restrict__ V,bf16*O,const float*__restrict__ cum,char*shm,int wave){
  int tid=wave*64+lane_now(); asm volatile("":"+v"(tid));
  const int lane=tid&63,r32=lane&31,hi=lane>>5; const int wid=__builtin_amdgcn_readfirstlane(tid>>6);
  const long rowbase=(long)b*SEQ; const int q0=qb*QB;
  const bf16*Qw=Q+(rowbase+q0+wid*QBLK)*DM+h*D;
  const bf16*Kh=K+rowbase*DM+h*D,*Vh=V+rowbase*DM+h*D;
  const unsigned lds0=(unsigned)(uintptr_t)shm;
  float*wsf=(float*)(shm+LDS_WS)+wid*64;
  const bf16*ksrc=Kh+(long)lane*DM+wid*8;
  const bf16*vsrc=Vh+(long)(16*(wid&3)+(lane>>2))*DM+(wid>>2)*32+(lane&3)*8;
  const unsigned kdst=lds0+LDS_K+wid*1024, vdst=lds0+LDS_V+wid*1024;
  #define DMA_K(t,slot) glds16(ksrc+(long)(t)*KVBLK*DM,(unsigned)__builtin_amdgcn_readfirstlane(kdst+(slot)))
  #define DMA_V(t,slot) glds16(vsrc+(long)(t)*KVBLK*DM,(unsigned)__builtin_amdgcn_readfirstlane(vdst+(slot)))
  const int vb0=(int)(lds0+LDS_V)+((lane>>4)&1)*32+(lane&3)*8+(4*hi+((lane&15)>>2))*64;
  const char*Kbase=shm+LDS_K; bf16x8 kf[8];
  const lds_cptr shm3=(lds_cptr)shm; const lds_cptr kp0=shm3+LDS_K+hi*1024+r32*16; const lds_cptr vp0=shm3+LDS_V+((lane>>4)&1)*32+(lane&3)*8+(4*hi+((lane&15)>>2))*64;
  const int NT=(q0+QB)/KVBLK;
  const lds_cptr kbp=shm3+LDS_KB+r32*16;
  DMA_K(0,0);DMA_V(0,0);DMA_K(1,SLOTB);
  { const float cref=cum[q0+QB-1];
    for(int kv=tid;kv<q0+QB;kv+=NW*64){ unsigned a,bb,c; split3((cref-cum[kv])*1.4426950408889634f,a,bb,c);
      *(__attribute__((address_space(3))) u32x4*)((__attribute__((address_space(3))) char*)shm3+LDS_KB+kv*16)=(u32x4){a|(bb<<16),c|0xBF800000u,0xBF80BF80u,0u}; } }
  bf16x8 qr[4];
  #pragma unroll
  for(int d0=0;d0<4;++d0)qr[d0]=*reinterpret_cast<const bf16x8*>(&Qw[(long)r32*DM+d0*16+hi*8]);
  float mhat=0.f,l_reg=0.f;f32x16 o[2];o[0]=f32x16{};o[1]=f32x16{};bf16x8 qx=make_qx(0.f,hi);const f32x16 zc=f32x16{};
  const int qrel=wid*QBLK+r32;
  #define CMASK(P0,P1,t) do{int jb_=(t)-(NT-4); if(jb_>=0)cmask(P0,P1,jb_,qrel,hi);}while(0)
  bool resc=false;
  #define START(P0,P1) do{ const float rm=rowmax(P0,P1); resc=false; \
    { const float dl=rm; mhat=fadd_s(mhat,dl); \
      _Pragma("unroll") for(int r=0;r<16;++r){P0[r]=fsub_s(P0[r],dl);P1[r]=fsub_s(P1[r],dl);} \
      qx=make_qx(mhat,hi); } \
    _Pragma("unroll") for(int r=0;r<16;++r)P0[r]=__builtin_amdgcn_exp2f(P0[r]); }while(0)
  #define RESC() do{ if(resc){ asm volatile("s_waitcnt lgkmcnt(0)":::"memory"); \
      _Pragma("unroll") for(int d_=0;d_<2;++d_) _Pragma("unroll") for(int r=0;r<16;++r)o[d_][r]*=wsf[crow(r,hi)]; } }while(0)
  f32x16 pA0,pA1,pB0,pB1;
  int sl_prev=0,sl_cur=0,sl_next=SLOTB;
  #define ROT() do{sl_prev=sl_cur;sl_cur=sl_next;sl_next=(sl_next==(NSLOT-1)*SLOTB)?0:sl_next+SLOTB;}while(0)
  DMA_K(2,2*SLOTB);
  WAIT_BAR(3);
  qkt(pA0,pA1,Kbase,qr,qx,*(const __attribute__((address_space(3))) bf16x8*)(kbp),*(const __attribute__((address_space(3))) bf16x8*)(kbp+512),r32,hi);asm volatile("s_nop 15\n\ts_nop 7":"+v"(pA0),"+v"(pA1));CMASK(pA0,pA1,0);
  START(pA0,pA1);
  _Pragma("unroll") for(int r=0;r<16;++r)pA1[r]=__builtin_amdgcn_exp2f(pA1[r]);
  WAIT_BAR(0);
  DMA_K(3,0);DMA_V(1,SLOTB);
  ROT();
  kload8(kf,kp0+sl_cur);
  WAIT_BAR(2);
  s16x4 vlo[8],vhi[8]; u32x4 pw0,pw1,pw2,pw3;
  #define PKW(P,B) cvtpk_s(P[B],P[B+1])
  #define PAF(k) __builtin_bit_cast(bf16x8,pw##k)
  #define VFR(i) (bf16x8){vlo[i][0],vlo[i][1],vlo[i][2],vlo[i][3],vhi[i][0],vhi[i][1],vhi[i][2],vhi[i][3]}
  #define PIN(x) asm volatile("":"+v"(x))
  #define MX3(a,b,c) __builtin_fmaxf(__builtin_fmaxf((a),(b)),(c))
  #define GAPA(MF,A0,A1,A2,A3,W0,W1,PW) do{ MF; sacc+=A0; sacc+=A1; sacc+=A2; sacc+=A3; PIN(sacc); W0; W1; PIN(PW); SBAR(); }while(0)
  #define EX(v) __builtin_amdgcn_exp2f(v)
  #define GAPB(MF,X,B) do{ MF; X[B]=EX(X[B]); X[B+1]=EX(X[B+1]); X[B+2]=EX(X[B+2]); X[B+3]=EX(X[B+3]); PIN(X); SBAR(); }while(0)
  #define VRD(i) do{ vlo[i]=vtr(vp_+(((i)>>2)*4096+((i)&3)*1024)); vhi[i]=vtr(vp_+(((i)>>2)*4096+((i)&3)*1024+512)); }while(0)
  #define KRD(G,j) do{ if(G){ kload2(kf,kp0+sl_next,j); SBAR(); } }while(0)
  #define STEP(C0,C1,P0,P1,t,GK,GV,GL) do{ SBAR(); \
    const lds_cptr vp_=vp0+sl_prev; \
    const bf16x8 kb0_=*(const __attribute__((address_space(3))) bf16x8*)(kbp+(t)*1024), kb1_=*(const __attribute__((address_space(3))) bf16x8*)(kbp+(t)*1024+512); \
    VRD(0); SBAR(); float sacc=(P0[0]+P0[1]); \
    GAPA(C0=__builtin_amdgcn_mfma_f32_32x32x16_bf16(kf[0],qr[0],zc,0,0,0), P0[2],P0[3],P0[4],P0[5],     pw0[0]=PKW(P0,0), pw0[1]=PKW(P0,2), pw0); \
    VRD(4); SBAR(); GAPA(C1=__builtin_amdgcn_mfma_f32_32x32x16_bf16(kf[1],qr[0],zc,0,0,0), P0[6],P0[7],P0[8],P0[9],     pw0[2]=PKW(P0,4), pw0[3]=PKW(P0,6), pw0); \
    VRD(1); SBAR(); GAPA(C0=__builtin_amdgcn_mfma_f32_32x32x16_bf16(kf[2],qr[1],C0,0,0,0),   P0[10],P0[11],P0[12],P0[13], pw1[0]=PKW(P0,8), pw1[1]=PKW(P0,10), pw1); \
    VRD(5); SBAR(); GAPA(C1=__builtin_amdgcn_mfma_f32_32x32x16_bf16(kf[3],qr[1],C1,0,0,0),   P0[14],P0[15],P1[0],P1[1],   pw1[2]=PKW(P0,12),pw1[3]=PKW(P0,14), pw1); \
    VRD(2); SBAR(); GAPA(C0=__builtin_amdgcn_mfma_f32_32x32x16_bf16(kf[4],qr[2],C0,0,0,0),   P1[2],P1[3],P1[4],P1[5],     pw2[0]=PKW(P1,0), pw2[1]=PKW(P1,2), pw2); \
    VRD(6); SBAR(); GAPA(C1=__builtin_amdgcn_mfma_f32_32x32x16_bf16(kf[5],qr[2],C1,0,0,0),   P1[6],P1[7],P1[8],P1[9],     pw2[2]=PKW(P1,4), pw2[3]=PKW(P1,6), pw2); \
    VRD(3); SBAR(); GAPA(C0=__builtin_amdgcn_mfma_f32_32x32x16_bf16(kf[6],qr[3],C0,0,0,0),   P1[10],P1[11],P1[12],P1[13], pw3[0]=PKW(P1,8), pw3[1]=PKW(P1,10), pw3); \
    VRD(7); SBAR(); GAPA(C1=__builtin_amdgcn_mfma_f32_32x32x16_bf16(kf[7],qr[3],C1,0,0,0),   P1[14],P1[15],0.f,0.f,       pw3[2]=PKW(P1,12),pw3[3]=PKW(P1,14), pw3); \
    C0=__builtin_amdgcn_mfma_f32_32x32x16_bf16(kb0_,qx,C0,0,0,0); C1=__builtin_amdgcn_mfma_f32_32x32x16_bf16(kb1_,qx,C1,0,0,0); SBAR(); \
    l_reg+=sacc; \
    if(GK){DMA_K((t)+3,sl_cur);} if(GV){DMA_V((t)+1,sl_next);} \
    CMASK(C0,C1,t); \
    { float a=MX3(C0[0],C0[1],C1[0]),b=MX3(C0[2],C0[3],C1[1]); a=MX3(a,C1[2],C1[3]); \
      _Pragma("unroll") for(int r=4;r<16;r+=4){a=MX3(a,C0[r],C0[r+1]);b=MX3(b,C0[r+2],C0[r+3]);a=MX3(a,C1[r],C1[r+1]);b=MX3(b,C1[r+2],C1[r+3]);} \
      float rm=__builtin_fmaxf(a,b); { auto rr=__builtin_amdgcn_permlane32_swap(__float_as_uint(rm),__float_as_uint(rm),false,false); rm=__builtin_fmaxf(__uint_as_float(rr[0]),__uint_as_float(rr[1])); } \
      resc=false; \
      if(__builtin_expect(__any(rm>(float)THRL),0)){ const float dl=__builtin_fmaxf(rm,0.f); mhat+=dl; \
        _Pragma("unroll") for(int r=0;r<16;++r){C0[r]-=dl;C1[r]-=dl;} \
        qx=make_qx(mhat,hi); \
        const float f=__builtin_amdgcn_exp2f(-dl); l_reg*=f; if(hi==0)wsf[r32]=f; resc=true; } } \
    SBAR(); \
    GAPB(o[0]=__builtin_amdgcn_mfma_f32_32x32x16_bf16(PAF(0),VFR(0),o[0],0,0,0), C0,0); \
    GAPB(o[1]=__builtin_amdgcn_mfma_f32_32x32x16_bf16(PAF(0),VFR(4),o[1],0,0,0), C0,4); \
    KRD(GL,0); GAPB(o[0]=__builtin_amdgcn_mfma_f32_32x32x16_bf16(PAF(1),VFR(1),o[0],0,0,0), C0,8); \
    KRD(GL,1); GAPB(o[1]=__builtin_amdgcn_mfma_f32_32x32x16_bf16(PAF(1),VFR(5),o[1],0,0,0), C0,12); \
    KRD(GL,2); GAPB(o[0]=__builtin_amdgcn_mfma_f32_32x32x16_bf16(PAF(2),VFR(2),o[0],0,0,0), C1,0); \
    KRD(GL,3); GAPB(o[1]=__builtin_amdgcn_mfma_f32_32x32x16_bf16(PAF(2),VFR(6),o[1],0,0,0), C1,4); \
    GAPB(o[0]=__builtin_amdgcn_mfma_f32_32x32x16_bf16(PAF(3),VFR(3),o[0],0,0,0), C1,8); \
    GAPB(o[1]=__builtin_amdgcn_mfma_f32_32x32x16_bf16(PAF(3),VFR(7),o[1],0,0,0), C1,12); \
    }while(0)
  int t=1;
  #undef CMASK
  #define CMASK(P0,P1,t) do{}while(0)
  for(;t+5<NT;t+=2){
    STEP(pB0,pB1,pA0,pA1,t,true,true,true);     WAIT_BAR(2); RESC(); ROT();
    STEP(pA0,pA1,pB0,pB1,t+1,true,true,true);   WAIT_BAR(2); RESC(); ROT();
  }
  #undef CMASK
  #define CMASK(P0,P1,t) do{int jb_=(t)-(NT-4); if(jb_>=0)cmask(P0,P1,jb_,qrel,hi);}while(0)
  #define ENDW(tt) do{ if((tt)+3<NT){WAIT_BAR(2);} else if((tt)+2<NT){WAIT_BAR(1);} else {WAIT_BAR(0);} }while(0)
  for(;t+1<NT;t+=2){
    STEP(pB0,pB1,pA0,pA1,t,(t+3<NT),(t+1<NT),(t+1<NT));       ENDW(t);   RESC(); ROT();
    STEP(pA0,pA1,pB0,pB1,t+1,(t+4<NT),(t+2<NT),(t+2<NT));     ENDW(t+1); RESC(); ROT();
  }
  STEP(pB0,pB1,pA0,pA1,NT-1,false,false,false); RESC();
  { float sacc=pB0[0]+pB0[1]; _Pragma("unroll") for(int r=2;r<16;++r)sacc+=pB0[r]; _Pragma("unroll") for(int r=0;r<16;++r)sacc+=pB1[r]; l_reg+=sacc;
    pw0=(u32x4){PKW(pB0,0),PKW(pB0,2),PKW(pB0,4),PKW(pB0,6)};pw1=(u32x4){PKW(pB0,8),PKW(pB0,10),PKW(pB0,12),PKW(pB0,14)};pw2=(u32x4){PKW(pB1,0),PKW(pB1,2),PKW(pB1,4),PKW(pB1,6)};pw3=(u32x4){PKW(pB1,8),PKW(pB1,10),PKW(pB1,12),PKW(pB1,14)};
    SBAR(); pv(o,vb0+sl_cur,PAF(0),PAF(1),PAF(2),PAF(3)); }
  #undef PKW
  #undef PAF
  #undef VFR
  #undef PIN
  #undef MX3
  #undef GAPA
  #undef GAPB
  #undef EX
  #undef VRD
  #undef KRD
  #undef STEP
  #undef ENDW
  {auto rr=__builtin_amdgcn_permlane32_swap(__float_as_uint(l_reg),__float_as_uint(l_reg),false,false);l_reg=__uint_as_float(rr[0])+__uint_as_float(rr[1]);}
  if(hi==0)wsf[32+r32]=l_reg;asm volatile("s_waitcnt lgkmcnt(0)":::"memory");
  float rli[16];
  #pragma unroll
  for(int r=0;r<16;++r)rli[r]=__builtin_amdgcn_rcpf(wsf[32+crow(r,hi)]);
  bf16*Ow=O+(rowbase+q0+wid*QBLK)*OPITCH+h*D;
  { bf16*stg=(bf16*)(shm+LDS_OST)+wid*2048;
    #pragma unroll
    for(int r=0;r<16;++r){const int orow=crow(r,hi);
      #pragma unroll
      for(int d0=0;d0<2;++d0)stg[orow*64+d0*32+r32]=__float2bfloat16(o[d0][r]*rli[r]);}
    asm volatile("s_waitcnt lgkmcnt(0)":::"memory");
    #pragma unroll
    for(int i=0;i<4;++i){const int row=i*8+(lane>>3),ch=lane&7; const u32x4 v=*(const u32x4*)(stg+row*64+ch*8); ATTN_STORE16(Ow+(long)row*OPITCH+ch*8,v);} }
  asm volatile("s_waitcnt lgkmcnt(0)\n\ts_barrier":::"memory");
  #undef DMA_K
  #undef DMA_V
  #undef CMASK
  #undef START
  #undef RESC
  #undef ROT
}
constexpr int ATTN_LDS_BYTES=LDS_BYTES;
#undef SBAR
#undef WAIT_BAR
}

namespace ret_body {
constexpr int VT_P = 272, KT_P = 272, ST_P = 144, PW_P = 272;
constexpr int KC_P = 144;
constexpr int L_VT = 0, L_KT = L_VT + 128 * VT_P, L_ST = L_KT + 64 * KT_P, L_PW = L_ST + 128 * ST_P, PW_BYTES = 16 * PW_P, L_KC = L_PW + 8 * PW_BYTES, LDS_BYTES = L_KC + 128 * KC_P;
typedef short bf16x8 __attribute__((ext_vector_type(8)));
typedef float f32x4 __attribute__((ext_vector_type(4)));
#define dpp_f(v, ctrl) __int_as_float(__builtin_amdgcn_update_dpp(0, __float_as_int(v), (ctrl), 0xF, 0xF, false))
#define RB_MFMA(a, b, c) __builtin_amdgcn_mfma_f32_16x16x32_bf16(__builtin_bit_cast(bf16x8, a), __builtin_bit_cast(bf16x8, b), c, 0, 0, 0)
__device__ __forceinline__ void ret_unit(LAS unsigned char* L, int b, int h, const bf16* RQ, const bf16* RK, const bf16* RVT, const bf16* RKT, const bf16* RGS, bf16* BR, int wave, int c0 = 0, int c1 = SEQ / 128, int pf0 = 0) {
    int tid = wave * 64 + lane_now(); asm volatile("" : "+v"(tid));
    const int lane = tid & 63, w = __builtin_amdgcn_readfirstlane(tid >> 6), r = lane & 15, q = lane >> 4;
    const float lg2 = log1pf(-exp2f(-5.f - (float)h)) * LOG2E;
    const float cd = __builtin_amdgcn_exp2f(128.f * lg2);
    unsigned z0 = 0u; asm volatile("" : "+v"(z0));
    f32x4 S[4];
#pragma unroll
    for (int i = 0; i < 4; ++i) { const float zf = __uint_as_float(z0); S[i] = (f32x4){zf, zf, zf, zf}; }
    for (int i = tid * 16; i < 128 * ST_P; i += NWAVES * 64 * 16) *(LAS v4u*)(L + L_ST + i) = (v4u){z0, z0, z0, z0};
    LAS unsigned char* Pw = L + L_PW + w * PW_BYTES;
    v4u pv[4], pkt[2], pkc[2], pq[2];
    const int t16 = tid & 15, trow = tid >> 4;
#define RB_LOAD(cc) do { const size_t r0_ = (size_t)b * SEQ + (size_t)(cc) * 128; const size_t it_ = (size_t)((b * 4 + h) * 16 + (cc)); \
        _Pragma("unroll") for (int j = 0; j < 4; ++j) pv[j] = *(const v4u*)(RVT + it_ * 16384 + (size_t)(32 * j + trow) * 128 + 8 * t16); \
        _Pragma("unroll") for (int j = 0; j < 2; ++j) pkt[j] = *(const v4u*)(RKT + it_ * 8192 + (size_t)(32 * j + trow) * 128 + 8 * t16); \
        _Pragma("unroll") for (int j = 0; j < 2; ++j) pkc[j] = *(const v4u*)(RK + (r0_ + 64 * j + (tid >> 3)) * 256 + h * 64 + 8 * (tid & 7)); \
        _Pragma("unroll") for (int ks = 0; ks < 2; ++ks) pq[ks] = *(const v4u*)(RQ + (r0_ + 16 * w + r) * 256 + h * 64 + 32 * ks + 8 * q); } while (0)
    RB_LOAD(0);
    for (int c = 0; c < c1; ++c) {
        const int pf = pf0 | ((c < c0) ? 3 : 0);
        const size_t row0 = (size_t)b * SEQ + (size_t)c * 128;
        float lg2c = lg2; asm volatile("" : "+v"(lg2c));
        if (!(pf & 8)) {
#pragma unroll
        for (int j = 0; j < 4; ++j) *(LAS v4u*)(L + L_VT + (32 * j + trow) * VT_P + 16 * t16) = pv[j];
#pragma unroll
        for (int j = 0; j < 2; ++j) *(LAS v4u*)(L + L_KT + (32 * j + trow) * KT_P + 16 * t16) = pkt[j];
        if (!(pf & 2)) {
#pragma unroll
        for (int j = 0; j < 2; ++j) *(LAS v4u*)(L + L_KC + (64 * j + (tid >> 3)) * KC_P + 16 * (tid & 7)) = pkc[j];
        }
        }
        v4u qf[2]; qf[0] = pq[0]; qf[1] = pq[1];
        __syncthreads();
        const float fdec = __builtin_amdgcn_exp2f((float)(16 * w + 4 * q - r) * lg2c);
        const float g1 = __builtin_amdgcn_exp2f(lg2c), g2 = g1 * g1, g3 = g2 * g1; float gm16[8];
        { const float gi = __builtin_amdgcn_exp2f(-16.f * lg2c); gm16[0] = 1.f;
#pragma unroll
          for (int j = 1; j < 8; ++j) gm16[j] = gm16[j - 1] * gi; }
        if (!(pf & 2)) {
#pragma unroll
        for (int jh = 0; jh < 2; ++jh) {
        v4u kk0[4], kk1[4];
#pragma unroll
        for (int jj = 0; jj < 4; ++jj) { const int jb = 4 * jh + jj; if (jb <= w) { kk0[jj] = *(const LAS v4u*)(L + L_KC + (16 * jb + r) * KC_P + 16 * q); kk1[jj] = *(const LAS v4u*)(L + L_KC + (16 * jb + r) * KC_P + 64 + 16 * q); } }
        __builtin_amdgcn_sched_barrier(0);
#pragma unroll
        for (int jj = 0; jj < 4; ++jj) { const int jb = 4 * jh + jj;
            if (jb <= w) {
                const v4u k0 = kk0[jj], k1 = kk1[jj];
                f32x4 acc = (f32x4){0.f, 0.f, 0.f, 0.f};
                acc = RB_MFMA(qf[0], k0, acc); acc = RB_MFMA(qf[1], k1, acc);
                const float f0 = fdec * gm16[jb];
                acc[0] *= f0; acc[1] *= f0 * g1; acc[2] *= f0 * g2; acc[3] *= f0 * g3;
                if (jb == w) {
#pragma unroll
                    for (int e = 0; e < 4; ++e) acc[e] = (4 * q - r + e >= 0) ? acc[e] : 0.f; }
                const unsigned p01 = cvt_pk_bf16(acc[0], acc[1]), p23 = cvt_pk_bf16(acc[2], acc[3]);
                LAS unsigned char* pp = Pw + (4 * q) * PW_P + (16 * jb + r) * 2;
                *(LAS unsigned short*)(pp) = (unsigned short)p01; *(LAS unsigned short*)(pp + PW_P) = (unsigned short)(p01 >> 16);
                *(LAS unsigned short*)(pp + 2 * PW_P) = (unsigned short)p23; *(LAS unsigned short*)(pp + 3 * PW_P) = (unsigned short)(p23 >> 16);
            } else if (jb == w + 1 && (w & 1) == 0) {
                LAS unsigned char* pp = Pw + (4 * q) * PW_P + (16 * jb + r) * 2;
                *(LAS unsigned short*)(pp) = 0; *(LAS unsigned short*)(pp + PW_P) = 0; *(LAS unsigned short*)(pp + 2 * PW_P) = 0; *(LAS unsigned short*)(pp + 3 * PW_P) = 0;
            }
        }
        __builtin_amdgcn_sched_barrier(0); }
        }
        LDS_WAIT(); asm volatile("" ::: "memory");
        if (c + 1 < c1) RB_LOAD(c + 1);
        if (!(pf & 2)) {
        v4u pg[4];
        { const size_t grow_ = row0 + 16 * w + (lane >> 4);
#pragma unroll
          for (int i = 0; i < 4; ++i) pg[i] = *(const v4u*)(RGS + (grow_ + 4 * i) * 512 + h * 128 + 8 * (lane & 15)); }
        f32x4 oi[8];
#pragma unroll
        for (int d = 0; d < 8; ++d) oi[d] = (f32x4){0.f, 0.f, 0.f, 0.f};
#pragma unroll
        for (int ks = 0; ks < 4; ++ks) {
            if (2 * ks <= w && !(pf & 2)) { const v4u pa = *(const LAS v4u*)(Pw + r * PW_P + (32 * ks + 8 * q) * 2); v4u vb[8];
#pragma unroll
                for (int d = 0; d < 8; ++d) vb[d] = *(const LAS v4u*)(L + L_VT + (16 * d + r) * VT_P + (32 * ks + 8 * q) * 2);
                __builtin_amdgcn_sched_barrier(0);
#pragma unroll
                for (int d = 0; d < 8; ++d) oi[d] = RB_MFMA(pa, vb[d], oi[d]);
                __builtin_amdgcn_sched_barrier(0); }
        }
        { const float rfq = __builtin_amdgcn_exp2f((float)(16 * w + r + 1) * lg2);
#pragma unroll
          for (int ks = 0; ks < 2; ++ks) { v4u sb[8], qs;
#pragma unroll
            for (int wd = 0; wd < 4; ++wd) qs[wd] = cvt_pk_bf16(bflo(qf[ks][wd]) * rfq, bfhi(qf[ks][wd]) * rfq);
#pragma unroll
            for (int d = 0; d < 8; ++d) sb[d] = *(const LAS v4u*)(L + L_ST + (16 * d + r) * ST_P + (32 * ks + 8 * q) * 2);
            __builtin_amdgcn_sched_barrier(0);
#pragma unroll
            for (int d = 0; d < 8; ++d) oi[d] = RB_MFMA(qs, sb[d], oi[d]);
            __builtin_amdgcn_sched_barrier(0); } }
        float ss[4];
#pragma unroll
        for (int e = 0; e < 4; ++e) ss[e] = 0.f;
#pragma unroll
        for (int d = 0; d < 8; ++d)
#pragma unroll
            for (int e = 0; e < 4; ++e) ss[e] += oi[d][e] * oi[d][e];
#pragma unroll
        for (int e = 0; e < 4; ++e) { float s = ss[e]; s += dpp_f(s, 0xB1); s += dpp_f(s, 0x4E); s += dpp_f(s, 0x141); s += dpp_f(s, 0x140); ss[e] = 1.f / sqrtf(s * (1.f / 128.f) + EPS); }
#pragma unroll
        for (int d = 0; d < 8; ++d) { const unsigned p01 = cvt_pk_bf16(oi[d][0] * ss[0], oi[d][1] * ss[1]), p23 = cvt_pk_bf16(oi[d][2] * ss[2], oi[d][3] * ss[3]);
            LAS unsigned char* pp = Pw + (4 * q) * PW_P + (16 * d + r) * 2;
            *(LAS unsigned short*)(pp) = (unsigned short)p01; *(LAS unsigned short*)(pp + PW_P) = (unsigned short)(p01 >> 16);
            *(LAS unsigned short*)(pp + 2 * PW_P) = (unsigned short)p23; *(LAS unsigned short*)(pp + 3 * PW_P) = (unsigned short)(p23 >> 16); }
        LDS_WAIT(); asm volatile("" ::: "memory");
        { const int orow = lane >> 4, oc = lane & 15; const size_t grow = row0 + 16 * w + orow;
#pragma unroll
          for (int i = 0; i < 4; ++i) { const v4u ov = *(const LAS v4u*)(Pw + (orow + 4 * i) * PW_P + 16 * oc); const v4u gv = pg[i];
              v4u o;
#pragma unroll
              for (int wd = 0; wd < 4; ++wd) o[wd] = cvt_pk_bf16(bflo(ov[wd]) * bflo(gv[wd]), bfhi(ov[wd]) * bfhi(gv[wd]));
              if (!(pf & 1)) *(v4u*)(BR + (grow + 4 * i) * 1024 + 512 + h * 128 + 8 * oc) = o; } }
        }
        if (!(pf & 2)) __syncthreads();
#pragma unroll
        for (int i = 0; i < 4; ++i) S[i] = S[i] * cd;
        if (!(pf & 4))
#pragma unroll
        for (int ks = 0; ks < 4; ++ks) { const v4u vb = *(const LAS v4u*)(L + L_VT + (16 * w + r) * VT_P + (32 * ks + 8 * q) * 2); v4u ka[4];
#pragma unroll
            for (int i = 0; i < 4; ++i) ka[i] = *(const LAS v4u*)(L + L_KT + (16 * i + r) * KT_P + (32 * ks + 8 * q) * 2);
            __builtin_amdgcn_sched_barrier(0);
#pragma unroll
            for (int i = 0; i < 4; ++i) S[i] = RB_MFMA(ka[i], vb, S[i]);
            __builtin_amdgcn_sched_barrier(0); }
#pragma unroll
        for (int i = 0; i < 4; ++i) { v2u sv; sv.x = cvt_pk_bf16(S[i][0], S[i][1]); sv.y = cvt_pk_bf16(S[i][2], S[i][3]); *(LAS v2u*)(L + L_ST + (16 * w + r) * ST_P + (16 * i + 4 * q) * 2) = sv; }
        __syncthreads();
    }
}
#undef RB_MFMA
#undef dpp_f
#undef RB_LOAD
}

struct TrItem { const float* src; bf16* dst; int ldw, K, base, mul, gu, f8; };
__device__ __forceinline__ int tr_row(const TrItem& t, int n) { if (t.gu) { const int a = t.base + (n >> 1), b = n & 1; return 256 * (a >> 7) + 128 * b + (a & 127); } return t.base + t.mul * n; }
__device__ __forceinline__ void tr_load(const TrItem& t, f32x4 (&v)[8], int lane) {
    const float* p = t.src + (size_t)(lane >> 3) * t.ldw + 4 * (lane & 7);
#pragma unroll
    for (int i = 0; i < 8; ++i) v[i] = *(const GAS f32x4*)(p + (size_t)(8 * i) * t.ldw);
}
__device__ __forceinline__ void tr_store(const TrItem& t, const f32x4 (&v)[8], LAS float* scr, int lane) {
    { LAS float* w = scr + (lane >> 3) * 33 + 4 * (lane & 7);
#pragma unroll
      for (int i = 0; i < 8; ++i) { w[(8 * i) * 33 + 0] = v[i][0]; w[(8 * i) * 33 + 1] = v[i][1]; w[(8 * i) * 33 + 2] = v[i][2]; w[(8 * i) * 33 + 3] = v[i][3]; } }
    LDS_WAIT(); asm volatile("" ::: "memory");
    const int c = lane & 7;
#pragma unroll
    for (int j = 0; j < 4; ++j) { const int n = (lane >> 3) + 8 * j; const LAS float* s = scr + (8 * c) * 33 + n;
        if (t.f8) { const f32x4 a = {s[0 * 33] * WSCALE, s[1 * 33] * WSCALE, s[2 * 33] * WSCALE, s[3 * 33] * WSCALE}, b = {s[4 * 33] * WSCALE, s[5 * 33] * WSCALE, s[6 * 33] * WSCALE, s[7 * 33] * WSCALE};
            *(GAS v2u*)((unsigned char*)t.dst + (size_t)tr_row(t, n) * t.K + 8 * c) = pack8_fp8(a, b); }
        else { v4u o; o.x = cvt_pk_bf16(s[0 * 33], s[1 * 33]); o.y = cvt_pk_bf16(s[2 * 33], s[3 * 33]); o.z = cvt_pk_bf16(s[4 * 33], s[5 * 33]); o.w = cvt_pk_bf16(s[6 * 33], s[7 * 33]);
            *(GAS v4u*)(t.dst + (size_t)tr_row(t, n) * t.K + 8 * c) = o; } }
    LDS_WAIT(); asm volatile("" ::: "memory");
}
__device__ __forceinline__ void tr_store2(const TrItem& t0, const f32x4 (&v0)[8], const TrItem& t1, const f32x4 (&v1)[8], LAS float* s0, LAS float* s1, int lane) {
    { LAS float* w0 = s0 + (lane >> 3) * 33 + 4 * (lane & 7); LAS float* w1 = s1 + (lane >> 3) * 33 + 4 * (lane & 7);
#pragma unroll
      for (int i = 0; i < 8; ++i) { w0[(8 * i) * 33 + 0] = v0[i][0]; w0[(8 * i) * 33 + 1] = v0[i][1]; w0[(8 * i) * 33 + 2] = v0[i][2]; w0[(8 * i) * 33 + 3] = v0[i][3];
                                    w1[(8 * i) * 33 + 0] = v1[i][0]; w1[(8 * i) * 33 + 1] = v1[i][1]; w1[(8 * i) * 33 + 2] = v1[i][2]; w1[(8 * i) * 33 + 3] = v1[i][3]; } }
    LDS_WAIT(); asm volatile("" ::: "memory");
    const int c = lane & 7;
#pragma unroll
    for (int u = 0; u < 2; ++u) { const TrItem& t = u ? t1 : t0; const LAS float* sb = u ? s1 : s0;
#pragma unroll
        for (int j = 0; j < 4; ++j) { const int n = (lane >> 3) + 8 * j; const LAS float* s = sb + (8 * c) * 33 + n;
            if (t.f8 == 1) { const f32x4 a = {s[0 * 33] * WSCALE, s[1 * 33] * WSCALE, s[2 * 33] * WSCALE, s[3 * 33] * WSCALE}, b = {s[4 * 33] * WSCALE, s[5 * 33] * WSCALE, s[6 * 33] * WSCALE, s[7 * 33] * WSCALE};
                *(GAS v2u*)((unsigned char*)t.dst + (size_t)tr_row(t, n) * t.K + 8 * c) = pack8_fp8(a, b); }
            else { v4u o; o.x = cvt_pk_bf16(s[0 * 33], s[1 * 33]); o.y = cvt_pk_bf16(s[2 * 33], s[3 * 33]); o.z = cvt_pk_bf16(s[4 * 33], s[5 * 33]); o.w = cvt_pk_bf16(s[6 * 33], s[7 * 33]);
                *(GAS v4u*)(t.dst + (size_t)tr_row(t, n) * t.K + 8 * c) = o; } } }
    LDS_WAIT(); asm volatile("" ::: "memory");
}
constexpr int TR_IN = 96 * 16, TR_MG = 64 * 16, TR_BR = 2 * 32 * 8, TR_O = 32 * 16, TR_PG = 32 * 16, TR_PP = 32 * 4, TR_GU = 32 * 64 * 16, TR_DN = 32 * 32 * 16;
constexpr int TR_ITEMS = TR_IN + TR_MG + TR_BR + TR_O + TR_PG + TR_PP + TR_GU + TR_DN;
__device__ __forceinline__ TrItem tr_decode(Frame& F, int it) {
    TrItem t; t.mul = 1; t.gu = 0; t.f8 = 0; int r = it;
    if (r < TR_GU) { const int e = r >> 10, rr = r & 1023, kb = rr >> 6, blk = rr & 63;
        t.src = (F.ap->in[12]) + (size_t)e * 1024 * 2048 + (size_t)(64 * kb) * 2048 + 32 * blk; t.ldw = 2048; t.dst = (bf16*)(WSP(unsigned char, WS_WGUT) + (size_t)e * 2048 * 1024 + 64 * kb); t.K = 1024; t.base = 16 * blk; t.gu = 1; t.f8 = 1; return t; } r -= TR_GU;
    if (r < TR_DN) { const int e = r >> 9, rr = r & 511, kb = rr >> 5, blk = rr & 31;
        t.src = (F.ap->in[14]) + (size_t)e * 1024 * 1024 + (size_t)(64 * kb) * 1024 + 32 * blk; t.ldw = 1024; t.dst = (bf16*)(WSP(unsigned char, WS_WDT) + (size_t)e * 1024 * 1024 + 64 * kb); t.K = 1024; t.base = 32 * blk; t.f8 = 1; return t; } r -= TR_DN;
    if (r < TR_IN) { const int kb = r / 96, blk = r % 96; int s0;
        if (blk < 32) { s0 = 32 * blk; t.base = 32 * blk; t.f8 = 1; }
        else if (blk < 48) { s0 = 32 * blk; t.base = 32 * (blk - 32); }
        else if (blk < 64) { s0 = 2056 + 32 * (blk - 48); t.base = 1024 + 32 * (blk - 48); }
        else if (blk < 80) { s0 = 2568 + 32 * (blk - 64); t.base = 1536 + 32 * (blk - 64); }
        else { const int hb = (blk - 80) & 7, head = hb >> 1, half = hb & 1, isk = (blk >= 88); s0 = (isk ? 1800 : 1544) + head * 64 + half * 32; t.base = (isk ? 768 : 512) + head * 64 + half; t.mul = 2; }
        t.src = (F.ap->in[3]) + (size_t)(64 * kb) * INW + s0; t.ldw = INW; t.dst = t.f8 ? (bf16*)(WSP(unsigned char, WS_WG8T) + 64 * kb) : WSP(bf16, WS_W1T) + 64 * kb; t.K = 1024; return t; } r -= TR_IN;
    if (r < TR_MG) { const int kb = r >> 6, blk = r & 63; t.src = (F.ap->in[6]) + (size_t)(64 * kb) * 2048 + 32 * blk; t.ldw = 2048; t.dst = (bf16*)(WSP(unsigned char, WS_WG8T) + 64 * kb); t.K = 1024; t.base = 1024 + 32 * blk; t.f8 = 1; return t; } r -= TR_MG;
    if (r < TR_BR) { const int gsel = r >> 8, rr = r & 255, kb = rr >> 5, blk = rr & 31;
        t.src = (F.ap->in[5]) + (size_t)gsel * 512 * 1024 + (size_t)(64 * kb) * 1024 + 32 * blk; t.ldw = 1024; t.dst = WSP(bf16, WS_WBT) + gsel * 512 + 64 * kb; t.K = 1024; t.base = 32 * blk; return t; } r -= TR_BR;
    if (r < TR_O) { const int kb = r >> 5, blk = r & 31; t.src = (F.ap->in[8]) + (size_t)(64 * kb) * 1024 + 32 * blk; t.ldw = 1024; t.dst = WSP(bf16, WS_WOT) + 64 * kb; t.K = 1024; t.base = 32 * blk; return t; } r -= TR_O;
    if (r < TR_PG) { const int kb = r >> 5, blk = r & 31; t.src = (F.ap->in[17]) + (size_t)(64 * kb) * 1024 + 32 * blk; t.ldw = 1024; t.dst = (bf16*)(WSP(unsigned char, WS_WPGT) + 64 * kb); t.K = 1024; t.base = 32 * blk; t.f8 = 1; return t; } r -= TR_PG;
    { const int kb = r >> 5, blk = r & 31; t.src = (F.ap->in[18]) + (size_t)(64 * kb) * 1024 + 32 * blk; t.ldw = 1024; t.dst = WSP(bf16, WS_WPPT) + 64 * kb; t.K = 256; t.base = 32 * blk; return t; }
}

__device__ __forceinline__ void p0_row(Frame& F, int m, f32x4 (&v)[4], LAS const float* WFt, int lane) {
    float s = 0.f;
#pragma unroll
    for (int j = 0; j < 4; ++j) s += (v[j].x * v[j].x + v[j].y * v[j].y) + (v[j].z * v[j].z + v[j].w * v[j].w);
    const float rstd = 1.f / sqrtf(wave_sum(s) * (1.f / DM) + EPS);
    GAS unsigned long long* o8 = (GAS unsigned long long*)(WSP(bf16, WS_XN) + (size_t)m * DM) + lane;
    GAS int* q8 = (GAS int*)(WSP(unsigned char, WS_XN8) + (size_t)m * DM) + lane;
#pragma unroll
    for (int j = 0; j < 4; ++j) { const f32x4 g = ((const GAS f32x4*)(F.ap->in[2]))[lane + 64 * j]; v[j] = v[j] * rstd * g;
        o8[64 * j] = (unsigned long long)cvt_pk_bf16(v[j].x, v[j].y) | ((unsigned long long)cvt_pk_bf16(v[j].z, v[j].w) << 32);
        { int w = 0; w = __builtin_amdgcn_cvt_pk_fp8_f32(clamp_f8(v[j].x), clamp_f8(v[j].y), w, false); w = __builtin_amdgcn_cvt_pk_fp8_f32(clamp_f8(v[j].z), clamp_f8(v[j].w), w, true); q8[64 * j] = w; } }
    float fa[8];
#pragma unroll
    for (int c = 0; c < 8; ++c) { float a = 0.f;
#pragma unroll
        for (int j = 0; j < 4; ++j) { const f32x4 w = *(const LAS f32x4*)(WFt + c * 1024 + 256 * j + 4 * lane); a += (v[j].x * w.x + v[j].y * w.y) + (v[j].z * w.z + v[j].w * w.w); }
        fa[c] = wave_sum(a); }
    float z = fa[0];
#pragma unroll
    for (int c = 1; c < 8; ++c) z = (lane == c) ? fa[c] : z;
    if (lane < 8) { z += (F.ap->in[4])[lane]; WSP(float, WS_LOGF)[(size_t)m * 8 + lane] = fminf(z, 0.f) - log1pf(expf(-fabsf(z))); }
}
__device__ __forceinline__ void p0_prologue(Frame& F) {
    LAS float* WFt = (LAS float*)(F.lds + RING_OFF);
    for (int idx = F.tid; idx < 8192; idx += NWAVES * 64) { const int k = idx >> 3, c = idx & 7; WFt[c * 1024 + k] = (F.ap->in[3])[(size_t)k * INW + 1536 + c]; }
    __syncthreads();
    const int gw = F.vcu * NWAVES + F.wave, NGW = F.G * NWAVES, lane = F.lane;
#ifndef P0_REP_ROWS
#define P0_REP_ROWS 1
#endif
#ifndef P0_REP_TR
#define P0_REP_TR 1
#endif
#ifndef P0_REP_ROWS
#define P0_REP_ROWS 1
#endif
#ifndef P0_REP_TR
#define P0_REP_TR 1
#endif
    for (int rep_ = 0; rep_ < P0_REP_ROWS; ++rep_)
    { f32x4 va[4], vb[4]; int m = gw;
      if (m < NT) {
#pragma unroll
          for (int j = 0; j < 4; ++j) va[j] = ((const GAS f32x4*)((F.ap->in[0]) + (size_t)m * DM))[lane + 64 * j]; }
      for (; m < NT; m += NGW) { const int m2 = m + NGW;
          if (m2 < NT) {
#pragma unroll
              for (int j = 0; j < 4; ++j) vb[j] = ((const GAS f32x4*)((F.ap->in[0]) + (size_t)m2 * DM))[lane + 64 * j]; }
          __builtin_amdgcn_sched_barrier(0);
          p0_row(F, m, va, WFt, lane);
          __builtin_amdgcn_sched_barrier(0);
#pragma unroll
          for (int j = 0; j < 4; ++j) va[j] = vb[j];
      } }
    __syncthreads();
    for (int rep_ = 0; rep_ < P0_REP_TR; ++rep_)
    { LAS float* scr = (LAS float*)(F.lds + RING_OFF + F.wave * 8704);
      constexpr int TR_P0_END = TR_GU + TR_DN + TR_IN + TR_MG;
      int it = TR_GU + TR_DN + gw; f32x4 cur[8], nxt[8]; TrItem tc, tn;
      if (it < TR_P0_END) { tc = tr_decode(F, it); tr_load(tc, cur, lane); }
      while (it < TR_P0_END) {
          const int itn = it + NGW; const bool hn = itn < TR_P0_END;
          if (hn) { tn = tr_decode(F, itn); tr_load(tn, nxt, lane); }
          tr_store(tc, cur, scr, lane);
          if (hn) { tc = tn;
#pragma unroll
              for (int i = 0; i < 8; ++i) cur[i] = nxt[i]; }
          it = itn;
      } }
    const int gt = F.vcu * (NWAVES * 64) + F.tid, NGT = F.G * NWAVES * 64;
    { float* rot = WSP(float, WS_ROT);
      for (int i = gt; i < SEQ * 32; i += NGT) { const int pos = i >> 5, j = i & 31;
          const float inv = powf(10000.f, -(float)j / 32.f); const float ang = (float)pos * inv;
          double rev = (double)ang * 0.15915494309189535; rev -= floor(rev); const float fr = (float)rev;
          rot[i] = __builtin_amdgcn_cosf(fr); rot[SEQ * 32 + i] = __builtin_amdgcn_sinf(fr); } }
    { bf16* wrt = WSP(bf16, WS_WRT);
      for (int i = gt; i < 1024 * 32; i += NGT) { const int k = i >> 5, n = i & 31; const float v = (F.ap->in[10])[i]; const unsigned hi = f2bf(v); const float rem = v - __uint_as_float(hi << 16);
          wrt[n * 1024 + k] = (bf16)hi; wrt[32768 + n * 1024 + k] = (bf16)f2bf(rem); } }
    if (gt < 64) { GAS v4u* z = (GAS v4u*)(WSP(unsigned char, WS_HB) + (size_t)NT * DM); z[gt] = (v4u){0u, 0u, 0u, 0u}; }
}

constexpr int CONV_ITEMS = 64, CONV_TR_ITEMS = TR_ITEMS - TR_IN - TR_MG, CONV_TR_CHUNKS = CONV_TR_ITEMS / CONV_ITEMS, CONV_PB_CHUNKS = NT * PLE / 4 / 16384, CONV_CHUNKS = CONV_TR_CHUNKS + CONV_PB_CHUNKS;
static_assert(CONV_TR_ITEMS % CONV_ITEMS == 0 && (TR_GU + TR_DN) % CONV_ITEMS == 0 && (NT * PLE / 4) % 16384 == 0, "whole chunks");
__device__ __forceinline__ TrItem conv_decode(Frame& F, int ci) { return tr_decode(F, ci < TR_GU + TR_DN ? ci : ci + TR_IN + TR_MG); }
__device__ __forceinline__ void conv_chunk(Frame& F, int c) {
    int lane = lane_now(); asm volatile("" : "+v"(lane));
    if (c >= CONV_TR_CHUNKS) {
        const int j = c - CONV_TR_CHUNKS, t = F.wave * 64 + lane;
        const GAS f32x4* ps = (const GAS f32x4*)(F.ap->in[1]) + (size_t)j * 16384 + t; GAS unsigned long long* pd = (GAS unsigned long long*)WSP(bf16, WS_PB) + (size_t)j * 16384 + t;
        for (int b = 0; b < 4; ++b) { f32x4 v[8];
#pragma unroll
            for (int u = 0; u < 8; ++u) v[u] = ps[b * 4096 + u * 512];
#pragma unroll
            for (int u = 0; u < 8; ++u) pd[b * 4096 + u * 512] = (unsigned long long)cvt_pk_bf16(v[u].x, v[u].y) | ((unsigned long long)cvt_pk_bf16(v[u].z, v[u].w) << 32); }
        return; }
    LAS float* scr = (LAS float*)(F.lds + RING_OFF + F.wave * 17408); LAS float* scr1 = scr + 2176;
    static_assert(NWAVES * 17408 <= SCH_OFF - RING_OFF, "conversion scratch inside ring + table region");
    const int base = c * CONV_ITEMS + F.wave;
    f32x4 a0[8], a1[8], b0[8], b1[8], c0[8], c1[8]; TrItem ta0, ta1, tb0, tb1, tc0, tc1;
    constexpr int NPAIR = CONV_ITEMS / NWAVES / 2;
    ta0 = conv_decode(F, base); ta1 = conv_decode(F, base + NWAVES); tr_load(ta0, a0, lane); tr_load(ta1, a1, lane);
    tb0 = conv_decode(F, base + 2 * NWAVES); tb1 = conv_decode(F, base + 3 * NWAVES); tr_load(tb0, b0, lane); tr_load(tb1, b1, lane);
    tc0 = tb0; tc1 = tb1;
#pragma unroll
    for (int i = 0; i < 8; ++i) { c0[i] = b0[i]; c1[i] = b1[i]; }
    for (int k = 0; k < NPAIR; ++k) {
        if (k + 2 < NPAIR) { tc0 = conv_decode(F, base + NWAVES * (2 * k + 4)); tc1 = conv_decode(F, base + NWAVES * (2 * k + 5)); tr_load(tc0, c0, lane); tr_load(tc1, c1, lane); }
        __builtin_amdgcn_sched_barrier(0);
        tr_store2(ta0, a0, ta1, a1, scr, scr1, lane);
        __builtin_amdgcn_sched_barrier(0);
        ta0 = tb0; ta1 = tb1; tb0 = tc0; tb1 = tc1;
#pragma unroll
        for (int i = 0; i < 8; ++i) { a0[i] = b0[i]; a1[i] = b1[i]; b0[i] = c0[i]; b1[i] = c1[i]; }
    }
}

__device__ __forceinline__ void cum_scan(Frame& F, int bh) {
    const float* lf = WSP(float, WS_LOGF); float* cum = WSP(float, WS_CUM);
    const int b = bh >> 3, h = bh & 7, t0 = 4 * F.tid;
    double a0 = lf[((size_t)(b * SEQ + t0 + 0)) * 8 + h], a1 = lf[((size_t)(b * SEQ + t0 + 1)) * 8 + h], a2 = lf[((size_t)(b * SEQ + t0 + 2)) * 8 + h], a3 = lf[((size_t)(b * SEQ + t0 + 3)) * 8 + h];
    a1 += a0; a2 += a1; a3 += a2;
    LAS double* tot = (LAS double*)(F.lds + RING_OFF);
    tot[F.tid] = a3;
    __syncthreads();
    double ex = 0.0;
    for (int j = 0; j < 63; ++j) { const double v = tot[F.wave * 64 + j]; ex += (j < F.lane) ? v : 0.0; }
    if (F.lane == 63) tot[512 + F.wave] = ex + a3;
    __syncthreads();
    for (int w = 0; w < F.wave; ++w) ex += tot[512 + w];
    *(GAS f32x4*)(cum + (size_t)bh * SEQ + t0) = (f32x4){(float)(ex + a0), (float)(ex + a1), (float)(ex + a2), (float)(ex + a3)};
    __syncthreads();
}

typedef pg8::f32x4 (&AccRef)[2][2][4][2];
using pg8::Unit;
__device__ __forceinline__ v4u pack8(const f32x4 a, const f32x4 b) { v4u w; w.x = cvt_pk_bf16(a[0], a[1]); w.y = cvt_pk_bf16(a[2], a[3]); w.z = cvt_pk_bf16(b[0], b[1]); w.w = cvt_pk_bf16(b[2], b[3]); return w; }
__device__ __forceinline__ void unpack8(const v4u w, f32x4& a, f32x4& b) { a = (f32x4){bflo(w.x), bfhi(w.x), bflo(w.y), bfhi(w.y)}; b = (f32x4){bflo(w.z), bfhi(w.z), bflo(w.w), bfhi(w.w)}; }

__device__ __forceinline__ void tstore32(LAS unsigned char* scr, const v4u wa, const v4u wb, int fr, int fq, bf16* dst, int cstride) {
    LAS unsigned short* s2 = (LAS unsigned short*)scr;
#pragma unroll
    for (int e2 = 0; e2 < 4; ++e2) { const int col = 8 * fq + 2 * e2;
        s2[col * 40 + fr] = (unsigned short)(wa[e2] & 0xffffu); s2[(col + 1) * 40 + fr] = (unsigned short)(wa[e2] >> 16);
        s2[col * 40 + 16 + fr] = (unsigned short)(wb[e2] & 0xffffu); s2[(col + 1) * 40 + 16 + fr] = (unsigned short)(wb[e2] >> 16); }
    asm volatile("" ::: "memory");
    const int lane = fr + 16 * fq, cl = lane >> 1, part = lane & 1;
    const v4u r0 = *(const LAS v4u*)(scr + cl * 80 + part * 32), r1 = *(const LAS v4u*)(scr + cl * 80 + part * 32 + 16);
    asm volatile("" ::: "memory");
    bf16* d = dst + (size_t)cl * cstride + part * 16;
    *(v4u*)d = r0; *(v4u*)(d + 8) = r1;
}
struct EpiIn {
    static constexpr bool PERM = true;
    bf16 *FQ, *FK, *FV, *RQ, *RK, *RV, *RGS; const float* rot; bf16* RKT; LAS unsigned char* scr; int skip;
    __device__ __forceinline__ void operator()(const pg8::f32x4 (&acc)[2][2][4][2], const Unit& u, int wr, int wc, int fr, int fq) const {
        if (skip == 1) return;
        asm volatile("" : "+v"(fr), "+v"(fq));
        const int pn = u.pn; bf16* base; int ldc, colt, mode = 0; float sc = 1.f;
        if (skip) { const int cls = pn < 6 ? 1 : pn < 8 ? 2 : pn < 10 ? 4 : 8; if (skip & (cls << 1)) return; }
        if (pn < 2) { base = FQ; ldc = 512; colt = pn * 256; sc = C2; }
        else if (pn < 4) { base = FK; ldc = 512; colt = (pn - 2) * 256; }
        else if (pn < 6) { base = FV; ldc = 512; colt = (pn - 4) * 256; }
        else if (pn == 6) { base = RQ; ldc = 256; colt = 0; mode = 1; }
        else if (pn == 7) { base = RK; ldc = 256; colt = 0; mode = 1; sc = 0.125f; }
        else if (pn < 10) { base = RV; ldc = 512; colt = (pn - 8) * 256; mode = 4; }
        else { base = RGS; ldc = 512; colt = (pn - 10) * 256; mode = 2; }
        const int row0 = u.pm * 256 + wr * 64 + fr, col0 = colt + wc * 32 + 8 * fq;
        LAS unsigned char* ws = scr + (wr * 4 + wc) * 3072;
        if (mode == 1) {
            f32x4 cs[2][4], sn[2][4]; const int j = (col0 & 63) >> 1;
#pragma unroll
            for (int ai = 0; ai < 2; ++ai)
#pragma unroll
                for (int m = 0; m < 4; ++m) { const int pos = (row0 + ai * 128 + m * 16) & (SEQ - 1); cs[ai][m] = *(const f32x4*)(rot + pos * 32 + j); sn[ai][m] = *(const f32x4*)(rot + SEQ * 32 + pos * 32 + j); }
            __builtin_amdgcn_sched_barrier(0);
            float lg2b[2] = {0.f, 0.f};
            if (pn == 7) { lg2b[0] = log1pf(-exp2f(-5.f - (float)(wc >> 1))) * LOG2E; lg2b[1] = log1pf(-exp2f(-5.f - (float)((wc >> 1) + 2))) * LOG2E; }
#pragma unroll
            for (int ai = 0; ai < 2; ++ai)
#pragma unroll
                for (int mh = 0; mh < 2; ++mh)
#pragma unroll
                    for (int bj = 0; bj < 2; ++bj) { const int c = col0 + bj * 128; v4u wt[2];
#pragma unroll
                        for (int mm = 0; mm < 2; ++mm) { const int m = 2 * mh + mm, row = row0 + ai * 128 + m * 16; const f32x4 a = acc[ai][bj][m][0], b = acc[ai][bj][m][1], cv = cs[ai][m], sv = sn[ai][m];
                            const f32x4 v0 = {(a[0] * cv[0] - a[1] * sv[0]) * sc, (a[1] * cv[0] + a[0] * sv[0]) * sc, (a[2] * cv[1] - a[3] * sv[1]) * sc, (a[3] * cv[1] + a[2] * sv[1]) * sc};
                            const f32x4 v1 = {(b[0] * cv[2] - b[1] * sv[2]) * sc, (b[1] * cv[2] + b[0] * sv[2]) * sc, (b[2] * cv[3] - b[3] * sv[3]) * sc, (b[3] * cv[3] + b[2] * sv[3]) * sc};
                            *(v4u*)(base + (size_t)row * ldc + c) = pack8(v0, v1);
                            if (pn == 7) { const float dk = __builtin_amdgcn_exp2f((float)(127 - (row & 127)) * lg2b[bj]); wt[mm] = pack8(v0 * dk, v1 * dk); } }
                        if (pn == 7) {
                            const int rowb = u.pm * 256 + ai * 128 + wr * 64 + mh * 32, cb = wc * 32 + bj * 128;
                            tstore32(ws, wt[0], wt[1], fr, fq, RKT + ((size_t)((rowb >> 11) * 4 + (cb >> 6)) * 16 + ((rowb >> 7) & 15)) * 8192 + (size_t)(cb & 63) * 128 + (rowb & 127), 128); } }
            return; }
        if (mode == 4) {
#pragma unroll
            for (int ai = 0; ai < 2; ++ai)
#pragma unroll
                for (int mh = 0; mh < 2; ++mh)
#pragma unroll
                    for (int bj = 0; bj < 2; ++bj) { const int rowb = u.pm * 256 + ai * 128 + wr * 64 + mh * 32, cb = colt + wc * 32 + bj * 128;
                        tstore32(ws, pack8(acc[ai][bj][2 * mh][0], acc[ai][bj][2 * mh][1]), pack8(acc[ai][bj][2 * mh + 1][0], acc[ai][bj][2 * mh + 1][1]), fr, fq,
                                 RV + ((size_t)((rowb >> 11) * 4 + (cb >> 7)) * 16 + ((rowb >> 7) & 15)) * 16384 + (size_t)(cb & 127) * 128 + (rowb & 127), 128); }
            return; }
#pragma unroll
        for (int ai = 0; ai < 2; ++ai)
#pragma unroll
            for (int m = 0; m < 4; ++m) { const int row = row0 + ai * 128 + m * 16;
#pragma unroll
                for (int bj = 0; bj < 2; ++bj) { const int c = col0 + bj * 128; f32x4 v0 = acc[ai][bj][m][0], v1 = acc[ai][bj][m][1];
                    if (mode == 0) { v0 = v0 * sc; v1 = v1 * sc; }
                    else {
#pragma unroll
                        for (int e = 0; e < 4; ++e) { v0[e] = v0[e] * fsigmoid(v0[e]); v1[e] = v1[e] * fsigmoid(v1[e]); } }
                    *(v4u*)(base + (size_t)row * ldc + c) = pack8(v0, v1); } }
    }
};
__device__ __forceinline__ void u8x8_to_f32(const v2u w, f32x4& a, f32x4& b) {
    a = (f32x4){(float)(w.x & 255u), (float)((w.x >> 8) & 255u), (float)((w.x >> 16) & 255u), (float)(w.x >> 24)}; b = (f32x4){(float)(w.y & 255u), (float)((w.y >> 8) & 255u), (float)((w.y >> 16) & 255u), (float)(w.y >> 24)}; }
struct EpiGate {
    static constexpr bool PERM = true;
    unsigned char* GATES; const float* bmg; bf16 *FQ, *FK; int skip;
    __device__ __forceinline__ void operator()(const pg8::f32x4 (&acc)[2][2][4][2], const Unit& u, int wr, int wc, int fr, int fq) const {
        if (skip & 33) return;
        { const int l_ = lane_now(); fr = l_ & 15; fq = (l_ >> 4) & 3; }
        if (u.pn < 4) {
            bf16* base = u.pn < 2 ? FQ : FK; const float sc = (u.pn < 2 ? C2 : 1.f) * (1.f / WSCALE);
            const int r0 = u.pm * 256 + wr * 64 + fr, c0 = (u.pn & 1) * 256 + wc * 32 + 8 * fq;
#pragma unroll
            for (int ai = 0; ai < 2; ++ai)
#pragma unroll
                for (int m = 0; m < 4; ++m)
#pragma unroll
                    for (int bj = 0; bj < 2; ++bj) *(v4u*)(base + (size_t)(r0 + ai * 128 + m * 16) * 512 + c0 + bj * 128) = pack8(acc[ai][bj][m][0] * sc, acc[ai][bj][m][1] * sc);
            return; }
        float ck = -LOG2E / WSCALE, cb = -LOG2E, c254 = 254.f; asm volatile("" : "+s"(ck), "+s"(cb), "+s"(c254));
        typedef float f2 __attribute__((ext_vector_type(2)));
        const int row0 = u.pm * 256 + wr * 64 + fr, col0 = (u.pn - 4) * 256 + wc * 32 + 8 * fq;
        f32x4 bb[2][2];
#pragma unroll
        for (int bj = 0; bj < 2; ++bj) { bb[bj][0] = *(const f32x4*)(bmg + col0 + bj * 128) * cb; bb[bj][1] = *(const f32x4*)(bmg + col0 + bj * 128 + 4) * cb; }
#pragma unroll
        for (int ai = 0; ai < 2; ++ai)
#pragma unroll
            for (int m = 0; m < 4; ++m) { unsigned char* rowp = GATES + (size_t)(row0 + ai * 128 + m * 16) * 2048 + col0;
#pragma unroll
                for (int bj = 0; bj < 2; ++bj) { v2u w;
#pragma unroll
                    for (int n = 0; n < 2; ++n) { const f32x4 a = acc[ai][bj][m][n], b = bb[bj][n]; unsigned b4 = 0u;
#pragma unroll
                        for (int hh = 0; hh < 2; ++hh) { const f2 t = (f2){a[2 * hh], a[2 * hh + 1]} * ck + (f2){b[2 * hh], b[2 * hh + 1]};
                            f2 ex; ex.x = __builtin_amdgcn_exp2f(t.x); ex.y = __builtin_amdgcn_exp2f(t.y); const f2 den = ex + 1.0f;
                            f2 rc; rc.x = __builtin_amdgcn_rcpf(den.x); rc.y = __builtin_amdgcn_rcpf(den.y); const f2 x = rc * c254 + 0.5f;
                            if (hh == 0) { b4 = __builtin_amdgcn_cvt_pk_u8_f32(x.x, 0, b4); b4 = __builtin_amdgcn_cvt_pk_u8_f32(x.y, 1, b4); }
                            else { b4 = __builtin_amdgcn_cvt_pk_u8_f32(x.x, 2, b4); b4 = __builtin_amdgcn_cvt_pk_u8_f32(x.y, 3, b4); } }
                        if (n == 0) w.x = b4; else w.y = b4; }
                    *(v2u*)(rowp + bj * 128) = w; } }
    }
};
struct HookMerge {
    static constexpr bool ON = true; static constexpr int AT = 6;
    const unsigned char* GATES;
    __device__ __forceinline__ void operator()(pg8::f32x4 (&acc)[2][2][4][2], const Unit& u, int wr, int wc, int fr, int fq) const {
        asm volatile("" : "+v"(fr), "+v"(fq));
        const int row0 = u.pm * 256 + wr * 64 + fr, col0 = u.pn * 256 + wc * 32 + 8 * fq;
        v2u ga[2][4][2], gb[2][4][2];
#pragma unroll
        for (int ai = 0; ai < 2; ++ai)
#pragma unroll
            for (int m = 0; m < 4; ++m) { const unsigned char* gp = GATES + (size_t)(row0 + ai * 128 + m * 16) * 2048 + col0;
#pragma unroll
                for (int bj = 0; bj < 2; ++bj) { ga[ai][m][bj] = *(const v2u*)(gp + bj * 128); gb[ai][m][bj] = *(const v2u*)(gp + 1024 + bj * 128); } }
        __builtin_amdgcn_sched_barrier(0);
#pragma unroll
        for (int ai = 0; ai < 2; ++ai)
#pragma unroll
            for (int m = 0; m < 4; ++m)
#pragma unroll
                for (int bj = 0; bj < 2; ++bj) { f32x4 a0, a1, b0, b1; u8x8_to_f32(ga[ai][m][bj], a0, a1); u8x8_to_f32(gb[ai][m][bj], b0, b1);
#pragma unroll
                    for (int e2 = 0; e2 < 4; ++e2) { acc[ai][bj][m][0][e2] *= a0[e2] * __builtin_amdgcn_rcpf(fmaxf(b0[e2], 1e-30f)); acc[ai][bj][m][1][e2] *= a1[e2] * __builtin_amdgcn_rcpf(fmaxf(b1[e2], 1e-30f)); } }
        __builtin_amdgcn_sched_barrier(0);
    }
};
struct EpiMerge {
    static constexpr bool PERM = true;
    const unsigned char* GATES; bf16* MERGED;
    __device__ __forceinline__ void operator()(const pg8::f32x4 (&acc)[2][2][4][2], const Unit& u, int wr, int wc, int fr, int fq) const {
        asm volatile("" : "+v"(fr), "+v"(fq));
        const int row0 = u.pm * 256 + wr * 64 + fr, col0 = u.pn * 256 + wc * 32 + 8 * fq;
        v2u gg[2][4][2];
#pragma unroll
        for (int ai = 0; ai < 2; ++ai)
#pragma unroll
            for (int m = 0; m < 4; ++m)
#pragma unroll
                for (int bj = 0; bj < 2; ++bj) gg[ai][m][bj] = *(const v2u*)(GATES + (size_t)(row0 + ai * 128 + m * 16) * 2048 + 1024 + col0 + bj * 128);
        __builtin_amdgcn_sched_barrier(0);
#pragma unroll
        for (int ai = 0; ai < 2; ++ai)
#pragma unroll
            for (int m = 0; m < 4; ++m)
#pragma unroll
                for (int bj = 0; bj < 2; ++bj) { f32x4 g0, g1; u8x8_to_f32(gg[ai][m][bj], g0, g1);
#pragma unroll
                    for (int e2 = 0; e2 < 4; ++e2) { g0[e2] = fmaxf(g0[e2], 1e-30f) * (1.f / 254.f); g1[e2] = fmaxf(g1[e2], 1e-30f) * (1.f / 254.f); }
                    *(v4u*)(MERGED + (size_t)(row0 + ai * 128 + m * 16) * 1024 + col0 + bj * 128) = pack8(acc[ai][bj][m][0] * g0, acc[ai][bj][m][1] * g1); }
    }
};
struct EpiMO {
    static constexpr bool PERM = true;
    bf16* MO;
    __device__ __forceinline__ void operator()(const pg8::f32x4 (&acc)[2][2][4][2], const Unit& u, int wr, int wc, int fr, int fq) const {
        asm volatile("" : "+v"(fr), "+v"(fq));
        const int row0 = u.pm * 256 + wr * 64 + fr, col0 = u.pn * 256 + wc * 32 + 8 * fq;
#pragma unroll
        for (int ai = 0; ai < 2; ++ai)
#pragma unroll
            for (int m = 0; m < 4; ++m) { bf16* rowp = MO + (size_t)(row0 + ai * 128 + m * 16) * 1024 + col0;
#pragma unroll
                for (int bj = 0; bj < 2; ++bj) *(v4u*)(rowp + bj * 128) = pack8(acc[ai][bj][m][0], acc[ai][bj][m][1]); }
    }
};
struct EpiGU {
    static constexpr bool PERM = true;
    const float* bgu; const float* rsof; unsigned char* ACT;
    __device__ __forceinline__ void operator()(const pg8::f32x4 (&acc)[2][2][4][2], const Unit& u, int wr, int wc, int fr, int fq) const {
        { const int l_ = lane_now(); fr = l_ & 15; fq = (l_ >> 4) & 3; }
        float c7 = 7.f, cm7 = -7.f, ck = -1.702f * 1.4426950408889634f; asm volatile("" : "+s"(c7), "+s"(cm7), "+s"(ck));
        const int j0 = u.pn * 128 + wc * 32 + 8 * fq;
        const float* bb = bgu + (size_t)u.e * 2048 + 2 * j0;
        const f32x4 q0 = *(const f32x4*)(bb), q1 = *(const f32x4*)(bb + 4), q2 = *(const f32x4*)(bb + 8), q3 = *(const f32x4*)(bb + 12);
        const f32x4 bg0 = {q0[0], q0[2], q1[0], q1[2]}, bl0 = {q0[1], q0[3], q1[1], q1[3]}, bg1 = {q2[0], q2[2], q3[0], q3[2]}, bl1 = {q2[1], q2[3], q3[1], q3[3]};
        const int rl0 = wr * 64 + fr;
        float rsv[2][4];
#pragma unroll
        for (int ai = 0; ai < 2; ++ai)
#pragma unroll
            for (int m = 0; m < 4; ++m) rsv[ai][m] = rsof[(size_t)u.e * NT + u.rtl * 256 + rl0 + ai * 128 + m * 16];
        __builtin_amdgcn_sched_barrier(0);
#pragma unroll
        for (int ai = 0; ai < 2; ++ai)
#pragma unroll
            for (int m = 0; m < 4; ++m) { const int rl = rl0 + ai * 128 + m * 16; const float rs = rsv[ai][m] * (1.f / WSCALE);
                int wpk[2];
#pragma unroll
                for (int n = 0; n < 2; ++n) { const f32x4 ga = acc[ai][0][m][n], la = acc[ai][1][m][n]; const f32x4 bgv = n ? bg1 : bg0, blv = n ? bl1 : bl0; int w = 0;
#pragma unroll
                    for (int hh = 0; hh < 2; ++hh) { typedef float f2 __attribute__((ext_vector_type(2)));
                        f2 g = (f2){ga[2 * hh], ga[2 * hh + 1]} * rs + (f2){bgv[2 * hh], bgv[2 * hh + 1]}, l = (f2){la[2 * hh], la[2 * hh + 1]} * rs + (f2){blv[2 * hh], blv[2 * hh + 1]};
                        f2 a, b; a.x = fminf(g.x, c7); a.y = fminf(g.y, c7); b.x = __builtin_amdgcn_fmed3f(l.x, cm7, c7); b.y = __builtin_amdgcn_fmed3f(l.y, cm7, c7);
                        const f2 t = a * ck; f2 ex; ex.x = __builtin_amdgcn_exp2f(t.x); ex.y = __builtin_amdgcn_exp2f(t.y);
                        const f2 den = ex + 1.0f; f2 rc; rc.x = __builtin_amdgcn_rcpf(den.x); rc.y = __builtin_amdgcn_rcpf(den.y);
                        const f2 o = (a * rc) * (b + 1.0f);
                        if (hh == 0) w = __builtin_amdgcn_cvt_pk_fp8_f32(o.x, o.y, w, false); else w = __builtin_amdgcn_cvt_pk_fp8_f32(o.x, o.y, w, true); }
                    wpk[n] = w; }
                *(v2u*)(ACT + ((size_t)u.pm * 256 + rl) * 1024 + j0) = (v2u){(unsigned)wpk[0], (unsigned)wpk[1]}; }
    }
};
struct EpiDN {
    static constexpr bool PERM = true;
    const float* bdn; unsigned char* Y;
    __device__ __forceinline__ void operator()(const pg8::f32x4 (&acc)[2][2][4][2], const Unit& u, int wr, int wc, int fr, int fq) const {
        asm volatile("" : "+v"(fr), "+v"(fq));
        const int col0 = u.pn * 256 + wc * 32 + 8 * fq; const float* bb = bdn + (size_t)u.e * 1024 + col0;
        f32x4 bv[2][2];
#pragma unroll
        for (int bj = 0; bj < 2; ++bj) { bv[bj][0] = *(const f32x4*)(bb + bj * 128) * YSCALE; bv[bj][1] = *(const f32x4*)(bb + bj * 128 + 4) * YSCALE; }
        const int rl0 = wr * 64 + fr;
#pragma unroll
        for (int ai = 0; ai < 2; ++ai)
#pragma unroll
            for (int m = 0; m < 4; ++m) { unsigned char* rowp = Y + ((size_t)u.pm * 256 + rl0 + ai * 128 + m * 16) * 1024 + col0;
#pragma unroll
                for (int bj = 0; bj < 2; ++bj) *(v2u*)(rowp + bj * 128) = pack8_fp8(acc[ai][bj][m][0] * (YSCALE / WSCALE) + bv[bj][0], acc[ai][bj][m][1] * (YSCALE / WSCALE) + bv[bj][1]); }
    }
};
struct EpiPJ {
    static constexpr bool PERM = false;
    bf16* PJ;
    __device__ __forceinline__ void operator()(const pg8::f32x4 (&acc)[2][2][4][2], const Unit& u, int wr, int wc, int fr, int fq) const {
        asm volatile("" : "+v"(fr), "+v"(fq));
        const int row0 = u.pm * 256 + wr * 64 + fr, col0 = u.pn * 256 + wc * 32 + 4 * fq;
#pragma unroll
        for (int ai = 0; ai < 2; ++ai)
#pragma unroll
            for (int m = 0; m < 4; ++m) { const size_t off = (size_t)(row0 + ai * 128 + m * 16) * 1024 + col0;
#pragma unroll
                for (int bj = 0; bj < 2; ++bj)
#pragma unroll
                    for (int n = 0; n < 2; ++n) { const f32x4 v = acc[ai][bj][m][n]; v2u w; w.x = cvt_pk_bf16(v[0], v[1]); w.y = cvt_pk_bf16(v[2], v[3]); *(v2u*)(PJ + off + bj * 128 + n * 16) = w; } }
    }
};
struct EpiPG {
    static constexpr bool PERM = true;
    unsigned char* G8; const float* rstd2;
    __device__ __forceinline__ void operator()(const pg8::f32x4 (&acc)[2][2][4][2], const Unit& u, int wr, int wc, int fr, int fq) const {
        { const int l_ = lane_now(); fr = l_ & 15; fq = (l_ >> 4) & 3; }
        float ck = -LOG2E / WSCALE, c254 = 254.f; asm volatile("" : "+s"(ck), "+s"(c254));
        typedef float f2 __attribute__((ext_vector_type(2)));
        const int row0 = u.pm * 256 + wr * 64 + fr, col0 = u.pn * 256 + wc * 32 + 8 * fq;
        float rsv[2][4];
#pragma unroll
        for (int ai = 0; ai < 2; ++ai)
#pragma unroll
            for (int m = 0; m < 4; ++m) rsv[ai][m] = rstd2[row0 + ai * 128 + m * 16];
        __builtin_amdgcn_sched_barrier(0);
#pragma unroll
        for (int ai = 0; ai < 2; ++ai)
#pragma unroll
            for (int m = 0; m < 4; ++m) { const float rs = rsv[ai][m] * ck; unsigned char* rowp = G8 + (size_t)(row0 + ai * 128 + m * 16) * 1024 + col0;
#pragma unroll
                for (int bj = 0; bj < 2; ++bj) { v2u w;
#pragma unroll
                    for (int n = 0; n < 2; ++n) { const f32x4 a = acc[ai][bj][m][n]; unsigned b4 = 0u;
#pragma unroll
                        for (int hh = 0; hh < 2; ++hh) { const f2 t = (f2){a[2 * hh], a[2 * hh + 1]} * rs;
                            f2 ex; ex.x = __builtin_amdgcn_exp2f(t.x); ex.y = __builtin_amdgcn_exp2f(t.y); const f2 den = ex + 1.0f;
                            f2 rc; rc.x = __builtin_amdgcn_rcpf(den.x); rc.y = __builtin_amdgcn_rcpf(den.y); const f2 x = rc * c254 + 0.5f;
                            if (hh == 0) { b4 = __builtin_amdgcn_cvt_pk_u8_f32(x.x, 0, b4); b4 = __builtin_amdgcn_cvt_pk_u8_f32(x.y, 1, b4); }
                            else { b4 = __builtin_amdgcn_cvt_pk_u8_f32(x.x, 2, b4); b4 = __builtin_amdgcn_cvt_pk_u8_f32(x.y, 3, b4); } }
                        if (n == 0) w.x = b4; else w.y = b4; }
                    *(v2u*)(rowp + bj * 128) = w; } }
    }
};

__device__ __forceinline__ int moe_setup(Frame& F) {
    LAS int* cnt = (LAS int*)(F.lds + SCH_CNT); LAS int* P = (LAS int*)(F.lds + SCH_P); LAS int* rt2e = (LAS int*)(F.lds + SCH_RT2E);
    if (F.tid < NE) cnt[F.tid] = (int)__hip_atomic_load(((gu32*)(F.ap->ws + WS_CTL)) + CW_CNT + F.tid, RLX_AGENT);
    __syncthreads();
    if (F.tid == 0) { int s = 0; for (int e = 0; e < NE; ++e) { P[e] = s; s += (cnt[e] + 255) >> 8; } P[NE] = s; }
    __syncthreads();
    const int RT = __builtin_amdgcn_readfirstlane(P[NE]);
    for (int t = F.tid; t < RT && t < MAXRT; t += NWAVES * 64) { int e = 0;
#pragma unroll
        for (int k = 1; k <= NE; ++k) e += (P[k] <= t) ? 1 : 0;
        rt2e[t] = e; }
    __syncthreads();
    return RT < MAXRT ? RT : MAXRT;
}
struct MoeOrder {
    pg8::DenseOrder d; LAS const int* P; LAS const int* rt2e; LAS const unsigned* tab;
    const char* Abase; size_t tsA; const char* Bbase; size_t estride, tsB; bool gather;
    __device__ __forceinline__ bool next(int i, Unit& u) const {
        if (!d.tile(i, u.pm, u.pn)) return false;
        const int e = __builtin_amdgcn_readfirstlane(rt2e[u.pm]); u.e = e; u.rtl = u.pm - __builtin_amdgcn_readfirstlane(P[e]);
        u.A = gather ? Abase : Abase + (size_t)u.pm * tsA; u.B = Bbase + (size_t)e * estride + (size_t)u.pn * tsB; return true;
    }
    __device__ __forceinline__ const LAS unsigned char* table(int ui) const { return (const LAS unsigned char*)tab + ui * 1024; }
};

__device__ __forceinline__ void router_pass(Frame& F) {
    LAS float* L = (LAS float*)(F.lds + RING_OFF + F.wave * 2304);
    LAS int* hist = (LAS int*)(F.lds + RING_OFF + 32768); LAS int* hbase = hist + 32;
    if (F.tid < 64) hist[F.tid] = 0;
    __syncthreads();
    const float* X = (F.ap->in[0]); const bf16* MO = WSP(bf16, WS_MO); bf16* MOw = WSP(bf16, WS_MO); unsigned char* HB = WSP(unsigned char, WS_HB); const bf16* wrt = WSP(bf16, WS_WRT);
    const int lane = F.lane, r = lane & 15, q = lane >> 4, tok0 = (int)blockIdx.x * 128 + F.wave * 16, token = tok0 + r;
    pg8::f32x4 acc0 = {0.f, 0.f, 0.f, 0.f}, acc1 = {0.f, 0.f, 0.f, 0.f}; float ss = 0.f;
    const float* hrow = X + (size_t)token * DM + q * 8; const bf16* morow = MO + (size_t)token * DM + q * 8; const bf16* b0p = wrt + (size_t)r * 1024 + q * 8;
    f32x4 xa[2][2][2], ga[2][2][2]; v4u ma[2][2], wa[2][2][4];
#define RT_LOAD(buf, grp) do { _Pragma("unroll") for (int s_ = 0; s_ < 2; ++s_) { const int kk_ = (grp) * 2 + s_; \
        xa[buf][s_][0] = *(const f32x4*)(hrow + kk_ * 32); xa[buf][s_][1] = *(const f32x4*)(hrow + kk_ * 32 + 4); ma[buf][s_] = *(const v4u*)(morow + kk_ * 32); \
        ga[buf][s_][0] = *(const f32x4*)((F.ap->in[9]) + kk_ * 32 + q * 8); ga[buf][s_][1] = *(const f32x4*)((F.ap->in[9]) + kk_ * 32 + q * 8 + 4); \
        wa[buf][s_][0] = *(const v4u*)(b0p + kk_ * 32); wa[buf][s_][1] = *(const v4u*)(b0p + 16 * 1024 + kk_ * 32); wa[buf][s_][2] = *(const v4u*)(b0p + 32768 + kk_ * 32); wa[buf][s_][3] = *(const v4u*)(b0p + 32768 + 16 * 1024 + kk_ * 32); } } while (0)
#define RT_STEP(buf, grp) do { _Pragma("unroll") for (int s_ = 0; s_ < 2; ++s_) { const int kk_ = (grp) * 2 + s_; \
        f32x4 h0 = xa[buf][s_][0], h1 = xa[buf][s_][1]; { f32x4 m0, m1; unpack8(ma[buf][s_], m0, m1); h0 = h0 + m0; h1 = h1 + m1; } \
        ss += (h0[0] * h0[0] + h0[1] * h0[1]) + (h0[2] * h0[2] + h0[3] * h0[3]) + (h1[0] * h1[0] + h1[1] * h1[1]) + (h1[2] * h1[2] + h1[3] * h1[3]); \
        const f32x4 x0 = h0 * ga[buf][s_][0], x1 = h1 * ga[buf][s_][1]; \
        const v4u hi = pack8(x0, x1); f32x4 y0, y1; unpack8(hi, y0, y1); const v4u lo = pack8(x0 - y0, x1 - y1); \
        *(v2u*)(HB + (size_t)token * DM + kk_ * 32 + q * 8) = pack8_fp8(x0, x1); *(v4u*)(MOw + (size_t)token * DM + q * 8 + kk_ * 32) = pack8(h0, h1);     \
        const bf16x8 ah = __builtin_bit_cast(bf16x8, hi), al = __builtin_bit_cast(bf16x8, lo); \
        acc0 = __builtin_amdgcn_mfma_f32_16x16x32_bf16(ah, __builtin_bit_cast(bf16x8, wa[buf][s_][0]), acc0, 0, 0, 0); acc0 = __builtin_amdgcn_mfma_f32_16x16x32_bf16(al, __builtin_bit_cast(bf16x8, wa[buf][s_][0]), acc0, 0, 0, 0); \
        acc0 = __builtin_amdgcn_mfma_f32_16x16x32_bf16(ah, __builtin_bit_cast(bf16x8, wa[buf][s_][2]), acc0, 0, 0, 0); \
        acc1 = __builtin_amdgcn_mfma_f32_16x16x32_bf16(ah, __builtin_bit_cast(bf16x8, wa[buf][s_][1]), acc1, 0, 0, 0); acc1 = __builtin_amdgcn_mfma_f32_16x16x32_bf16(al, __builtin_bit_cast(bf16x8, wa[buf][s_][1]), acc1, 0, 0, 0); \
        acc1 = __builtin_amdgcn_mfma_f32_16x16x32_bf16(ah, __builtin_bit_cast(bf16x8, wa[buf][s_][3]), acc1, 0, 0, 0); } } while (0)
    RT_LOAD(0, 0);
#pragma unroll
    for (int gp = 0; gp < 16; gp += 2) {
        RT_LOAD(1, gp + 1); __builtin_amdgcn_sched_barrier(0); RT_STEP(0, gp); __builtin_amdgcn_sched_barrier(0);
        if (gp + 2 < 16) RT_LOAD(0, gp + 2);
        __builtin_amdgcn_sched_barrier(0); RT_STEP(1, gp + 1); __builtin_amdgcn_sched_barrier(0);
    }
#undef RT_LOAD
#undef RT_STEP
    ss = xor16_sum(ss); ss = xor32_sum(ss);
    const float rstd = 1.f / sqrtf(ss * (1.f / DM) + EPS);
#pragma unroll
    for (int i = 0; i < 4; ++i) { L[(4 * q + i) * 33 + r] = acc0[i]; L[(4 * q + i) * 33 + 16 + r] = acc1[i]; }
    LDS_WAIT(); asm volatile("" ::: "memory");
    int te0 = 0, te1 = 0, te2 = 0, te3 = 0, rk0 = 0, rk1 = 0, rk2 = 0, rk3 = 0; float w0 = 0.f, w1 = 0.f, w2 = 0.f, w3 = 0.f;
    if (lane < 16) {
        float v[32];
#pragma unroll
        for (int e = 0; e < 32; ++e) v[e] = L[lane * 33 + e] * rstd + (F.ap->in[11])[e];
        float tv[4]; int te[4];
#pragma unroll
        for (int k = 0; k < 4; ++k) { float best = v[0]; int bi = 0;
#pragma unroll
            for (int e = 1; e < 32; ++e) if (v[e] > best) { best = v[e]; bi = e; }
            tv[k] = best; te[k] = bi;
#pragma unroll
            for (int e = 0; e < 32; ++e) v[e] = (e == bi) ? -INFINITY : v[e]; }
        const float e1 = expf(tv[1] - tv[0]), e2 = expf(tv[2] - tv[0]), e3 = expf(tv[3] - tv[0]), inv = 1.f / (1.f + e1 + e2 + e3);
        w0 = inv; w1 = e1 * inv; w2 = e2 * inv; w3 = e3 * inv; te0 = te[0]; te1 = te[1]; te2 = te[2]; te3 = te[3];
        rk0 = __hip_atomic_fetch_add(hist + te0, 1, __ATOMIC_RELAXED, __HIP_MEMORY_SCOPE_WORKGROUP); rk1 = __hip_atomic_fetch_add(hist + te1, 1, __ATOMIC_RELAXED, __HIP_MEMORY_SCOPE_WORKGROUP);
        rk2 = __hip_atomic_fetch_add(hist + te2, 1, __ATOMIC_RELAXED, __HIP_MEMORY_SCOPE_WORKGROUP); rk3 = __hip_atomic_fetch_add(hist + te3, 1, __ATOMIC_RELAXED, __HIP_MEMORY_SCOPE_WORKGROUP);
    }
    __syncthreads();
    if (F.tid < NE) hbase[F.tid] = (int)__hip_atomic_fetch_add(((gu32*)(F.ap->ws + WS_CTL)) + CW_CNT + F.tid, (unsigned)hist[F.tid], RLX_AGENT);
    __syncthreads();
    if (lane < 16) {
        int* TOK = WSP(int, WS_TOK); float* RSOF = WSP(float, WS_RSOF); int* TOPE = WSP(int, WS_TOPE); float* TOPW = WSP(float, WS_TOPW); int* POS = WSP(int, WS_POS);
        const int p0 = hbase[te0] + rk0, p1 = hbase[te1] + rk1, p2 = hbase[te2] + rk2, p3 = hbase[te3] + rk3;
        TOK[(size_t)te0 * NT + p0] = token; TOK[(size_t)te1 * NT + p1] = token; TOK[(size_t)te2 * NT + p2] = token; TOK[(size_t)te3 * NT + p3] = token;
        RSOF[(size_t)te0 * NT + p0] = rstd; RSOF[(size_t)te1 * NT + p1] = rstd; RSOF[(size_t)te2 * NT + p2] = rstd; RSOF[(size_t)te3 * NT + p3] = rstd;
        *(int4*)(TOPE + (size_t)token * 4) = make_int4(te0, te1, te2, te3); *(float4*)(TOPW + (size_t)token * 4) = make_float4(w0, w1, w2, w3); *(int4*)(POS + (size_t)token * 4) = make_int4(p0, p1, p2, p3);
    }
    __syncthreads();
}
__device__ __forceinline__ void combine_pass(Frame& F) {
    LAS const int* P = (LAS const int*)(F.lds + SCH_P);
    const unsigned char* Y = WSP(unsigned char, WS_Y); const bf16* MO = WSP(bf16, WS_MO); unsigned char* HB2 = WSP(unsigned char, WS_HB2); float* RSTD2 = WSP(float, WS_RSTD2); bf16* H2B = WSP(bf16, WS_H2B);
    const int* TOPE = WSP(int, WS_TOPE); const float* TOPW = WSP(float, WS_TOPW); const int* POS = WSP(int, WS_POS);
    const int lane = F.lane, tok0 = (int)blockIdx.x * 128 + F.wave * 16;
    int4 te_n[2], tp_n[2]; float4 tw_n[2], tw_c[2]; v4u mc[2][2], mn[2][2]; v2u yc[2][4][2], yn[2][4][2];
#define CB_ROUTE(i) do { _Pragma("unroll") for (int t_ = 0; t_ < 2; ++t_) { te_n[t_] = *(const int4*)(TOPE + (size_t)(tok0 + (i) + t_) * 4); tw_n[t_] = *(const float4*)(TOPW + (size_t)(tok0 + (i) + t_) * 4); tp_n[t_] = *(const int4*)(POS + (size_t)(tok0 + (i) + t_) * 4); } } while (0)
#define CB_DATA(dm, dy, i) do { _Pragma("unroll") for (int t_ = 0; t_ < 2; ++t_) { \
        const size_t s0_ = (size_t)(P[te_n[t_].x] * 256 + tp_n[t_].x) * DM, s1_ = (size_t)(P[te_n[t_].y] * 256 + tp_n[t_].y) * DM, s2_ = (size_t)(P[te_n[t_].z] * 256 + tp_n[t_].z) * DM, s3_ = (size_t)(P[te_n[t_].w] * 256 + tp_n[t_].w) * DM; \
        _Pragma("unroll") for (int j = 0; j < 2; ++j) { const int c = 8 * lane + 512 * j; dm[t_][j] = *(const v4u*)(MO + (size_t)(tok0 + (i) + t_) * DM + c); \
            dy[t_][0][j] = *(const v2u*)(Y + s0_ + c); dy[t_][1][j] = *(const v2u*)(Y + s1_ + c); dy[t_][2][j] = *(const v2u*)(Y + s2_ + c); dy[t_][3][j] = *(const v2u*)(Y + s3_ + c); } } } while (0)
    CB_ROUTE(0); CB_DATA(mc, yc, 0); tw_c[0] = tw_n[0]; tw_c[1] = tw_n[1]; CB_ROUTE(2);
    for (int i = 0; i < 16; i += 2) {
        const float4 tw_x0 = tw_n[0], tw_x1 = tw_n[1];
        if (i + 2 < 16) CB_DATA(mn, yn, i + 2);
        if (i + 4 < 16) CB_ROUTE(i + 4);
        __builtin_amdgcn_sched_barrier(0);
#pragma unroll
        for (int t = 0; t < 2; ++t) { const int token = tok0 + i + t; f32x4 v[2][2]; float ss = 0.f; const float4 tw = tw_c[t] * (1.f / YSCALE);
#pragma unroll
            for (int j = 0; j < 2; ++j) { f32x4 a, b; unpack8(mc[t][j], a, b);
#pragma unroll
                for (int k = 0; k < 4; ++k) { const v2u y = yc[t][k][j]; const float w = k == 0 ? tw.x : k == 1 ? tw.y : k == 2 ? tw.z : tw.w;
                    const auto p0 = __builtin_amdgcn_cvt_pk_f32_fp8((int)y.x, false), p1 = __builtin_amdgcn_cvt_pk_f32_fp8((int)y.x, true), p2 = __builtin_amdgcn_cvt_pk_f32_fp8((int)y.y, false), p3 = __builtin_amdgcn_cvt_pk_f32_fp8((int)y.y, true);
                    a += w * (f32x4){p0[0], p0[1], p1[0], p1[1]}; b += w * (f32x4){p2[0], p2[1], p3[0], p3[1]}; }
                v[j][0] = a; v[j][1] = b;
                ss += ((a.x * a.x + a.y * a.y) + (a.z * a.z + a.w * a.w)) + ((b.x * b.x + b.y * b.y) + (b.z * b.z + b.w * b.w)); }
            const float rstd = 1.f / sqrtf(wave_sum(ss) * (1.f / DM) + EPS);
#pragma unroll
            for (int j = 0; j < 2; ++j) { const int c = 8 * lane + 512 * j; *(v4u*)(H2B + (size_t)token * DM + c) = pack8(v[j][0], v[j][1]);
                const f32x4 g0 = *(const f32x4*)((F.ap->in[16]) + c), g1 = *(const f32x4*)((F.ap->in[16]) + c + 4);
                *(v2u*)(HB2 + (size_t)token * DM + c) = pack8_fp8(v[j][0] * g0, v[j][1] * g1); }
            if (lane == 0) RSTD2[token] = rstd; }
        __builtin_amdgcn_sched_barrier(0);
#pragma unroll
        for (int t = 0; t < 2; ++t)
#pragma unroll
            for (int j = 0; j < 2; ++j) { mc[t][j] = mn[t][j];
#pragma unroll
                for (int k = 0; k < 4; ++k) yc[t][k][j] = yn[t][k][j]; }
        tw_c[0] = tw_x0; tw_c[1] = tw_x1;
    }
#undef CB_ROUTE
#undef CB_DATA
}
__device__ __forceinline__ void final_pass(Frame& F) {
    const bf16* PJ = WSP(bf16, WS_PJ); const bf16* H2B = WSP(bf16, WS_H2B); const unsigned char* G8 = WSP(unsigned char, WS_G8); const int lane = F.lane, tok0 = (int)blockIdx.x * 128 + F.wave * 16;
    v4u hc[2][2], hn[2][2], pc[2][2], pn[2][2]; v2u gc[2][2], gn[2][2];
#define FP_LOAD(hd, pd, gd, i) do { _Pragma("unroll") for (int t_ = 0; t_ < 2; ++t_) _Pragma("unroll") for (int j = 0; j < 2; ++j) { const size_t o_ = (size_t)(tok0 + (i) + t_) * DM + 8 * lane + 512 * j; \
        hd[t_][j] = *(const v4u*)(H2B + o_); pd[t_][j] = *(const v4u*)(PJ + o_); gd[t_][j] = *(const v2u*)(G8 + o_); } } while (0)
    FP_LOAD(hc, pc, gc, 0);
    for (int i = 0; i < 16; i += 2) {
        if (i + 2 < 16) FP_LOAD(hn, pn, gn, i + 2);
        __builtin_amdgcn_sched_barrier(0);
#pragma unroll
        for (int t = 0; t < 2; ++t) { f32x4 v[2][2]; float ss = 0.f;
#pragma unroll
            for (int j = 0; j < 2; ++j) { f32x4 a, b, pa, pb; unpack8(hc[t][j], a, b); unpack8(pc[t][j], pa, pb); const unsigned g0 = gc[t][j].x, g1 = gc[t][j].y;
                const f32x4 ga = {(float)(g0 & 255u), (float)((g0 >> 8) & 255u), (float)((g0 >> 16) & 255u), (float)(g0 >> 24)}, gb = {(float)(g1 & 255u), (float)((g1 >> 8) & 255u), (float)((g1 >> 16) & 255u), (float)(g1 >> 24)};
                a += (ga * (1.f / 254.f)) * pa; b += (gb * (1.f / 254.f)) * pb; v[j][0] = a; v[j][1] = b;
                ss += ((a.x * a.x + a.y * a.y) + (a.z * a.z + a.w * a.w)) + ((b.x * b.x + b.y * b.y) + (b.z * b.z + b.w * b.w)); }
            const float rstd = 1.f / sqrtf(wave_sum(ss) * (1.f / DM) + EPS); float* hr = (F.ap->out) + (size_t)(tok0 + i + t) * DM;
#pragma unroll
            for (int j = 0; j < 2; ++j) { const int c = 8 * lane + 512 * j; const f32x4 g0 = *(const f32x4*)((F.ap->in[19]) + c), g1 = *(const f32x4*)((F.ap->in[19]) + c + 4);
                *(f32x4*)(hr + c) = v[j][0] * rstd * g0; *(f32x4*)(hr + c + 4) = v[j][1] * rstd * g1; } }
        __builtin_amdgcn_sched_barrier(0);
#pragma unroll
        for (int t = 0; t < 2; ++t)
#pragma unroll
            for (int j = 0; j < 2; ++j) { hc[t][j] = hn[t][j]; pc[t][j] = pn[t][j]; gc[t][j] = gn[t][j]; }
    }
#undef FP_LOAD
}

struct PnOffOrder { pg8::DenseOrder d; int off;
    __device__ __forceinline__ bool next(int i, pg8::Unit& u) const { if (!d.next(i, u)) return false; u.pn += off; return true; }
    __device__ __forceinline__ const LAS unsigned char* table(int) const { return nullptr; } };
struct StrideOrder { int start, stride, n; const char* A; const char* B; size_t tsA, tsB;
    __device__ __forceinline__ bool next(int i, pg8::Unit& u) const { const int idx = start + i * stride; if (idx >= n) return false; u.pm = idx >> 2; u.pn = idx & 3; u.A = A + (size_t)u.pm * tsA; u.B = B + (size_t)u.pn * tsB; u.e = 0; u.rtl = 0; return true; }
    __device__ __forceinline__ const LAS unsigned char* table(int) const { return nullptr; } };
constexpr int N_PHASES = 11;

__global__ void __launch_bounds__(NWAVES * 64, 2) fwd(Args args) {
    extern __shared__ __attribute__((aligned(16))) unsigned char lds[];
    Frame F;
    F.lds = (LAS unsigned char*)lds;
    F.MISC = (volatile LAS unsigned*)(F.lds + MISC_OFF);
    F.tid = threadIdx.x; F.lane = F.tid & 63; F.wave = __builtin_amdgcn_readfirstlane(F.tid >> 6);
    F.G = gridDim.x; { const int bx = blockIdx.x; F.vcu = (F.G % 8 == 0) ? (bx % 8) * (F.G / 8) + bx / 8 : bx; }
    REARGS();
    for (int u = F.tid; u < 64; u += NWAVES * 64) ((LAS unsigned*)(F.lds + MISC_OFF))[u] = 0u;
    __syncthreads();
    const bool one = (F.ap->ph_hi - F.ap->ph_lo) > 1;
    XcdBarrier bar; bar.bar = (unsigned*)(((gu32*)(F.ap->ws + WS_CTL)) + CW_BAR); bar.x = 0; bar.st = nullptr;
    if (one) bar = xcd_barrier_post((unsigned*)(((gu32*)(F.ap->ws + WS_CTL)) + CW_BAR), F.MISC + 8, F.tid);
#ifdef ONLY_PHASE
    constexpr int lo = ONLY_PHASE, hi = ONLY_PHASE + 1;
#else
    const int lo = F.ap->ph_lo, hi = F.ap->ph_hi;
#endif
    int cid = (int)blockIdx.x;
#define IN(k) (lo <= (k) && (k) < hi)
#define RELANE() do { int l_ = lane_now(); asm volatile("" : "+v"(l_)); F.lane = l_; F.tid = F.wave * 64 + l_; REARGS(); asm volatile("" : "+s"(cid)); } while (0)
#define GBAR() do { RELANE(); xcd_barrier(bar, F.tid); } while (0)
#define SEAM(k) do { if (IN(k) && IN((k) + 1)) GBAR(); } while (0)
    const int rep_phase = F.ap->rep_phase, rep_mode = F.ap->rep_mode;
#define NREP(k) (((k) == rep_phase) ? 2 : 1)
    LAS unsigned char* ring = F.lds + RING_OFF;

    for (int rep = 0; rep < NREP(0); ++rep) { if (rep) GBAR(); if (IN(0)) { RELANE(); p0_prologue(F); } } SEAM(0);
    for (int rep = 0; rep < NREP(1); ++rep) { if (rep) GBAR(); if (IN(1)) { RELANE();
        if (cid < NBATCH * 8) cum_scan(F, cid);
        { pg8::Gemm g{1024, 1024, 1024}; PnOffOrder S; S.off = 4; S.d.init(NT / 256, 8, F.G, cid, WSP(bf16, WS_XN), (size_t)256 * 1024 * 2, WSP(bf16, WS_W1T), (size_t)256 * 1024 * 2);
          EpiIn E{WSP(bf16, WS_FQ), WSP(bf16, WS_FK), WSP(bf16, WS_FV), WSP(bf16, WS_RQ), WSP(bf16, WS_RK), WSP(bf16, WS_RV), WSP(bf16, WS_RGS), WSP(float, WS_ROT), WSP(bf16, WS_RKT), F.lds + TAB_OFF, (rep == 1 && rep_mode >= 7) ? (rep_mode == 7 ? 1 : rep_mode - 64) : 0};
          pg8::gemm_phase<EpiIn, PnOffOrder, true, false>(ring, g, S, E, F.wave); }
        { RELANE();
          pg8::Gemm g{1024, 1024, 1024}; pg8::DenseOrder S; S.init(NT / 256, 12, F.G, cid, WSP(unsigned char, WS_XN8), (size_t)256 * 1024, WSP(unsigned char, WS_WG8T), (size_t)256 * 1024);
          EpiGate E{WSP(unsigned char, WS_GATES), (F.ap->in[7]), WSP(bf16, WS_FQ), WSP(bf16, WS_FK), (rep == 1 && rep_mode >= 7) ? (rep_mode == 7 ? 1 : rep_mode - 64) : 0};
          pg8::gemm_phase<EpiGate, pg8::DenseOrder, true, false, 1>(ring, g, S, E, F.wave); }
    } } SEAM(1);
    for (int rep = 0; rep < NREP(2); ++rep) { if (rep) GBAR(); if (IN(2)) { RELANE();
        { static_assert(ret_body::LDS_BYTES <= RING_BYTES && attn_body::ATTN_LDS_BYTES <= RING_BYTES, "phase scratch inside the ring");
          volatile LAS int* qn = (volatile LAS int*)(F.MISC + 16);
          const attn_body::bf16* Q = (const attn_body::bf16*)WSP(bf16, WS_FQ); const attn_body::bf16* K = (const attn_body::bf16*)WSP(bf16, WS_FK); const attn_body::bf16* V = (const attn_body::bf16*)WSP(bf16, WS_FV);
          attn_body::bf16* O = (attn_body::bf16*)WSP(bf16, WS_BR);
          if (lane_now() + F.wave * 64 == 0) qn[0] = (int)__hip_atomic_fetch_add(((gu32*)(F.ap->ws + WS_CTL)) + CW_QUEUE + 64 * rep, 1u, RLX_AGENT);
          __syncthreads();
          for (int n = 0;; ++n) {
              const int item = __builtin_amdgcn_readfirstlane(qn[n & 1]);
              if (item >= 64 + 1024 + CONV_CHUNKS) break;
              int nxt_item = 0;
              if (lane_now() + F.wave * 64 == 0) nxt_item = (int)__hip_atomic_fetch_add(((gu32*)(F.ap->ws + WS_CTL)) + CW_QUEUE + 64 * rep, 1u, RLX_AGENT);
              if (item < 64) { const int bh4 = item;
                  ret_body::ret_unit(ring, bh4 >> 2, bh4 & 3, WSP(bf16, WS_RQ), WSP(bf16, WS_RK), WSP(bf16, WS_RV), WSP(bf16, WS_RKT), WSP(bf16, WS_RGS), WSP(bf16, WS_BR), F.wave, 0, 16, 0); }
              else { const int r = item - 64, cb = (int)(((long)r * CONV_CHUNKS) / (1024 + CONV_CHUNKS)), cn = (int)(((long)(r + 1) * CONV_CHUNKS) / (1024 + CONV_CHUNKS));
                  if (cn > cb) { RELANE(); conv_chunk(F, cb); }
                  else { const int k = r - cb, qb = 7 - (k >> 7), bh = k & 127;
                      attn_body::attn_unit<8>(bh >> 3, bh & 7, qb, Q, K, V, O, WSP(float, WS_CUM) + (size_t)bh * SEQ, (char*)lds + RING_OFF, F.wave); } }
              if (lane_now() + F.wave * 64 == 0) qn[(n + 1) & 1] = nxt_item;
              __syncthreads();
          } }
    } } SEAM(2);
    for (int rep = 0; rep < NREP(3); ++rep) { if (rep) GBAR(); if (IN(3)) { RELANE();
        pg8::Gemm g{1024, 1024, 1024}; pg8::DenseOrder S; S.init(NT / 256, 4, F.G, cid, WSP(bf16, WS_BR), (size_t)256 * 1024 * 2, WSP(bf16, WS_WBT), (size_t)256 * 1024 * 2);
        EpiMerge E{WSP(unsigned char, WS_GATES), WSP(bf16, WS_MERGED)}; HookMerge H{WSP(unsigned char, WS_GATES)};
        pg8::gemm_phase<EpiMerge, pg8::DenseOrder, true, false, 2, HookMerge>(ring, g, S, E, F.wave, H);
    } } SEAM(3);
    for (int rep = 0; rep < NREP(4); ++rep) { if (rep) GBAR(); if (IN(4)) { RELANE();
        pg8::Gemm g{1024, 1024, 1024}; pg8::DenseOrder S; S.init(NT / 256, 4, F.G, cid, WSP(bf16, WS_MERGED), (size_t)256 * 1024 * 2, WSP(bf16, WS_WOT), (size_t)256 * 1024 * 2);
        EpiMO E{WSP(bf16, WS_MO)}; pg8::gemm_phase<EpiMO, pg8::DenseOrder, true, false>(ring, g, S, E, F.wave);
    } } SEAM(4);
    for (int rep = 0; rep < NREP(5); ++rep) { if (rep) GBAR(); if (IN(5)) { RELANE(); router_pass(F); } } SEAM(5);
    for (int rep = 0; rep < NREP(6); ++rep) { if (rep) GBAR(); if (IN(6)) { RELANE();
        const int RT = moe_setup(F);
        MoeOrder S; S.d.init(RT, 8, F.G, cid, nullptr, 0, nullptr, 0); S.P = (LAS const int*)(F.lds + SCH_P); S.rt2e = (LAS const int*)(F.lds + SCH_RT2E); S.tab = (LAS const unsigned*)(F.lds + TAB_OFF);
        S.Abase = (const char*)WSP(unsigned char, WS_HB); S.tsA = 0; S.Bbase = (const char*)WSP(unsigned char, WS_WGUT); S.estride = (size_t)2048 * 1024; S.tsB = (size_t)256 * 1024; S.gather = true;
        { LAS const int* cnt = (LAS const int*)(F.lds + SCH_CNT); LAS unsigned* tab = (LAS unsigned*)(F.lds + TAB_OFF); const int* TOK = WSP(int, WS_TOK);
          int tokv[MAXUNITS / 2];
#pragma unroll
          for (int j = 0; j < MAXUNITS / 2; ++j) { const int ui = 2 * j + (F.tid >> 8), r = F.tid & 255; int pm, pn; tokv[j] = -1;
              if (S.d.tile(ui, pm, pn)) { const int e = S.rt2e[pm], pos = (pm - S.P[e]) * 256 + r; tokv[j] = pos < cnt[e] ? TOK[(size_t)e * NT + pos] : NT; } }
#pragma unroll
          for (int j = 0; j < MAXUNITS / 2; ++j) { const int ui = 2 * j + (F.tid >> 8), r = F.tid & 255; if (tokv[j] >= 0) tab[ui * 256 + r] = (unsigned)tokv[j] * 1024u; }
          __syncthreads(); }
        pg8::Gemm g{1024, 1024, 1024};
        EpiGU E{(F.ap->in[13]), WSP(float, WS_RSOF), WSP(unsigned char, WS_ACT)}; pg8::gemm_phase<EpiGU, MoeOrder, true, true, 1>(ring, g, S, E, F.wave);
    } } SEAM(6);
    for (int rep = 0; rep < NREP(7); ++rep) { if (rep) GBAR(); if (IN(7)) { RELANE();
        const int RT = moe_setup(F);
        MoeOrder S; S.d.init(RT, 4, F.G, cid, nullptr, 0, nullptr, 0); S.P = (LAS const int*)(F.lds + SCH_P); S.rt2e = (LAS const int*)(F.lds + SCH_RT2E); S.tab = (LAS const unsigned*)(F.lds + TAB_OFF);
        S.Abase = (const char*)WSP(unsigned char, WS_ACT); S.tsA = (size_t)256 * 1024; S.Bbase = (const char*)WSP(unsigned char, WS_WDT); S.estride = (size_t)1024 * 1024; S.tsB = (size_t)256 * 1024; S.gather = false;
        pg8::Gemm g{1024, 1024, 1024};
        EpiDN E{(F.ap->in[15]), WSP(unsigned char, WS_Y)}; pg8::gemm_phase<EpiDN, MoeOrder, true, false, 1>(ring, g, S, E, F.wave);
        { const int rem = (RT * 4) % F.G, nidle = F.G - rem; const bool tail = 2 * nidle >= F.G;
          if (!tail || cid >= rem) { RELANE(); pg8::Gemm g2{256, 256, 256}; StrideOrder S2; S2.start = tail ? cid - rem : cid; S2.stride = tail ? nidle : F.G; S2.n = (NT / 256) * 4; S2.A = (const char*)WSP(bf16, WS_PB); S2.tsA = (size_t)256 * 256 * 2; S2.B = (const char*)WSP(bf16, WS_WPPT); S2.tsB = (size_t)256 * 256 * 2;
              EpiPJ E2{WSP(bf16, WS_PJ)}; pg8::gemm_phase<EpiPJ, StrideOrder, true, false>(ring, g2, S2, E2, F.wave); } }
    } } SEAM(7);
    for (int rep = 0; rep < NREP(8); ++rep) { if (rep) GBAR(); if (IN(8)) { RELANE(); (void)moe_setup(F); combine_pass(F); } } SEAM(8);
    for (int rep = 0; rep < NREP(9); ++rep) { if (rep) GBAR(); if (IN(9)) { RELANE();
        { pg8::Gemm g{1024, 1024, 1024}; pg8::DenseOrder S; S.init(NT / 256, 4, F.G, cid, WSP(unsigned char, WS_HB2), (size_t)256 * 1024, WSP(unsigned char, WS_WPGT), (size_t)256 * 1024);
          EpiPG E{WSP(unsigned char, WS_G8), WSP(float, WS_RSTD2)}; pg8::gemm_phase<EpiPG, pg8::DenseOrder, true, false, 1>(ring, g, S, E, F.wave); }
    } } SEAM(9);
    if (IN(10)) { RELANE(); final_pass(F); }
#undef IN
#undef SEAM
}

extern "C" void kernel_launch(void* const* d_in, const int* in_sizes, int n_in, void* d_out, int out_size, void* d_ws, size_t ws_size, hipStream_t stream) {
    static int grid = 0;
    if (grid == 0) {
        if (n_in != 20 || in_sizes[0] != NT * DM || out_size != NT * DM || ws_size < WS_END) { fprintf(stderr, "kernel_launch: unexpected shapes / workspace (%zu < %zu); nothing launched\n", ws_size, (size_t)WS_END); grid = -1; return; }
        int dev = 0, cus = 0, per_cu = 0;
        if (hipGetDevice(&dev) != hipSuccess || hipDeviceGetAttribute(&cus, hipDeviceAttributeMultiprocessorCount, dev) != hipSuccess) { grid = -1; return; }
        if (hipFuncSetAttribute((const void*)fwd, hipFuncAttributeMaxDynamicSharedMemorySize, LDS_BYTES) != hipSuccess) { fprintf(stderr, "kernel_launch: hipFuncSetAttribute failed\n"); grid = -1; return; }
        if (hipOccupancyMaxActiveBlocksPerMultiprocessor(&per_cu, (const void*)fwd, NWAVES * 64, LDS_BYTES) != hipSuccess || per_cu < 1) { fprintf(stderr, "kernel_launch: occupancy query reports %d workgroups per CU\n", per_cu); }
        (void)hipGetLastError();
        grid = cus;
        if (grid != 256) { fprintf(stderr, "kernel_launch: built for 256 CUs, found %d; nothing launched\n", cus); grid = -1; return; }
    }
    if (grid < 0) return;
    if (hipMemsetAsync((char*)d_ws + WS_CTL, 0, CTL_ZERO_BYTES, stream) != hipSuccess) return;
    Args a; memset(&a, 0, sizeof a);
    for (int i = 0; i < 20; ++i) a.in[i] = (const float*)d_in[i];
    a.out = (float*)d_out; a.ws = (unsigned char*)d_ws;
#ifndef MK_SPLIT
    a.ph_lo = 0; a.ph_hi = N_PHASES;
#ifdef PROBE_PHASE
    a.rep_phase = PROBE_PHASE; a.rep_mode = PROBE_MODE;
#else
    a.rep_phase = -1; a.rep_mode = 0;
#endif
    hipLaunchKernelGGL(fwd, dim3(grid), dim3(NWAVES * 64), LDS_BYTES, stream, a);
#else
    for (int ph = 0; ph < N_PHASES; ++ph) { a.ph_lo = ph; a.ph_hi = ph + 1; hipLaunchKernelGGL(fwd, dim3(grid), dim3(NWAVES * 64), LDS_BYTES, stream, a); }
#endif
}
```

```cpp
#include <hip/hip_runtime.h>
#include <cstdio>
#include <cstdint>
#include <cstring>
#include <cmath>
__device__ __forceinline__ int lane_now() { int l; asm volatile("v_mbcnt_lo_u32_b32 %0, -1, 0\n\tv_mbcnt_hi_u32_b32 %0, -1, %0" : "=v"(l)); return l; }
namespace pg8 {
#define PG8_LAS __attribute__((address_space(3)))
typedef unsigned short bf16_t;
typedef short bf16x8 __attribute__((ext_vector_type(8)));
typedef float f32x4 __attribute__((ext_vector_type(4)));
typedef float f32x2 __attribute__((ext_vector_type(2)));
typedef unsigned u32x4 __attribute__((ext_vector_type(4)));
typedef unsigned u32x2 __attribute__((ext_vector_type(2)));
constexpr int BM = 256, BK = 64, HALF = 128, HTB = HALF * BK * 2  , STAGE_BYTES = 8 * HTB, NXCD = 8, WGM = 8;

__host__ __device__ __forceinline__ int lds_byte(int r, int c) { const int st = (r >> 4) * 2 + (c >> 5), rr = r & 15, cc = c & 31, ob = rr * 64 + cc * 2; return st * 1024 + (ob ^ (((ob >> 9) & 1) << 5)); }
__host__ __device__ __forceinline__ void stage_rc(int b, int& R, int& C) { const int st = b / 1024, sb = b % 1024, swz = sb ^ (((sb >> 9) & 1) << 5); R = (st >> 1) * 16 + swz / 64; C = (st & 1) * 32 + (swz % 64) / 2; }
__host__ __device__ __forceinline__ int perm32(int rho) { const int n = rho >> 4, i = rho & 15; return 8 * (i >> 2) + 4 * n + (i & 3); }

struct Unit { int pm, pn; const char* A; const char* B; int e, rtl; };
struct Gemm { int lda, ldb, K; };

struct DenseOrder {
    int nM, nN, nwg, G, c; const char* A; const char* B; size_t tsA, tsB;
    __device__ __forceinline__ void init(int nM_, int nN_, int G_, int c_, const void* A_, size_t tsA_, const void* B_, size_t tsB_) { nM = nM_; nN = nN_; nwg = nM * nN; G = G_; c = c_; A = (const char*)A_; B = (const char*)B_; tsA = tsA_; tsB = tsB_; }
    __device__ __forceinline__ bool tile(int i, int& pm, int& pn) const {
        const long L = (long)i * G + c; if (L >= nwg) return false;
        int wgid = (int)L; { const int q = nwg / NXCD, r = nwg % NXCD, xcd = wgid % NXCD, off = wgid / NXCD; wgid = (xcd < r ? xcd * (q + 1) : r * (q + 1) + (xcd - r) * q) + off; }
        const int nig = WGM * nN, gid = wgid / nig, fm = gid * WGM, gsz = (nM - fm) < WGM ? (nM - fm) : WGM;
        pm = fm + ((wgid % nig) % gsz); pn = (wgid % nig) / gsz; return true;
    }
    __device__ __forceinline__ bool next(int i, Unit& u) const { if (!tile(i, u.pm, u.pn)) return false; u.A = A + (size_t)u.pm * tsA; u.B = B + (size_t)u.pn * tsB; u.e = 0; u.rtl = 0; return true; }
    __device__ __forceinline__ const PG8_LAS unsigned char* table(int) const { return nullptr; }
};

__device__ __forceinline__ unsigned cvt_pk_bf16(float lo, float hi) { unsigned r; asm volatile("s_nop 0\n\tv_cvt_pk_bf16_f32 %0, %1, %2" : "=v"(r) : "v"(lo), "v"(hi)); return r; }
__device__ __forceinline__ float bflo(unsigned w) { return __uint_as_float(w << 16); }
__device__ __forceinline__ float bfhi(unsigned w) { return __uint_as_float(w & 0xffff0000u); }
__device__ __forceinline__ float fsigmoid(float x) { return __builtin_amdgcn_rcpf(1.0f + __builtin_amdgcn_exp2f(-1.4426950408889634f * x)); }

__device__ __forceinline__ const char* uni_ptr(const char* p) { const unsigned long long v = (unsigned long long)p; const unsigned lo = __builtin_amdgcn_readfirstlane((unsigned)v), hi = __builtin_amdgcn_readfirstlane((unsigned)(v >> 32)); return (const char*)(((unsigned long long)hi << 32) | lo); }
__device__ __forceinline__ void uni_unit(Unit& u) { u.pm = __builtin_amdgcn_readfirstlane(u.pm); u.pn = __builtin_amdgcn_readfirstlane(u.pn); u.e = __builtin_amdgcn_readfirstlane(u.e); u.rtl = __builtin_amdgcn_readfirstlane(u.rtl); u.A = uni_ptr(u.A); u.B = uni_ptr(u.B); }
struct NoHook { static constexpr bool ON = false; static constexpr int AT = -1; template <class A> __device__ __forceinline__ void operator()(A&, const Unit&, int, int, int, int) const {} };
template <class Epi, class Sched, bool ALIGN_EPI, bool GATHER, int ES = 2, class Hook = NoHook>
__device__ __forceinline__ void gemm_phase(PG8_LAS unsigned char* lds, const Gemm g, const Sched& S, const Epi& E, int wave, const Hook& H = Hook()) {
    int tid = wave * 64 + lane_now(); asm volatile("" : "+v"(tid));
    const int wid = __builtin_amdgcn_readfirstlane(tid >> 6), lane = tid & 63, wr = wid >> 2, wc = wid & 3, fr = lane & 15, fq = lane >> 4;
    const int K = g.K, nt = K * ES / (BK * 2);
    unsigned voffA[2], voffB[2];
#pragma unroll
    for (int i = 0; i < 2; ++i) { int R, C; stage_rc(tid * 16 + i * 8192, R, C); const int Rb = Epi::PERM ? ((R & ~31) + perm32(R & 31)) : R;
        voffA[i] = (unsigned)(R * g.lda * ES + C * 2); voffB[i] = (unsigned)(Rb * g.ldb * ES + C * 2); }
    const size_t kstep = (size_t)(BK * 2);
    const size_t hstepA = GATHER ? (size_t)0 : (size_t)HALF * g.lda * ES;
    const size_t hstepB = (size_t)HALF * g.ldb * ES;
    const unsigned ldsw = (unsigned)wid * 1024u;
    const int aoff = lds_byte(wr * 64 + fr, fq * 8), boff = lds_byte(wc * 32 + fr, fq * 8);
    unsigned vA[2][2], nvA[2][2];
#define PG8_ROWS(dst, uidx) do { int t_ = wave * 64 + lane_now(); asm volatile("" : "+v"(t_)); int R0_, C0_; stage_rc(t_ * 16, R0_, C0_); \
        const PG8_LAS unsigned char* _t = S.table(uidx) + (unsigned)R0_ * 4u; const unsigned c2_ = (unsigned)C0_ * 2u; _Pragma("unroll") for (int h = 0; h < 2; ++h) _Pragma("unroll") for (int i = 0; i < 2; ++i) \
        dst[h][i] = *(const PG8_LAS unsigned*)(_t + h * 512 + i * 256) + c2_; } while (0)
#define PG8_SA(b, h) (((b) * 2 + (h)) * HTB)
#define PG8_SB(b, h) ((4 + (b) * 2 + (h)) * HTB)
#define PG8_STAGE(bufoff, gbase, voff) do { const char* _gb = (const char*)(gbase); asm volatile("" : "+s"(_gb));     \
        _Pragma("unroll") for (int _i = 0; _i < 2; ++_i) { const unsigned _la = (unsigned)__builtin_amdgcn_readfirstlane((int)(unsigned)(uintptr_t)(lds + (bufoff) + ldsw + _i * 8192)); \
            asm volatile("s_mov_b32 m0, %2\n\ts_nop 0\n\tglobal_load_lds_dwordx4 %0, %1" :: "v"((voff)[_i]), "s"(_gb), "s"(_la) : "memory", "m0"); } } while (0)
#define PG8_STB(b, h, ptr) PG8_STAGE(PG8_SB(b, h), (ptr) + (h) * hstepB, voffB)
#define PG8_STA(b, h, ptr, nx) do { if constexpr (GATHER) { unsigned _v[2]; _v[0] = (nx) ? nvA[h][0] : vA[h][0]; _v[1] = (nx) ? nvA[h][1] : vA[h][1]; PG8_STAGE(PG8_SA(b, h), (ptr), _v); } \
        else { PG8_STAGE(PG8_SA(b, h), (ptr) + (h) * hstepA, voffA); } } while (0)
#define PG8_LDA(dst, b, h) do { _Pragma("unroll") for (int m = 0; m < 4; ++m) _Pragma("unroll") for (int k = 0; k < 2; ++k) dst[m][k] = *(const PG8_LAS bf16x8*)(lds + PG8_SA(b, h) + aoff + m * 2048 + k * 1024); } while (0)
#define PG8_LDB(dst, b, h) do { _Pragma("unroll") for (int n = 0; n < 2; ++n) _Pragma("unroll") for (int k = 0; k < 2; ++k) dst[n][k] = *(const PG8_LAS bf16x8*)(lds + PG8_SB(b, h) + boff + n * 2048 + k * 1024); } while (0)
#define PG8_MMA(ai, bj, At, Bt, Z) do { const f32x4 z4_ = {0.f, 0.f, 0.f, 0.f}; __builtin_amdgcn_s_setprio(1); _Pragma("unroll") for (int m = 0; m < 4; ++m) _Pragma("unroll") for (int n = 0; n < 2; ++n) { \
        if constexpr (ES == 2) { acc[ai][bj][m][n] = __builtin_amdgcn_mfma_f32_16x16x32_bf16(Bt[n][0], At[m][0], (Z) ? z4_ : acc[ai][bj][m][n], 0, 0, 0); acc[ai][bj][m][n] = __builtin_amdgcn_mfma_f32_16x16x32_bf16(Bt[n][1], At[m][1], acc[ai][bj][m][n], 0, 0, 0); } \
        else { typedef int v8i_ __attribute__((ext_vector_type(8))); const u32x4 b0_ = __builtin_bit_cast(u32x4, Bt[n][0]), b1_ = __builtin_bit_cast(u32x4, Bt[n][1]), a0_ = __builtin_bit_cast(u32x4, At[m][0]), a1_ = __builtin_bit_cast(u32x4, At[m][1]); \
            const v8i_ bv_ = {(int)b0_[0], (int)b0_[1], (int)b0_[2], (int)b0_[3], (int)b1_[0], (int)b1_[1], (int)b1_[2], (int)b1_[3]}, av_ = {(int)a0_[0], (int)a0_[1], (int)a0_[2], (int)a0_[3], (int)a1_[0], (int)a1_[1], (int)a1_[2], (int)a1_[3]}; \
            acc[ai][bj][m][n] = __builtin_amdgcn_mfma_scale_f32_16x16x128_f8f6f4(bv_, av_, (Z) ? z4_ : acc[ai][bj][m][n], 0, 0, 0, 0, 0, 0); } }     \
        __builtin_amdgcn_s_setprio(0); \
        _Pragma("unroll") for (int m = 0; m < 4; ++m) asm volatile("" : "+v"(acc[ai][bj][m][0]), "+v"(acc[ai][bj][m][1]));     \
        } while (0)
#define PG8_WAIT_V(n) asm volatile("s_waitcnt vmcnt(" #n ")" ::: "memory")
#define PG8_WAIT_L(n) asm volatile("s_waitcnt lgkmcnt(" #n ")" ::: "memory")
#define PG8_BAR __builtin_amdgcn_s_barrier()
#define PG8_SCHED __builtin_amdgcn_sched_barrier(0)
    Unit cur, nxt; int ui = 0;
    if (!S.next(0, cur)) return;
    uni_unit(cur);
    f32x4 acc[2][2][4][2];
    bf16x8 At[4][2], B0[2][2], B1[2][2];
    const char* cA = cur.A; const char* cB = cur.B;
    if constexpr (GATHER) { PG8_ROWS(vA, 0); }
    PG8_STB(0, 0, cB); PG8_STB(0, 1, cB); PG8_STA(0, 0, cA, false); PG8_STA(0, 1, cA, false);
    if (wr == 1) PG8_BAR;
    PG8_WAIT_V(2); PG8_BAR;
    PG8_STB(1, 0, cB + kstep); PG8_STA(1, 0, cA + kstep, false); PG8_STB(1, 1, cB + kstep);
    PG8_WAIT_V(6); PG8_BAR;
    for (;;) {
        const bool has_next = S.next(ui + 1, nxt);
        if (has_next) uni_unit(nxt);
        const char* nA = has_next ? nxt.A : cA; const char* nB = has_next ? nxt.B : cB;
#define PG8_KPAIR(t, LAST, ZERO) do { \
            const char* a1 = cA + (size_t)((t) + 1) * kstep; \
            const char* a2 = (LAST) ? nA : cA + (size_t)((t) + 2) * kstep; const char* b2 = (LAST) ? nB : cB + (size_t)((t) + 2) * kstep; \
            const char* a3 = a2 + kstep; const char* b3 = b2 + kstep; \
              \
            PG8_LDB(B0, 0, 0); PG8_LDB(B1, 0, 1); PG8_SCHED; PG8_LDA(At, 0, 0); PG8_STA(1, 1, a1, false); \
            PG8_WAIT_V(8); PG8_WAIT_L(0); PG8_BAR; PG8_MMA(0, 0, At, B0, ZERO); PG8_MMA(0, 1, At, B1, ZERO); PG8_BAR; PG8_SCHED; \
              \
            PG8_LDA(At, 0, 1); PG8_STB(0, 0, b2); PG8_STB(0, 1, b2); PG8_STA(0, 0, a2, LAST); \
            PG8_WAIT_V(8); PG8_WAIT_L(0); PG8_BAR; PG8_MMA(1, 0, At, B0, ZERO); PG8_MMA(1, 1, At, B1, ZERO); PG8_BAR; PG8_SCHED; \
              \
            PG8_LDB(B0, 1, 0); PG8_LDB(B1, 1, 1); PG8_SCHED; PG8_LDA(At, 1, 0); PG8_STA(0, 1, a2, LAST); \
            PG8_WAIT_V(8); PG8_WAIT_L(0); PG8_BAR; PG8_MMA(0, 0, At, B0, false); PG8_MMA(0, 1, At, B1, false); PG8_BAR; PG8_SCHED; \
              \
            PG8_LDA(At, 1, 1); PG8_STB(1, 0, b3); PG8_STB(1, 1, b3); PG8_STA(1, 0, a3, LAST); \
            PG8_WAIT_V(8); PG8_WAIT_L(0); PG8_BAR; PG8_MMA(1, 0, At, B0, false); PG8_MMA(1, 1, At, B1, false); PG8_BAR; PG8_SCHED; } while (0)
        PG8_KPAIR(0, false, true);
        _Pragma("nounroll") for (int t = 2; t < nt - 2; t += 2) { PG8_KPAIR(t, false, false); if constexpr (Hook::ON) { if (t == Hook::AT) H(acc, cur, wr, wc, fr, fq); } }
        if constexpr (GATHER) {
            if (has_next) { PG8_ROWS(nvA, ui + 1); }
            else {
#pragma unroll
                for (int h = 0; h < 2; ++h)
#pragma unroll
                    for (int i = 0; i < 2; ++i) nvA[h][i] = vA[h][i]; }
        }
        PG8_KPAIR(nt - 2, true, false);
#undef PG8_KPAIR
        if constexpr (ALIGN_EPI) { if (wr == 0) PG8_BAR; }
        E(acc, cur, wr, wc, fr, fq);
        if (!has_next) break;
        cur = nxt; cA = nA; cB = nB; ++ui;
        if constexpr (GATHER) {
#pragma unroll
            for (int h = 0; h < 2; ++h)
#pragma unroll
                for (int i = 0; i < 2; ++i) vA[h][i] = nvA[h][i];
        }
        if constexpr (ALIGN_EPI) { if (wr == 1) PG8_BAR; }
    }
    PG8_WAIT_V(0);
    if constexpr (!ALIGN_EPI) { if (wr == 0) PG8_BAR; }
    PG8_BAR;
#undef PG8_SA
#undef PG8_SB
#undef PG8_STAGE
#undef PG8_STB
#undef PG8_ROWS
#undef PG8_STA
#undef PG8_LDA
#undef PG8_LDB
#undef PG8_MMA
#undef PG8_WAIT_V
#undef PG8_WAIT_L
#undef PG8_BAR
#undef PG8_SCHED
}
}

constexpr int NWAVES = 8;
constexpr int NT = 32768, DM = 1024, SEQ = 2048, NBATCH = 16, INW = 3080, NE = 32, PLE = 256;
constexpr float EPS = 1e-6f;
constexpr float LOG2E = 1.4426950408889634f;
constexpr float C2 = 0.125f * 1.4426950408889634f;
constexpr int N1 = 5120;
constexpr int MAXRT = 576;
constexpr int MAXUNITS = 24;

constexpr size_t MiB = 1u << 20;
constexpr size_t WS_CTL = 0, CTL_ZERO_BYTES = 1 * MiB;
constexpr size_t WS_TOK = 2 * MiB;
constexpr size_t WS_RSOF = 6 * MiB;
constexpr size_t WS_TOPE = 10 * MiB;
constexpr size_t WS_TOPW = 10 * MiB + 512 * 1024;
constexpr size_t WS_POS = 11 * MiB;
constexpr size_t WS_LOGF = 12 * MiB;
constexpr size_t WS_CUM = 13 * MiB;
constexpr size_t WS_ROT = 14 * MiB;
constexpr size_t WS_RSTD2 = 14 * MiB + 512 * 1024;
constexpr size_t WS_WRT = 15 * MiB;
constexpr size_t WS_W1T = 16 * MiB;
constexpr size_t WS_WBT = 26 * MiB;
constexpr size_t WS_WOT = 28 * MiB;
constexpr size_t WS_WPGT = 30 * MiB;
constexpr size_t WS_WPPT = 32 * MiB;
constexpr size_t WS_WGUT = 34 * MiB;
constexpr size_t WS_WDT = 162 * MiB;
constexpr size_t WS_HB = 226 * MiB;
constexpr size_t WS_PB = 291 * MiB;
constexpr size_t WS_Z = 307 * MiB;
constexpr size_t WS_XN = WS_Z, WS_FQ = WS_Z + 64 * MiB, WS_FK = WS_Z + 96 * MiB, WS_FV = WS_Z + 128 * MiB, WS_RQ = WS_Z + 160 * MiB, WS_RK = WS_Z + 176 * MiB;
constexpr size_t WS_RV = WS_Z + 192 * MiB, WS_RGS = WS_Z + 224 * MiB, WS_GATES = WS_Z + 256 * MiB, WS_BR = WS_Z + 384 * MiB, WS_MERGED = WS_Z + 448 * MiB;
constexpr size_t WS_RKT = WS_Z + 512 * MiB;
constexpr size_t WS_XN8 = WS_Z + 528 * MiB;
constexpr size_t WS_WG8T = WS_W1T + 4 * MiB;
constexpr size_t WS_H2B = WS_Z + 448 * MiB;
constexpr size_t WS_MO = WS_Z + 512 * MiB;
constexpr size_t WS_ACT = WS_Z, WS_Y = WS_Z + 144 * MiB;
constexpr size_t WS_HB2 = WS_Z, WS_PJ = WS_Z + 384 * MiB, WS_G8 = WS_Z + 160 * MiB;
constexpr size_t WS_END = WS_Z + 576 * MiB;
constexpr int CW_BAR = 4096;
constexpr int CW_CNT = 8192;
constexpr int CW_QUEUE = 8256;
constexpr int CW_SSQ = 16384;
static_assert((CW_SSQ + NT) * 4 <= (int)CTL_ZERO_BYTES, "CTL words inside the memset region");

constexpr int RING_OFF = 0, RING_BYTES = 131072;
constexpr int TAB_OFF = RING_BYTES;
constexpr int SCH_OFF = TAB_OFF + MAXUNITS * 1024;
constexpr int SCH_CNT = SCH_OFF, SCH_P = SCH_OFF + 128, SCH_RT2E = SCH_OFF + 128 + 160;
constexpr int MISC_OFF = SCH_RT2E + MAXRT * 4;
constexpr int LDS_BYTES = 163840;
static_assert(MISC_OFF + 256 <= LDS_BYTES && (MISC_OFF % 16) == 0, "LDS map");

#define GAS __attribute__((address_space(1)))
#define LAS __attribute__((address_space(3)))
typedef unsigned short bf16;
typedef unsigned v4u __attribute__((ext_vector_type(4)));
typedef unsigned v2u __attribute__((ext_vector_type(2)));
typedef float f32x4 __attribute__((ext_vector_type(4)));
typedef short bf16x8 __attribute__((ext_vector_type(8)));
typedef GAS unsigned gu32;
#define RLX_AGENT __ATOMIC_RELAXED, __HIP_MEMORY_SCOPE_AGENT
#define LDS_WAIT() asm volatile("s_waitcnt lgkmcnt(0)" ::: "memory")
#define VM_WAIT() asm volatile("s_waitcnt vmcnt(0)" ::: "memory")
__device__ __forceinline__ unsigned f2bf(float f) { unsigned u = __builtin_bit_cast(unsigned, f); return (u + 0x7fffu + ((u >> 16) & 1u)) >> 16; }
__device__ __forceinline__ unsigned pk2(float lo, float hi) { return f2bf(lo) | (f2bf(hi) << 16); }
using pg8::bflo; using pg8::bfhi; using pg8::fsigmoid; using pg8::cvt_pk_bf16;
constexpr float WSCALE = 32.f;
constexpr float YSCALE = 8.f;
__device__ __forceinline__ float clamp_f8(float v) { return fminf(fmaxf(v, -448.f), 448.f); }
__device__ __forceinline__ v2u pack8_fp8(const f32x4 a, const f32x4 b) {
    int w0 = 0, w1 = 0;
    w0 = __builtin_amdgcn_cvt_pk_fp8_f32(clamp_f8(a[0]), clamp_f8(a[1]), w0, false); w0 = __builtin_amdgcn_cvt_pk_fp8_f32(clamp_f8(a[2]), clamp_f8(a[3]), w0, true);
    w1 = __builtin_amdgcn_cvt_pk_fp8_f32(clamp_f8(b[0]), clamp_f8(b[1]), w1, false); w1 = __builtin_amdgcn_cvt_pk_fp8_f32(clamp_f8(b[2]), clamp_f8(b[3]), w1, true);
    return (v2u){(unsigned)w0, (unsigned)w1}; }
#define DPP_F(v, ctrl) __int_as_float(__builtin_amdgcn_update_dpp(0, __float_as_int(v), (ctrl), 0xF, 0xF, false))
__device__ __forceinline__ float wave_sum(float v) {
    v += DPP_F(v, 0xB1); v += DPP_F(v, 0x4E); v += DPP_F(v, 0x141); v += DPP_F(v, 0x140);
    const int b = __float_as_int(v);
    return (__int_as_float(__builtin_amdgcn_readlane(b, 0)) + __int_as_float(__builtin_amdgcn_readlane(b, 16))) + (__int_as_float(__builtin_amdgcn_readlane(b, 32)) + __int_as_float(__builtin_amdgcn_readlane(b, 48)));
}
__device__ __forceinline__ float xor32_sum(float v) { auto rr = __builtin_amdgcn_permlane32_swap(__float_as_uint(v), __float_as_uint(v), false, false); return __uint_as_float(rr[0]) + __uint_as_float(rr[1]); }
__device__ __forceinline__ float xor16_sum(float v) { auto rr = __builtin_amdgcn_permlane16_swap(__float_as_uint(v), __float_as_uint(v), false, false); return __uint_as_float(rr[0]) + __uint_as_float(rr[1]); }

#define XB_TMO      128
#define XB_XCNT(j)  (256  + 64 * (j))
#define XB_XSUB(j)  (1280 + 64 * (j))
#define XB_XGEN(j)  (2304 + 64 * (j))
#define XB_TOP      3328
#define XB_TOPGEN   3392
#define XCD_BAR_WORDS 3456
#define XB_SPIN_CAP (1u << 20)

__device__ __forceinline__ unsigned xb_ld(unsigned* p)              { return __hip_atomic_load(p, __ATOMIC_RELAXED, __HIP_MEMORY_SCOPE_AGENT); }
__device__ __forceinline__ unsigned xb_add(unsigned* p, unsigned v) { return __hip_atomic_fetch_add(p, v, __ATOMIC_RELAXED, __HIP_MEMORY_SCOPE_AGENT); }
__device__ __forceinline__ unsigned xb_xcc_id() { return (unsigned)__builtin_amdgcn_s_getreg((3 << 11) | 20) & 0xFu; }
#define XB_SPIN(cond, bar) do { unsigned _sp = 0; while (cond) { __builtin_amdgcn_s_sleep(1); \
    if ((++_sp & 255u) == 0u) { if (xb_ld(&(bar)[XB_TMO])) break; if (_sp > XB_SPIN_CAP) { atomicAdd(&(bar)[XB_TMO], 1u); break; } } } } while (0)

struct XcdBarrier {
    unsigned* bar; unsigned x;
    volatile LAS unsigned* st;
};
__device__ __forceinline__ XcdBarrier xcd_barrier_post(unsigned* bar, volatile LAS unsigned* st, int tid) {
    XcdBarrier b; b.bar = bar; b.x = xb_xcc_id(); b.st = st;
    if (tid == 0) (void)xb_add(&bar[XB_XCNT(b.x)], 1u);
    return b;
}
__device__ __forceinline__ void xcd_barrier_complete(unsigned* bar, unsigned x, unsigned& nloc, unsigned& nx) {
    const unsigned G = gridDim.x * gridDim.y * gridDim.z;
    unsigned sum, cnt, mine, sp = 0u;
    for (;;) {
        sum = 0u; cnt = 0u; mine = 0u;
#pragma unroll
        for (unsigned j = 0; j < 16; ++j) { const unsigned c = xb_ld(&bar[XB_XCNT(j)]); sum += c; cnt += (c > 0u) ? 1u : 0u; mine = (j == x) ? c : mine; }
        if (sum == G) break;
        __builtin_amdgcn_s_sleep(1);
        if ((++sp & 255u) == 0u) { if (xb_ld(&bar[XB_TMO])) break; if (sp > XB_SPIN_CAP) { atomicAdd(&bar[XB_TMO], 1u); break; } }
    }
    nloc = mine > 0u ? mine : 1u; nx = cnt > 0u ? cnt : 1u;
}
__device__ __forceinline__ void xcd_barrier(const XcdBarrier& b, int tid) {
    asm volatile("s_waitcnt vmcnt(0)" ::: "memory");
    __syncthreads();
    if (tid == 0) {
        unsigned* bar = b.bar;
        __builtin_amdgcn_s_waitcnt(0);
        unsigned nloc = b.st[0], nx = b.st[1];
        if (nloc == 0u) { xcd_barrier_complete(bar, b.x, nloc, nx); b.st[0] = nloc; b.st[1] = nx; }
        const unsigned old = xb_add(&bar[XB_XSUB(b.x)], 1u);
        const unsigned gen = old / nloc;
        if (old + 1u == (gen + 1u) * nloc) {
            __builtin_amdgcn_fence(__ATOMIC_RELEASE, "agent");
            asm volatile("s_waitcnt vmcnt(0)" ::: "memory");
            const unsigned og = xb_add(&bar[XB_TOP], 1u);
            const unsigned tg = og / nx;
            if (og + 1u == (tg + 1u) * nx) xb_add(&bar[XB_TOPGEN], 1u);
            else XB_SPIN(xb_ld(&bar[XB_TOPGEN]) == tg, bar);
            __builtin_amdgcn_fence(__ATOMIC_ACQUIRE, "agent");
            xb_add(&bar[XB_XGEN(b.x)], 1u);
            asm volatile("s_waitcnt vmcnt(0)" ::: "memory");
        } else {
            XB_SPIN(xb_ld(&bar[XB_XGEN(b.x)]) == gen, bar);
            __builtin_amdgcn_fence(__ATOMIC_ACQUIRE, "agent");
            asm volatile("s_waitcnt vmcnt(0)" ::: "memory");
        }
    }
    __syncthreads();
}

struct Args { const float* in[20]; float* out; unsigned char* ws; int ph_lo, ph_hi, rep_phase, rep_mode; };
struct Frame {
    LAS unsigned char* lds;
    volatile LAS unsigned* MISC;
    int tid, lane, wave;
    int vcu, G;
    const __attribute__((address_space(4))) Args* ap;
};
#define REARGS() do { F.ap = (const __attribute__((address_space(4))) Args*)__builtin_amdgcn_kernarg_segment_ptr(); asm volatile("" : "+s"(F.ap)); } while (0)
#define WSP(T, off) ((T*)(F.ap->ws + (off)))

#include <hip/hip_bf16.h>
namespace attn_body {
using bf16=__hip_bfloat16;
using bf16x8=__attribute__((ext_vector_type(8)))short;
using s16x4=__attribute__((ext_vector_type(4)))short;
using f32x16=__attribute__((ext_vector_type(16)))float;
using u32x4=__attribute__((ext_vector_type(4)))unsigned;
constexpr int BATCH=16,NHEAD=8,SEQ=2048,D=64,DM=NHEAD*D,OPITCH=1024;
constexpr int NW=8,QBLK=32,QB=QBLK*NW,KVBLK=64,NQB=SEQ/QB;
constexpr int ATTN_PITCH=DM, ATTN_UNIT_ROWS=QB;
__device__ __forceinline__ int crow(int r,int hi){return (r&3)+8*(r>>2)+4*hi;}
#define SBAR() __builtin_amdgcn_sched_barrier(0)
__device__ __forceinline__ void cmask(f32x16&p0,f32x16&p1,int jb,int qrel,int hi){
  const float NEG=-INFINITY; int kb=64*jb+4*hi;
  #pragma unroll
  for(int r=0;r<16;++r){int kv=kb+(r&3)+8*(r>>2); if(kv>qrel)p0[r]=NEG; if(kv+32>qrel)p1[r]=NEG;}
}

constexpr int NSLOT=3, SLOTB=8192;
constexpr int LDS_K=0, LDS_V=NSLOT*SLOTB, LDS_WS=2*NSLOT*SLOTB, LDS_OST=LDS_WS+NW*64*4, LDS_KB=LDS_OST+NW*4096, LDS_BYTES=LDS_KB+SEQ*16;
constexpr float C2=0.125f*1.4426950408889634f;
__device__ __forceinline__ void glds16(const void*gsrc,unsigned lds_dst){unsigned keep;
  asm volatile("s_mov_b32 %0, m0\n\ts_mov_b32 m0, %2\n\ts_nop 0\n\tglobal_load_lds_dwordx4 %1, off\n\ts_mov_b32 m0, %0":"=&s"(keep):"v"(gsrc),"s"(lds_dst):"memory");}
__device__ __forceinline__ float max3f(float a,float b,float c){float r;asm("v_max3_f32 %0, %1, %2, %3":"=v"(r):"v"(a),"v"(b),"v"(c));return r;}
__device__ __forceinline__ float max2f(float a,float b){float r;asm("v_max_f32_e32 %0, %1, %2":"=v"(r):"v"(a),"v"(b));return r;}
__device__ __forceinline__ float fadd_s(float a,float b){float r;asm("v_add_f32_e32 %0, %1, %2":"=v"(r):"v"(a),"v"(b));return r;}
__device__ __forceinline__ float fsub_s(float a,float b){float r;asm("v_sub_f32_e32 %0, %1, %2":"=v"(r):"v"(a),"v"(b));return r;}
typedef float f32x2_t __attribute__((ext_vector_type(2))); typedef __bf16 bf16x2_t __attribute__((ext_vector_type(2)));
__device__ __forceinline__ unsigned cvtpk_s(float lo,float hi){f32x2_t v={lo,hi};bf16x2_t b=__builtin_convertvector(v,bf16x2_t);return __builtin_bit_cast(unsigned,b);}
#define WAIT_BAR(N) asm volatile("s_waitcnt vmcnt(" #N ") lgkmcnt(0)\n\ts_barrier":::"memory")

__device__ __forceinline__ void qkt(f32x16&p0,f32x16&p1,const char*Kslot,const bf16x8*qr,const bf16x8 qx,const bf16x8 kb0,const bf16x8 kb1,int r32,int hi){
  const f32x16 zc=f32x16{};
  const char*kb=Kslot+hi*1024+r32*16;
  #pragma unroll
  for(int d0=0;d0<4;++d0){
    const bf16x8 b0=*reinterpret_cast<const bf16x8*>(kb+d0*2048);
    const bf16x8 b1=*reinterpret_cast<const bf16x8*>(kb+d0*2048+512);
    if(d0==0){p0=__builtin_amdgcn_mfma_f32_32x32x16_bf16(b0,qr[0],zc,0,0,0);p1=__builtin_amdgcn_mfma_f32_32x32x16_bf16(b1,qr[0],zc,0,0,0);}
    else{p0=__builtin_amdgcn_mfma_f32_32x32x16_bf16(b0,qr[d0],p0,0,0,0);p1=__builtin_amdgcn_mfma_f32_32x32x16_bf16(b1,qr[d0],p1,0,0,0);}}
  p0=__builtin_amdgcn_mfma_f32_32x32x16_bf16(kb0,qx,p0,0,0,0);p1=__builtin_amdgcn_mfma_f32_32x32x16_bf16(kb1,qx,p1,0,0,0);
}
typedef __attribute__((address_space(3))) const char* lds_cptr;
typedef short v4i16_t __attribute__((ext_vector_type(4)));
__device__ __forceinline__ void kload8(bf16x8*kf,lds_cptr kp){
  kf[0]=*(const __attribute__((address_space(3))) bf16x8*)(kp);      kf[1]=*(const __attribute__((address_space(3))) bf16x8*)(kp+512);
  kf[2]=*(const __attribute__((address_space(3))) bf16x8*)(kp+2048); kf[3]=*(const __attribute__((address_space(3))) bf16x8*)(kp+2560);
  kf[4]=*(const __attribute__((address_space(3))) bf16x8*)(kp+4096); kf[5]=*(const __attribute__((address_space(3))) bf16x8*)(kp+4608);
  kf[6]=*(const __attribute__((address_space(3))) bf16x8*)(kp+6144); kf[7]=*(const __attribute__((address_space(3))) bf16x8*)(kp+6656);
}
__device__ __forceinline__ void kload2(bf16x8*kf,lds_cptr kp,int j){ kf[2*j]=*(const __attribute__((address_space(3))) bf16x8*)(kp+j*2048); kf[2*j+1]=*(const __attribute__((address_space(3))) bf16x8*)(kp+j*2048+512); }
__device__ __forceinline__ s16x4 vtr(lds_cptr p){ return __builtin_bit_cast(s16x4,__builtin_amdgcn_ds_read_tr16_b64_v4i16((__attribute__((address_space(3))) v4i16_t*)p)); }
__device__ __forceinline__ float rowmax(const f32x16&p0,const f32x16&p1){
  float a=max3f(p0[0],p0[1],p1[0]),b=max3f(p0[2],p0[3],p1[1]);a=max3f(a,p1[2],p1[3]);
  #pragma unroll
  for(int r=4;r<16;r+=4){a=max3f(a,p0[r],p0[r+1]);b=max3f(b,p0[r+2],p0[r+3]);a=max3f(a,p1[r],p1[r+1]);b=max3f(b,p1[r+2],p1[r+3]);}
  const float m=max2f(a,b);
  auto rr=__builtin_amdgcn_permlane32_swap(__float_as_uint(m),__float_as_uint(m),false,false);
  return max2f(__uint_as_float(rr[0]),__uint_as_float(rr[1]));
}
__device__ __forceinline__ void pv(f32x16*o,int vb,bf16x8 pa0,bf16x8 pa1,bf16x8 pa2,bf16x8 pa3){
  #pragma unroll
  for(int d0=0;d0<2;++d0){s16x4 lo[4],hi[4];
    #pragma unroll
    for(int ks=0;ks<4;++ks){
      asm volatile("ds_read_b64_tr_b16 %0,%1 offset:%c2":"=&v"(lo[ks]):"v"(vb),"i"(d0*4096+ks*1024):"memory");
      asm volatile("ds_read_b64_tr_b16 %0,%1 offset:%c2":"=&v"(hi[ks]):"v"(vb),"i"(d0*4096+ks*1024+512):"memory");}
    asm volatile("s_waitcnt lgkmcnt(0)":::"memory");SBAR();
    #define PK(k) (bf16x8){lo[k][0],lo[k][1],lo[k][2],lo[k][3],hi[k][0],hi[k][1],hi[k][2],hi[k][3]}
    o[d0]=__builtin_amdgcn_mfma_f32_32x32x16_bf16(pa0,PK(0),o[d0],0,0,0);
    o[d0]=__builtin_amdgcn_mfma_f32_32x32x16_bf16(pa1,PK(1),o[d0],0,0,0);
    o[d0]=__builtin_amdgcn_mfma_f32_32x32x16_bf16(pa2,PK(2),o[d0],0,0,0);
    o[d0]=__builtin_amdgcn_mfma_f32_32x32x16_bf16(pa3,PK(3),o[d0],0,0,0);
    #undef PK
  }
}

__device__ __forceinline__ void split3(float v,unsigned&a,unsigned&b,unsigned&c){ a=cvtpk_s(v,0.f)&0xffffu; const float r1=v-__uint_as_float(a<<16); b=cvtpk_s(r1,0.f)&0xffffu; const float r2=r1-__uint_as_float(b<<16); c=cvtpk_s(r2,0.f)&0xffffu; }
__device__ __forceinline__ bf16x8 make_qx(float m,int hi){ unsigned a,b,c; split3(m,a,b,c); u32x4 w={0x3F803F80u,0x3F80u|(a<<16),b|(c<<16),0u}; if(hi)w=(u32x4){0u,0u,0u,0u}; return __builtin_bit_cast(bf16x8,w); }
#ifndef ATTN_STORE16
#define ATTN_STORE16(p,v) (*(u32x4*)(p)=(v))
#endif
template<int THRL> __device__ __forceinline__ void attn_unit(int b,int h,int qb,const bf16*Q,const bf16*__restrict__ K,const bf16*__restrict__ V,bf16*O,const float*__restrict__ cum,char*shm,int wave){
  int tid=wave*64+lane_now(); asm volatile("":"+v"(tid));
  const int lane=tid&63,r32=lane&31,hi=lane>>5; const int wid=__builtin_amdgcn_readfirstlane(tid>>6);
  const long rowbase=(long)b*SEQ; const int q0=qb*QB;
  const bf16*Qw=Q+(rowbase+q0+wid*QBLK)*DM+h*D;
  const bf16*Kh=K+rowbase*DM+h*D,*Vh=V+rowbase*DM+h*D;
  const unsigned lds0=(unsigned)(uintptr_t)shm;
  float*wsf=(float*)(shm+LDS_WS)+wid*64;
  const bf16*ksrc=Kh+(long)lane*DM+wid*8;
  const bf16*vsrc=Vh+(long)(16*(wid&3)+(lane>>2))*DM+(wid>>2)*32+(lane&3)*8;
  const unsigned kdst=lds0+LDS_K+wid*1024, vdst=lds0+LDS_V+wid*1024;
  #define DMA_K(t,slot) glds16(ksrc+(long)(t)*KVBLK*DM,(unsigned)__builtin_amdgcn_readfirstlane(kdst+(slot)))
  #define DMA_V(t,slot) glds16(vsrc+(long)(t)*KVBLK*DM,(unsigned)__builtin_amdgcn_readfirstlane(vdst+(slot)))
  const int vb0=(int)(lds0+LDS_V)+((lane>>4)&1)*32+(lane&3)*8+(4*hi+((lane&15)>>2))*64;
  const char*Kbase=shm+LDS_K; bf16x8 kf[8];
  const lds_cptr shm3=(lds_cptr)shm; const lds_cptr kp0=shm3+LDS_K+hi*1024+r32*16; const lds_cptr vp0=shm3+LDS_V+((lane>>4)&1)*32+(lane&3)*8+(4*hi+((lane&15)>>2))*64;
  const int NT=(q0+QB)/KVBLK;
  const lds_cptr kbp=shm3+LDS_KB+r32*16;
  DMA_K(0,0);DMA_V(0,0);DMA_K(1,SLOTB);
  { const float cref=cum[q0+QB-1]; float cv[SEQ/(NW*64)];
    #pragma unroll
    for(int i=0;i<SEQ/(NW*64);++i){ const int kv=tid+i*NW*64; cv[i]=(kv<q0+QB)?cum[kv]:0.f; }
    #pragma unroll
    for(int i=0;i<SEQ/(NW*64);++i){ const int kv=tid+i*NW*64; if(kv<q0+QB){ unsigned a,bb,c; split3((cref-cv[i])*1.4426950408889634f,a,bb,c);
      *(__attribute__((address_space(3))) u32x4*)((__attribute__((address_space(3))) char*)shm3+LDS_KB+kv*16)=(u32x4){a|(bb<<16),c|0xBF800000u,0xBF80BF80u,0u}; } } }
  bf16x8 qr[4];
  #pragma unroll
  for(int d0=0;d0<4;++d0)qr[d0]=*reinterpret_cast<const bf16x8*>(&Qw[(long)r32*DM+d0*16+hi*8]);
  float mhat=0.f,l_reg=0.f;f32x16 o[2];o[0]=f32x16{};o[1]=f32x16{};bf16x8 qx=make_qx(0.f,hi);const f32x16 zc=f32x16{};
  const int qrel=wid*QBLK+r32;
  #define CMASK(P0,P1,t) do{int jb_=(t)-(NT-4); if(jb_>=0)cmask(P0,P1,jb_,qrel,hi);}while(0)
  bool resc=false;
  #define START(P0,P1) do{ const float rm=rowmax(P0,P1); resc=false; \
    { const float dl=rm; mhat=fadd_s(mhat,dl); \
      _Pragma("unroll") for(int r=0;r<16;++r){P0[r]=fsub_s(P0[r],dl);P1[r]=fsub_s(P1[r],dl);} \
      qx=make_qx(mhat,hi); } \
    _Pragma("unroll") for(int r=0;r<16;++r)P0[r]=__builtin_amdgcn_exp2f(P0[r]); }while(0)
  #define RESC() do{ if(resc){ asm volatile("s_waitcnt lgkmcnt(0)":::"memory"); \
      _Pragma("unroll") for(int d_=0;d_<2;++d_) _Pragma("unroll") for(int r=0;r<16;++r)o[d_][r]*=wsf[crow(r,hi)]; } }while(0)
  f32x16 pA0,pA1,pB0,pB1;
  int sl_prev=0,sl_cur=0,sl_next=SLOTB;
  #define ROT() do{sl_prev=sl_cur;sl_cur=sl_next;sl_next=(sl_next==(NSLOT-1)*SLOTB)?0:sl_next+SLOTB;}while(0)
  DMA_K(2,2*SLOTB);
  WAIT_BAR(3);
  qkt(pA0,pA1,Kbase,qr,qx,*(const __attribute__((address_space(3))) bf16x8*)(kbp),*(const __attribute__((address_space(3))) bf16x8*)(kbp+512),r32,hi);asm volatile("s_nop 15\n\ts_nop 7":"+v"(pA0),"+v"(pA1));CMASK(pA0,pA1,0);
  START(pA0,pA1);
  _Pragma("unroll") for(int r=0;r<16;++r)pA1[r]=__builtin_amdgcn_exp2f(pA1[r]);
  WAIT_BAR(0);
  DMA_K(3,0);DMA_V(1,SLOTB);
  ROT();
  kload8(kf,kp0+sl_cur);
  WAIT_BAR(2);
  s16x4 vlo[8],vhi[8]; u32x4 pw0,pw1,pw2,pw3;
  #define PKW(P,B) cvtpk_s(P[B],P[B+1])
  #define PAF(k) __builtin_bit_cast(bf16x8,pw##k)
  #define VFR(i) (bf16x8){vlo[i][0],vlo[i][1],vlo[i][2],vlo[i][3],vhi[i][0],vhi[i][1],vhi[i][2],vhi[i][3]}
  #define PIN(x) asm volatile("":"+v"(x))
  #define MX3(a,b,c) __builtin_fmaxf(__builtin_fmaxf((a),(b)),(c))
  #define GAPA(MF,A0,A1,A2,A3,W0,W1,PW) do{ MF; sacc+=A0; sacc+=A1; sacc+=A2; sacc+=A3; PIN(sacc); W0; W1; PIN(PW); SBAR(); }while(0)
  #define EX(v) __builtin_amdgcn_exp2f(v)
  #define GAPB(MF,X,B) do{ MF; X[B]=EX(X[B]); X[B+1]=EX(X[B+1]); X[B+2]=EX(X[B+2]); X[B+3]=EX(X[B+3]); PIN(X); SBAR(); }while(0)
  #define VRD(i) do{ vlo[i]=vtr(vp_+(((i)>>2)*4096+((i)&3)*1024)); vhi[i]=vtr(vp_+(((i)>>2)*4096+((i)&3)*1024+512)); }while(0)
  #define KRD(G,j) do{ if(G){ kload2(kf,kp0+sl_next,j); SBAR(); } }while(0)
  #define STEP(C0,C1,P0,P1,t,GK,GV,GL) do{ SBAR(); \
    const lds_cptr vp_=vp0+sl_prev; \
    const bf16x8 kb0_=*(const __attribute__((address_space(3))) bf16x8*)(kbp+(t)*1024), kb1_=*(const __attribute__((address_space(3))) bf16x8*)(kbp+(t)*1024+512); \
    VRD(0); SBAR(); float sacc=(P0[0]+P0[1]); \
    GAPA(C0=__builtin_amdgcn_mfma_f32_32x32x16_bf16(kf[0],qr[0],zc,0,0,0), P0[2],P0[3],P0[4],P0[5],     pw0[0]=PKW(P0,0), pw0[1]=PKW(P0,2), pw0); \
    VRD(4); SBAR(); GAPA(C1=__builtin_amdgcn_mfma_f32_32x32x16_bf16(kf[1],qr[0],zc,0,0,0), P0[6],P0[7],P0[8],P0[9],     pw0[2]=PKW(P0,4), pw0[3]=PKW(P0,6), pw0); \
    VRD(1); SBAR(); GAPA(C0=__builtin_amdgcn_mfma_f32_32x32x16_bf16(kf[2],qr[1],C0,0,0,0),   P0[10],P0[11],P0[12],P0[13], pw1[0]=PKW(P0,8), pw1[1]=PKW(P0,10), pw1); \
    VRD(5); SBAR(); GAPA(C1=__builtin_amdgcn_mfma_f32_32x32x16_bf16(kf[3],qr[1],C1,0,0,0),   P0[14],P0[15],P1[0],P1[1],   pw1[2]=PKW(P0,12),pw1[3]=PKW(P0,14), pw1); \
    VRD(2); SBAR(); GAPA(C0=__builtin_amdgcn_mfma_f32_32x32x16_bf16(kf[4],qr[2],C0,0,0,0),   P1[2],P1[3],P1[4],P1[5],     pw2[0]=PKW(P1,0), pw2[1]=PKW(P1,2), pw2); \
    VRD(6); SBAR(); GAPA(C1=__builtin_amdgcn_mfma_f32_32x32x16_bf16(kf[5],qr[2],C1,0,0,0),   P1[6],P1[7],P1[8],P1[9],     pw2[2]=PKW(P1,4), pw2[3]=PKW(P1,6), pw2); \
    VRD(3); SBAR(); GAPA(C0=__builtin_amdgcn_mfma_f32_32x32x16_bf16(kf[6],qr[3],C0,0,0,0),   P1[10],P1[11],P1[12],P1[13], pw3[0]=PKW(P1,8), pw3[1]=PKW(P1,10), pw3); \
    VRD(7); SBAR(); GAPA(C1=__builtin_amdgcn_mfma_f32_32x32x16_bf16(kf[7],qr[3],C1,0,0,0),   P1[14],P1[15],0.f,0.f,       pw3[2]=PKW(P1,12),pw3[3]=PKW(P1,14), pw3); \
    C0=__builtin_amdgcn_mfma_f32_32x32x16_bf16(kb0_,qx,C0,0,0,0); C1=__builtin_amdgcn_mfma_f32_32x32x16_bf16(kb1_,qx,C1,0,0,0); SBAR(); \
    l_reg+=sacc; \
    if(GK){DMA_K((t)+3,sl_cur);} if(GV){DMA_V((t)+1,sl_next);} \
    CMASK(C0,C1,t); \
    { float a=MX3(C0[0],C0[1],C1[0]),b=MX3(C0[2],C0[3],C1[1]); a=MX3(a,C1[2],C1[3]); \
      _Pragma("unroll") for(int r=4;r<16;r+=4){a=MX3(a,C0[r],C0[r+1]);b=MX3(b,C0[r+2],C0[r+3]);a=MX3(a,C1[r],C1[r+1]);b=MX3(b,C1[r+2],C1[r+3]);} \
      float rm=__builtin_fmaxf(a,b); { auto rr=__builtin_amdgcn_permlane32_swap(__float_as_uint(rm),__float_as_uint(rm),false,false); rm=__builtin_fmaxf(__uint_as_float(rr[0]),__uint_as_float(rr[1])); } \
      resc=false; \
      if(__builtin_expect(__any(rm>(float)THRL),0)){ const float dl=__builtin_fmaxf(rm,0.f); mhat+=dl; \
        _Pragma("unroll") for(int r=0;r<16;++r){C0[r]-=dl;C1[r]-=dl;} \
        qx=make_qx(mhat,hi); \
        const float f=__builtin_amdgcn_exp2f(-dl); l_reg*=f; if(hi==0)wsf[r32]=f; resc=true; } } \
    SBAR(); \
    GAPB(o[0]=__builtin_amdgcn_mfma_f32_32x32x16_bf16(PAF(0),VFR(0),o[0],0,0,0), C0,0); \
    GAPB(o[1]=__builtin_amdgcn_mfma_f32_32x32x16_bf16(PAF(0),VFR(4),o[1],0,0,0), C0,4); \
    KRD(GL,0); GAPB(o[0]=__builtin_amdgcn_mfma_f32_32x32x16_bf16(PAF(1),VFR(1),o[0],0,0,0), C0,8); \
    KRD(GL,1); GAPB(o[1]=__builtin_amdgcn_mfma_f32_32x32x16_bf16(PAF(1),VFR(5),o[1],0,0,0), C0,12); \
    KRD(GL,2); GAPB(o[0]=__builtin_amdgcn_mfma_f32_32x32x16_bf16(PAF(2),VFR(2),o[0],0,0,0), C1,0); \
    KRD(GL,3); GAPB(o[1]=__builtin_amdgcn_mfma_f32_32x32x16_bf16(PAF(2),VFR(6),o[1],0,0,0), C1,4); \
    GAPB(o[0]=__builtin_amdgcn_mfma_f32_32x32x16_bf16(PAF(3),VFR(3),o[0],0,0,0), C1,8); \
    GAPB(o[1]=__builtin_amdgcn_mfma_f32_32x32x16_bf16(PAF(3),VFR(7),o[1],0,0,0), C1,12); \
    }while(0)
  int t=1;
  #undef CMASK
  #define CMASK(P0,P1,t) do{}while(0)
  for(;t+5<NT;t+=2){
    STEP(pB0,pB1,pA0,pA1,t,true,true,true);     WAIT_BAR(2); RESC(); ROT();
    STEP(pA0,pA1,pB0,pB1,t+1,true,true,true);   WAIT_BAR(2); RESC(); ROT();
  }
  #undef CMASK
  #define CMASK(P0,P1,t) do{int jb_=(t)-(NT-4); if(jb_>=0)cmask(P0,P1,jb_,qrel,hi);}while(0)
  #define ENDW(tt) do{ if((tt)+3<NT){WAIT_BAR(2);} else if((tt)+2<NT){WAIT_BAR(1);} else {WAIT_BAR(0);} }while(0)
  for(;t+1<NT;t+=2){
    STEP(pB0,pB1,pA0,pA1,t,(t+3<NT),(t+1<NT),(t+1<NT));       ENDW(t);   RESC(); ROT();
    STEP(pA0,pA1,pB0,pB1,t+1,(t+4<NT),(t+2<NT),(t+2<NT));     ENDW(t+1); RESC(); ROT();
  }
  STEP(pB0,pB1,pA0,pA1,NT-1,false,false,false); RESC();
  { float sacc=pB0[0]+pB0[1]; _Pragma("unroll") for(int r=2;r<16;++r)sacc+=pB0[r]; _Pragma("unroll") for(int r=0;r<16;++r)sacc+=pB1[r]; l_reg+=sacc;
    pw0=(u32x4){PKW(pB0,0),PKW(pB0,2),PKW(pB0,4),PKW(pB0,6)};pw1=(u32x4){PKW(pB0,8),PKW(pB0,10),PKW(pB0,12),PKW(pB0,14)};pw2=(u32x4){PKW(pB1,0),PKW(pB1,2),PKW(pB1,4),PKW(pB1,6)};pw3=(u32x4){PKW(pB1,8),PKW(pB1,10),PKW(pB1,12),PKW(pB1,14)};
    SBAR(); pv(o,vb0+sl_cur,PAF(0),PAF(1),PAF(2),PAF(3)); }
  #undef PKW
  #undef PAF
  #undef VFR
  #undef PIN
  #undef MX3
  #undef GAPA
  #undef GAPB
  #undef EX
  #undef VRD
  #undef KRD
  #undef STEP
  #undef ENDW
  {auto rr=__builtin_amdgcn_permlane32_swap(__float_as_uint(l_reg),__float_as_uint(l_reg),false,false);l_reg=__uint_as_float(rr[0])+__uint_as_float(rr[1]);}
  if(hi==0)wsf[32+r32]=l_reg;asm volatile("s_waitcnt lgkmcnt(0)":::"memory");
  float rli[16];
  #pragma unroll
  for(int r=0;r<16;++r)rli[r]=__builtin_amdgcn_rcpf(wsf[32+crow(r,hi)]);
  bf16*Ow=O+(rowbase+q0+wid*QBLK)*OPITCH+h*D;
  { bf16*stg=(bf16*)(shm+LDS_OST)+wid*2048;
    #pragma unroll
    for(int r=0;r<16;++r){const int orow=crow(r,hi);
      #pragma unroll
      for(int d0=0;d0<2;++d0)stg[orow*64+d0*32+r32]=__float2bfloat16(o[d0][r]*rli[r]);}
    asm volatile("s_waitcnt lgkmcnt(0)":::"memory");
    #pragma unroll
    for(int i=0;i<4;++i){const int row=i*8+(lane>>3),ch=lane&7; const u32x4 v=*(const u32x4*)(stg+row*64+ch*8); ATTN_STORE16(Ow+(long)row*OPITCH+ch*8,v);} }
  asm volatile("s_waitcnt lgkmcnt(0)\n\ts_barrier":::"memory");
  #undef DMA_K
  #undef DMA_V
  #undef CMASK
  #undef START
  #undef RESC
  #undef ROT
}
constexpr int ATTN_LDS_BYTES=LDS_BYTES;
#undef SBAR
#undef WAIT_BAR
}

namespace ret_body {
constexpr int VT_P = 272, KT_P = 272, ST_P = 144, PW_P = 272;
constexpr int KC_P = 144;
constexpr int L_VT = 0, L_KT = L_VT + 128 * VT_P, L_ST = L_KT + 64 * KT_P, L_PW = L_ST + 128 * ST_P, PW_BYTES = 16 * PW_P, L_KC = L_PW + 8 * PW_BYTES, LDS_BYTES = L_KC + 128 * KC_P;
typedef short bf16x8 __attribute__((ext_vector_type(8)));
typedef float f32x4 __attribute__((ext_vector_type(4)));
#define dpp_f(v, ctrl) __int_as_float(__builtin_amdgcn_update_dpp(0, __float_as_int(v), (ctrl), 0xF, 0xF, false))
#define RB_MFMA(a, b, c) __builtin_amdgcn_mfma_f32_16x16x32_bf16(__builtin_bit_cast(bf16x8, a), __builtin_bit_cast(bf16x8, b), c, 0, 0, 0)
__device__ __forceinline__ void ret_unit(LAS unsigned char* L, int b, int h, const bf16* RQ, const bf16* RK, const bf16* RVT, const bf16* RKT, const bf16* RGS, bf16* BR, int wave, int c0 = 0, int c1 = SEQ / 128, int pf0 = 0) {
    int tid = wave * 64 + lane_now(); asm volatile("" : "+v"(tid));
    const int lane = tid & 63, w = __builtin_amdgcn_readfirstlane(tid >> 6), r = lane & 15, q = lane >> 4;
    const float lg2 = log1pf(-exp2f(-5.f - (float)h)) * LOG2E;
    const float cd = __builtin_amdgcn_exp2f(128.f * lg2);
    unsigned z0 = 0u; asm volatile("" : "+v"(z0));
    f32x4 S[4];
#pragma unroll
    for (int i = 0; i < 4; ++i) { const float zf = __uint_as_float(z0); S[i] = (f32x4){zf, zf, zf, zf}; }
    for (int i = tid * 16; i < 128 * ST_P; i += NWAVES * 64 * 16) *(LAS v4u*)(L + L_ST + i) = (v4u){z0, z0, z0, z0};
    LAS unsigned char* Pw = L + L_PW + w * PW_BYTES;
    v4u pv[4], pkt[2], pkc[2], pq[2];
    const int t16 = tid & 15, trow = tid >> 4;
#define RB_LOAD(cc) do { const size_t r0_ = (size_t)b * SEQ + (size_t)(cc) * 128; const size_t it_ = (size_t)((b * 4 + h) * 16 + (cc)); \
        _Pragma("unroll") for (int j = 0; j < 4; ++j) pv[j] = *(const v4u*)(RVT + it_ * 16384 + (size_t)(32 * j + trow) * 128 + 8 * t16); \
        _Pragma("unroll") for (int j = 0; j < 2; ++j) pkt[j] = *(const v4u*)(RKT + it_ * 8192 + (size_t)(32 * j + trow) * 128 + 8 * t16); \
        _Pragma("unroll") for (int j = 0; j < 2; ++j) pkc[j] = *(const v4u*)(RK + (r0_ + 64 * j + (tid >> 3)) * 256 + h * 64 + 8 * (tid & 7)); \
        _Pragma("unroll") for (int ks = 0; ks < 2; ++ks) pq[ks] = *(const v4u*)(RQ + (r0_ + 16 * w + r) * 256 + h * 64 + 32 * ks + 8 * q); } while (0)
    RB_LOAD(0);
    for (int c = 0; c < c1; ++c) {
        const int pf = pf0 | ((c < c0) ? 3 : 0);
        const size_t row0 = (size_t)b * SEQ + (size_t)c * 128;
        float lg2c = lg2; asm volatile("" : "+v"(lg2c));
        if (!(pf & 8)) {
#pragma unroll
        for (int j = 0; j < 4; ++j) *(LAS v4u*)(L + L_VT + (32 * j + trow) * VT_P + 16 * t16) = pv[j];
#pragma unroll
        for (int j = 0; j < 2; ++j) *(LAS v4u*)(L + L_KT + (32 * j + trow) * KT_P + 16 * t16) = pkt[j];
        if (!(pf & 2)) {
#pragma unroll
        for (int j = 0; j < 2; ++j) *(LAS v4u*)(L + L_KC + (64 * j + (tid >> 3)) * KC_P + 16 * (tid & 7)) = pkc[j];
        }
        }
        v4u qf[2]; qf[0] = pq[0]; qf[1] = pq[1];
        __syncthreads();
        const float fdec = __builtin_amdgcn_exp2f((float)(16 * w + 4 * q - r) * lg2c);
        const float g1 = __builtin_amdgcn_exp2f(lg2c), g2 = g1 * g1, g3 = g2 * g1; float gm16[8];
        { const float gi = __builtin_amdgcn_exp2f(-16.f * lg2c); gm16[0] = 1.f;
#pragma unroll
          for (int j = 1; j < 8; ++j) gm16[j] = gm16[j - 1] * gi; }
        if (!(pf & 2)) {
#pragma unroll
        for (int jh = 0; jh < 2; ++jh) {
        v4u kk0[4], kk1[4];
#pragma unroll
        for (int jj = 0; jj < 4; ++jj) { const int jb = 4 * jh + jj; if (jb <= w) { kk0[jj] = *(const LAS v4u*)(L + L_KC + (16 * jb + r) * KC_P + 16 * q); kk1[jj] = *(const LAS v4u*)(L + L_KC + (16 * jb + r) * KC_P + 64 + 16 * q); } }
        __builtin_amdgcn_sched_barrier(0);
#pragma unroll
        for (int jj = 0; jj < 4; ++jj) { const int jb = 4 * jh + jj;
            if (jb <= w) {
                const v4u k0 = kk0[jj], k1 = kk1[jj];
                f32x4 acc = (f32x4){0.f, 0.f, 0.f, 0.f};
                acc = RB_MFMA(qf[0], k0, acc); acc = RB_MFMA(qf[1], k1, acc);
                const float f0 = fdec * gm16[jb];
                acc[0] *= f0; acc[1] *= f0 * g1; acc[2] *= f0 * g2; acc[3] *= f0 * g3;
                if (jb == w) {
#pragma unroll
                    for (int e = 0; e < 4; ++e) acc[e] = (4 * q - r + e >= 0) ? acc[e] : 0.f; }
                const unsigned p01 = cvt_pk_bf16(acc[0], acc[1]), p23 = cvt_pk_bf16(acc[2], acc[3]);
                LAS unsigned char* pp = Pw + (4 * q) * PW_P + (16 * jb + r) * 2;
                *(LAS unsigned short*)(pp) = (unsigned short)p01; *(LAS unsigned short*)(pp + PW_P) = (unsigned short)(p01 >> 16);
                *(LAS unsigned short*)(pp + 2 * PW_P) = (unsigned short)p23; *(LAS unsigned short*)(pp + 3 * PW_P) = (unsigned short)(p23 >> 16);
            } else if (jb == w + 1 && (w & 1) == 0) {
                LAS unsigned char* pp = Pw + (4 * q) * PW_P + (16 * jb + r) * 2;
                *(LAS unsigned short*)(pp) = 0; *(LAS unsigned short*)(pp + PW_P) = 0; *(LAS unsigned short*)(pp + 2 * PW_P) = 0; *(LAS unsigned short*)(pp + 3 * PW_P) = 0;
            }
        }
        __builtin_amdgcn_sched_barrier(0); }
        }
        LDS_WAIT(); asm volatile("" ::: "memory");
        if (c + 1 < c1) RB_LOAD(c + 1);
        if (!(pf & 2)) {
        v4u pg[4];
        { const size_t grow_ = row0 + 16 * w + (lane >> 4);
#pragma unroll
          for (int i = 0; i < 4; ++i) pg[i] = *(const v4u*)(RGS + (grow_ + 4 * i) * 512 + h * 128 + 8 * (lane & 15)); }
        f32x4 oi[8];
#pragma unroll
        for (int d = 0; d < 8; ++d) oi[d] = (f32x4){0.f, 0.f, 0.f, 0.f};
#pragma unroll
        for (int ks = 0; ks < 4; ++ks) {
            if (2 * ks <= w && !(pf & 2)) { const v4u pa = *(const LAS v4u*)(Pw + r * PW_P + (32 * ks + 8 * q) * 2); v4u vb[8];
#pragma unroll
                for (int d = 0; d < 8; ++d) vb[d] = *(const LAS v4u*)(L + L_VT + (16 * d + r) * VT_P + (32 * ks + 8 * q) * 2);
                __builtin_amdgcn_sched_barrier(0);
#pragma unroll
                for (int d = 0; d < 8; ++d) oi[d] = RB_MFMA(pa, vb[d], oi[d]);
                __builtin_amdgcn_sched_barrier(0); }
        }
        { const float rfq = __builtin_amdgcn_exp2f((float)(16 * w + r + 1) * lg2);
#pragma unroll
          for (int ks = 0; ks < 2; ++ks) { v4u sb[8], qs;
#pragma unroll
            for (int wd = 0; wd < 4; ++wd) qs[wd] = cvt_pk_bf16(bflo(qf[ks][wd]) * rfq, bfhi(qf[ks][wd]) * rfq);
#pragma unroll
            for (int d = 0; d < 8; ++d) sb[d] = *(const LAS v4u*)(L + L_ST + (16 * d + r) * ST_P + (32 * ks + 8 * q) * 2);
            __builtin_amdgcn_sched_barrier(0);
#pragma unroll
            for (int d = 0; d < 8; ++d) oi[d] = RB_MFMA(qs, sb[d], oi[d]);
            __builtin_amdgcn_sched_barrier(0); } }
        float ss[4];
#pragma unroll
        for (int e = 0; e < 4; ++e) ss[e] = 0.f;
#pragma unroll
        for (int d = 0; d < 8; ++d)
#pragma unroll
            for (int e = 0; e < 4; ++e) ss[e] += oi[d][e] * oi[d][e];
#pragma unroll
        for (int e = 0; e < 4; ++e) { float s = ss[e]; s += dpp_f(s, 0xB1); s += dpp_f(s, 0x4E); s += dpp_f(s, 0x141); s += dpp_f(s, 0x140); ss[e] = 1.f / sqrtf(s * (1.f / 128.f) + EPS); }
#pragma unroll
        for (int d = 0; d < 8; ++d) { const unsigned p01 = cvt_pk_bf16(oi[d][0] * ss[0], oi[d][1] * ss[1]), p23 = cvt_pk_bf16(oi[d][2] * ss[2], oi[d][3] * ss[3]);
            LAS unsigned char* pp = Pw + (4 * q) * PW_P + (16 * d + r) * 2;
            *(LAS unsigned short*)(pp) = (unsigned short)p01; *(LAS unsigned short*)(pp + PW_P) = (unsigned short)(p01 >> 16);
            *(LAS unsigned short*)(pp + 2 * PW_P) = (unsigned short)p23; *(LAS unsigned short*)(pp + 3 * PW_P) = (unsigned short)(p23 >> 16); }
        LDS_WAIT(); asm volatile("" ::: "memory");
        { const int orow = lane >> 4, oc = lane & 15; const size_t grow = row0 + 16 * w + orow;
#pragma unroll
          for (int i = 0; i < 4; ++i) { const v4u ov = *(const LAS v4u*)(Pw + (orow + 4 * i) * PW_P + 16 * oc); const v4u gv = pg[i];
              v4u o;
#pragma unroll
              for (int wd = 0; wd < 4; ++wd) o[wd] = cvt_pk_bf16(bflo(ov[wd]) * bflo(gv[wd]), bfhi(ov[wd]) * bfhi(gv[wd]));
              if (!(pf & 1)) *(v4u*)(BR + (grow + 4 * i) * 1024 + 512 + h * 128 + 8 * oc) = o; } }
        }
        if (!(pf & 2)) __syncthreads();
#pragma unroll
        for (int i = 0; i < 4; ++i) S[i] = S[i] * cd;
        if (!(pf & 4))
#pragma unroll
        for (int ks = 0; ks < 4; ++ks) { const v4u vb = *(const LAS v4u*)(L + L_VT + (16 * w + r) * VT_P + (32 * ks + 8 * q) * 2); v4u ka[4];
#pragma unroll
            for (int i = 0; i < 4; ++i) ka[i] = *(const LAS v4u*)(L + L_KT + (16 * i + r) * KT_P + (32 * ks + 8 * q) * 2);
            __builtin_amdgcn_sched_barrier(0);
#pragma unroll
            for (int i = 0; i < 4; ++i) S[i] = RB_MFMA(ka[i], vb, S[i]);
            __builtin_amdgcn_sched_barrier(0); }
#pragma unroll
        for (int i = 0; i < 4; ++i) { v2u sv; sv.x = cvt_pk_bf16(S[i][0], S[i][1]); sv.y = cvt_pk_bf16(S[i][2], S[i][3]); *(LAS v2u*)(L + L_ST + (16 * w + r) * ST_P + (16 * i + 4 * q) * 2) = sv; }
        __syncthreads();
    }
}
#undef RB_MFMA
#undef dpp_f
#undef RB_LOAD
}

struct TrItem { const float* src; bf16* dst; int ldw, K, base, mul, gu, f8; };
__device__ __forceinline__ int tr_row(const TrItem& t, int n) { if (t.gu) { const int a = t.base + (n >> 1), b = n & 1; return 256 * (a >> 7) + 128 * b + (a & 127); } return t.base + t.mul * n; }
__device__ __forceinline__ void tr_load(const TrItem& t, f32x4 (&v)[8], int lane) {
    const float* p = t.src + (size_t)(lane >> 3) * t.ldw + 4 * (lane & 7);
#pragma unroll
    for (int i = 0; i < 8; ++i) v[i] = *(const GAS f32x4*)(p + (size_t)(8 * i) * t.ldw);
}
__device__ __forceinline__ void tr_store(const TrItem& t, const f32x4 (&v)[8], LAS float* scr, int lane) {
    { LAS float* w = scr + (lane >> 3) * 33 + 4 * (lane & 7);
#pragma unroll
      for (int i = 0; i < 8; ++i) { w[(8 * i) * 33 + 0] = v[i][0]; w[(8 * i) * 33 + 1] = v[i][1]; w[(8 * i) * 33 + 2] = v[i][2]; w[(8 * i) * 33 + 3] = v[i][3]; } }
    LDS_WAIT(); asm volatile("" ::: "memory");
    const int c = lane & 7;
#pragma unroll
    for (int j = 0; j < 4; ++j) { const int n = (lane >> 3) + 8 * j; const LAS float* s = scr + (8 * c) * 33 + n;
        if (t.f8) { const f32x4 a = {s[0 * 33] * WSCALE, s[1 * 33] * WSCALE, s[2 * 33] * WSCALE, s[3 * 33] * WSCALE}, b = {s[4 * 33] * WSCALE, s[5 * 33] * WSCALE, s[6 * 33] * WSCALE, s[7 * 33] * WSCALE};
            *(GAS v2u*)((unsigned char*)t.dst + (size_t)tr_row(t, n) * t.K + 8 * c) = pack8_fp8(a, b); }
        else { v4u o; o.x = cvt_pk_bf16(s[0 * 33], s[1 * 33]); o.y = cvt_pk_bf16(s[2 * 33], s[3 * 33]); o.z = cvt_pk_bf16(s[4 * 33], s[5 * 33]); o.w = cvt_pk_bf16(s[6 * 33], s[7 * 33]);
            *(GAS v4u*)(t.dst + (size_t)tr_row(t, n) * t.K + 8 * c) = o; } }
    LDS_WAIT(); asm volatile("" ::: "memory");
}
__device__ __forceinline__ void tr_store2(const TrItem& t0, const f32x4 (&v0)[8], const TrItem& t1, const f32x4 (&v1)[8], LAS float* s0, LAS float* s1, int lane) {
    { LAS float* w0 = s0 + (lane >> 3) * 33 + 4 * (lane & 7); LAS float* w1 = s1 + (lane >> 3) * 33 + 4 * (lane & 7);
#pragma unroll
      for (int i = 0; i < 8; ++i) { w0[(8 * i) * 33 + 0] = v0[i][0]; w0[(8 * i) * 33 + 1] = v0[i][1]; w0[(8 * i) * 33 + 2] = v0[i][2]; w0[(8 * i) * 33 + 3] = v0[i][3];
                                    w1[(8 * i) * 33 + 0] = v1[i][0]; w1[(8 * i) * 33 + 1] = v1[i][1]; w1[(8 * i) * 33 + 2] = v1[i][2]; w1[(8 * i) * 33 + 3] = v1[i][3]; } }
    LDS_WAIT(); asm volatile("" ::: "memory");
    const int c = lane & 7;
#pragma unroll
    for (int u = 0; u < 2; ++u) { const TrItem& t = u ? t1 : t0; const LAS float* sb = u ? s1 : s0;
#pragma unroll
        for (int j = 0; j < 4; ++j) { const int n = (lane >> 3) + 8 * j; const LAS float* s = sb + (8 * c) * 33 + n;
            if (t.f8 == 1) { const f32x4 a = {s[0 * 33] * WSCALE, s[1 * 33] * WSCALE, s[2 * 33] * WSCALE, s[3 * 33] * WSCALE}, b = {s[4 * 33] * WSCALE, s[5 * 33] * WSCALE, s[6 * 33] * WSCALE, s[7 * 33] * WSCALE};
                *(GAS v2u*)((unsigned char*)t.dst + (size_t)tr_row(t, n) * t.K + 8 * c) = pack8_fp8(a, b); }
            else { v4u o; o.x = cvt_pk_bf16(s[0 * 33], s[1 * 33]); o.y = cvt_pk_bf16(s[2 * 33], s[3 * 33]); o.z = cvt_pk_bf16(s[4 * 33], s[5 * 33]); o.w = cvt_pk_bf16(s[6 * 33], s[7 * 33]);
                *(GAS v4u*)(t.dst + (size_t)tr_row(t, n) * t.K + 8 * c) = o; } } }
    LDS_WAIT(); asm volatile("" ::: "memory");
}
constexpr int TR_IN = 96 * 16, TR_MG = 64 * 16, TR_BR = 2 * 32 * 8, TR_O = 32 * 16, TR_PG = 32 * 16, TR_PP = 32 * 4, TR_GU = 32 * 64 * 16, TR_DN = 32 * 32 * 16;
constexpr int TR_ITEMS = TR_IN + TR_MG + TR_BR + TR_O + TR_PG + TR_PP + TR_GU + TR_DN;
__device__ __forceinline__ TrItem tr_decode(Frame& F, int it) {
    TrItem t; t.mul = 1; t.gu = 0; t.f8 = 0; int r = it;
    if (r < TR_GU) { const int e = r >> 10, rr = r & 1023, kb = rr >> 6, blk = rr & 63;
        t.src = (F.ap->in[12]) + (size_t)e * 1024 * 2048 + (size_t)(64 * kb) * 2048 + 32 * blk; t.ldw = 2048; t.dst = (bf16*)(WSP(unsigned char, WS_WGUT) + (size_t)e * 2048 * 1024 + 64 * kb); t.K = 1024; t.base = 16 * blk; t.gu = 1; t.f8 = 1; return t; } r -= TR_GU;
    if (r < TR_DN) { const int e = r >> 9, rr = r & 511, kb = rr >> 5, blk = rr & 31;
        t.src = (F.ap->in[14]) + (size_t)e * 1024 * 1024 + (size_t)(64 * kb) * 1024 + 32 * blk; t.ldw = 1024; t.dst = (bf16*)(WSP(unsigned char, WS_WDT) + (size_t)e * 1024 * 1024 + 64 * kb); t.K = 1024; t.base = 32 * blk; t.f8 = 1; return t; } r -= TR_DN;
    if (r < TR_IN) { const int kb = r / 96, blk = r % 96; int s0;
        if (blk < 32) { s0 = 32 * blk; t.base = 32 * blk; t.f8 = 1; }
        else if (blk < 48) { s0 = 32 * blk; t.base = 32 * (blk - 32); }
        else if (blk < 64) { s0 = 2056 + 32 * (blk - 48); t.base = 1024 + 32 * (blk - 48); }
        else if (blk < 80) { s0 = 2568 + 32 * (blk - 64); t.base = 1536 + 32 * (blk - 64); }
        else { const int hb = (blk - 80) & 7, head = hb >> 1, half = hb & 1, isk = (blk >= 88); s0 = (isk ? 1800 : 1544) + head * 64 + half * 32; t.base = (isk ? 768 : 512) + head * 64 + half; t.mul = 2; }
        t.src = (F.ap->in[3]) + (size_t)(64 * kb) * INW + s0; t.ldw = INW; t.dst = t.f8 ? (bf16*)(WSP(unsigned char, WS_WG8T) + 64 * kb) : WSP(bf16, WS_W1T) + 64 * kb; t.K = 1024; return t; } r -= TR_IN;
    if (r < TR_MG) { const int kb = r >> 6, blk = r & 63; t.src = (F.ap->in[6]) + (size_t)(64 * kb) * 2048 + 32 * blk; t.ldw = 2048; t.dst = (bf16*)(WSP(unsigned char, WS_WG8T) + 64 * kb); t.K = 1024; t.base = 1024 + 32 * blk; t.f8 = 1; return t; } r -= TR_MG;
    if (r < TR_BR) { const int gsel = r >> 8, rr = r & 255, kb = rr >> 5, blk = rr & 31;
        t.src = (F.ap->in[5]) + (size_t)gsel * 512 * 1024 + (size_t)(64 * kb) * 1024 + 32 * blk; t.ldw = 1024; t.dst = WSP(bf16, WS_WBT) + gsel * 512 + 64 * kb; t.K = 1024; t.base = 32 * blk; return t; } r -= TR_BR;
    if (r < TR_O) { const int kb = r >> 5, blk = r & 31; t.src = (F.ap->in[8]) + (size_t)(64 * kb) * 1024 + 32 * blk; t.ldw = 1024; t.dst = WSP(bf16, WS_WOT) + 64 * kb; t.K = 1024; t.base = 32 * blk; return t; } r -= TR_O;
    if (r < TR_PG) { const int kb = r >> 5, blk = r & 31; t.src = (F.ap->in[17]) + (size_t)(64 * kb) * 1024 + 32 * blk; t.ldw = 1024; t.dst = (bf16*)(WSP(unsigned char, WS_WPGT) + 64 * kb); t.K = 1024; t.base = 32 * blk; t.f8 = 1; return t; } r -= TR_PG;
    { const int kb = r >> 5, blk = r & 31; t.src = (F.ap->in[18]) + (size_t)(64 * kb) * 1024 + 32 * blk; t.ldw = 1024; t.dst = WSP(bf16, WS_WPPT) + 64 * kb; t.K = 256; t.base = 32 * blk; return t; }
}

__device__ __forceinline__ void p0_row(Frame& F, int m, f32x4 (&v)[4], LAS const float* WFt, int lane) {
    float s = 0.f;
#pragma unroll
    for (int j = 0; j < 4; ++j) s += (v[j].x * v[j].x + v[j].y * v[j].y) + (v[j].z * v[j].z + v[j].w * v[j].w);
    const float rstd = 1.f / sqrtf(wave_sum(s) * (1.f / DM) + EPS);
    GAS unsigned long long* o8 = (GAS unsigned long long*)(WSP(bf16, WS_XN) + (size_t)m * DM) + lane;
    GAS int* q8 = (GAS int*)(WSP(unsigned char, WS_XN8) + (size_t)m * DM) + lane;
#pragma unroll
    for (int j = 0; j < 4; ++j) { const f32x4 g = ((const GAS f32x4*)(F.ap->in[2]))[lane + 64 * j]; v[j] = v[j] * rstd * g;
        o8[64 * j] = (unsigned long long)cvt_pk_bf16(v[j].x, v[j].y) | ((unsigned long long)cvt_pk_bf16(v[j].z, v[j].w) << 32);
        { int w = 0; w = __builtin_amdgcn_cvt_pk_fp8_f32(clamp_f8(v[j].x), clamp_f8(v[j].y), w, false); w = __builtin_amdgcn_cvt_pk_fp8_f32(clamp_f8(v[j].z), clamp_f8(v[j].w), w, true); q8[64 * j] = w; } }
    float fa[8];
#pragma unroll
    for (int c = 0; c < 8; ++c) { float a = 0.f;
#pragma unroll
        for (int j = 0; j < 4; ++j) { const f32x4 w = *(const LAS f32x4*)(WFt + c * 1024 + 256 * j + 4 * lane); a += (v[j].x * w.x + v[j].y * w.y) + (v[j].z * w.z + v[j].w * w.w); }
        fa[c] = wave_sum(a); }
    float z = fa[0];
#pragma unroll
    for (int c = 1; c < 8; ++c) z = (lane == c) ? fa[c] : z;
    if (lane < 8) { z += (F.ap->in[4])[lane]; WSP(float, WS_LOGF)[(size_t)m * 8 + lane] = fminf(z, 0.f) - log1pf(expf(-fabsf(z))); }
}
__device__ __forceinline__ void p0_prologue(Frame& F) {
    LAS float* WFt = (LAS float*)(F.lds + RING_OFF);
    for (int idx = F.tid; idx < 8192; idx += NWAVES * 64) { const int k = idx >> 3, c = idx & 7; WFt[c * 1024 + k] = (F.ap->in[3])[(size_t)k * INW + 1536 + c]; }
    __syncthreads();
    const int gw = F.vcu * NWAVES + F.wave, NGW = F.G * NWAVES, lane = F.lane;
#ifndef P0_REP_ROWS
#define P0_REP_ROWS 1
#endif
#ifndef P0_REP_TR
#define P0_REP_TR 1
#endif
#ifndef P0_REP_ROWS
#define P0_REP_ROWS 1
#endif
#ifndef P0_REP_TR
#define P0_REP_TR 1
#endif
    for (int rep_ = 0; rep_ < P0_REP_ROWS; ++rep_)
    { f32x4 va[4], vb[4]; int m = gw;
      if (m < NT) {
#pragma unroll
          for (int j = 0; j < 4; ++j) va[j] = ((const GAS f32x4*)((F.ap->in[0]) + (size_t)m * DM))[lane + 64 * j]; }
      for (; m < NT; m += NGW) { const int m2 = m + NGW;
          if (m2 < NT) {
#pragma unroll
              for (int j = 0; j < 4; ++j) vb[j] = ((const GAS f32x4*)((F.ap->in[0]) + (size_t)m2 * DM))[lane + 64 * j]; }
          __builtin_amdgcn_sched_barrier(0);
          p0_row(F, m, va, WFt, lane);
          __builtin_amdgcn_sched_barrier(0);
#pragma unroll
          for (int j = 0; j < 4; ++j) va[j] = vb[j];
      } }
    __syncthreads();
    for (int rep_ = 0; rep_ < P0_REP_TR; ++rep_)
    { LAS float* scr = (LAS float*)(F.lds + RING_OFF + F.wave * 8704);
      constexpr int TR_P0_END = TR_GU + TR_DN + TR_IN + TR_MG;
      int it = TR_GU + TR_DN + gw; f32x4 cur[8], nxt[8]; TrItem tc, tn;
      if (it < TR_P0_END) { tc = tr_decode(F, it); tr_load(tc, cur, lane); }
      while (it < TR_P0_END) {
          const int itn = it + NGW; const bool hn = itn < TR_P0_END;
          if (hn) { tn = tr_decode(F, itn); tr_load(tn, nxt, lane); }
          tr_store(tc, cur, scr, lane);
          if (hn) { tc = tn;
#pragma unroll
              for (int i = 0; i < 8; ++i) cur[i] = nxt[i]; }
          it = itn;
      } }
    const int gt = F.vcu * (NWAVES * 64) + F.tid, NGT = F.G * NWAVES * 64;
    { float* rot = WSP(float, WS_ROT);
      for (int i = gt; i < SEQ * 32; i += NGT) { const int pos = i >> 5, j = i & 31;
          const float inv = powf(10000.f, -(float)j / 32.f); const float ang = (float)pos * inv;
          double rev = (double)ang * 0.15915494309189535; rev -= floor(rev); const float fr = (float)rev;
          rot[i] = __builtin_amdgcn_cosf(fr); rot[SEQ * 32 + i] = __builtin_amdgcn_sinf(fr); } }
    { bf16* wrt = WSP(bf16, WS_WRT);
      for (int i = gt; i < 1024 * 32; i += NGT) { const int k = i >> 5, n = i & 31; const float v = (F.ap->in[10])[i]; const unsigned hi = f2bf(v); const float rem = v - __uint_as_float(hi << 16);
          wrt[n * 1024 + k] = (bf16)hi; wrt[32768 + n * 1024 + k] = (bf16)f2bf(rem); } }
    if (gt < 64) { GAS v4u* z = (GAS v4u*)(WSP(unsigned char, WS_HB) + (size_t)NT * DM); z[gt] = (v4u){0u, 0u, 0u, 0u}; }
}

constexpr int CONV_ITEMS = 64, CONV_TR_ITEMS = TR_ITEMS - TR_IN - TR_MG, CONV_TR_CHUNKS = CONV_TR_ITEMS / CONV_ITEMS, CONV_PB_CHUNKS = NT * PLE / 4 / 16384, CONV_CHUNKS = CONV_TR_CHUNKS + CONV_PB_CHUNKS;
static_assert(CONV_TR_ITEMS % CONV_ITEMS == 0 && (TR_GU + TR_DN) % CONV_ITEMS == 0 && (NT * PLE / 4) % 16384 == 0, "whole chunks");
__device__ __forceinline__ TrItem conv_decode(Frame& F, int ci) { return tr_decode(F, ci < TR_GU + TR_DN ? ci : ci + TR_IN + TR_MG); }
__device__ __forceinline__ void conv_chunk(Frame& F, int c) {
    int lane = lane_now(); asm volatile("" : "+v"(lane));
    if (c >= CONV_TR_CHUNKS) {
        const int j = c - CONV_TR_CHUNKS, t = F.wave * 64 + lane;
        const GAS f32x4* ps = (const GAS f32x4*)(F.ap->in[1]) + (size_t)j * 16384 + t; GAS unsigned long long* pd = (GAS unsigned long long*)WSP(bf16, WS_PB) + (size_t)j * 16384 + t;
        for (int b = 0; b < 4; ++b) { f32x4 v[8];
#pragma unroll
            for (int u = 0; u < 8; ++u) v[u] = ps[b * 4096 + u * 512];
#pragma unroll
            for (int u = 0; u < 8; ++u) pd[b * 4096 + u * 512] = (unsigned long long)cvt_pk_bf16(v[u].x, v[u].y) | ((unsigned long long)cvt_pk_bf16(v[u].z, v[u].w) << 32); }
        return; }
    LAS float* scr = (LAS float*)(F.lds + RING_OFF + F.wave * 17408); LAS float* scr1 = scr + 2176;
    static_assert(NWAVES * 17408 <= SCH_OFF - RING_OFF, "conversion scratch inside ring + table region");
    const int base = c * CONV_ITEMS + F.wave;
    f32x4 a0[8], a1[8], b0[8], b1[8], c0[8], c1[8]; TrItem ta0, ta1, tb0, tb1, tc0, tc1;
    constexpr int NPAIR = CONV_ITEMS / NWAVES / 2;
    ta0 = conv_decode(F, base); ta1 = conv_decode(F, base + NWAVES); tr_load(ta0, a0, lane); tr_load(ta1, a1, lane);
    tb0 = conv_decode(F, base + 2 * NWAVES); tb1 = conv_decode(F, base + 3 * NWAVES); tr_load(tb0, b0, lane); tr_load(tb1, b1, lane);
    tc0 = tb0; tc1 = tb1;
#pragma unroll
    for (int i = 0; i < 8; ++i) { c0[i] = b0[i]; c1[i] = b1[i]; }
    for (int k = 0; k < NPAIR; ++k) {
        if (k + 2 < NPAIR) { tc0 = conv_decode(F, base + NWAVES * (2 * k + 4)); tc1 = conv_decode(F, base + NWAVES * (2 * k + 5)); tr_load(tc0, c0, lane); tr_load(tc1, c1, lane); }
        __builtin_amdgcn_sched_barrier(0);
        tr_store2(ta0, a0, ta1, a1, scr, scr1, lane);
        __builtin_amdgcn_sched_barrier(0);
        ta0 = tb0; ta1 = tb1; tb0 = tc0; tb1 = tc1;
#pragma unroll
        for (int i = 0; i < 8; ++i) { a0[i] = b0[i]; a1[i] = b1[i]; b0[i] = c0[i]; b1[i] = c1[i]; }
    }
}

__device__ __forceinline__ void cum_scan(Frame& F, int bh) {
    const float* lf = WSP(float, WS_LOGF); float* cum = WSP(float, WS_CUM);
    const int b = bh >> 3, h = bh & 7, t0 = 4 * F.tid;
    double a0 = lf[((size_t)(b * SEQ + t0 + 0)) * 8 + h], a1 = lf[((size_t)(b * SEQ + t0 + 1)) * 8 + h], a2 = lf[((size_t)(b * SEQ + t0 + 2)) * 8 + h], a3 = lf[((size_t)(b * SEQ + t0 + 3)) * 8 + h];
    a1 += a0; a2 += a1; a3 += a2;
    LAS double* tot = (LAS double*)(F.lds + RING_OFF);
    tot[F.tid] = a3;
    __syncthreads();
    double ex = 0.0;
    for (int j = 0; j < 63; ++j) { const double v = tot[F.wave * 64 + j]; ex += (j < F.lane) ? v : 0.0; }
    if (F.lane == 63) tot[512 + F.wave] = ex + a3;
    __syncthreads();
    for (int w = 0; w < F.wave; ++w) ex += tot[512 + w];
    *(GAS f32x4*)(cum + (size_t)bh * SEQ + t0) = (f32x4){(float)(ex + a0), (float)(ex + a1), (float)(ex + a2), (float)(ex + a3)};
    __syncthreads();
}

typedef pg8::f32x4 (&AccRef)[2][2][4][2];
using pg8::Unit;
__device__ __forceinline__ v4u pack8(const f32x4 a, const f32x4 b) { v4u w; w.x = cvt_pk_bf16(a[0], a[1]); w.y = cvt_pk_bf16(a[2], a[3]); w.z = cvt_pk_bf16(b[0], b[1]); w.w = cvt_pk_bf16(b[2], b[3]); return w; }
__device__ __forceinline__ void unpack8(const v4u w, f32x4& a, f32x4& b) { a = (f32x4){bflo(w.x), bfhi(w.x), bflo(w.y), bfhi(w.y)}; b = (f32x4){bflo(w.z), bfhi(w.z), bflo(w.w), bfhi(w.w)}; }

__device__ __forceinline__ void tstore32(LAS unsigned char* scr, const v4u wa, const v4u wb, int fr, int fq, bf16* dst, int cstride) {
    LAS unsigned short* s2 = (LAS unsigned short*)scr;
#pragma unroll
    for (int e2 = 0; e2 < 4; ++e2) { const int col = 8 * fq + 2 * e2;
        s2[col * 40 + fr] = (unsigned short)(wa[e2] & 0xffffu); s2[(col + 1) * 40 + fr] = (unsigned short)(wa[e2] >> 16);
        s2[col * 40 + 16 + fr] = (unsigned short)(wb[e2] & 0xffffu); s2[(col + 1) * 40 + 16 + fr] = (unsigned short)(wb[e2] >> 16); }
    asm volatile("" ::: "memory");
    const int lane = fr + 16 * fq, cl = lane >> 1, part = lane & 1;
    const v4u r0 = *(const LAS v4u*)(scr + cl * 80 + part * 32), r1 = *(const LAS v4u*)(scr + cl * 80 + part * 32 + 16);
    asm volatile("" ::: "memory");
    bf16* d = dst + (size_t)cl * cstride + part * 16;
    *(v4u*)d = r0; *(v4u*)(d + 8) = r1;
}
struct EpiIn {
    static constexpr bool PERM = true;
    bf16 *FQ, *FK, *FV, *RQ, *RK, *RV, *RGS; const float* rot; bf16* RKT; LAS unsigned char* scr; int skip;
    __device__ __forceinline__ void operator()(const pg8::f32x4 (&acc)[2][2][4][2], const Unit& u, int wr, int wc, int fr, int fq) const {
        if (skip == 1) return;
        asm volatile("" : "+v"(fr), "+v"(fq));
        const int pn = u.pn; bf16* base; int ldc, colt, mode = 0; float sc = 1.f;
        if (skip) { const int cls = pn < 6 ? 1 : pn < 8 ? 2 : pn < 10 ? 4 : 8; if (skip & (cls << 1)) return; }
        if (pn < 2) { base = FQ; ldc = 512; colt = pn * 256; sc = C2; }
        else if (pn < 4) { base = FK; ldc = 512; colt = (pn - 2) * 256; }
        else if (pn < 6) { base = FV; ldc = 512; colt = (pn - 4) * 256; }
        else if (pn == 6) { base = RQ; ldc = 256; colt = 0; mode = 1; }
        else if (pn == 7) { base = RK; ldc = 256; colt = 0; mode = 1; sc = 0.125f; }
        else if (pn < 10) { base = RV; ldc = 512; colt = (pn - 8) * 256; mode = 4; }
        else { base = RGS; ldc = 512; colt = (pn - 10) * 256; mode = 2; }
        const int row0 = u.pm * 256 + wr * 64 + fr, col0 = colt + wc * 32 + 8 * fq;
        LAS unsigned char* ws = scr + (wr * 4 + wc) * 3072;
        if (mode == 1) {
            f32x4 cs[2][4], sn[2][4]; const int j = (col0 & 63) >> 1;
#pragma unroll
            for (int ai = 0; ai < 2; ++ai)
#pragma unroll
                for (int m = 0; m < 4; ++m) { const int pos = (row0 + ai * 128 + m * 16) & (SEQ - 1); cs[ai][m] = *(const f32x4*)(rot + pos * 32 + j); sn[ai][m] = *(const f32x4*)(rot + SEQ * 32 + pos * 32 + j); }
            __builtin_amdgcn_sched_barrier(0);
            float lg2b[2] = {0.f, 0.f};
            if (pn == 7) { lg2b[0] = log1pf(-exp2f(-5.f - (float)(wc >> 1))) * LOG2E; lg2b[1] = log1pf(-exp2f(-5.f - (float)((wc >> 1) + 2))) * LOG2E; }
#pragma unroll
            for (int ai = 0; ai < 2; ++ai)
#pragma unroll
                for (int mh = 0; mh < 2; ++mh)
#pragma unroll
                    for (int bj = 0; bj < 2; ++bj) { const int c = col0 + bj * 128; v4u wt[2];
#pragma unroll
                        for (int mm = 0; mm < 2; ++mm) { const int m = 2 * mh + mm, row = row0 + ai * 128 + m * 16; const f32x4 a = acc[ai][bj][m][0], b = acc[ai][bj][m][1], cv = cs[ai][m], sv = sn[ai][m];
                            const f32x4 v0 = {(a[0] * cv[0] - a[1] * sv[0]) * sc, (a[1] * cv[0] + a[0] * sv[0]) * sc, (a[2] * cv[1] - a[3] * sv[1]) * sc, (a[3] * cv[1] + a[2] * sv[1]) * sc};
                            const f32x4 v1 = {(b[0] * cv[2] - b[1] * sv[2]) * sc, (b[1] * cv[2] + b[0] * sv[2]) * sc, (b[2] * cv[3] - b[3] * sv[3]) * sc, (b[3] * cv[3] + b[2] * sv[3]) * sc};
                            *(v4u*)(base + (size_t)row * ldc + c) = pack8(v0, v1);
                            if (pn == 7) { const float dk = __builtin_amdgcn_exp2f((float)(127 - (row & 127)) * lg2b[bj]); wt[mm] = pack8(v0 * dk, v1 * dk); } }
                        if (pn == 7) {
                            const int rowb = u.pm * 256 + ai * 128 + wr * 64 + mh * 32, cb = wc * 32 + bj * 128;
                            tstore32(ws, wt[0], wt[1], fr, fq, RKT + ((size_t)((rowb >> 11) * 4 + (cb >> 6)) * 16 + ((rowb >> 7) & 15)) * 8192 + (size_t)(cb & 63) * 128 + (rowb & 127), 128); } }
            return; }
        if (mode == 4) {
#pragma unroll
            for (int ai = 0; ai < 2; ++ai)
#pragma unroll
                for (int mh = 0; mh < 2; ++mh)
#pragma unroll
                    for (int bj = 0; bj < 2; ++bj) { const int rowb = u.pm * 256 + ai * 128 + wr * 64 + mh * 32, cb = colt + wc * 32 + bj * 128;
                        tstore32(ws, pack8(acc[ai][bj][2 * mh][0], acc[ai][bj][2 * mh][1]), pack8(acc[ai][bj][2 * mh + 1][0], acc[ai][bj][2 * mh + 1][1]), fr, fq,
                                 RV + ((size_t)((rowb >> 11) * 4 + (cb >> 7)) * 16 + ((rowb >> 7) & 15)) * 16384 + (size_t)(cb & 127) * 128 + (rowb & 127), 128); }
            return; }
#pragma unroll
        for (int ai = 0; ai < 2; ++ai)
#pragma unroll
            for (int m = 0; m < 4; ++m) { const int row = row0 + ai * 128 + m * 16;
#pragma unroll
                for (int bj = 0; bj < 2; ++bj) { const int c = col0 + bj * 128; f32x4 v0 = acc[ai][bj][m][0], v1 = acc[ai][bj][m][1];
                    if (mode == 0) { v0 = v0 * sc; v1 = v1 * sc; }
                    else {
#pragma unroll
                        for (int e = 0; e < 4; ++e) { v0[e] = v0[e] * fsigmoid(v0[e]); v1[e] = v1[e] * fsigmoid(v1[e]); } }
                    *(v4u*)(base + (size_t)row * ldc + c) = pack8(v0, v1); } }
    }
};
__device__ __forceinline__ void u8x8_to_f32(const v2u w, f32x4& a, f32x4& b) {
    a = (f32x4){(float)(w.x & 255u), (float)((w.x >> 8) & 255u), (float)((w.x >> 16) & 255u), (float)(w.x >> 24)}; b = (f32x4){(float)(w.y & 255u), (float)((w.y >> 8) & 255u), (float)((w.y >> 16) & 255u), (float)(w.y >> 24)}; }
struct EpiGate {
    static constexpr bool PERM = true;
    unsigned char* GATES; const float* bmg; bf16 *FQ, *FK; int skip;
    __device__ __forceinline__ void operator()(const pg8::f32x4 (&acc)[2][2][4][2], const Unit& u, int wr, int wc, int fr, int fq) const {
        if (skip & 33) return;
        { const int l_ = lane_now(); fr = l_ & 15; fq = (l_ >> 4) & 3; }
        if (u.pn < 4) {
            bf16* base = u.pn < 2 ? FQ : FK; const float sc = (u.pn < 2 ? C2 : 1.f) * (1.f / WSCALE);
            const int r0 = u.pm * 256 + wr * 64 + fr, c0 = (u.pn & 1) * 256 + wc * 32 + 8 * fq;
#pragma unroll
            for (int ai = 0; ai < 2; ++ai)
#pragma unroll
                for (int m = 0; m < 4; ++m)
#pragma unroll
                    for (int bj = 0; bj < 2; ++bj) *(v4u*)(base + (size_t)(r0 + ai * 128 + m * 16) * 512 + c0 + bj * 128) = pack8(acc[ai][bj][m][0] * sc, acc[ai][bj][m][1] * sc);
            return; }
        float ck = -LOG2E / WSCALE, cb = -LOG2E, c254 = 254.f; asm volatile("" : "+s"(ck), "+s"(cb), "+s"(c254));
        typedef float f2 __attribute__((ext_vector_type(2)));
        const int row0 = u.pm * 256 + wr * 64 + fr, col0 = (u.pn - 4) * 256 + wc * 32 + 8 * fq;
        f32x4 bb[2][2];
#pragma unroll
        for (int bj = 0; bj < 2; ++bj) { bb[bj][0] = *(const f32x4*)(bmg + col0 + bj * 128) * cb; bb[bj][1] = *(const f32x4*)(bmg + col0 + bj * 128 + 4) * cb; }
#pragma unroll
        for (int ai = 0; ai < 2; ++ai)
#pragma unroll
            for (int m = 0; m < 4; ++m) { unsigned char* rowp = GATES + (size_t)(row0 + ai * 128 + m * 16) * 2048 + col0;
#pragma unroll
                for (int bj = 0; bj < 2; ++bj) { v2u w;
#pragma unroll
                    for (int n = 0; n < 2; ++n) { const f32x4 a = acc[ai][bj][m][n], b = bb[bj][n]; unsigned b4 = 0u;
#pragma unroll
                        for (int hh = 0; hh < 2; ++hh) { const f2 t = (f2){a[2 * hh], a[2 * hh + 1]} * ck + (f2){b[2 * hh], b[2 * hh + 1]};
                            f2 ex; ex.x = __builtin_amdgcn_exp2f(t.x); ex.y = __builtin_amdgcn_exp2f(t.y); const f2 den = ex + 1.0f;
                            f2 rc; rc.x = __builtin_amdgcn_rcpf(den.x); rc.y = __builtin_amdgcn_rcpf(den.y); const f2 x = rc * c254 + 0.5f;
                            if (hh == 0) { b4 = __builtin_amdgcn_cvt_pk_u8_f32(x.x, 0, b4); b4 = __builtin_amdgcn_cvt_pk_u8_f32(x.y, 1, b4); }
                            else { b4 = __builtin_amdgcn_cvt_pk_u8_f32(x.x, 2, b4); b4 = __builtin_amdgcn_cvt_pk_u8_f32(x.y, 3, b4); } }
                        if (n == 0) w.x = b4; else w.y = b4; }
                    *(v2u*)(rowp + bj * 128) = w; } }
    }
};
struct HookMerge {
    static constexpr bool ON = true; static constexpr int AT = 6;
    const unsigned char* GATES;
    __device__ __forceinline__ void operator()(pg8::f32x4 (&acc)[2][2][4][2], const Unit& u, int wr, int wc, int fr, int fq) const {
        asm volatile("" : "+v"(fr), "+v"(fq));
        const int row0 = u.pm * 256 + wr * 64 + fr, col0 = u.pn * 256 + wc * 32 + 8 * fq;
        v2u ga[2][4][2], gb[2][4][2];
#pragma unroll
        for (int ai = 0; ai < 2; ++ai)
#pragma unroll
            for (int m = 0; m < 4; ++m) { const unsigned char* gp = GATES + (size_t)(row0 + ai * 128 + m * 16) * 2048 + col0;
#pragma unroll
                for (int bj = 0; bj < 2; ++bj) { ga[ai][m][bj] = *(const v2u*)(gp + bj * 128); gb[ai][m][bj] = *(const v2u*)(gp + 1024 + bj * 128); } }
        __builtin_amdgcn_sched_barrier(0);
#pragma unroll
        for (int ai = 0; ai < 2; ++ai)
#pragma unroll
            for (int m = 0; m < 4; ++m)
#pragma unroll
                for (int bj = 0; bj < 2; ++bj) { f32x4 a0, a1, b0, b1; u8x8_to_f32(ga[ai][m][bj], a0, a1); u8x8_to_f32(gb[ai][m][bj], b0, b1);
#pragma unroll
                    for (int e2 = 0; e2 < 4; ++e2) { acc[ai][bj][m][0][e2] *= a0[e2] * __builtin_amdgcn_rcpf(fmaxf(b0[e2], 1e-30f)); acc[ai][bj][m][1][e2] *= a1[e2] * __builtin_amdgcn_rcpf(fmaxf(b1[e2], 1e-30f)); } }
        __builtin_amdgcn_sched_barrier(0);
    }
};
struct EpiMerge {
    static constexpr bool PERM = true;
    const unsigned char* GATES; bf16* MERGED;
    __device__ __forceinline__ void operator()(const pg8::f32x4 (&acc)[2][2][4][2], const Unit& u, int wr, int wc, int fr, int fq) const {
        asm volatile("" : "+v"(fr), "+v"(fq));
        const int row0 = u.pm * 256 + wr * 64 + fr, col0 = u.pn * 256 + wc * 32 + 8 * fq;
        v2u gg[2][4][2];
#pragma unroll
        for (int ai = 0; ai < 2; ++ai)
#pragma unroll
            for (int m = 0; m < 4; ++m)
#pragma unroll
                for (int bj = 0; bj < 2; ++bj) gg[ai][m][bj] = *(const v2u*)(GATES + (size_t)(row0 + ai * 128 + m * 16) * 2048 + 1024 + col0 + bj * 128);
        __builtin_amdgcn_sched_barrier(0);
#pragma unroll
        for (int ai = 0; ai < 2; ++ai)
#pragma unroll
            for (int m = 0; m < 4; ++m)
#pragma unroll
                for (int bj = 0; bj < 2; ++bj) { f32x4 g0, g1; u8x8_to_f32(gg[ai][m][bj], g0, g1);
#pragma unroll
                    for (int e2 = 0; e2 < 4; ++e2) { g0[e2] = fmaxf(g0[e2], 1e-30f) * (1.f / 254.f); g1[e2] = fmaxf(g1[e2], 1e-30f) * (1.f / 254.f); }
                    *(v4u*)(MERGED + (size_t)(row0 + ai * 128 + m * 16) * 1024 + col0 + bj * 128) = pack8(acc[ai][bj][m][0] * g0, acc[ai][bj][m][1] * g1); }
    }
};
struct EpiMO {
    static constexpr bool PERM = true;
    bf16* MO;
    __device__ __forceinline__ void operator()(const pg8::f32x4 (&acc)[2][2][4][2], const Unit& u, int wr, int wc, int fr, int fq) const {
        asm volatile("" : "+v"(fr), "+v"(fq));
        const int row0 = u.pm * 256 + wr * 64 + fr, col0 = u.pn * 256 + wc * 32 + 8 * fq;
#pragma unroll
        for (int ai = 0; ai < 2; ++ai)
#pragma unroll
            for (int m = 0; m < 4; ++m) { bf16* rowp = MO + (size_t)(row0 + ai * 128 + m * 16) * 1024 + col0;
#pragma unroll
                for (int bj = 0; bj < 2; ++bj) *(v4u*)(rowp + bj * 128) = pack8(acc[ai][bj][m][0], acc[ai][bj][m][1]); }
    }
};
struct EpiGU {
    static constexpr bool PERM = true;
    const float* bgu; const float* rsof; unsigned char* ACT;
    __device__ __forceinline__ void operator()(const pg8::f32x4 (&acc)[2][2][4][2], const Unit& u, int wr, int wc, int fr, int fq) const {
        { const int l_ = lane_now(); fr = l_ & 15; fq = (l_ >> 4) & 3; }
        float c7 = 7.f, cm7 = -7.f, ck = -1.702f * 1.4426950408889634f; asm volatile("" : "+s"(c7), "+s"(cm7), "+s"(ck));
        const int j0 = u.pn * 128 + wc * 32 + 8 * fq;
        const float* bb = bgu + (size_t)u.e * 2048 + 2 * j0;
        const f32x4 q0 = *(const f32x4*)(bb), q1 = *(const f32x4*)(bb + 4), q2 = *(const f32x4*)(bb + 8), q3 = *(const f32x4*)(bb + 12);
        const f32x4 bg0 = {q0[0], q0[2], q1[0], q1[2]}, bl0 = {q0[1], q0[3], q1[1], q1[3]}, bg1 = {q2[0], q2[2], q3[0], q3[2]}, bl1 = {q2[1], q2[3], q3[1], q3[3]};
        const int rl0 = wr * 64 + fr;
        float rsv[2][4];
#pragma unroll
        for (int ai = 0; ai < 2; ++ai)
#pragma unroll
            for (int m = 0; m < 4; ++m) rsv[ai][m] = rsof[(size_t)u.e * NT + u.rtl * 256 + rl0 + ai * 128 + m * 16];
        __builtin_amdgcn_sched_barrier(0);
#pragma unroll
        for (int ai = 0; ai < 2; ++ai)
#pragma unroll
            for (int m = 0; m < 4; ++m) { const int rl = rl0 + ai * 128 + m * 16; const float rs = rsv[ai][m] * (1.f / WSCALE);
                int wpk[2];
#pragma unroll
                for (int n = 0; n < 2; ++n) { const f32x4 ga = acc[ai][0][m][n], la = acc[ai][1][m][n]; const f32x4 bgv = n ? bg1 : bg0, blv = n ? bl1 : bl0; int w = 0;
#pragma unroll
                    for (int hh = 0; hh < 2; ++hh) { typedef float f2 __attribute__((ext_vector_type(2)));
                        f2 g = (f2){ga[2 * hh], ga[2 * hh + 1]} * rs + (f2){bgv[2 * hh], bgv[2 * hh + 1]}, l = (f2){la[2 * hh], la[2 * hh + 1]} * rs + (f2){blv[2 * hh], blv[2 * hh + 1]};
                        f2 a, b; a.x = fminf(g.x, c7); a.y = fminf(g.y, c7); b.x = __builtin_amdgcn_fmed3f(l.x, cm7, c7); b.y = __builtin_amdgcn_fmed3f(l.y, cm7, c7);
                        const f2 t = a * ck; f2 ex; ex.x = __builtin_amdgcn_exp2f(t.x); ex.y = __builtin_amdgcn_exp2f(t.y);
                        const f2 den = ex + 1.0f; f2 rc; rc.x = __builtin_amdgcn_rcpf(den.x); rc.y = __builtin_amdgcn_rcpf(den.y);
                        const f2 o = (a * rc) * (b + 1.0f);
                        if (hh == 0) w = __builtin_amdgcn_cvt_pk_fp8_f32(o.x, o.y, w, false); else w = __builtin_amdgcn_cvt_pk_fp8_f32(o.x, o.y, w, true); }
                    wpk[n] = w; }
                *(v2u*)(ACT + ((size_t)u.pm * 256 + rl) * 1024 + j0) = (v2u){(unsigned)wpk[0], (unsigned)wpk[1]}; }
    }
};
struct EpiDN {
    static constexpr bool PERM = true;
    const float* bdn; unsigned char* Y;
    __device__ __forceinline__ void operator()(const pg8::f32x4 (&acc)[2][2][4][2], const Unit& u, int wr, int wc, int fr, int fq) const {
        asm volatile("" : "+v"(fr), "+v"(fq));
        const int col0 = u.pn * 256 + wc * 32 + 8 * fq; const float* bb = bdn + (size_t)u.e * 1024 + col0;
        f32x4 bv[2][2];
#pragma unroll
        for (int bj = 0; bj < 2; ++bj) { bv[bj][0] = *(const f32x4*)(bb + bj * 128) * YSCALE; bv[bj][1] = *(const f32x4*)(bb + bj * 128 + 4) * YSCALE; }
        const int rl0 = wr * 64 + fr;
#pragma unroll
        for (int ai = 0; ai < 2; ++ai)
#pragma unroll
            for (int m = 0; m < 4; ++m) { unsigned char* rowp = Y + ((size_t)u.pm * 256 + rl0 + ai * 128 + m * 16) * 1024 + col0;
#pragma unroll
                for (int bj = 0; bj < 2; ++bj) *(v2u*)(rowp + bj * 128) = pack8_fp8(acc[ai][bj][m][0] * (YSCALE / WSCALE) + bv[bj][0], acc[ai][bj][m][1] * (YSCALE / WSCALE) + bv[bj][1]); }
    }
};
struct EpiPJ {
    static constexpr bool PERM = false;
    bf16* PJ;
    __device__ __forceinline__ void operator()(const pg8::f32x4 (&acc)[2][2][4][2], const Unit& u, int wr, int wc, int fr, int fq) const {
        asm volatile("" : "+v"(fr), "+v"(fq));
        const int row0 = u.pm * 256 + wr * 64 + fr, col0 = u.pn * 256 + wc * 32 + 4 * fq;
#pragma unroll
        for (int ai = 0; ai < 2; ++ai)
#pragma unroll
            for (int m = 0; m < 4; ++m) { const size_t off = (size_t)(row0 + ai * 128 + m * 16) * 1024 + col0;
#pragma unroll
                for (int bj = 0; bj < 2; ++bj)
#pragma unroll
                    for (int n = 0; n < 2; ++n) { const f32x4 v = acc[ai][bj][m][n]; v2u w; w.x = cvt_pk_bf16(v[0], v[1]); w.y = cvt_pk_bf16(v[2], v[3]); *(v2u*)(PJ + off + bj * 128 + n * 16) = w; } }
    }
};
struct EpiPG {
    static constexpr bool PERM = true;
    unsigned char* G8; const float* rstd2;
    __device__ __forceinline__ void operator()(const pg8::f32x4 (&acc)[2][2][4][2], const Unit& u, int wr, int wc, int fr, int fq) const {
        { const int l_ = lane_now(); fr = l_ & 15; fq = (l_ >> 4) & 3; }
        float ck = -LOG2E / WSCALE, c254 = 254.f; asm volatile("" : "+s"(ck), "+s"(c254));
        typedef float f2 __attribute__((ext_vector_type(2)));
        const int row0 = u.pm * 256 + wr * 64 + fr, col0 = u.pn * 256 + wc * 32 + 8 * fq;
        float rsv[2][4];
#pragma unroll
        for (int ai = 0; ai < 2; ++ai)
#pragma unroll
            for (int m = 0; m < 4; ++m) rsv[ai][m] = rstd2[row0 + ai * 128 + m * 16];
        __builtin_amdgcn_sched_barrier(0);
#pragma unroll
        for (int ai = 0; ai < 2; ++ai)
#pragma unroll
            for (int m = 0; m < 4; ++m) { const float rs = rsv[ai][m] * ck; unsigned char* rowp = G8 + (size_t)(row0 + ai * 128 + m * 16) * 1024 + col0;
#pragma unroll
                for (int bj = 0; bj < 2; ++bj) { v2u w;
#pragma unroll
                    for (int n = 0; n < 2; ++n) { const f32x4 a = acc[ai][bj][m][n]; unsigned b4 = 0u;
#pragma unroll
                        for (int hh = 0; hh < 2; ++hh) { const f2 t = (f2){a[2 * hh], a[2 * hh + 1]} * rs;
                            f2 ex; ex.x = __builtin_amdgcn_exp2f(t.x); ex.y = __builtin_amdgcn_exp2f(t.y); const f2 den = ex + 1.0f;
                            f2 rc; rc.x = __builtin_amdgcn_rcpf(den.x); rc.y = __builtin_amdgcn_rcpf(den.y); const f2 x = rc * c254 + 0.5f;
                            if (hh == 0) { b4 = __builtin_amdgcn_cvt_pk_u8_f32(x.x, 0, b4); b4 = __builtin_amdgcn_cvt_pk_u8_f32(x.y, 1, b4); }
                            else { b4 = __builtin_amdgcn_cvt_pk_u8_f32(x.x, 2, b4); b4 = __builtin_amdgcn_cvt_pk_u8_f32(x.y, 3, b4); } }
                        if (n == 0) w.x = b4; else w.y = b4; }
                    *(v2u*)(rowp + bj * 128) = w; } }
    }
};

__device__ __forceinline__ int moe_setup(Frame& F) {
    LAS int* cnt = (LAS int*)(F.lds + SCH_CNT); LAS int* P = (LAS int*)(F.lds + SCH_P); LAS int* rt2e = (LAS int*)(F.lds + SCH_RT2E);
    if (F.tid < NE) cnt[F.tid] = (int)__hip_atomic_load(((gu32*)(F.ap->ws + WS_CTL)) + CW_CNT + F.tid, RLX_AGENT);
    __syncthreads();
    if (F.tid == 0) { int s = 0; for (int e = 0; e < NE; ++e) { P[e] = s; s += (cnt[e] + 255) >> 8; } P[NE] = s; }
    __syncthreads();
    const int RT = __builtin_amdgcn_readfirstlane(P[NE]);
    for (int t = F.tid; t < RT && t < MAXRT; t += NWAVES * 64) { int e = 0;
#pragma unroll
        for (int k = 1; k <= NE; ++k) e += (P[k] <= t) ? 1 : 0;
        rt2e[t] = e; }
    __syncthreads();
    return RT < MAXRT ? RT : MAXRT;
}
struct MoeOrder {
    pg8::DenseOrder d; LAS const int* P; LAS const int* rt2e; LAS const unsigned* tab;
    const char* Abase; size_t tsA; const char* Bbase; size_t estride, tsB; bool gather;
    __device__ __forceinline__ bool next(int i, Unit& u) const {
        if (!d.tile(i, u.pm, u.pn)) return false;
        const int e = __builtin_amdgcn_readfirstlane(rt2e[u.pm]); u.e = e; u.rtl = u.pm - __builtin_amdgcn_readfirstlane(P[e]);
        u.A = gather ? Abase : Abase + (size_t)u.pm * tsA; u.B = Bbase + (size_t)e * estride + (size_t)u.pn * tsB; return true;
    }
    __device__ __forceinline__ const LAS unsigned char* table(int ui) const { return (const LAS unsigned char*)tab + ui * 1024; }
};

__device__ __forceinline__ void router_pass(Frame& F) {
    LAS float* L = (LAS float*)(F.lds + RING_OFF + F.wave * 2304);
    LAS int* hist = (LAS int*)(F.lds + RING_OFF + 32768); LAS int* hbase = hist + 32;
    if (F.tid < 64) hist[F.tid] = 0;
    __syncthreads();
    const float* X = (F.ap->in[0]); const bf16* MO = WSP(bf16, WS_MO); bf16* MOw = WSP(bf16, WS_MO); unsigned char* HB = WSP(unsigned char, WS_HB); const bf16* wrt = WSP(bf16, WS_WRT);
    const int lane = F.lane, r = lane & 15, q = lane >> 4, tok0 = (int)blockIdx.x * 128 + F.wave * 16, token = tok0 + r;
    pg8::f32x4 acc0 = {0.f, 0.f, 0.f, 0.f}, acc1 = {0.f, 0.f, 0.f, 0.f}; float ss = 0.f;
    const float* hrow = X + (size_t)token * DM + q * 8; const bf16* morow = MO + (size_t)token * DM + q * 8; const bf16* b0p = wrt + (size_t)r * 1024 + q * 8;
    f32x4 xa[2][2][2], ga[2][2][2]; v4u ma[2][2], wa[2][2][4];
#define RT_LOAD(buf, grp) do { _Pragma("unroll") for (int s_ = 0; s_ < 2; ++s_) { const int kk_ = (grp) * 2 + s_; \
        xa[buf][s_][0] = *(const f32x4*)(hrow + kk_ * 32); xa[buf][s_][1] = *(const f32x4*)(hrow + kk_ * 32 + 4); ma[buf][s_] = *(const v4u*)(morow + kk_ * 32); \
        ga[buf][s_][0] = *(const f32x4*)((F.ap->in[9]) + kk_ * 32 + q * 8); ga[buf][s_][1] = *(const f32x4*)((F.ap->in[9]) + kk_ * 32 + q * 8 + 4); \
        wa[buf][s_][0] = *(const v4u*)(b0p + kk_ * 32); wa[buf][s_][1] = *(const v4u*)(b0p + 16 * 1024 + kk_ * 32); wa[buf][s_][2] = *(const v4u*)(b0p + 32768 + kk_ * 32); wa[buf][s_][3] = *(const v4u*)(b0p + 32768 + 16 * 1024 + kk_ * 32); } } while (0)
#define RT_STEP(buf, grp) do { _Pragma("unroll") for (int s_ = 0; s_ < 2; ++s_) { const int kk_ = (grp) * 2 + s_; \
        f32x4 h0 = xa[buf][s_][0], h1 = xa[buf][s_][1]; { f32x4 m0, m1; unpack8(ma[buf][s_], m0, m1); h0 = h0 + m0; h1 = h1 + m1; } \
        ss += (h0[0] * h0[0] + h0[1] * h0[1]) + (h0[2] * h0[2] + h0[3] * h0[3]) + (h1[0] * h1[0] + h1[1] * h1[1]) + (h1[2] * h1[2] + h1[3] * h1[3]); \
        const f32x4 x0 = h0 * ga[buf][s_][0], x1 = h1 * ga[buf][s_][1]; \
        const v4u hi = pack8(x0, x1); f32x4 y0, y1; unpack8(hi, y0, y1); const v4u lo = pack8(x0 - y0, x1 - y1); \
        *(v2u*)(HB + (size_t)token * DM + kk_ * 32 + q * 8) = pack8_fp8(x0, x1); *(v4u*)(MOw + (size_t)token * DM + q * 8 + kk_ * 32) = pack8(h0, h1);     \
        const bf16x8 ah = __builtin_bit_cast(bf16x8, hi), al = __builtin_bit_cast(bf16x8, lo); \
        acc0 = __builtin_amdgcn_mfma_f32_16x16x32_bf16(ah, __builtin_bit_cast(bf16x8, wa[buf][s_][0]), acc0, 0, 0, 0); acc0 = __builtin_amdgcn_mfma_f32_16x16x32_bf16(al, __builtin_bit_cast(bf16x8, wa[buf][s_][0]), acc0, 0, 0, 0); \
        acc0 = __builtin_amdgcn_mfma_f32_16x16x32_bf16(ah, __builtin_bit_cast(bf16x8, wa[buf][s_][2]), acc0, 0, 0, 0); \
        acc1 = __builtin_amdgcn_mfma_f32_16x16x32_bf16(ah, __builtin_bit_cast(bf16x8, wa[buf][s_][1]), acc1, 0, 0, 0); acc1 = __builtin_amdgcn_mfma_f32_16x16x32_bf16(al, __builtin_bit_cast(bf16x8, wa[buf][s_][1]), acc1, 0, 0, 0); \
        acc1 = __builtin_amdgcn_mfma_f32_16x16x32_bf16(ah, __builtin_bit_cast(bf16x8, wa[buf][s_][3]), acc1, 0, 0, 0); } } while (0)
    RT_LOAD(0, 0);
#pragma unroll
    for (int gp = 0; gp < 16; gp += 2) {
        RT_LOAD(1, gp + 1); __builtin_amdgcn_sched_barrier(0); RT_STEP(0, gp); __builtin_amdgcn_sched_barrier(0);
        if (gp + 2 < 16) RT_LOAD(0, gp + 2);
        __builtin_amdgcn_sched_barrier(0); RT_STEP(1, gp + 1); __builtin_amdgcn_sched_barrier(0);
    }
#undef RT_LOAD
#undef RT_STEP
    ss = xor16_sum(ss); ss = xor32_sum(ss);
    const float rstd = 1.f / sqrtf(ss * (1.f / DM) + EPS);
#pragma unroll
    for (int i = 0; i < 4; ++i) { L[(4 * q + i) * 33 + r] = acc0[i]; L[(4 * q + i) * 33 + 16 + r] = acc1[i]; }
    LDS_WAIT(); asm volatile("" ::: "memory");
    int te0 = 0, te1 = 0, te2 = 0, te3 = 0, rk0 = 0, rk1 = 0, rk2 = 0, rk3 = 0; float w0 = 0.f, w1 = 0.f, w2 = 0.f, w3 = 0.f;
    if (lane < 16) {
        float v[32];
#pragma unroll
        for (int e = 0; e < 32; ++e) v[e] = L[lane * 33 + e] * rstd + (F.ap->in[11])[e];
        float tv[4]; int te[4];
#pragma unroll
        for (int k = 0; k < 4; ++k) { float best = v[0]; int bi = 0;
#pragma unroll
            for (int e = 1; e < 32; ++e) if (v[e] > best) { best = v[e]; bi = e; }
            tv[k] = best; te[k] = bi;
#pragma unroll
            for (int e = 0; e < 32; ++e) v[e] = (e == bi) ? -INFINITY : v[e]; }
        const float e1 = expf(tv[1] - tv[0]), e2 = expf(tv[2] - tv[0]), e3 = expf(tv[3] - tv[0]), inv = 1.f / (1.f + e1 + e2 + e3);
        w0 = inv; w1 = e1 * inv; w2 = e2 * inv; w3 = e3 * inv; te0 = te[0]; te1 = te[1]; te2 = te[2]; te3 = te[3];
        rk0 = __hip_atomic_fetch_add(hist + te0, 1, __ATOMIC_RELAXED, __HIP_MEMORY_SCOPE_WORKGROUP); rk1 = __hip_atomic_fetch_add(hist + te1, 1, __ATOMIC_RELAXED, __HIP_MEMORY_SCOPE_WORKGROUP);
        rk2 = __hip_atomic_fetch_add(hist + te2, 1, __ATOMIC_RELAXED, __HIP_MEMORY_SCOPE_WORKGROUP); rk3 = __hip_atomic_fetch_add(hist + te3, 1, __ATOMIC_RELAXED, __HIP_MEMORY_SCOPE_WORKGROUP);
    }
    __syncthreads();
    if (F.tid < NE) hbase[F.tid] = (int)__hip_atomic_fetch_add(((gu32*)(F.ap->ws + WS_CTL)) + CW_CNT + F.tid, (unsigned)hist[F.tid], RLX_AGENT);
    __syncthreads();
    if (lane < 16) {
        int* TOK = WSP(int, WS_TOK); float* RSOF = WSP(float, WS_RSOF); int* TOPE = WSP(int, WS_TOPE); float* TOPW = WSP(float, WS_TOPW); int* POS = WSP(int, WS_POS);
        const int p0 = hbase[te0] + rk0, p1 = hbase[te1] + rk1, p2 = hbase[te2] + rk2, p3 = hbase[te3] + rk3;
        TOK[(size_t)te0 * NT + p0] = token; TOK[(size_t)te1 * NT + p1] = token; TOK[(size_t)te2 * NT + p2] = token; TOK[(size_t)te3 * NT + p3] = token;
        RSOF[(size_t)te0 * NT + p0] = rstd; RSOF[(size_t)te1 * NT + p1] = rstd; RSOF[(size_t)te2 * NT + p2] = rstd; RSOF[(size_t)te3 * NT + p3] = rstd;
        *(int4*)(TOPE + (size_t)token * 4) = make_int4(te0, te1, te2, te3); *(float4*)(TOPW + (size_t)token * 4) = make_float4(w0, w1, w2, w3); *(int4*)(POS + (size_t)token * 4) = make_int4(p0, p1, p2, p3);
    }
    __syncthreads();
}
__device__ __forceinline__ void combine_pass(Frame& F) {
    LAS const int* P = (LAS const int*)(F.lds + SCH_P);
    const unsigned char* Y = WSP(unsigned char, WS_Y); const bf16* MO = WSP(bf16, WS_MO); unsigned char* HB2 = WSP(unsigned char, WS_HB2); float* RSTD2 = WSP(float, WS_RSTD2); bf16* H2B = WSP(bf16, WS_H2B);
    const int* TOPE = WSP(int, WS_TOPE); const float* TOPW = WSP(float, WS_TOPW); const int* POS = WSP(int, WS_POS);
    const int lane = F.lane, tok0 = (int)blockIdx.x * 128 + F.wave * 16;
    int4 te_n[2], tp_n[2]; float4 tw_n[2], tw_c[2]; v4u mc[2][2], mn[2][2]; v2u yc[2][4][2], yn[2][4][2];
#define CB_ROUTE(i) do { _Pragma("unroll") for (int t_ = 0; t_ < 2; ++t_) { te_n[t_] = *(const int4*)(TOPE + (size_t)(tok0 + (i) + t_) * 4); tw_n[t_] = *(const float4*)(TOPW + (size_t)(tok0 + (i) + t_) * 4); tp_n[t_] = *(const int4*)(POS + (size_t)(tok0 + (i) + t_) * 4); } } while (0)
#define CB_DATA(dm, dy, i) do { _Pragma("unroll") for (int t_ = 0; t_ < 2; ++t_) { \
        const size_t s0_ = (size_t)(P[te_n[t_].x] * 256 + tp_n[t_].x) * DM, s1_ = (size_t)(P[te_n[t_].y] * 256 + tp_n[t_].y) * DM, s2_ = (size_t)(P[te_n[t_].z] * 256 + tp_n[t_].z) * DM, s3_ = (size_t)(P[te_n[t_].w] * 256 + tp_n[t_].w) * DM; \
        _Pragma("unroll") for (int j = 0; j < 2; ++j) { const int c = 8 * lane + 512 * j; dm[t_][j] = *(const v4u*)(MO + (size_t)(tok0 + (i) + t_) * DM + c); \
            dy[t_][0][j] = *(const v2u*)(Y + s0_ + c); dy[t_][1][j] = *(const v2u*)(Y + s1_ + c); dy[t_][2][j] = *(const v2u*)(Y + s2_ + c); dy[t_][3][j] = *(const v2u*)(Y + s3_ + c); } } } while (0)
    CB_ROUTE(0); CB_DATA(mc, yc, 0); tw_c[0] = tw_n[0]; tw_c[1] = tw_n[1]; CB_ROUTE(2);
    for (int i = 0; i < 16; i += 2) {
        const float4 tw_x0 = tw_n[0], tw_x1 = tw_n[1];
        if (i + 2 < 16) CB_DATA(mn, yn, i + 2);
        if (i + 4 < 16) CB_ROUTE(i + 4);
        __builtin_amdgcn_sched_barrier(0);
#pragma unroll
        for (int t = 0; t < 2; ++t) { const int token = tok0 + i + t; f32x4 v[2][2]; float ss = 0.f; const float4 tw = tw_c[t] * (1.f / YSCALE);
#pragma unroll
            for (int j = 0; j < 2; ++j) { f32x4 a, b; unpack8(mc[t][j], a, b);
#pragma unroll
                for (int k = 0; k < 4; ++k) { const v2u y = yc[t][k][j]; const float w = k == 0 ? tw.x : k == 1 ? tw.y : k == 2 ? tw.z : tw.w;
                    const auto p0 = __builtin_amdgcn_cvt_pk_f32_fp8((int)y.x, false), p1 = __builtin_amdgcn_cvt_pk_f32_fp8((int)y.x, true), p2 = __builtin_amdgcn_cvt_pk_f32_fp8((int)y.y, false), p3 = __builtin_amdgcn_cvt_pk_f32_fp8((int)y.y, true);
                    a += w * (f32x4){p0[0], p0[1], p1[0], p1[1]}; b += w * (f32x4){p2[0], p2[1], p3[0], p3[1]}; }
                v[j][0] = a; v[j][1] = b;
                ss += ((a.x * a.x + a.y * a.y) + (a.z * a.z + a.w * a.w)) + ((b.x * b.x + b.y * b.y) + (b.z * b.z + b.w * b.w)); }
            const float rstd = 1.f / sqrtf(wave_sum(ss) * (1.f / DM) + EPS);
#pragma unroll
            for (int j = 0; j < 2; ++j) { const int c = 8 * lane + 512 * j; *(v4u*)(H2B + (size_t)token * DM + c) = pack8(v[j][0], v[j][1]);
                const f32x4 g0 = *(const f32x4*)((F.ap->in[16]) + c), g1 = *(const f32x4*)((F.ap->in[16]) + c + 4);
                *(v2u*)(HB2 + (size_t)token * DM + c) = pack8_fp8(v[j][0] * g0, v[j][1] * g1); }
            if (lane == 0) RSTD2[token] = rstd; }
        __builtin_amdgcn_sched_barrier(0);
#pragma unroll
        for (int t = 0; t < 2; ++t)
#pragma unroll
            for (int j = 0; j < 2; ++j) { mc[t][j] = mn[t][j];
#pragma unroll
                for (int k = 0; k < 4; ++k) yc[t][k][j] = yn[t][k][j]; }
        tw_c[0] = tw_x0; tw_c[1] = tw_x1;
    }
#undef CB_ROUTE
#undef CB_DATA
}
__device__ __forceinline__ void final_pass(Frame& F) {
    const bf16* PJ = WSP(bf16, WS_PJ); const bf16* H2B = WSP(bf16, WS_H2B); const unsigned char* G8 = WSP(unsigned char, WS_G8); const int lane = F.lane, tok0 = (int)blockIdx.x * 128 + F.wave * 16;
    v4u hc[2][2], hn[2][2], pc[2][2], pn[2][2]; v2u gc[2][2], gn[2][2];
#define FP_LOAD(hd, pd, gd, i) do { _Pragma("unroll") for (int t_ = 0; t_ < 2; ++t_) _Pragma("unroll") for (int j = 0; j < 2; ++j) { const size_t o_ = (size_t)(tok0 + (i) + t_) * DM + 8 * lane + 512 * j; \
        hd[t_][j] = *(const v4u*)(H2B + o_); pd[t_][j] = *(const v4u*)(PJ + o_); gd[t_][j] = *(const v2u*)(G8 + o_); } } while (0)
    FP_LOAD(hc, pc, gc, 0);
    for (int i = 0; i < 16; i += 2) {
        if (i + 2 < 16) FP_LOAD(hn, pn, gn, i + 2);
        __builtin_amdgcn_sched_barrier(0);
#pragma unroll
        for (int t = 0; t < 2; ++t) { f32x4 v[2][2]; float ss = 0.f;
#pragma unroll
            for (int j = 0; j < 2; ++j) { f32x4 a, b, pa, pb; unpack8(hc[t][j], a, b); unpack8(pc[t][j], pa, pb); const unsigned g0 = gc[t][j].x, g1 = gc[t][j].y;
                const f32x4 ga = {(float)(g0 & 255u), (float)((g0 >> 8) & 255u), (float)((g0 >> 16) & 255u), (float)(g0 >> 24)}, gb = {(float)(g1 & 255u), (float)((g1 >> 8) & 255u), (float)((g1 >> 16) & 255u), (float)(g1 >> 24)};
                a += (ga * (1.f / 254.f)) * pa; b += (gb * (1.f / 254.f)) * pb; v[j][0] = a; v[j][1] = b;
                ss += ((a.x * a.x + a.y * a.y) + (a.z * a.z + a.w * a.w)) + ((b.x * b.x + b.y * b.y) + (b.z * b.z + b.w * b.w)); }
            const float rstd = 1.f / sqrtf(wave_sum(ss) * (1.f / DM) + EPS); float* hr = (F.ap->out) + (size_t)(tok0 + i + t) * DM;
#pragma unroll
            for (int j = 0; j < 2; ++j) { const int c = 8 * lane + 512 * j; const f32x4 g0 = *(const f32x4*)((F.ap->in[19]) + c), g1 = *(const f32x4*)((F.ap->in[19]) + c + 4);
                *(f32x4*)(hr + c) = v[j][0] * rstd * g0; *(f32x4*)(hr + c + 4) = v[j][1] * rstd * g1; } }
        __builtin_amdgcn_sched_barrier(0);
#pragma unroll
        for (int t = 0; t < 2; ++t)
#pragma unroll
            for (int j = 0; j < 2; ++j) { hc[t][j] = hn[t][j]; pc[t][j] = pn[t][j]; gc[t][j] = gn[t][j]; }
    }
#undef FP_LOAD
}

struct PnOffOrder { pg8::DenseOrder d; int off;
    __device__ __forceinline__ bool next(int i, pg8::Unit& u) const { if (!d.next(i, u)) return false; u.pn += off; return true; }
    __device__ __forceinline__ const LAS unsigned char* table(int) const { return nullptr; } };
struct StrideOrder { int start, stride, n; const char* A; const char* B; size_t tsA, tsB;
    __device__ __forceinline__ bool next(int i, pg8::Unit& u) const { const int idx = start + i * stride; if (idx >= n) return false; u.pm = idx >> 2; u.pn = idx & 3; u.A = A + (size_t)u.pm * tsA; u.B = B + (size_t)u.pn * tsB; u.e = 0; u.rtl = 0; return true; }
    __device__ __forceinline__ const LAS unsigned char* table(int) const { return nullptr; } };
constexpr int N_PHASES = 11;

__global__ void __launch_bounds__(NWAVES * 64, 2) fwd(Args args) {
    extern __shared__ __attribute__((aligned(16))) unsigned char lds[];
    Frame F;
    F.lds = (LAS unsigned char*)lds;
    F.MISC = (volatile LAS unsigned*)(F.lds + MISC_OFF);
    F.tid = threadIdx.x; F.lane = F.tid & 63; F.wave = __builtin_amdgcn_readfirstlane(F.tid >> 6);
    F.G = gridDim.x; { const int bx = blockIdx.x; F.vcu = (F.G % 8 == 0) ? (bx % 8) * (F.G / 8) + bx / 8 : bx; }
    REARGS();
    for (int u = F.tid; u < 64; u += NWAVES * 64) ((LAS unsigned*)(F.lds + MISC_OFF))[u] = 0u;
    __syncthreads();
    const bool one = (F.ap->ph_hi - F.ap->ph_lo) > 1;
    XcdBarrier bar; bar.bar = (unsigned*)(((gu32*)(F.ap->ws + WS_CTL)) + CW_BAR); bar.x = 0; bar.st = nullptr;
    if (one) bar = xcd_barrier_post((unsigned*)(((gu32*)(F.ap->ws + WS_CTL)) + CW_BAR), F.MISC + 8, F.tid);
#ifdef ONLY_PHASE
    constexpr int lo = ONLY_PHASE, hi = ONLY_PHASE + 1;
#else
    const int lo = F.ap->ph_lo, hi = F.ap->ph_hi;
#endif
    int cid = (int)blockIdx.x;
#define IN(k) (lo <= (k) && (k) < hi)
#define RELANE() do { int l_ = lane_now(); asm volatile("" : "+v"(l_)); F.lane = l_; F.tid = F.wave * 64 + l_; REARGS(); asm volatile("" : "+s"(cid)); } while (0)
#define GBAR() do { RELANE(); xcd_barrier(bar, F.tid); } while (0)
#define SEAM(k) do { if (IN(k) && IN((k) + 1)) GBAR(); } while (0)
    const int rep_phase = F.ap->rep_phase, rep_mode = F.ap->rep_mode;
#define NREP(k) (((k) == rep_phase) ? 2 : 1)
    LAS unsigned char* ring = F.lds + RING_OFF;

    for (int rep = 0; rep < NREP(0); ++rep) { if (rep) GBAR(); if (IN(0)) { RELANE(); p0_prologue(F); } } SEAM(0);
    for (int rep = 0; rep < NREP(1); ++rep) { if (rep) GBAR(); if (IN(1)) { RELANE();
        if (cid < NBATCH * 8) cum_scan(F, cid);
        { pg8::Gemm g{1024, 1024, 1024}; PnOffOrder S; S.off = 4; S.d.init(NT / 256, 8, F.G, cid, WSP(bf16, WS_XN), (size_t)256 * 1024 * 2, WSP(bf16, WS_W1T), (size_t)256 * 1024 * 2);
          EpiIn E{WSP(bf16, WS_FQ), WSP(bf16, WS_FK), WSP(bf16, WS_FV), WSP(bf16, WS_RQ), WSP(bf16, WS_RK), WSP(bf16, WS_RV), WSP(bf16, WS_RGS), WSP(float, WS_ROT), WSP(bf16, WS_RKT), F.lds + TAB_OFF, (rep == 1 && rep_mode >= 7) ? (rep_mode == 7 ? 1 : rep_mode - 64) : 0};
          pg8::gemm_phase<EpiIn, PnOffOrder, true, false>(ring, g, S, E, F.wave); }
        { RELANE();
          pg8::Gemm g{1024, 1024, 1024}; pg8::DenseOrder S; S.init(NT / 256, 12, F.G, cid, WSP(unsigned char, WS_XN8), (size_t)256 * 1024, WSP(unsigned char, WS_WG8T), (size_t)256 * 1024);
          EpiGate E{WSP(unsigned char, WS_GATES), (F.ap->in[7]), WSP(bf16, WS_FQ), WSP(bf16, WS_FK), (rep == 1 && rep_mode >= 7) ? (rep_mode == 7 ? 1 : rep_mode - 64) : 0};
          pg8::gemm_phase<EpiGate, pg8::DenseOrder, true, false, 1>(ring, g, S, E, F.wave); }
    } } SEAM(1);
    for (int rep = 0; rep < NREP(2); ++rep) { if (rep) GBAR(); if (IN(2)) { RELANE();
        { static_assert(ret_body::LDS_BYTES <= RING_BYTES && attn_body::ATTN_LDS_BYTES <= RING_BYTES, "phase scratch inside the ring");
          volatile LAS int* qn = (volatile LAS int*)(F.MISC + 16);
          const attn_body::bf16* Q = (const attn_body::bf16*)WSP(bf16, WS_FQ); const attn_body::bf16* K = (const attn_body::bf16*)WSP(bf16, WS_FK); const attn_body::bf16* V = (const attn_body::bf16*)WSP(bf16, WS_FV);
          attn_body::bf16* O = (attn_body::bf16*)WSP(bf16, WS_BR);
          if (lane_now() + F.wave * 64 == 0) qn[0] = (int)__hip_atomic_fetch_add(((gu32*)(F.ap->ws + WS_CTL)) + CW_QUEUE + 64 * rep, 1u, RLX_AGENT);
          __syncthreads();
          for (int n = 0;; ++n) {
              const int item = __builtin_amdgcn_readfirstlane(qn[n & 1]);
              if (item >= 64 + 1024 + CONV_CHUNKS) break;
              int nxt_item = 0;
              if (lane_now() + F.wave * 64 == 0) nxt_item = (int)__hip_atomic_fetch_add(((gu32*)(F.ap->ws + WS_CTL)) + CW_QUEUE + 64 * rep, 1u, RLX_AGENT);
              if (item < 64) { const int bh4 = item;
                  ret_body::ret_unit(ring, bh4 >> 2, bh4 & 3, WSP(bf16, WS_RQ), WSP(bf16, WS_RK), WSP(bf16, WS_RV), WSP(bf16, WS_RKT), WSP(bf16, WS_RGS), WSP(bf16, WS_BR), F.wave, 0, 16, 0); }
              else { const int r = item - 64, cb = (int)(((long)r * CONV_CHUNKS) / (1024 + CONV_CHUNKS)), cn = (int)(((long)(r + 1) * CONV_CHUNKS) / (1024 + CONV_CHUNKS));
                  if (cn > cb) { RELANE(); conv_chunk(F, cb); }
                  else { const int k = r - cb, qb = 7 - (k >> 7), bh = k & 127;
                      attn_body::attn_unit<8>(bh >> 3, bh & 7, qb, Q, K, V, O, WSP(float, WS_CUM) + (size_t)bh * SEQ, (char*)lds + RING_OFF, F.wave); } }
              if (lane_now() + F.wave * 64 == 0) qn[(n + 1) & 1] = nxt_item;
              __syncthreads();
          } }
    } } SEAM(2);
    for (int rep = 0; rep < NREP(3); ++rep) { if (rep) GBAR(); if (IN(3)) { RELANE();
        pg8::Gemm g{1024, 1024, 1024}; pg8::DenseOrder S; S.init(NT / 256, 4, F.G, cid, WSP(bf16, WS_BR), (size_t)256 * 1024 * 2, WSP(bf16, WS_WBT), (size_t)256 * 1024 * 2);
        EpiMerge E{WSP(unsigned char, WS_GATES), WSP(bf16, WS_MERGED)}; HookMerge H{WSP(unsigned char, WS_GATES)};
        pg8::gemm_phase<EpiMerge, pg8::DenseOrder, true, false, 2, HookMerge>(ring, g, S, E, F.wave, H);
    } } SEAM(3);
    for (int rep = 0; rep < NREP(4); ++rep) { if (rep) GBAR(); if (IN(4)) { RELANE();
        pg8::Gemm g{1024, 1024, 1024}; pg8::DenseOrder S; S.init(NT / 256, 4, F.G, cid, WSP(bf16, WS_MERGED), (size_t)256 * 1024 * 2, WSP(bf16, WS_WOT), (size_t)256 * 1024 * 2);
        EpiMO E{WSP(bf16, WS_MO)}; pg8::gemm_phase<EpiMO, pg8::DenseOrder, true, false>(ring, g, S, E, F.wave);
    } } SEAM(4);
    for (int rep = 0; rep < NREP(5); ++rep) { if (rep) GBAR(); if (IN(5)) { RELANE(); router_pass(F); } } SEAM(5);
    for (int rep = 0; rep < NREP(6); ++rep) { if (rep) GBAR(); if (IN(6)) { RELANE();
        const int RT = moe_setup(F);
        MoeOrder S; S.d.init(RT, 8, F.G, cid, nullptr, 0, nullptr, 0); S.P = (LAS const int*)(F.lds + SCH_P); S.rt2e = (LAS const int*)(F.lds + SCH_RT2E); S.tab = (LAS const unsigned*)(F.lds + TAB_OFF);
        S.Abase = (const char*)WSP(unsigned char, WS_HB); S.tsA = 0; S.Bbase = (const char*)WSP(unsigned char, WS_WGUT); S.estride = (size_t)2048 * 1024; S.tsB = (size_t)256 * 1024; S.gather = true;
        { LAS const int* cnt = (LAS const int*)(F.lds + SCH_CNT); LAS unsigned* tab = (LAS unsigned*)(F.lds + TAB_OFF); const int* TOK = WSP(int, WS_TOK);
          int tokv[MAXUNITS / 2];
#pragma unroll
          for (int j = 0; j < MAXUNITS / 2; ++j) { const int ui = 2 * j + (F.tid >> 8), r = F.tid & 255; int pm, pn; tokv[j] = -1;
              if (S.d.tile(ui, pm, pn)) { const int e = S.rt2e[pm], pos = (pm - S.P[e]) * 256 + r; tokv[j] = pos < cnt[e] ? TOK[(size_t)e * NT + pos] : NT; } }
#pragma unroll
          for (int j = 0; j < MAXUNITS / 2; ++j) { const int ui = 2 * j + (F.tid >> 8), r = F.tid & 255; if (tokv[j] >= 0) tab[ui * 256 + r] = (unsigned)tokv[j] * 1024u; }
          __syncthreads(); }
        pg8::Gemm g{1024, 1024, 1024};
        EpiGU E{(F.ap->in[13]), WSP(float, WS_RSOF), WSP(unsigned char, WS_ACT)}; pg8::gemm_phase<EpiGU, MoeOrder, true, true, 1>(ring, g, S, E, F.wave);
    } } SEAM(6);
    for (int rep = 0; rep < NREP(7); ++rep) { if (rep) GBAR(); if (IN(7)) { RELANE();
        const int RT = moe_setup(F);
        MoeOrder S; S.d.init(RT, 4, F.G, cid, nullptr, 0, nullptr, 0); S.P = (LAS const int*)(F.lds + SCH_P); S.rt2e = (LAS const int*)(F.lds + SCH_RT2E); S.tab = (LAS const unsigned*)(F.lds + TAB_OFF);
        S.Abase = (const char*)WSP(unsigned char, WS_ACT); S.tsA = (size_t)256 * 1024; S.Bbase = (const char*)WSP(unsigned char, WS_WDT); S.estride = (size_t)1024 * 1024; S.tsB = (size_t)256 * 1024; S.gather = false;
        pg8::Gemm g{1024, 1024, 1024};
        EpiDN E{(F.ap->in[15]), WSP(unsigned char, WS_Y)}; pg8::gemm_phase<EpiDN, MoeOrder, true, false, 1>(ring, g, S, E, F.wave);
        { const int rem = (RT * 4) % F.G, nidle = F.G - rem; const bool tail = 2 * nidle >= F.G;
          if (!tail || cid >= rem) { RELANE(); pg8::Gemm g2{256, 256, 256}; StrideOrder S2; S2.start = tail ? cid - rem : cid; S2.stride = tail ? nidle : F.G; S2.n = (NT / 256) * 4; S2.A = (const char*)WSP(bf16, WS_PB); S2.tsA = (size_t)256 * 256 * 2; S2.B = (const char*)WSP(bf16, WS_WPPT); S2.tsB = (size_t)256 * 256 * 2;
              EpiPJ E2{WSP(bf16, WS_PJ)}; pg8::gemm_phase<EpiPJ, StrideOrder, true, false>(ring, g2, S2, E2, F.wave); } }
    } } SEAM(7);
    for (int rep = 0; rep < NREP(8); ++rep) { if (rep) GBAR(); if (IN(8)) { RELANE(); (void)moe_setup(F); combine_pass(F); } } SEAM(8);
    for (int rep = 0; rep < NREP(9); ++rep) { if (rep) GBAR(); if (IN(9)) { RELANE();
        { pg8::Gemm g{1024, 1024, 1024}; pg8::DenseOrder S; S.init(NT / 256, 4, F.G, cid, WSP(unsigned char, WS_HB2), (size_t)256 * 1024, WSP(unsigned char, WS_WPGT), (size_t)256 * 1024);
          EpiPG E{WSP(unsigned char, WS_G8), WSP(float, WS_RSTD2)}; pg8::gemm_phase<EpiPG, pg8::DenseOrder, true, false, 1>(ring, g, S, E, F.wave); }
    } } SEAM(9);
    if (IN(10)) { RELANE(); final_pass(F); }
#undef IN
#undef SEAM
}

extern "C" void kernel_launch(void* const* d_in, const int* in_sizes, int n_in, void* d_out, int out_size, void* d_ws, size_t ws_size, hipStream_t stream) {
    static int grid = 0;
    if (grid == 0) {
        if (n_in != 20 || in_sizes[0] != NT * DM || out_size != NT * DM || ws_size < WS_END) { fprintf(stderr, "kernel_launch: unexpected shapes / workspace (%zu < %zu); nothing launched\n", ws_size, (size_t)WS_END); grid = -1; return; }
        int dev = 0, cus = 0, per_cu = 0;
        if (hipGetDevice(&dev) != hipSuccess || hipDeviceGetAttribute(&cus, hipDeviceAttributeMultiprocessorCount, dev) != hipSuccess) { grid = -1; return; }
        if (hipFuncSetAttribute((const void*)fwd, hipFuncAttributeMaxDynamicSharedMemorySize, LDS_BYTES) != hipSuccess) { fprintf(stderr, "kernel_launch: hipFuncSetAttribute failed\n"); grid = -1; return; }
        if (hipOccupancyMaxActiveBlocksPerMultiprocessor(&per_cu, (const void*)fwd, NWAVES * 64, LDS_BYTES) != hipSuccess || per_cu < 1) { fprintf(stderr, "kernel_launch: occupancy query reports %d workgroups per CU\n", per_cu); }
        (void)hipGetLastError();
        grid = cus;
        if (grid != 256) { fprintf(stderr, "kernel_launch: built for 256 CUs, found %d; nothing launched\n", cus); grid = -1; return; }
    }
    if (grid < 0) return;
    if (hipMemsetAsync((char*)d_ws + WS_CTL, 0, CTL_ZERO_BYTES, stream) != hipSuccess) return;
    Args a; memset(&a, 0, sizeof a);
    for (int i = 0; i < 20; ++i) a.in[i] = (const float*)d_in[i];
    a.out = (float*)d_out; a.ws = (unsigned char*)d_ws;
#ifndef MK_SPLIT
    a.ph_lo = 0; a.ph_hi = N_PHASES;
#ifdef PROBE_PHASE
    a.rep_phase = PROBE_PHASE; a.rep_mode = PROBE_MODE;
#else
    a.rep_phase = -1; a.rep_mode = 0;
#endif
    hipLaunchKernelGGL(fwd, dim3(grid), dim3(NWAVES * 64), LDS_BYTES, stream, a);
#else
    for (int ph = 0; ph < N_PHASES; ++ph) { a.ph_lo = ph; a.ph_hi = ph + 1; hipLaunchKernelGGL(fwd, dim3(grid), dim3(NWAVES * 64), LDS_BYTES, stream, a); }
#endif
}
```

```cpp
#include <hip/hip_runtime.h>
#include <cstdio>
#include <cstdint>
#include <cstring>
#include <cmath>
__device__ __forceinline__ int lane_now() { int l; asm volatile("v_mbcnt_lo_u32_b32 %0, -1, 0\n\tv_mbcnt_hi_u32_b32 %0, -1, %0" : "=v"(l)); return l; }
namespace pg8 {
#define PG8_LAS __attribute__((address_space(3)))
typedef unsigned short bf16_t;
typedef short bf16x8 __attribute__((ext_vector_type(8)));
typedef float f32x4 __attribute__((ext_vector_type(4)));
typedef float f32x2 __attribute__((ext_vector_type(2)));
typedef unsigned u32x4 __attribute__((ext_vector_type(4)));
typedef unsigned u32x2 __attribute__((ext_vector_type(2)));
constexpr int BM = 256, BK = 64, HALF = 128, HTB = HALF * BK * 2  , STAGE_BYTES = 8 * HTB, NXCD = 8, WGM = 8;

__host__ __device__ __forceinline__ int lds_byte(int r, int c) { const int st = (r >> 4) * 2 + (c >> 5), rr = r & 15, cc = c & 31, ob = rr * 64 + cc * 2; return st * 1024 + (ob ^ (((ob >> 9) & 1) << 5)); }
__host__ __device__ __forceinline__ void stage_rc(int b, int& R, int& C) { const int st = b / 1024, sb = b % 1024, swz = sb ^ (((sb >> 9) & 1) << 5); R = (st >> 1) * 16 + swz / 64; C = (st & 1) * 32 + (swz % 64) / 2; }
__host__ __device__ __forceinline__ int perm32(int rho) { const int n = rho >> 4, i = rho & 15; return 8 * (i >> 2) + 4 * n + (i & 3); }

struct Unit { int pm, pn; const char* A; const char* B; int e, rtl; };
struct Gemm { int lda, ldb, K; };

struct DenseOrder {
    int nM, nN, nwg, G, c; const char* A; const char* B; size_t tsA, tsB;
    __device__ __forceinline__ void init(int nM_, int nN_, int G_, int c_, const void* A_, size_t tsA_, const void* B_, size_t tsB_) { nM = nM_; nN = nN_; nwg = nM * nN; G = G_; c = c_; A = (const char*)A_; B = (const char*)B_; tsA = tsA_; tsB = tsB_; }
    __device__ __forceinline__ bool tile(int i, int& pm, int& pn) const {
        const long L = (long)i * G + c; if (L >= nwg) return false;
        int wgid = (int)L; { const int q = nwg / NXCD, r = nwg % NXCD, xcd = wgid % NXCD, off = wgid / NXCD; wgid = (xcd < r ? xcd * (q + 1) : r * (q + 1) + (xcd - r) * q) + off; }
        const int nig = WGM * nN, gid = wgid / nig, fm = gid * WGM, gsz = (nM - fm) < WGM ? (nM - fm) : WGM;
        pm = fm + ((wgid % nig) % gsz); pn = (wgid % nig) / gsz; return true;
    }
    __device__ __forceinline__ bool next(int i, Unit& u) const { if (!tile(i, u.pm, u.pn)) return false; u.A = A + (size_t)u.pm * tsA; u.B = B + (size_t)u.pn * tsB; u.e = 0; u.rtl = 0; return true; }
    __device__ __forceinline__ const PG8_LAS unsigned char* table(int) const { return nullptr; }
};

__device__ __forceinline__ unsigned cvt_pk_bf16(float lo, float hi) { unsigned r; asm volatile("s_nop 0\n\tv_cvt_pk_bf16_f32 %0, %1, %2" : "=v"(r) : "v"(lo), "v"(hi)); return r; }
__device__ __forceinline__ float bflo(unsigned w) { return __uint_as_float(w << 16); }
__device__ __forceinline__ float bfhi(unsigned w) { return __uint_as_float(w & 0xffff0000u); }
__device__ __forceinline__ float fsigmoid(float x) { return __builtin_amdgcn_rcpf(1.0f + __builtin_amdgcn_exp2f(-1.4426950408889634f * x)); }

__device__ __forceinline__ const char* uni_ptr(const char* p) { const unsigned long long v = (unsigned long long)p; const unsigned lo = __builtin_amdgcn_readfirstlane((unsigned)v), hi = __builtin_amdgcn_readfirstlane((unsigned)(v >> 32)); return (const char*)(((unsigned long long)hi << 32) | lo); }
__device__ __forceinline__ void uni_unit(Unit& u) { u.pm = __builtin_amdgcn_readfirstlane(u.pm); u.pn = __builtin_amdgcn_readfirstlane(u.pn); u.e = __builtin_amdgcn_readfirstlane(u.e); u.rtl = __builtin_amdgcn_readfirstlane(u.rtl); u.A = uni_ptr(u.A); u.B = uni_ptr(u.B); }
struct NoHook { static constexpr bool ON = false; static constexpr int AT = -1; template <class A> __device__ __forceinline__ void operator()(A&, const Unit&, int, int, int, int) const {} };
template <class Epi, class Sched, bool ALIGN_EPI, bool GATHER, int ES = 2, class Hook = NoHook>
__device__ __forceinline__ void gemm_phase(PG8_LAS unsigned char* lds, const Gemm g, const Sched& S, const Epi& E, int wave, const Hook& H = Hook()) {
    int tid = wave * 64 + lane_now(); asm volatile("" : "+v"(tid));
    const int wid = __builtin_amdgcn_readfirstlane(tid >> 6), lane = tid & 63, wr = wid >> 2, wc = wid & 3, fr = lane & 15, fq = lane >> 4;
    const int K = g.K, nt = K * ES / (BK * 2);
    unsigned voffA[2], voffB[2];
#pragma unroll
    for (int i = 0; i < 2; ++i) { int R, C; stage_rc(tid * 16 + i * 8192, R, C); const int Rb = Epi::PERM ? ((R & ~31) + perm32(R & 31)) : R;
        voffA[i] = (unsigned)(R * g.lda * ES + C * 2); voffB[i] = (unsigned)(Rb * g.ldb * ES + C * 2); }
    const size_t kstep = (size_t)(BK * 2);
    const size_t hstepA = GATHER ? (size_t)0 : (size_t)HALF * g.lda * ES;
    const size_t hstepB = (size_t)HALF * g.ldb * ES;
    const unsigned ldsw = (unsigned)wid * 1024u;
    const int aoff = lds_byte(wr * 64 + fr, fq * 8), boff = lds_byte(wc * 32 + fr, fq * 8);
    unsigned vA[2][2], nvA[2][2];
#define PG8_ROWS(dst, uidx) do { int t_ = wave * 64 + lane_now(); asm volatile("" : "+v"(t_)); int R0_, C0_; stage_rc(t_ * 16, R0_, C0_); \
        const PG8_LAS unsigned char* _t = S.table(uidx) + (unsigned)R0_ * 4u; const unsigned c2_ = (unsigned)C0_ * 2u; _Pragma("unroll") for (int h = 0; h < 2; ++h) _Pragma("unroll") for (int i = 0; i < 2; ++i) \
        dst[h][i] = *(const PG8_LAS unsigned*)(_t + h * 512 + i * 256) + c2_; } while (0)
#define PG8_SA(b, h) (((b) * 2 + (h)) * HTB)
#define PG8_SB(b, h) ((4 + (b) * 2 + (h)) * HTB)
#define PG8_STAGE(bufoff, gbase, voff) do { const char* _gb = (const char*)(gbase); asm volatile("" : "+s"(_gb));     \
        _Pragma("unroll") for (int _i = 0; _i < 2; ++_i) { const unsigned _la = (unsigned)__builtin_amdgcn_readfirstlane((int)(unsigned)(uintptr_t)(lds + (bufoff) + ldsw + _i * 8192)); \
            asm volatile("s_mov_b32 m0, %2\n\ts_nop 0\n\tglobal_load_lds_dwordx4 %0, %1" :: "v"((voff)[_i]), "s"(_gb), "s"(_la) : "memory", "m0"); } } while (0)
#define PG8_STB(b, h, ptr) PG8_STAGE(PG8_SB(b, h), (ptr) + (h) * hstepB, voffB)
#define PG8_STA(b, h, ptr, nx) do { if constexpr (GATHER) { unsigned _v[2]; _v[0] = (nx) ? nvA[h][0] : vA[h][0]; _v[1] = (nx) ? nvA[h][1] : vA[h][1]; PG8_STAGE(PG8_SA(b, h), (ptr), _v); } \
        else { PG8_STAGE(PG8_SA(b, h), (ptr) + (h) * hstepA, voffA); } } while (0)
#define PG8_LDA(dst, b, h) do { _Pragma("unroll") for (int m = 0; m < 4; ++m) _Pragma("unroll") for (int k = 0; k < 2; ++k) dst[m][k] = *(const PG8_LAS bf16x8*)(lds + PG8_SA(b, h) + aoff + m * 2048 + k * 1024); } while (0)
#define PG8_LDB(dst, b, h) do { _Pragma("unroll") for (int n = 0; n < 2; ++n) _Pragma("unroll") for (int k = 0; k < 2; ++k) dst[n][k] = *(const PG8_LAS bf16x8*)(lds + PG8_SB(b, h) + boff + n * 2048 + k * 1024); } while (0)
#define PG8_MMA(ai, bj, At, Bt, Z) do { const f32x4 z4_ = {0.f, 0.f, 0.f, 0.f}; __builtin_amdgcn_s_setprio(1); _Pragma("unroll") for (int m = 0; m < 4; ++m) _Pragma("unroll") for (int n = 0; n < 2; ++n) { \
        if constexpr (ES == 2) { acc[ai][bj][m][n] = __builtin_amdgcn_mfma_f32_16x16x32_bf16(Bt[n][0], At[m][0], (Z) ? z4_ : acc[ai][bj][m][n], 0, 0, 0); acc[ai][bj][m][n] = __builtin_amdgcn_mfma_f32_16x16x32_bf16(Bt[n][1], At[m][1], acc[ai][bj][m][n], 0, 0, 0); } \
        else { typedef int v8i_ __attribute__((ext_vector_type(8))); const u32x4 b0_ = __builtin_bit_cast(u32x4, Bt[n][0]), b1_ = __builtin_bit_cast(u32x4, Bt[n][1]), a0_ = __builtin_bit_cast(u32x4, At[m][0]), a1_ = __builtin_bit_cast(u32x4, At[m][1]); \
            const v8i_ bv_ = {(int)b0_[0], (int)b0_[1], (int)b0_[2], (int)b0_[3], (int)b1_[0], (int)b1_[1], (int)b1_[2], (int)b1_[3]}, av_ = {(int)a0_[0], (int)a0_[1], (int)a0_[2], (int)a0_[3], (int)a1_[0], (int)a1_[1], (int)a1_[2], (int)a1_[3]}; \
            acc[ai][bj][m][n] = __builtin_amdgcn_mfma_scale_f32_16x16x128_f8f6f4(bv_, av_, (Z) ? z4_ : acc[ai][bj][m][n], 0, 0, 0, 0, 0, 0); } }     \
        __builtin_amdgcn_s_setprio(0); \
        _Pragma("unroll") for (int m = 0; m < 4; ++m) asm volatile("" : "+v"(acc[ai][bj][m][0]), "+v"(acc[ai][bj][m][1]));     \
        } while (0)
#define PG8_WAIT_V(n) asm volatile("s_waitcnt vmcnt(" #n ")" ::: "memory")
#define PG8_WAIT_L(n) asm volatile("s_waitcnt lgkmcnt(" #n ")" ::: "memory")
#define PG8_BAR __builtin_amdgcn_s_barrier()
#define PG8_SCHED __builtin_amdgcn_sched_barrier(0)
    Unit cur, nxt; int ui = 0;
    if (!S.next(0, cur)) return;
    uni_unit(cur);
    f32x4 acc[2][2][4][2];
    bf16x8 At[4][2], B0[2][2], B1[2][2];
    const char* cA = cur.A; const char* cB = cur.B;
    if constexpr (GATHER) { PG8_ROWS(vA, 0); }
    PG8_STB(0, 0, cB); PG8_STB(0, 1, cB); PG8_STA(0, 0, cA, false); PG8_STA(0, 1, cA, false);
    if (wr == 1) PG8_BAR;
    PG8_WAIT_V(2); PG8_BAR;
    PG8_STB(1, 0, cB + kstep); PG8_STA(1, 0, cA + kstep, false); PG8_STB(1, 1, cB + kstep);
    PG8_WAIT_V(6); PG8_BAR;
    for (;;) {
        const bool has_next = S.next(ui + 1, nxt);
        if (has_next) uni_unit(nxt);
        const char* nA = has_next ? nxt.A : cA; const char* nB = has_next ? nxt.B : cB;
#define PG8_KPAIR(t, LAST, ZERO) do { \
            const char* a1 = cA + (size_t)((t) + 1) * kstep; \
            const char* a2 = (LAST) ? nA : cA + (size_t)((t) + 2) * kstep; const char* b2 = (LAST) ? nB : cB + (size_t)((t) + 2) * kstep; \
            const char* a3 = a2 + kstep; const char* b3 = b2 + kstep; \
              \
            PG8_LDB(B0, 0, 0); PG8_LDB(B1, 0, 1); PG8_SCHED; PG8_LDA(At, 0, 0); PG8_STA(1, 1, a1, false); \
            PG8_WAIT_V(8); PG8_WAIT_L(0); PG8_BAR; PG8_MMA(0, 0, At, B0, ZERO); PG8_MMA(0, 1, At, B1, ZERO); PG8_BAR; PG8_SCHED; \
              \
            PG8_LDA(At, 0, 1); PG8_STB(0, 0, b2); PG8_STB(0, 1, b2); PG8_STA(0, 0, a2, LAST); \
            PG8_WAIT_V(8); PG8_WAIT_L(0); PG8_BAR; PG8_MMA(1, 0, At, B0, ZERO); PG8_MMA(1, 1, At, B1, ZERO); PG8_BAR; PG8_SCHED; \
              \
            PG8_LDB(B0, 1, 0); PG8_LDB(B1, 1, 1); PG8_SCHED; PG8_LDA(At, 1, 0); PG8_STA(0, 1, a2, LAST); \
            PG8_WAIT_V(8); PG8_WAIT_L(0); PG8_BAR; PG8_MMA(0, 0, At, B0, false); PG8_MMA(0, 1, At, B1, false); PG8_BAR; PG8_SCHED; \
              \
            PG8_LDA(At, 1, 1); PG8_STB(1, 0, b3); PG8_STB(1, 1, b3); PG8_STA(1, 0, a3, LAST); \
            PG8_WAIT_V(8); PG8_WAIT_L(0); PG8_BAR; PG8_MMA(1, 0, At, B0, false); PG8_MMA(1, 1, At, B1, false); PG8_BAR; PG8_SCHED; } while (0)
        PG8_KPAIR(0, false, true);
        _Pragma("nounroll") for (int t = 2; t < nt - 2; t += 2) { PG8_KPAIR(t, false, false); if constexpr (Hook::ON) { if (t == Hook::AT) H(acc, cur, wr, wc, fr, fq); } }
        if constexpr (GATHER) {
            if (has_next) { PG8_ROWS(nvA, ui + 1); }
            else {
#pragma unroll
                for (int h = 0; h < 2; ++h)
#pragma unroll
                    for (int i = 0; i < 2; ++i) nvA[h][i] = vA[h][i]; }
        }
        PG8_KPAIR(nt - 2, true, false);
#undef PG8_KPAIR
        if constexpr (ALIGN_EPI) { if (wr == 0) PG8_BAR; }
        E(acc, cur, wr, wc, fr, fq);
        if (!has_next) break;
        cur = nxt; cA = nA; cB = nB; ++ui;
        if constexpr (GATHER) {
#pragma unroll
            for (int h = 0; h < 2; ++h)
#pragma unroll
                for (int i = 0; i < 2; ++i) vA[h][i] = nvA[h][i];
        }
        if constexpr (ALIGN_EPI) { if (wr == 1) PG8_BAR; }
    }
    PG8_WAIT_V(0);
    if constexpr (!ALIGN_EPI) { if (wr == 0) PG8_BAR; }
    PG8_BAR;
#undef PG8_SA
#undef PG8_SB
#undef PG8_STAGE
#undef PG8_STB
#undef PG8_ROWS
#undef PG8_STA
#undef PG8_LDA
#undef PG8_LDB
#undef PG8_MMA
#undef PG8_WAIT_V
#undef PG8_WAIT_L
#undef PG8_BAR
#undef PG8_SCHED
}
}

constexpr int NWAVES = 8;
constexpr int NT = 32768, DM = 1024, SEQ = 2048, NBATCH = 16, INW = 3080, NE = 32, PLE = 256;
constexpr float EPS = 1e-6f;
constexpr float LOG2E = 1.4426950408889634f;
constexpr float C2 = 0.125f * 1.4426950408889634f;
constexpr int N1 = 5120;
constexpr int MAXRT = 576;
constexpr int MAXUNITS = 24;

constexpr size_t MiB = 1u << 20;
constexpr size_t WS_CTL = 0, CTL_ZERO_BYTES = 1 * MiB;
constexpr size_t WS_TOK = 2 * MiB;
constexpr size_t WS_RSOF = 6 * MiB;
constexpr size_t WS_TOPE = 10 * MiB;
constexpr size_t WS_TOPW = 10 * MiB + 512 * 1024;
constexpr size_t WS_POS = 11 * MiB;
constexpr size_t WS_LOGF = 12 * MiB;
constexpr size_t WS_CUM = 13 * MiB;
constexpr size_t WS_ROT = 14 * MiB;
constexpr size_t WS_RSTD2 = 14 * MiB + 512 * 1024;
constexpr size_t WS_WRT = 15 * MiB;
constexpr size_t WS_W1T = 16 * MiB;
constexpr size_t WS_WBT = 26 * MiB;
constexpr size_t WS_WOT = 28 * MiB;
constexpr size_t WS_WPGT = 30 * MiB;
constexpr size_t WS_WPPT = 32 * MiB;
constexpr size_t WS_WGUT = 34 * MiB;
constexpr size_t WS_WDT = 162 * MiB;
constexpr size_t WS_HB = 226 * MiB;
constexpr size_t WS_PB = 291 * MiB;
constexpr size_t WS_Z = 307 * MiB;
constexpr size_t WS_XN = WS_Z, WS_FQ = WS_Z + 64 * MiB, WS_FK = WS_Z + 96 * MiB, WS_FV = WS_Z + 128 * MiB, WS_RQ = WS_Z + 160 * MiB, WS_RK = WS_Z + 176 * MiB;
constexpr size_t WS_RV = WS_Z + 192 * MiB, WS_RGS = WS_Z + 224 * MiB, WS_GATES = WS_Z + 256 * MiB, WS_BR = WS_Z + 384 * MiB, WS_MERGED = WS_Z + 448 * MiB;
constexpr size_t WS_RKT = WS_Z + 512 * MiB;
constexpr size_t WS_XN8 = WS_Z + 528 * MiB;
constexpr size_t WS_WG8T = WS_W1T + 4 * MiB;
constexpr size_t WS_H2B = WS_Z + 448 * MiB;
constexpr size_t WS_MO = WS_Z + 512 * MiB;
constexpr size_t WS_ACT = WS_Z, WS_Y = WS_Z + 144 * MiB;
constexpr size_t WS_HB2 = WS_Z, WS_PJ = WS_Z + 384 * MiB, WS_G8 = WS_Z + 160 * MiB;
constexpr size_t WS_END = WS_Z + 576 * MiB;
constexpr int CW_BAR = 4096;
constexpr int CW_CNT = 8192;
constexpr int CW_QUEUE = 8256;
constexpr int CW_SSQ = 16384;
static_assert((CW_SSQ + NT) * 4 <= (int)CTL_ZERO_BYTES, "CTL words inside the memset region");

constexpr int RING_OFF = 0, RING_BYTES = 131072;
constexpr int TAB_OFF = RING_BYTES;
constexpr int SCH_OFF = TAB_OFF + MAXUNITS * 1024;
constexpr int SCH_CNT = SCH_OFF, SCH_P = SCH_OFF + 128, SCH_RT2E = SCH_OFF + 128 + 160;
constexpr int MISC_OFF = SCH_RT2E + MAXRT * 4;
constexpr int LDS_BYTES = 163840;
static_assert(MISC_OFF + 256 <= LDS_BYTES && (MISC_OFF % 16) == 0, "LDS map");

#define GAS __attribute__((address_space(1)))
#define LAS __attribute__((address_space(3)))
typedef unsigned short bf16;
typedef unsigned v4u __attribute__((ext_vector_type(4)));
typedef unsigned v2u __attribute__((ext_vector_type(2)));
typedef float f32x4 __attribute__((ext_vector_type(4)));
typedef short bf16x8 __attribute__((ext_vector_type(8)));
typedef GAS unsigned gu32;
#define RLX_AGENT __ATOMIC_RELAXED, __HIP_MEMORY_SCOPE_AGENT
#define LDS_WAIT() asm volatile("s_waitcnt lgkmcnt(0)" ::: "memory")
#define VM_WAIT() asm volatile("s_waitcnt vmcnt(0)" ::: "memory")
__device__ __forceinline__ unsigned f2bf(float f) { unsigned u = __builtin_bit_cast(unsigned, f); return (u + 0x7fffu + ((u >> 16) & 1u)) >> 16; }
__device__ __forceinline__ unsigned pk2(float lo, float hi) { return f2bf(lo) | (f2bf(hi) << 16); }
using pg8::bflo; using pg8::bfhi; using pg8::fsigmoid; using pg8::cvt_pk_bf16;
constexpr float WSCALE = 32.f;
constexpr float YSCALE = 8.f;
__device__ __forceinline__ float clamp_f8(float v) { return fminf(fmaxf(v, -448.f), 448.f); }
__device__ __forceinline__ v2u pack8_fp8(const f32x4 a, const f32x4 b) {
    int w0 = 0, w1 = 0;
    w0 = __builtin_amdgcn_cvt_pk_fp8_f32(clamp_f8(a[0]), clamp_f8(a[1]), w0, false); w0 = __builtin_amdgcn_cvt_pk_fp8_f32(clamp_f8(a[2]), clamp_f8(a[3]), w0, true);
    w1 = __builtin_amdgcn_cvt_pk_fp8_f32(clamp_f8(b[0]), clamp_f8(b[1]), w1, false); w1 = __builtin_amdgcn_cvt_pk_fp8_f32(clamp_f8(b[2]), clamp_f8(b[3]), w1, true);
    return (v2u){(unsigned)w0, (unsigned)w1}; }
#define DPP_F(v, ctrl) __int_as_float(__builtin_amdgcn_update_dpp(0, __float_as_int(v), (ctrl), 0xF, 0xF, false))
__device__ __forceinline__ float wave_sum(float v) {
    v += DPP_F(v, 0xB1); v += DPP_F(v, 0x4E); v += DPP_F(v, 0x141); v += DPP_F(v, 0x140);
    const int b = __float_as_int(v);
    return (__int_as_float(__builtin_amdgcn_readlane(b, 0)) + __int_as_float(__builtin_amdgcn_readlane(b, 16))) + (__int_as_float(__builtin_amdgcn_readlane(b, 32)) + __int_as_float(__builtin_amdgcn_readlane(b, 48)));
}
__device__ __forceinline__ float xor32_sum(float v) { auto rr = __builtin_amdgcn_permlane32_swap(__float_as_uint(v), __float_as_uint(v), false, false); return __uint_as_float(rr[0]) + __uint_as_float(rr[1]); }
__device__ __forceinline__ float xor16_sum(float v) { auto rr = __builtin_amdgcn_permlane16_swap(__float_as_uint(v), __float_as_uint(v), false, false); return __uint_as_float(rr[0]) + __uint_as_float(rr[1]); }

#define XB_TMO      128
#define XB_XCNT(j)  (256  + 64 * (j))
#define XB_XSUB(j)  (1280 + 64 * (j))
#define XB_XGEN(j)  (2304 + 64 * (j))
#define XB_TOP      3328
#define XB_TOPGEN   3392
#define XCD_BAR_WORDS 3456
#define XB_SPIN_CAP (1u << 20)

__device__ __forceinline__ unsigned xb_ld(unsigned* p)              { return __hip_atomic_load(p, __ATOMIC_RELAXED, __HIP_MEMORY_SCOPE_AGENT); }
__device__ __forceinline__ unsigned xb_add(unsigned* p, unsigned v) { return __hip_atomic_fetch_add(p, v, __ATOMIC_RELAXED, __HIP_MEMORY_SCOPE_AGENT); }
__device__ __forceinline__ unsigned xb_xcc_id() { return (unsigned)__builtin_amdgcn_s_getreg((3 << 11) | 20) & 0xFu; }
#define XB_SPIN(cond, bar) do { unsigned _sp = 0; while (cond) { __builtin_amdgcn_s_sleep(1); \
    if ((++_sp & 255u) == 0u) { if (xb_ld(&(bar)[XB_TMO])) break; if (_sp > XB_SPIN_CAP) { atomicAdd(&(bar)[XB_TMO], 1u); break; } } } } while (0)

struct XcdBarrier {
    unsigned* bar; unsigned x;
    volatile LAS unsigned* st;
};
__device__ __forceinline__ XcdBarrier xcd_barrier_post(unsigned* bar, volatile LAS unsigned* st, int tid) {
    XcdBarrier b; b.bar = bar; b.x = xb_xcc_id(); b.st = st;
    if (tid == 0) (void)xb_add(&bar[XB_XCNT(b.x)], 1u);
    return b;
}
__device__ __forceinline__ void xcd_barrier_complete(unsigned* bar, unsigned x, unsigned& nloc, unsigned& nx) {
    const unsigned G = gridDim.x * gridDim.y * gridDim.z;
    unsigned sum, cnt, mine, sp = 0u;
    for (;;) {
        sum = 0u; cnt = 0u; mine = 0u;
#pragma unroll
        for (unsigned j = 0; j < 16; ++j) { const unsigned c = xb_ld(&bar[XB_XCNT(j)]); sum += c; cnt += (c > 0u) ? 1u : 0u; mine = (j == x) ? c : mine; }
        if (sum == G) break;
        __builtin_amdgcn_s_sleep(1);
        if ((++sp & 255u) == 0u) { if (xb_ld(&bar[XB_TMO])) break; if (sp > XB_SPIN_CAP) { atomicAdd(&bar[XB_TMO], 1u); break; } }
    }
    nloc = mine > 0u ? mine : 1u; nx = cnt > 0u ? cnt : 1u;
}
__device__ __forceinline__ void xcd_barrier(const XcdBarrier& b, int tid) {
    asm volatile("s_waitcnt vmcnt(0)" ::: "memory");
    __syncthreads();
    if (tid == 0) {
        unsigned* bar = b.bar;
        __builtin_amdgcn_s_waitcnt(0);
        unsigned nloc = b.st[0], nx = b.st[1];
        if (nloc == 0u) { xcd_barrier_complete(bar, b.x, nloc, nx); b.st[0] = nloc; b.st[1] = nx; }
        const unsigned old = xb_add(&bar[XB_XSUB(b.x)], 1u);
        const unsigned gen = old / nloc;
        if (old + 1u == (gen + 1u) * nloc) {
            __builtin_amdgcn_fence(__ATOMIC_RELEASE, "agent");
            asm volatile("s_waitcnt vmcnt(0)" ::: "memory");
            const unsigned og = xb_add(&bar[XB_TOP], 1u);
            const unsigned tg = og / nx;
            if (og + 1u == (tg + 1u) * nx) xb_add(&bar[XB_TOPGEN], 1u);
            else XB_SPIN(xb_ld(&bar[XB_TOPGEN]) == tg, bar);
            __builtin_amdgcn_fence(__ATOMIC_ACQUIRE, "agent");
            xb_add(&bar[XB_XGEN(b.x)], 1u);
            asm volatile("s_waitcnt vmcnt(0)" ::: "memory");
        } else {
            XB_SPIN(xb_ld(&bar[XB_XGEN(b.x)]) == gen, bar);
            __builtin_amdgcn_fence(__ATOMIC_ACQUIRE, "agent");
            asm volatile("s_waitcnt vmcnt(0)" ::: "memory");
        }
    }
    __syncthreads();
}

struct Args { const float* in[20]; float* out; unsigned char* ws; int ph_lo, ph_hi, rep_phase, rep_mode; };
struct Frame {
    LAS unsigned char* lds;
    volatile LAS unsigned* MISC;
    int tid, lane, wave;
    int vcu, G;
    const __attribute__((address_space(4))) Args* ap;
};
#define REARGS() do { F.ap = (const __attribute__((address_space(4))) Args*)__builtin_amdgcn_kernarg_segment_ptr(); asm volatile("" : "+s"(F.ap)); } while (0)
#define WSP(T, off) ((T*)(F.ap->ws + (off)))

#include <hip/hip_bf16.h>
namespace attn_body {
using bf16=__hip_bfloat16;
using bf16x8=__attribute__((ext_vector_type(8)))short;
using s16x4=__attribute__((ext_vector_type(4)))short;
using f32x16=__attribute__((ext_vector_type(16)))float;
using u32x4=__attribute__((ext_vector_type(4)))unsigned;
constexpr int BATCH=16,NHEAD=8,SEQ=2048,D=64,DM=NHEAD*D,OPITCH=1024;
constexpr int NW=8,QBLK=32,QB=QBLK*NW,KVBLK=64,NQB=SEQ/QB;
constexpr int ATTN_PITCH=DM, ATTN_UNIT_ROWS=QB;
__device__ __forceinline__ int crow(int r,int hi){return (r&3)+8*(r>>2)+4*hi;}
#define SBAR() __builtin_amdgcn_sched_barrier(0)
__device__ __forceinline__ void cmask(f32x16&p0,f32x16&p1,int jb,int qrel,int hi){
  const float NEG=-INFINITY; int kb=64*jb+4*hi;
  #pragma unroll
  for(int r=0;r<16;++r){int kv=kb+(r&3)+8*(r>>2); if(kv>qrel)p0[r]=NEG; if(kv+32>qrel)p1[r]=NEG;}
}

constexpr int NSLOT=3, SLOTB=8192;
constexpr int LDS_K=0, LDS_V=NSLOT*SLOTB, LDS_WS=2*NSLOT*SLOTB, LDS_OST=LDS_WS+NW*64*4, LDS_KB=LDS_OST+NW*4096, LDS_BYTES=LDS_KB+SEQ*16;
constexpr float C2=0.125f*1.4426950408889634f;
__device__ __forceinline__ void glds16(const void*gsrc,unsigned lds_dst){unsigned keep;
  asm volatile("s_mov_b32 %0, m0\n\ts_mov_b32 m0, %2\n\ts_nop 0\n\tglobal_load_lds_dwordx4 %1, off\n\ts_mov_b32 m0, %0":"=&s"(keep):"v"(gsrc),"s"(lds_dst):"memory");}
__device__ __forceinline__ float max3f(float a,float b,float c){float r;asm("v_max3_f32 %0, %1, %2, %3":"=v"(r):"v"(a),"v"(b),"v"(c));return r;}
__device__ __forceinline__ float max2f(float a,float b){float r;asm("v_max_f32_e32 %0, %1, %2":"=v"(r):"v"(a),"v"(b));return r;}
__device__ __forceinline__ float fadd_s(float a,float b){float r;asm("v_add_f32_e32 %0, %1, %2":"=v"(r):"v"(a),"v"(b));return r;}
__device__ __forceinline__ float fsub_s(float a,float b){float r;asm("v_sub_f32_e32 %0, %1, %2":"=v"(r):"v"(a),"v"(b));return r;}
typedef float f32x2_t __attribute__((ext_vector_type(2))); typedef __bf16 bf16x2_t __attribute__((ext_vector_type(2)));
__device__ __forceinline__ unsigned cvtpk_s(float lo,float hi){f32x2_t v={lo,hi};bf16x2_t b=__builtin_convertvector(v,bf16x2_t);return __builtin_bit_cast(unsigned,b);}
#define WAIT_BAR(N) asm volatile("s_waitcnt vmcnt(" #N ") lgkmcnt(0)\n\ts_barrier":::"memory")

__device__ __forceinline__ void qkt(f32x16&p0,f32x16&p1,const char*Kslot,const bf16x8*qr,const bf16x8 qx,const bf16x8 kb0,const bf16x8 kb1,int r32,int hi){
  const f32x16 zc=f32x16{};
  const char*kb=Kslot+hi*1024+r32*16;
  #pragma unroll
  for(int d0=0;d0<4;++d0){
    const bf16x8 b0=*reinterpret_cast<const bf16x8*>(kb+d0*2048);
    const bf16x8 b1=*reinterpret_cast<const bf16x8*>(kb+d0*2048+512);
    if(d0==0){p0=__builtin_amdgcn_mfma_f32_32x32x16_bf16(b0,qr[0],zc,0,0,0);p1=__builtin_amdgcn_mfma_f32_32x32x16_bf16(b1,qr[0],zc,0,0,0);}
    else{p0=__builtin_amdgcn_mfma_f32_32x32x16_bf16(b0,qr[d0],p0,0,0,0);p1=__builtin_amdgcn_mfma_f32_32x32x16_bf16(b1,qr[d0],p1,0,0,0);}}
  p0=__builtin_amdgcn_mfma_f32_32x32x16_bf16(kb0,qx,p0,0,0,0);p1=__builtin_amdgcn_mfma_f32_32x32x16_bf16(kb1,qx,p1,0,0,0);
}
typedef __attribute__((address_space(3))) const char* lds_cptr;
typedef short v4i16_t __attribute__((ext_vector_type(4)));
__device__ __forceinline__ void kload8(bf16x8*kf,lds_cptr kp){
  kf[0]=*(const __attribute__((address_space(3))) bf16x8*)(kp);      kf[1]=*(const __attribute__((address_space(3))) bf16x8*)(kp+512);
  kf[2]=*(const __attribute__((address_space(3))) bf16x8*)(kp+2048); kf[3]=*(const __attribute__((address_space(3))) bf16x8*)(kp+2560);
  kf[4]=*(const __attribute__((address_space(3))) bf16x8*)(kp+4096); kf[5]=*(const __attribute__((address_space(3))) bf16x8*)(kp+4608);
  kf[6]=*(const __attribute__((address_space(3))) bf16x8*)(kp+6144); kf[7]=*(const __attribute__((address_space(3))) bf16x8*)(kp+6656);
}
__device__ __forceinline__ void kload2(bf16x8*kf,lds_cptr kp,int j){ kf[2*j]=*(const __attribute__((address_space(3))) bf16x8*)(kp+j*2048); kf[2*j+1]=*(const __attribute__((address_space(3))) bf16x8*)(kp+j*2048+512); }
__device__ __forceinline__ s16x4 vtr(lds_cptr p){ return __builtin_bit_cast(s16x4,__builtin_amdgcn_ds_read_tr16_b64_v4i16((__attribute__((address_space(3))) v4i16_t*)p)); }
__device__ __forceinline__ float rowmax(const f32x16&p0,const f32x16&p1){
  float a=max3f(p0[0],p0[1],p1[0]),b=max3f(p0[2],p0[3],p1[1]);a=max3f(a,p1[2],p1[3]);
  #pragma unroll
  for(int r=4;r<16;r+=4){a=max3f(a,p0[r],p0[r+1]);b=max3f(b,p0[r+2],p0[r+3]);a=max3f(a,p1[r],p1[r+1]);b=max3f(b,p1[r+2],p1[r+3]);}
  const float m=max2f(a,b);
  auto rr=__builtin_amdgcn_permlane32_swap(__float_as_uint(m),__float_as_uint(m),false,false);
  return max2f(__uint_as_float(rr[0]),__uint_as_float(rr[1]));
}
__device__ __forceinline__ void pv(f32x16*o,int vb,bf16x8 pa0,bf16x8 pa1,bf16x8 pa2,bf16x8 pa3){
  #pragma unroll
  for(int d0=0;d0<2;++d0){s16x4 lo[4],hi[4];
    #pragma unroll
    for(int ks=0;ks<4;++ks){
      asm volatile("ds_read_b64_tr_b16 %0,%1 offset:%c2":"=&v"(lo[ks]):"v"(vb),"i"(d0*4096+ks*1024):"memory");
      asm volatile("ds_read_b64_tr_b16 %0,%1 offset:%c2":"=&v"(hi[ks]):"v"(vb),"i"(d0*4096+ks*1024+512):"memory");}
    asm volatile("s_waitcnt lgkmcnt(0)":::"memory");SBAR();
    #define PK(k) (bf16x8){lo[k][0],lo[k][1],lo[k][2],lo[k][3],hi[k][0],hi[k][1],hi[k][2],hi[k][3]}
    o[d0]=__builtin_amdgcn_mfma_f32_32x32x16_bf16(pa0,PK(0),o[d0],0,0,0);
    o[d0]=__builtin_amdgcn_mfma_f32_32x32x16_bf16(pa1,PK(1),o[d0],0,0,0);
    o[d0]=__builtin_amdgcn_mfma_f32_32x32x16_bf16(pa2,PK(2),o[d0],0,0,0);
    o[d0]=__builtin_amdgcn_mfma_f32_32x32x16_bf16(pa3,PK(3),o[d0],0,0,0);
    #undef PK
  }
}

__device__ __forceinline__ void split3(float v,unsigned&a,unsigned&b,unsigned&c){ a=cvtpk_s(v,0.f)&0xffffu; const float r1=v-__uint_as_float(a<<16); b=cvtpk_s(r1,0.f)&0xffffu; const float r2=r1-__uint_as_float(b<<16); c=cvtpk_s(r2,0.f)&0xffffu; }
__device__ __forceinline__ bf16x8 make_qx(float m,int hi){ unsigned a,b,c; split3(m,a,b,c); u32x4 w={0x3F803F80u,0x3F80u|(a<<16),b|(c<<16),0u}; if(hi)w=(u32x4){0u,0u,0u,0u}; return __builtin_bit_cast(bf16x8,w); }
#ifndef ATTN_STORE16
#define ATTN_STORE16(p,v) (*(u32x4*)(p)=(v))
#endif
template<int THRL> __device__ __forceinline__ void attn_unit(int b,int h,int qb,const bf16*Q,const bf16*__restrict__ K,const bf16*__restrict__ V,bf16*O,const float*__restrict__ cum,char*shm,int wave){
  int tid=wave*64+lane_now(); asm volatile("":"+v"(tid));
  const int lane=tid&63,r32=lane&31,hi=lane>>5; const int wid=__builtin_amdgcn_readfirstlane(tid>>6);
  const long rowbase=(long)b*SEQ; const int q0=qb*QB;
  const bf16*Qw=Q+(rowbase+q0+wid*QBLK)*DM+h*D;
  const bf16*Kh=K+rowbase*DM+h*D,*Vh=V+rowbase*DM+h*D;
  const unsigned lds0=(unsigned)(uintptr_t)shm;
  float*wsf=(float*)(shm+LDS_WS)+wid*64;
  const bf16*ksrc=Kh+(long)lane*DM+wid*8;
  const bf16*vsrc=Vh+(long)(16*(wid&3)+(lane>>2))*DM+(wid>>2)*32+(lane&3)*8;
  const unsigned kdst=lds0+LDS_K+wid*1024, vdst=lds0+LDS_V+wid*1024;
  #define DMA_K(t,slot) glds16(ksrc+(long)(t)*KVBLK*DM,(unsigned)__builtin_amdgcn_readfirstlane(kdst+(slot)))
  #define DMA_V(t,slot) glds16(vsrc+(long)(t)*KVBLK*DM,(unsigned)__builtin_amdgcn_readfirstlane(vdst+(slot)))
  const int vb0=(int)(lds0+LDS_V)+((lane>>4)&1)*32+(lane&3)*8+(4*hi+((lane&15)>>2))*64;
  const char*Kbase=shm+LDS_K; bf16x8 kf[8];
  const lds_cptr shm3=(lds_cptr)shm; const lds_cptr kp0=shm3+LDS_K+hi*1024+r32*16; const lds_cptr vp0=shm3+LDS_V+((lane>>4)&1)*32+(lane&3)*8+(4*hi+((lane&15)>>2))*64;
  const int NT=(q0+QB)/KVBLK;
  const lds_cptr kbp=shm3+LDS_KB+r32*16;
  DMA_K(0,0);DMA_V(0,0);DMA_K(1,SLOTB);
  { const float cref=cum[q0+QB-1]; float cv[SEQ/(NW*64)];
    #pragma unroll
    for(int i=0;i<SEQ/(NW*64);++i){ const int kv=tid+i*NW*64; cv[i]=(kv<q0+QB)?cum[kv]:0.f; }
    #pragma unroll
    for(int i=0;i<SEQ/(NW*64);++i){ const int kv=tid+i*NW*64; if(kv<q0+QB){ unsigned a,bb,c; split3((cref-cv[i])*1.4426950408889634f,a,bb,c);
      *(__attribute__((address_space(3))) u32x4*)((__attribute__((address_space(3))) char*)shm3+LDS_KB+kv*16)=(u32x4){a|(bb<<16),c|0xBF800000u,0xBF80BF80u,0u}; } } }
  bf16x8 qr[4];
  #pragma unroll
  for(int d0=0;d0<4;++d0)qr[d0]=*reinterpret_cast<const bf16x8*>(&Qw[(long)r32*DM+d0*16+hi*8]);
  float mhat=0.f,l_reg=0.f;f32x16 o[2];o[0]=f32x16{};o[1]=f32x16{};bf16x8 qx=make_qx(0.f,hi);const f32x16 zc=f32x16{};
  const int qrel=wid*QBLK+r32;
  #define CMASK(P0,P1,t) do{int jb_=(t)-(NT-4); if(jb_>=0)cmask(P0,P1,jb_,qrel,hi);}while(0)
  bool resc=false;
  #define START(P0,P1) do{ const float rm=rowmax(P0,P1); resc=false; \
    { const float dl=rm; mhat=fadd_s(mhat,dl); \
      _Pragma("unroll") for(int r=0;r<16;++r){P0[r]=fsub_s(P0[r],dl);P1[r]=fsub_s(P1[r],dl);} \
      qx=make_qx(mhat,hi); } \
    _Pragma("unroll") for(int r=0;r<16;++r)P0[r]=__builtin_amdgcn_exp2f(P0[r]); }while(0)
  #define RESC() do{ if(resc){ asm volatile("s_waitcnt lgkmcnt(0)":::"memory"); \
      _Pragma("unroll") for(int d_=0;d_<2;++d_) _Pragma("unroll") for(int r=0;r<16;++r)o[d_][r]*=wsf[crow(r,hi)]; } }while(0)
  f32x16 pA0,pA1,pB0,pB1;
  int sl_prev=0,sl_cur=0,sl_next=SLOTB;
  #define ROT() do{sl_prev=sl_cur;sl_cur=sl_next;sl_next=(sl_next==(NSLOT-1)*SLOTB)?0:sl_next+SLOTB;}while(0)
  DMA_K(2,2*SLOTB);
  WAIT_BAR(3);
  qkt(pA0,pA1,Kbase,qr,qx,*(const __attribute__((address_space(3))) bf16x8*)(kbp),*(const __attribute__((address_space(3))) bf16x8*)(kbp+512),r32,hi);asm volatile("s_nop 15\n\ts_nop 7":"+v"(pA0),"+v"(pA1));CMASK(pA0,pA1,0);
  START(pA0,pA1);
  _Pragma("unroll") for(int r=0;r<16;++r)pA1[r]=__builtin_amdgcn_exp2f(pA1[r]);
  WAIT_BAR(0);
  DMA_K(3,0);DMA_V(1,SLOTB);
  ROT();
  kload8(kf,kp0+sl_cur);
  WAIT_BAR(2);
  s16x4 vlo[8],vhi[8]; u32x4 pw0,pw1,pw2,pw3;
  #define PKW(P,B) cvtpk_s(P[B],P[B+1])
  #define PAF(k) __builtin_bit_cast(bf16x8,pw##k)
  #define VFR(i) (bf16x8){vlo[i][0],vlo[i][1],vlo[i][2],vlo[i][3],vhi[i][0],vhi[i][1],vhi[i][2],vhi[i][3]}
  #define PIN(x) asm volatile("":"+v"(x))
  #define MX3(a,b,c) __builtin_fmaxf(__builtin_fmaxf((a),(b)),(c))
  #define GAPA(MF,A0,A1,A2,A3,W0,W1,PW) do{ MF; sacc+=A0; sacc+=A1; sacc+=A2; sacc+=A3; PIN(sacc); W0; W1; PIN(PW); SBAR(); }while(0)
  #define EX(v) __builtin_amdgcn_exp2f(v)
  #define GAPB(MF,X,B) do{ MF; X[B]=EX(X[B]); X[B+1]=EX(X[B+1]); X[B+2]=EX(X[B+2]); X[B+3]=EX(X[B+3]); PIN(X); SBAR(); }while(0)
  #define VRD(i) do{ vlo[i]=vtr(vp_+(((i)>>2)*4096+((i)&3)*1024)); vhi[i]=vtr(vp_+(((i)>>2)*4096+((i)&3)*1024+512)); }while(0)
  #define KRD(G,j) do{ if(G){ kload2(kf,kp0+sl_next,j); SBAR(); } }while(0)
  #define STEP(C0,C1,P0,P1,t,GK,GV,GL) do{ SBAR(); \
    const lds_cptr vp_=vp0+sl_prev; \
    const bf16x8 kb0_=*(const __attribute__((address_space(3))) bf16x8*)(kbp+(t)*1024), kb1_=*(const __attribute__((address_space(3))) bf16x8*)(kbp+(t)*1024+512); \
    VRD(0); SBAR(); float sacc=(P0[0]+P0[1]); \
    GAPA(C0=__builtin_amdgcn_mfma_f32_32x32x16_bf16(kf[0],qr[0],zc,0,0,0), P0[2],P0[3],P0[4],P0[5],     pw0[0]=PKW(P0,0), pw0[1]=PKW(P0,2), pw0); \
    VRD(4); SBAR(); GAPA(C1=__builtin_amdgcn_mfma_f32_32x32x16_bf16(kf[1],qr[0],zc,0,0,0), P0[6],P0[7],P0[8],P0[9],     pw0[2]=PKW(P0,4), pw0[3]=PKW(P0,6), pw0); \
    VRD(1); SBAR(); GAPA(C0=__builtin_amdgcn_mfma_f32_32x32x16_bf16(kf[2],qr[1],C0,0,0,0),   P0[10],P0[11],P0[12],P0[13], pw1[0]=PKW(P0,8), pw1[1]=PKW(P0,10), pw1); \
    VRD(5); SBAR(); GAPA(C1=__builtin_amdgcn_mfma_f32_32x32x16_bf16(kf[3],qr[1],C1,0,0,0),   P0[14],P0[15],P1[0],P1[1],   pw1[2]=PKW(P0,12),pw1[3]=PKW(P0,14), pw1); \
    VRD(2); SBAR(); GAPA(C0=__builtin_amdgcn_mfma_f32_32x32x16_bf16(kf[4],qr[2],C0,0,0,0),   P1[2],P1[3],P1[4],P1[5],     pw2[0]=PKW(P1,0), pw2[1]=PKW(P1,2), pw2); \
    VRD(6); SBAR(); GAPA(C1=__builtin_amdgcn_mfma_f32_32x32x16_bf16(kf[5],qr[2],C1,0,0,0),   P1[6],P1[7],P1[8],P1[9],     pw2[2]=PKW(P1,4), pw2[3]=PKW(P1,6), pw2); \
    VRD(3); SBAR(); GAPA(C0=__builtin_amdgcn_mfma_f32_32x32x16_bf16(kf[6],qr[3],C0,0,0,0),   P1[10],P1[11],P1[12],P1[13], pw3[0]=PKW(P1,8), pw3[1]=PKW(P1,10), pw3); \
    VRD(7); SBAR(); GAPA(C1=__builtin_amdgcn_mfma_f32_32x32x16_bf16(kf[7],qr[3],C1,0,0,0),   P1[14],P1[15],0.f,0.f,       pw3[2]=PKW(P1,12),pw3[3]=PKW(P1,14), pw3); \
    C0=__builtin_amdgcn_mfma_f32_32x32x16_bf16(kb0_,qx,C0,0,0,0); C1=__builtin_amdgcn_mfma_f32_32x32x16_bf16(kb1_,qx,C1,0,0,0); SBAR(); \
    l_reg+=sacc; \
    if(GK){DMA_K((t)+3,sl_cur);} if(GV){DMA_V((t)+1,sl_next);} \
    CMASK(C0,C1,t); \
    { float a=MX3(C0[0],C0[1],C1[0]),b=MX3(C0[2],C0[3],C1[1]); a=MX3(a,C1[2],C1[3]); \
      _Pragma("unroll") for(int r=4;r<16;r+=4){a=MX3(a,C0[r],C0[r+1]);b=MX3(b,C0[r+2],C0[r+3]);a=MX3(a,C1[r],C1[r+1]);b=MX3(b,C1[r+2],C1[r+3]);} \
      float rm=__builtin_fmaxf(a,b); { auto rr=__builtin_amdgcn_permlane32_swap(__float_as_uint(rm),__float_as_uint(rm),false,false); rm=__builtin_fmaxf(__uint_as_float(rr[0]),__uint_as_float(rr[1])); } \
      resc=false; \
      if(__builtin_expect(__any(rm>(float)THRL),0)){ const float dl=__builtin_fmaxf(rm,0.f); mhat+=dl; \
        _Pragma("unroll") for(int r=0;r<16;++r){C0[r]-=dl;C1[r]-=dl;} \
        qx=make_qx(mhat,hi); \
        const float f=__builtin_amdgcn_exp2f(-dl); l_reg*=f; if(hi==0)wsf[r32]=f; resc=true; } } \
    SBAR(); \
    GAPB(o[0]=__builtin_amdgcn_mfma_f32_32x32x16_bf16(PAF(0),VFR(0),o[0],0,0,0), C0,0); \
    GAPB(o[1]=__builtin_amdgcn_mfma_f32_32x32x16_bf16(PAF(0),VFR(4),o[1],0,0,0), C0,4); \
    KRD(GL,0); GAPB(o[0]=__builtin_amdgcn_mfma_f32_32x32x16_bf16(PAF(1),VFR(1),o[0],0,0,0), C0,8); \
    KRD(GL,1); GAPB(o[1]=__builtin_amdgcn_mfma_f32_32x32x16_bf16(PAF(1),VFR(5),o[1],0,0,0), C0,12); \
    KRD(GL,2); GAPB(o[0]=__builtin_amdgcn_mfma_f32_32x32x16_bf16(PAF(2),VFR(2),o[0],0,0,0), C1,0); \
    KRD(GL,3); GAPB(o[1]=__builtin_amdgcn_mfma_f32_32x32x16_bf16(PAF(2),VFR(6),o[1],0,0,0), C1,4); \
    GAPB(o[0]=__builtin_amdgcn_mfma_f32_32x32x16_bf16(PAF(3),VFR(3),o[0],0,0,0), C1,8); \
    GAPB(o[1]=__builtin_amdgcn_mfma_f32_32x32x16_bf16(PAF(3),VFR(7),o[1],0,0,0), C1,12); \
    }while(0)
  int t=1;
  #undef CMASK
  #define CMASK(P0,P1,t) do{}while(0)
  for(;t+5<NT;t+=2){
    STEP(pB0,pB1,pA0,pA1,t,true,true,true);     WAIT_BAR(2); RESC(); ROT();
    STEP(pA0,pA1,pB0,pB1,t+1,true,true,true);   WAIT_BAR(2); RESC(); ROT();
  }
  #undef CMASK
  #define CMASK(P0,P1,t) do{int jb_=(t)-(NT-4); if(jb_>=0)cmask(P0,P1,jb_,qrel,hi);}while(0)
  #define ENDW(tt) do{ if((tt)+3<NT){WAIT_BAR(2);} else if((tt)+2<NT){WAIT_BAR(1);} else {WAIT_BAR(0);} }while(0)
  for(;t+1<NT;t+=2){
    STEP(pB0,pB1,pA0,pA1,t,(t+3<NT),(t+1<NT),(t+1<NT));       ENDW(t);   RESC(); ROT();
    STEP(pA0,pA1,pB0,pB1,t+1,(t+4<NT),(t+2<NT),(t+2<NT));     ENDW(t+1); RESC(); ROT();
  }
  STEP(pB0,pB1,pA0,pA1,NT-1,false,false,false); RESC();
  { float sacc=pB0[0]+pB0[1]; _Pragma("unroll") for(int r=2;r<16;++r)sacc+=pB0[r]; _Pragma("unroll") for(int r=0;r<16;++r)sacc+=pB1[r]; l_reg+=sacc;
    pw0=(u32x4){PKW(pB0,0),PKW(pB0,2),PKW(pB0,4),PKW(pB0,6)};pw1=(u32x4){PKW(pB0,8),PKW(pB0,10),PKW(pB0,12),PKW(pB0,14)};pw2=(u32x4){PKW(pB1,0),PKW(pB1,2),PKW(pB1,4),PKW(pB1,6)};pw3=(u32x4){PKW(pB1,8),PKW(pB1,10),PKW(pB1,12),PKW(pB1,14)};
    SBAR(); pv(o,vb0+sl_cur,PAF(0),PAF(1),PAF(2),PAF(3)); }
  #undef PKW
  #undef PAF
  #undef VFR
  #undef PIN
  #undef MX3
  #undef GAPA
  #undef GAPB
  #undef EX
  #undef VRD
  #undef KRD
  #undef STEP
  #undef ENDW
  {auto rr=__builtin_amdgcn_permlane32_swap(__float_as_uint(l_reg),__float_as_uint(l_reg),false,false);l_reg=__uint_as_float(rr[0])+__uint_as_float(rr[1]);}
  if(hi==0)wsf[32+r32]=l_reg;asm volatile("s_waitcnt lgkmcnt(0)":::"memory");
  float rli[16];
  #pragma unroll
  for(int r=0;r<16;++r)rli[r]=__builtin_amdgcn_rcpf(wsf[32+crow(r,hi)]);
  bf16*Ow=O+(rowbase+q0+wid*QBLK)*OPITCH+h*D;
  { bf16*stg=(bf16*)(shm+LDS_OST)+wid*2048;
    #pragma unroll
    for(int r=0;r<16;++r){const int orow=crow(r,hi);
      #pragma unroll
      for(int d0=0;d0<2;++d0)stg[orow*64+d0*32+r32]=__float2bfloat16(o[d0][r]*rli[r]);}
    asm volatile("s_waitcnt lgkmcnt(0)":::"memory");
    #pragma unroll
    for(int i=0;i<4;++i){const int row=i*8+(lane>>3),ch=lane&7; const u32x4 v=*(const u32x4*)(stg+row*64+ch*8); ATTN_STORE16(Ow+(long)row*OPITCH+ch*8,v);} }
  asm volatile("s_waitcnt lgkmcnt(0)\n\ts_barrier":::"memory");
  #undef DMA_K
  #undef DMA_V
  #undef CMASK
  #undef START
  #undef RESC
  #undef ROT
}
constexpr int ATTN_LDS_BYTES=LDS_BYTES;
#undef SBAR
#undef WAIT_BAR
}

namespace ret_body {
constexpr int VT_P = 272, KT_P = 272, ST_P = 144, PW_P = 272;
constexpr int KC_P = 144;
constexpr int L_VT = 0, L_KT = L_VT + 128 * VT_P, L_ST = L_KT + 64 * KT_P, L_PW = L_ST + 128 * ST_P, PW_BYTES = 16 * PW_P, L_KC = L_PW + 8 * PW_BYTES, LDS_BYTES = L_KC + 128 * KC_P;
typedef short bf16x8 __attribute__((ext_vector_type(8)));
typedef float f32x4 __attribute__((ext_vector_type(4)));
#define dpp_f(v, ctrl) __int_as_float(__builtin_amdgcn_update_dpp(0, __float_as_int(v), (ctrl), 0xF, 0xF, false))
#define RB_MFMA(a, b, c) __builtin_amdgcn_mfma_f32_16x16x32_bf16(__builtin_bit_cast(bf16x8, a), __builtin_bit_cast(bf16x8, b), c, 0, 0, 0)
__device__ __forceinline__ void ret_unit(LAS unsigned char* L, int b, int h, const bf16* RQ, const bf16* RK, const bf16* RVT, const bf16* RKT, const bf16* RGS, bf16* BR, int wave, int c0 = 0, int c1 = SEQ / 128, int pf0 = 0) {
    int tid = wave * 64 + lane_now(); asm volatile("" : "+v"(tid));
    const int lane = tid & 63, w = __builtin_amdgcn_readfirstlane(tid >> 6), r = lane & 15, q = lane >> 4;
    const float lg2 = log1pf(-exp2f(-5.f - (float)h)) * LOG2E;
    const float cd = __builtin_amdgcn_exp2f(128.f * lg2);
    unsigned z0 = 0u; asm volatile("" : "+v"(z0));
    f32x4 S[4];
#pragma unroll
    for (int i = 0; i < 4; ++i) { const float zf = __uint_as_float(z0); S[i] = (f32x4){zf, zf, zf, zf}; }
    for (int i = tid * 16; i < 128 * ST_P; i += NWAVES * 64 * 16) *(LAS v4u*)(L + L_ST + i) = (v4u){z0, z0, z0, z0};
    LAS unsigned char* Pw = L + L_PW + w * PW_BYTES;
    v4u pv[4], pkt[2], pkc[2], pq[2];
    const int t16 = tid & 15, trow = tid >> 4;
#define RB_LOAD(cc) do { const size_t r0_ = (size_t)b * SEQ + (size_t)(cc) * 128; const size_t it_ = (size_t)((b * 4 + h) * 16 + (cc)); \
        _Pragma("unroll") for (int j = 0; j < 4; ++j) pv[j] = *(const v4u*)(RVT + it_ * 16384 + (size_t)(32 * j + trow) * 128 + 8 * t16); \
        _Pragma("unroll") for (int j = 0; j < 2; ++j) pkt[j] = *(const v4u*)(RKT + it_ * 8192 + (size_t)(32 * j + trow) * 128 + 8 * t16); \
        _Pragma("unroll") for (int j = 0; j < 2; ++j) pkc[j] = *(const v4u*)(RK + (r0_ + 64 * j + (tid >> 3)) * 256 + h * 64 + 8 * (tid & 7)); \
        _Pragma("unroll") for (int ks = 0; ks < 2; ++ks) pq[ks] = *(const v4u*)(RQ + (r0_ + 16 * w + r) * 256 + h * 64 + 32 * ks + 8 * q); } while (0)
    RB_LOAD(0);
    for (int c = 0; c < c1; ++c) {
        const int pf = pf0 | ((c < c0) ? 3 : 0);
        const size_t row0 = (size_t)b * SEQ + (size_t)c * 128;
        float lg2c = lg2; asm volatile("" : "+v"(lg2c));
        if (!(pf & 8)) {
#pragma unroll
        for (int j = 0; j < 4; ++j) *(LAS v4u*)(L + L_VT + (32 * j + trow) * VT_P + 16 * t16) = pv[j];
#pragma unroll
        for (int j = 0; j < 2; ++j) *(LAS v4u*)(L + L_KT + (32 * j + trow) * KT_P + 16 * t16) = pkt[j];
        if (!(pf & 2)) {
#pragma unroll
        for (int j = 0; j < 2; ++j) *(LAS v4u*)(L + L_KC + (64 * j + (tid >> 3)) * KC_P + 16 * (tid & 7)) = pkc[j];
        }
        }
        v4u qf[2]; qf[0] = pq[0]; qf[1] = pq[1];
        __syncthreads();
        const float fdec = __builtin_amdgcn_exp2f((float)(16 * w + 4 * q - r) * lg2c);
        const float g1 = __builtin_amdgcn_exp2f(lg2c), g2 = g1 * g1, g3 = g2 * g1; float gm16[8];
        { const float gi = __builtin_amdgcn_exp2f(-16.f * lg2c); gm16[0] = 1.f;
#pragma unroll
          for (int j = 1; j < 8; ++j) gm16[j] = gm16[j - 1] * gi; }
        if (!(pf & 2)) {
#pragma unroll
        for (int jh = 0; jh < 2; ++jh) {
        v4u kk0[4], kk1[4];
#pragma unroll
        for (int jj = 0; jj < 4; ++jj) { const int jb = 4 * jh + jj; if (jb <= w) { kk0[jj] = *(const LAS v4u*)(L + L_KC + (16 * jb + r) * KC_P + 16 * q); kk1[jj] = *(const LAS v4u*)(L + L_KC + (16 * jb + r) * KC_P + 64 + 16 * q); } }
        __builtin_amdgcn_sched_barrier(0);
#pragma unroll
        for (int jj = 0; jj < 4; ++jj) { const int jb = 4 * jh + jj;
            if (jb <= w) {
                const v4u k0 = kk0[jj], k1 = kk1[jj];
                f32x4 acc = (f32x4){0.f, 0.f, 0.f, 0.f};
                acc = RB_MFMA(qf[0], k0, acc); acc = RB_MFMA(qf[1], k1, acc);
                const float f0 = fdec * gm16[jb];
                acc[0] *= f0; acc[1] *= f0 * g1; acc[2] *= f0 * g2; acc[3] *= f0 * g3;
                if (jb == w) {
#pragma unroll
                    for (int e = 0; e < 4; ++e) acc[e] = (4 * q - r + e >= 0) ? acc[e] : 0.f; }
                const unsigned p01 = cvt_pk_bf16(acc[0], acc[1]), p23 = cvt_pk_bf16(acc[2], acc[3]);
                LAS unsigned char* pp = Pw + (4 * q) * PW_P + (16 * jb + r) * 2;
                *(LAS unsigned short*)(pp) = (unsigned short)p01; *(LAS unsigned short*)(pp + PW_P) = (unsigned short)(p01 >> 16);
                *(LAS unsigned short*)(pp + 2 * PW_P) = (unsigned short)p23; *(LAS unsigned short*)(pp + 3 * PW_P) = (unsigned short)(p23 >> 16);
            } else if (jb == w + 1 && (w & 1) == 0) {
                LAS unsigned char* pp = Pw + (4 * q) * PW_P + (16 * jb + r) * 2;
                *(LAS unsigned short*)(pp) = 0; *(LAS unsigned short*)(pp + PW_P) = 0; *(LAS unsigned short*)(pp + 2 * PW_P) = 0; *(LAS unsigned short*)(pp + 3 * PW_P) = 0;
            }
        }
        __builtin_amdgcn_sched_barrier(0); }
        }
        LDS_WAIT(); asm volatile("" ::: "memory");
        if (c + 1 < c1) RB_LOAD(c + 1);
        if (!(pf & 2)) {
        v4u pg[4];
        { const size_t grow_ = row0 + 16 * w + (lane >> 4);
#pragma unroll
          for (int i = 0; i < 4; ++i) pg[i] = *(const v4u*)(RGS + (grow_ + 4 * i) * 512 + h * 128 + 8 * (lane & 15)); }
        f32x4 oi[8];
#pragma unroll
        for (int d = 0; d < 8; ++d) oi[d] = (f32x4){0.f, 0.f, 0.f, 0.f};
#pragma unroll
        for (int ks = 0; ks < 4; ++ks) {
            if (2 * ks <= w && !(pf & 2)) { const v4u pa = *(const LAS v4u*)(Pw + r * PW_P + (32 * ks + 8 * q) * 2); v4u vb[8];
#pragma unroll
                for (int d = 0; d < 8; ++d) vb[d] = *(const LAS v4u*)(L + L_VT + (16 * d + r) * VT_P + (32 * ks + 8 * q) * 2);
                __builtin_amdgcn_sched_barrier(0);
#pragma unroll
                for (int d = 0; d < 8; ++d) oi[d] = RB_MFMA(pa, vb[d], oi[d]);
                __builtin_amdgcn_sched_barrier(0); }
        }
        { const float rfq = __builtin_amdgcn_exp2f((float)(16 * w + r + 1) * lg2);
#pragma unroll
          for (int ks = 0; ks < 2; ++ks) { v4u sb[8], qs;
#pragma unroll
            for (int wd = 0; wd < 4; ++wd) qs[wd] = cvt_pk_bf16(bflo(qf[ks][wd]) * rfq, bfhi(qf[ks][wd]) * rfq);
#pragma unroll
            for (int d = 0; d < 8; ++d) sb[d] = *(const LAS v4u*)(L + L_ST + (16 * d + r) * ST_P + (32 * ks + 8 * q) * 2);
            __builtin_amdgcn_sched_barrier(0);
#pragma unroll
            for (int d = 0; d < 8; ++d) oi[d] = RB_MFMA(qs, sb[d], oi[d]);
            __builtin_amdgcn_sched_barrier(0); } }
        float ss[4];
#pragma unroll
        for (int e = 0; e < 4; ++e) ss[e] = 0.f;
#pragma unroll
        for (int d = 0; d < 8; ++d)
#pragma unroll
            for (int e = 0; e < 4; ++e) ss[e] += oi[d][e] * oi[d][e];
#pragma unroll
        for (int e = 0; e < 4; ++e) { float s = ss[e]; s += dpp_f(s, 0xB1); s += dpp_f(s, 0x4E); s += dpp_f(s, 0x141); s += dpp_f(s, 0x140); ss[e] = 1.f / sqrtf(s * (1.f / 128.f) + EPS); }
#pragma unroll
        for (int d = 0; d < 8; ++d) { const unsigned p01 = cvt_pk_bf16(oi[d][0] * ss[0], oi[d][1] * ss[1]), p23 = cvt_pk_bf16(oi[d][2] * ss[2], oi[d][3] * ss[3]);
            LAS unsigned char* pp = Pw + (4 * q) * PW_P + (16 * d + r) * 2;
            *(LAS unsigned short*)(pp) = (unsigned short)p01; *(LAS unsigned short*)(pp + PW_P) = (unsigned short)(p01 >> 16);
            *(LAS unsigned short*)(pp + 2 * PW_P) = (unsigned short)p23; *(LAS unsigned short*)(pp + 3 * PW_P) = (unsigned short)(p23 >> 16); }
        LDS_WAIT(); asm volatile("" ::: "memory");
        { const int orow = lane >> 4, oc = lane & 15; const size_t grow = row0 + 16 * w + orow;
#pragma unroll
          for (int i = 0; i < 4; ++i) { const v4u ov = *(const LAS v4u*)(Pw + (orow + 4 * i) * PW_P + 16 * oc); const v4u gv = pg[i];
              v4u o;
#pragma unroll
              for (int wd = 0; wd < 4; ++wd) o[wd] = cvt_pk_bf16(bflo(ov[wd]) * bflo(gv[wd]), bfhi(ov[wd]) * bfhi(gv[wd]));
              if (!(pf & 1)) *(v4u*)(BR + (grow + 4 * i) * 1024 + 512 + h * 128 + 8 * oc) = o; } }
        }
        if (!(pf & 2)) __syncthreads();
#pragma unroll
        for (int i = 0; i < 4; ++i) S[i] = S[i] * cd;
        if (!(pf & 4))
#pragma unroll
        for (int ks = 0; ks < 4; ++ks) { const v4u vb = *(const LAS v4u*)(L + L_VT + (16 * w + r) * VT_P + (32 * ks + 8 * q) * 2); v4u ka[4];
#pragma unroll
            for (int i = 0; i < 4; ++i) ka[i] = *(const LAS v4u*)(L + L_KT + (16 * i + r) * KT_P + (32 * ks + 8 * q) * 2);
            __builtin_amdgcn_sched_barrier(0);
#pragma unroll
            for (int i = 0; i < 4; ++i) S[i] = RB_MFMA(ka[i], vb, S[i]);
            __builtin_amdgcn_sched_barrier(0); }
#pragma unroll
        for (int i = 0; i < 4; ++i) { v2u sv; sv.x = cvt_pk_bf16(S[i][0], S[i][1]); sv.y = cvt_pk_bf16(S[i][2], S[i][3]); *(LAS v2u*)(L + L_ST + (16 * w + r) * ST_P + (16 * i + 4 * q) * 2) = sv; }
        __syncthreads();
    }
}
#undef RB_MFMA
#undef dpp_f
#undef RB_LOAD
}

struct TrItem { const float* src; bf16* dst; int ldw, K, base, mul, gu, f8; };
__device__ __forceinline__ int tr_row(const TrItem& t, int n) { if (t.gu) { const int a = t.base + (n >> 1), b = n & 1; return 256 * (a >> 7) + 128 * b + (a & 127); } return t.base + t.mul * n; }
__device__ __forceinline__ void tr_load(const TrItem& t, f32x4 (&v)[8], int lane) {
    const float* p = t.src + (size_t)(lane >> 3) * t.ldw + 4 * (lane & 7);
#pragma unroll
    for (int i = 0; i < 8; ++i) v[i] = *(const GAS f32x4*)(p + (size_t)(8 * i) * t.ldw);
}
__device__ __forceinline__ void tr_store(const TrItem& t, const f32x4 (&v)[8], LAS float* scr, int lane) {
    { LAS float* w = scr + (lane >> 3) * 33 + 4 * (lane & 7);
#pragma unroll
      for (int i = 0; i < 8; ++i) { w[(8 * i) * 33 + 0] = v[i][0]; w[(8 * i) * 33 + 1] = v[i][1]; w[(8 * i) * 33 + 2] = v[i][2]; w[(8 * i) * 33 + 3] = v[i][3]; } }
    LDS_WAIT(); asm volatile("" ::: "memory");
    const int c = lane & 7;
#pragma unroll
    for (int j = 0; j < 4; ++j) { const int n = (lane >> 3) + 8 * j; const LAS float* s = scr + (8 * c) * 33 + n;
        if (t.f8) { const f32x4 a = {s[0 * 33] * WSCALE, s[1 * 33] * WSCALE, s[2 * 33] * WSCALE, s[3 * 33] * WSCALE}, b = {s[4 * 33] * WSCALE, s[5 * 33] * WSCALE, s[6 * 33] * WSCALE, s[7 * 33] * WSCALE};
            *(GAS v2u*)((unsigned char*)t.dst + (size_t)tr_row(t, n) * t.K + 8 * c) = pack8_fp8(a, b); }
        else { v4u o; o.x = cvt_pk_bf16(s[0 * 33], s[1 * 33]); o.y = cvt_pk_bf16(s[2 * 33], s[3 * 33]); o.z = cvt_pk_bf16(s[4 * 33], s[5 * 33]); o.w = cvt_pk_bf16(s[6 * 33], s[7 * 33]);
            *(GAS v4u*)(t.dst + (size_t)tr_row(t, n) * t.K + 8 * c) = o; } }
    LDS_WAIT(); asm volatile("" ::: "memory");
}
__device__ __forceinline__ void tr_store2(const TrItem& t0, const f32x4 (&v0)[8], const TrItem& t1, const f32x4 (&v1)[8], LAS float* s0, LAS float* s1, int lane) {
    { LAS float* w0 = s0 + (lane >> 3) * 33 + 4 * (lane & 7); LAS float* w1 = s1 + (lane >> 3) * 33 + 4 * (lane & 7);
#pragma unroll
      for (int i = 0; i < 8; ++i) { w0[(8 * i) * 33 + 0] = v0[i][0]; w0[(8 * i) * 33 + 1] = v0[i][1]; w0[(8 * i) * 33 + 2] = v0[i][2]; w0[(8 * i) * 33 + 3] = v0[i][3];
                                    w1[(8 * i) * 33 + 0] = v1[i][0]; w1[(8 * i) * 33 + 1] = v1[i][1]; w1[(8 * i) * 33 + 2] = v1[i][2]; w1[(8 * i) * 33 + 3] = v1[i][3]; } }
    LDS_WAIT(); asm volatile("" ::: "memory");
    const int c = lane & 7;
#pragma unroll
    for (int u = 0; u < 2; ++u) { const TrItem& t = u ? t1 : t0; const LAS float* sb = u ? s1 : s0;
#pragma unroll
        for (int j = 0; j < 4; ++j) { const int n = (lane >> 3) + 8 * j; const LAS float* s = sb + (8 * c) * 33 + n;
            if (t.f8 == 1) { const f32x4 a = {s[0 * 33] * WSCALE, s[1 * 33] * WSCALE, s[2 * 33] * WSCALE, s[3 * 33] * WSCALE}, b = {s[4 * 33] * WSCALE, s[5 * 33] * WSCALE, s[6 * 33] * WSCALE, s[7 * 33] * WSCALE};
                *(GAS v2u*)((unsigned char*)t.dst + (size_t)tr_row(t, n) * t.K + 8 * c) = pack8_fp8(a, b); }
            else { v4u o; o.x = cvt_pk_bf16(s[0 * 33], s[1 * 33]); o.y = cvt_pk_bf16(s[2 * 33], s[3 * 33]); o.z = cvt_pk_bf16(s[4 * 33], s[5 * 33]); o.w = cvt_pk_bf16(s[6 * 33], s[7 * 33]);
                *(GAS v4u*)(t.dst + (size_t)tr_row(t, n) * t.K + 8 * c) = o; } } }
    LDS_WAIT(); asm volatile("" ::: "memory");
}
constexpr int TR_IN = 96 * 16, TR_MG = 64 * 16, TR_BR = 2 * 32 * 8, TR_O = 32 * 16, TR_PG = 32 * 16, TR_PP = 32 * 4, TR_GU = 32 * 64 * 16, TR_DN = 32 * 32 * 16;
constexpr int TR_ITEMS = TR_IN + TR_MG + TR_BR + TR_O + TR_PG + TR_PP + TR_GU + TR_DN;
__device__ __forceinline__ TrItem tr_decode(Frame& F, int it) {
    TrItem t; t.mul = 1; t.gu = 0; t.f8 = 0; int r = it;
    if (r < TR_GU) { const int e = r >> 10, rr = r & 1023, kb = rr >> 6, blk = rr & 63;
        t.src = (F.ap->in[12]) + (size_t)e * 1024 * 2048 + (size_t)(64 * kb) * 2048 + 32 * blk; t.ldw = 2048; t.dst = (bf16*)(WSP(unsigned char, WS_WGUT) + (size_t)e * 2048 * 1024 + 64 * kb); t.K = 1024; t.base = 16 * blk; t.gu = 1; t.f8 = 1; return t; } r -= TR_GU;
    if (r < TR_DN) { const int e = r >> 9, rr = r & 511, kb = rr >> 5, blk = rr & 31;
        t.src = (F.ap->in[14]) + (size_t)e * 1024 * 1024 + (size_t)(64 * kb) * 1024 + 32 * blk; t.ldw = 1024; t.dst = (bf16*)(WSP(unsigned char, WS_WDT) + (size_t)e * 1024 * 1024 + 64 * kb); t.K = 1024; t.base = 32 * blk; t.f8 = 1; return t; } r -= TR_DN;
    if (r < TR_IN) { const int kb = r / 96, blk = r % 96; int s0;
        if (blk < 32) { s0 = 32 * blk; t.base = 32 * blk; t.f8 = 1; }
        else if (blk < 48) { s0 = 32 * blk; t.base = 32 * (blk - 32); }
        else if (blk < 64) { s0 = 2056 + 32 * (blk - 48); t.base = 1024 + 32 * (blk - 48); }
        else if (blk < 80) { s0 = 2568 + 32 * (blk - 64); t.base = 1536 + 32 * (blk - 64); }
        else { const int hb = (blk - 80) & 7, head = hb >> 1, half = hb & 1, isk = (blk >= 88); s0 = (isk ? 1800 : 1544) + head * 64 + half * 32; t.base = (isk ? 768 : 512) + head * 64 + half; t.mul = 2; }
        t.src = (F.ap->in[3]) + (size_t)(64 * kb) * INW + s0; t.ldw = INW; t.dst = t.f8 ? (bf16*)(WSP(unsigned char, WS_WG8T) + 64 * kb) : WSP(bf16, WS_W1T) + 64 * kb; t.K = 1024; return t; } r -= TR_IN;
    if (r < TR_MG) { const int kb = r >> 6, blk = r & 63; t.src = (F.ap->in[6]) + (size_t)(64 * kb) * 2048 + 32 * blk; t.ldw = 2048; t.dst = (bf16*)(WSP(unsigned char, WS_WG8T) + 64 * kb); t.K = 1024; t.base = 1024 + 32 * blk; t.f8 = 1; return t; } r -= TR_MG;
    if (r < TR_BR) { const int gsel = r >> 8, rr = r & 255, kb = rr >> 5, blk = rr & 31;
        t.src = (F.ap->in[5]) + (size_t)gsel * 512 * 1024 + (size_t)(64 * kb) * 1024 + 32 * blk; t.ldw = 1024; t.dst = WSP(bf16, WS_WBT) + gsel * 512 + 64 * kb; t.K = 1024; t.base = 32 * blk; return t; } r -= TR_BR;
    if (r < TR_O) { const int kb = r >> 5, blk = r & 31; t.src = (F.ap->in[8]) + (size_t)(64 * kb) * 1024 + 32 * blk; t.ldw = 1024; t.dst = WSP(bf16, WS_WOT) + 64 * kb; t.K = 1024; t.base = 32 * blk; return t; } r -= TR_O;
    if (r < TR_PG) { const int kb = r >> 5, blk = r & 31; t.src = (F.ap->in[17]) + (size_t)(64 * kb) * 1024 + 32 * blk; t.ldw = 1024; t.dst = (bf16*)(WSP(unsigned char, WS_WPGT) + 64 * kb); t.K = 1024; t.base = 32 * blk; t.f8 = 1; return t; } r -= TR_PG;
    { const int kb = r >> 5, blk = r & 31; t.src = (F.ap->in[18]) + (size_t)(64 * kb) * 1024 + 32 * blk; t.ldw = 1024; t.dst = WSP(bf16, WS_WPPT) + 64 * kb; t.K = 256; t.base = 32 * blk; return t; }
}

__device__ __forceinline__ void p0_row(Frame& F, int m, f32x4 (&v)[4], LAS const float* WFt, int lane) {
    float s = 0.f;
#pragma unroll
    for (int j = 0; j < 4; ++j) s += (v[j].x * v[j].x + v[j].y * v[j].y) + (v[j].z * v[j].z + v[j].w * v[j].w);
    const float rstd = 1.f / sqrtf(wave_sum(s) * (1.f / DM) + EPS);
    GAS unsigned long long* o8 = (GAS unsigned long long*)(WSP(bf16, WS_XN) + (size_t)m * DM) + lane;
    GAS int* q8 = (GAS int*)(WSP(unsigned char, WS_XN8) + (size_t)m * DM) + lane;
#pragma unroll
    for (int j = 0; j < 4; ++j) { const f32x4 g = ((const GAS f32x4*)(F.ap->in[2]))[lane + 64 * j]; v[j] = v[j] * rstd * g;
        o8[64 * j] = (unsigned long long)cvt_pk_bf16(v[j].x, v[j].y) | ((unsigned long long)cvt_pk_bf16(v[j].z, v[j].w) << 32);
        { int w = 0; w = __builtin_amdgcn_cvt_pk_fp8_f32(clamp_f8(v[j].x), clamp_f8(v[j].y), w, false); w = __builtin_amdgcn_cvt_pk_fp8_f32(clamp_f8(v[j].z), clamp_f8(v[j].w), w, true); q8[64 * j] = w; } }
    float fa[8];
#pragma unroll
    for (int c = 0; c < 8; ++c) { float a = 0.f;
#pragma unroll
        for (int j = 0; j < 4; ++j) { const f32x4 w = *(const LAS f32x4*)(WFt + c * 1024 + 256 * j + 4 * lane); a += (v[j].x * w.x + v[j].y * w.y) + (v[j].z * w.z + v[j].w * w.w); }
        fa[c] = wave_sum(a); }
    float z = fa[0];
#pragma unroll
    for (int c = 1; c < 8; ++c) z = (lane == c) ? fa[c] : z;
    if (lane < 8) { z += (F.ap->in[4])[lane]; WSP(float, WS_LOGF)[(size_t)m * 8 + lane] = fminf(z, 0.f) - log1pf(expf(-fabsf(z))); }
}
__device__ __forceinline__ void p0_prologue(Frame& F) {
    LAS float* WFt = (LAS float*)(F.lds + RING_OFF);
    { f32x4 wv[2][2];
#pragma unroll
      for (int i = 0; i < 2; ++i) { const float* wp = (F.ap->in[3]) + (size_t)(F.tid + NWAVES * 64 * i) * INW + 1536; wv[i][0] = *(const GAS f32x4*)wp; wv[i][1] = *(const GAS f32x4*)(wp + 4); }
#pragma unroll
      for (int i = 0; i < 2; ++i) { const int k = F.tid + NWAVES * 64 * i;
#pragma unroll
          for (int c = 0; c < 8; ++c) WFt[c * 1024 + k] = wv[i][c >> 2][c & 3]; } }
    __syncthreads();
    const int gw = F.vcu * NWAVES + F.wave, NGW = F.G * NWAVES, lane = F.lane;
#ifndef P0_REP_ROWS
#define P0_REP_ROWS 1
#endif
#ifndef P0_REP_TR
#define P0_REP_TR 1
#endif
#ifndef P0_REP_ROWS
#define P0_REP_ROWS 1
#endif
#ifndef P0_REP_TR
#define P0_REP_TR 1
#endif
    for (int rep_ = 0; rep_ < P0_REP_ROWS; ++rep_)
    { f32x4 va[4], vb[4]; int m = gw;
      if (m < NT) {
#pragma unroll
          for (int j = 0; j < 4; ++j) va[j] = ((const GAS f32x4*)((F.ap->in[0]) + (size_t)m * DM))[lane + 64 * j]; }
      for (; m < NT; m += NGW) { const int m2 = m + NGW;
          if (m2 < NT) {
#pragma unroll
              for (int j = 0; j < 4; ++j) vb[j] = ((const GAS f32x4*)((F.ap->in[0]) + (size_t)m2 * DM))[lane + 64 * j]; }
          __builtin_amdgcn_sched_barrier(0);
          p0_row(F, m, va, WFt, lane);
          __builtin_amdgcn_sched_barrier(0);
#pragma unroll
          for (int j = 0; j < 4; ++j) va[j] = vb[j];
      } }
    __syncthreads();
    for (int rep_ = 0; rep_ < P0_REP_TR; ++rep_)
    { LAS float* scr = (LAS float*)(F.lds + RING_OFF + F.wave * 8704);
      constexpr int TR_P0_END = TR_GU + TR_DN + TR_IN + TR_MG;
      int it = TR_GU + TR_DN + gw; f32x4 cur[8], nxt[8]; TrItem tc, tn;
      if (it < TR_P0_END) { tc = tr_decode(F, it); tr_load(tc, cur, lane); }
      while (it < TR_P0_END) {
          const int itn = it + NGW; const bool hn = itn < TR_P0_END;
          if (hn) { tn = tr_decode(F, itn); tr_load(tn, nxt, lane); }
          tr_store(tc, cur, scr, lane);
          if (hn) { tc = tn;
#pragma unroll
              for (int i = 0; i < 8; ++i) cur[i] = nxt[i]; }
          it = itn;
      } }
    const int gt = F.vcu * (NWAVES * 64) + F.tid, NGT = F.G * NWAVES * 64;
    { float* rot = WSP(float, WS_ROT);
      for (int i = gt; i < SEQ * 32; i += NGT) { const int pos = i >> 5, j = i & 31;
          const float inv = powf(10000.f, -(float)j / 32.f); const float ang = (float)pos * inv;
          double rev = (double)ang * 0.15915494309189535; rev -= floor(rev); const float fr = (float)rev;
          rot[i] = __builtin_amdgcn_cosf(fr); rot[SEQ * 32 + i] = __builtin_amdgcn_sinf(fr); } }
    { bf16* wrt = WSP(bf16, WS_WRT);
      for (int i = gt; i < 1024 * 32; i += NGT) { const int k = i >> 5, n = i & 31; const float v = (F.ap->in[10])[i]; const unsigned hi = f2bf(v); const float rem = v - __uint_as_float(hi << 16);
          wrt[n * 1024 + k] = (bf16)hi; wrt[32768 + n * 1024 + k] = (bf16)f2bf(rem); } }
    if (gt < 64) { GAS v4u* z = (GAS v4u*)(WSP(unsigned char, WS_HB) + (size_t)NT * DM); z[gt] = (v4u){0u, 0u, 0u, 0u}; }
}

constexpr int CONV_ITEMS = 64, CONV_TR_ITEMS = TR_ITEMS - TR_IN - TR_MG, CONV_TR_CHUNKS = CONV_TR_ITEMS / CONV_ITEMS, CONV_PB_CHUNKS = NT * PLE / 4 / 16384, CONV_CHUNKS = CONV_TR_CHUNKS + CONV_PB_CHUNKS;
static_assert(CONV_TR_ITEMS % CONV_ITEMS == 0 && (TR_GU + TR_DN) % CONV_ITEMS == 0 && (NT * PLE / 4) % 16384 == 0, "whole chunks");
__device__ __forceinline__ TrItem conv_decode(Frame& F, int ci) { return tr_decode(F, ci < TR_GU + TR_DN ? ci : ci + TR_IN + TR_MG); }
__device__ __forceinline__ void conv_chunk(Frame& F, int c) {
    int lane = lane_now(); asm volatile("" : "+v"(lane));
    if (c >= CONV_TR_CHUNKS) {
        const int j = c - CONV_TR_CHUNKS, t = F.wave * 64 + lane;
        const GAS f32x4* ps = (const GAS f32x4*)(F.ap->in[1]) + (size_t)j * 16384 + t; GAS unsigned long long* pd = (GAS unsigned long long*)WSP(bf16, WS_PB) + (size_t)j * 16384 + t;
        for (int b = 0; b < 4; ++b) { f32x4 v[8];
#pragma unroll
            for (int u = 0; u < 8; ++u) v[u] = ps[b * 4096 + u * 512];
#pragma unroll
            for (int u = 0; u < 8; ++u) pd[b * 4096 + u * 512] = (unsigned long long)cvt_pk_bf16(v[u].x, v[u].y) | ((unsigned long long)cvt_pk_bf16(v[u].z, v[u].w) << 32); }
        return; }
    LAS float* scr = (LAS float*)(F.lds + RING_OFF + F.wave * 17408); LAS float* scr1 = scr + 2176;
    static_assert(NWAVES * 17408 <= SCH_OFF - RING_OFF, "conversion scratch inside ring + table region");
    const int base = c * CONV_ITEMS + F.wave;
    f32x4 a0[8], a1[8], b0[8], b1[8], c0[8], c1[8]; TrItem ta0, ta1, tb0, tb1, tc0, tc1;
    constexpr int NPAIR = CONV_ITEMS / NWAVES / 2;
    ta0 = conv_decode(F, base); ta1 = conv_decode(F, base + NWAVES); tr_load(ta0, a0, lane); tr_load(ta1, a1, lane);
    tb0 = conv_decode(F, base + 2 * NWAVES); tb1 = conv_decode(F, base + 3 * NWAVES); tr_load(tb0, b0, lane); tr_load(tb1, b1, lane);
    tc0 = tb0; tc1 = tb1;
#pragma unroll
    for (int i = 0; i < 8; ++i) { c0[i] = b0[i]; c1[i] = b1[i]; }
    for (int k = 0; k < NPAIR; ++k) {
        if (k + 2 < NPAIR) { tc0 = conv_decode(F, base + NWAVES * (2 * k + 4)); tc1 = conv_decode(F, base + NWAVES * (2 * k + 5)); tr_load(tc0, c0, lane); tr_load(tc1, c1, lane); }
        __builtin_amdgcn_sched_barrier(0);
        tr_store2(ta0, a0, ta1, a1, scr, scr1, lane);
        __builtin_amdgcn_sched_barrier(0);
        ta0 = tb0; ta1 = tb1; tb0 = tc0; tb1 = tc1;
#pragma unroll
        for (int i = 0; i < 8; ++i) { a0[i] = b0[i]; a1[i] = b1[i]; b0[i] = c0[i]; b1[i] = c1[i]; }
    }
}

__device__ __forceinline__ void cum_scan(Frame& F, int bh) {
    const float* lf = WSP(float, WS_LOGF); float* cum = WSP(float, WS_CUM);
    const int b = bh >> 3, h = bh & 7, t0 = 4 * F.tid;
    double a0 = lf[((size_t)(b * SEQ + t0 + 0)) * 8 + h], a1 = lf[((size_t)(b * SEQ + t0 + 1)) * 8 + h], a2 = lf[((size_t)(b * SEQ + t0 + 2)) * 8 + h], a3 = lf[((size_t)(b * SEQ + t0 + 3)) * 8 + h];
    a1 += a0; a2 += a1; a3 += a2;
    LAS double* tot = (LAS double*)(F.lds + RING_OFF);
    tot[F.tid] = a3;
    __syncthreads();
    double ex = 0.0;
    for (int j = 0; j < 63; ++j) { const double v = tot[F.wave * 64 + j]; ex += (j < F.lane) ? v : 0.0; }
    if (F.lane == 63) tot[512 + F.wave] = ex + a3;
    __syncthreads();
    for (int w = 0; w < F.wave; ++w) ex += tot[512 + w];
    *(GAS f32x4*)(cum + (size_t)bh * SEQ + t0) = (f32x4){(float)(ex + a0), (float)(ex + a1), (float)(ex + a2), (float)(ex + a3)};
    __syncthreads();
}

typedef pg8::f32x4 (&AccRef)[2][2][4][2];
using pg8::Unit;
__device__ __forceinline__ v4u pack8(const f32x4 a, const f32x4 b) { v4u w; w.x = cvt_pk_bf16(a[0], a[1]); w.y = cvt_pk_bf16(a[2], a[3]); w.z = cvt_pk_bf16(b[0], b[1]); w.w = cvt_pk_bf16(b[2], b[3]); return w; }
__device__ __forceinline__ void unpack8(const v4u w, f32x4& a, f32x4& b) { a = (f32x4){bflo(w.x), bfhi(w.x), bflo(w.y), bfhi(w.y)}; b = (f32x4){bflo(w.z), bfhi(w.z), bflo(w.w), bfhi(w.w)}; }

__device__ __forceinline__ void tstore32(LAS unsigned char* scr, const v4u wa, const v4u wb, int fr, int fq, bf16* dst, int cstride) {
    LAS unsigned short* s2 = (LAS unsigned short*)scr;
#pragma unroll
    for (int e2 = 0; e2 < 4; ++e2) { const int col = 8 * fq + 2 * e2;
        s2[col * 40 + fr] = (unsigned short)(wa[e2] & 0xffffu); s2[(col + 1) * 40 + fr] = (unsigned short)(wa[e2] >> 16);
        s2[col * 40 + 16 + fr] = (unsigned short)(wb[e2] & 0xffffu); s2[(col + 1) * 40 + 16 + fr] = (unsigned short)(wb[e2] >> 16); }
    asm volatile("" ::: "memory");
    const int lane = fr + 16 * fq, cl = lane >> 1, part = lane & 1;
    const v4u r0 = *(const LAS v4u*)(scr + cl * 80 + part * 32), r1 = *(const LAS v4u*)(scr + cl * 80 + part * 32 + 16);
    asm volatile("" ::: "memory");
    bf16* d = dst + (size_t)cl * cstride + part * 16;
    *(v4u*)d = r0; *(v4u*)(d + 8) = r1;
}
struct EpiIn {
    static constexpr bool PERM = true;
    bf16 *FQ, *FK, *FV, *RQ, *RK, *RV, *RGS; const float* rot; bf16* RKT; LAS unsigned char* scr; int skip;
    __device__ __forceinline__ void operator()(const pg8::f32x4 (&acc)[2][2][4][2], const Unit& u, int wr, int wc, int fr, int fq) const {
        if (skip == 1) return;
        asm volatile("" : "+v"(fr), "+v"(fq));
        const int pn = u.pn; bf16* base; int ldc, colt, mode = 0; float sc = 1.f;
        if (skip) { const int cls = pn < 6 ? 1 : pn < 8 ? 2 : pn < 10 ? 4 : 8; if (skip & (cls << 1)) return; }
        if (pn < 2) { base = FQ; ldc = 512; colt = pn * 256; sc = C2; }
        else if (pn < 4) { base = FK; ldc = 512; colt = (pn - 2) * 256; }
        else if (pn < 6) { base = FV; ldc = 512; colt = (pn - 4) * 256; }
        else if (pn == 6) { base = RQ; ldc = 256; colt = 0; mode = 1; }
        else if (pn == 7) { base = RK; ldc = 256; colt = 0; mode = 1; sc = 0.125f; }
        else if (pn < 10) { base = RV; ldc = 512; colt = (pn - 8) * 256; mode = 4; }
        else { base = RGS; ldc = 512; colt = (pn - 10) * 256; mode = 2; }
        const int row0 = u.pm * 256 + wr * 64 + fr, col0 = colt + wc * 32 + 8 * fq;
        LAS unsigned char* ws = scr + (wr * 4 + wc) * 3072;
        if (mode == 1) {
            f32x4 cs[2][4], sn[2][4]; const int j = (col0 & 63) >> 1;
#pragma unroll
            for (int ai = 0; ai < 2; ++ai)
#pragma unroll
                for (int m = 0; m < 4; ++m) { const int pos = (row0 + ai * 128 + m * 16) & (SEQ - 1); cs[ai][m] = *(const f32x4*)(rot + pos * 32 + j); sn[ai][m] = *(const f32x4*)(rot + SEQ * 32 + pos * 32 + j); }
            __builtin_amdgcn_sched_barrier(0);
            float lg2b[2] = {0.f, 0.f};
            if (pn == 7) { lg2b[0] = log1pf(-exp2f(-5.f - (float)(wc >> 1))) * LOG2E; lg2b[1] = log1pf(-exp2f(-5.f - (float)((wc >> 1) + 2))) * LOG2E; }
#pragma unroll
            for (int ai = 0; ai < 2; ++ai)
#pragma unroll
                for (int mh = 0; mh < 2; ++mh)
#pragma unroll
                    for (int bj = 0; bj < 2; ++bj) { const int c = col0 + bj * 128; v4u wt[2];
#pragma unroll
                        for (int mm = 0; mm < 2; ++mm) { const int m = 2 * mh + mm, row = row0 + ai * 128 + m * 16; const f32x4 a = acc[ai][bj][m][0], b = acc[ai][bj][m][1], cv = cs[ai][m], sv = sn[ai][m];
                            const f32x4 v0 = {(a[0] * cv[0] - a[1] * sv[0]) * sc, (a[1] * cv[0] + a[0] * sv[0]) * sc, (a[2] * cv[1] - a[3] * sv[1]) * sc, (a[3] * cv[1] + a[2] * sv[1]) * sc};
                            const f32x4 v1 = {(b[0] * cv[2] - b[1] * sv[2]) * sc, (b[1] * cv[2] + b[0] * sv[2]) * sc, (b[2] * cv[3] - b[3] * sv[3]) * sc, (b[3] * cv[3] + b[2] * sv[3]) * sc};
                            *(v4u*)(base + (size_t)row * ldc + c) = pack8(v0, v1);
                            if (pn == 7) { const float dk = __builtin_amdgcn_exp2f((float)(127 - (row & 127)) * lg2b[bj]); wt[mm] = pack8(v0 * dk, v1 * dk); } }
                        if (pn == 7) {
                            const int rowb = u.pm * 256 + ai * 128 + wr * 64 + mh * 32, cb = wc * 32 + bj * 128;
                            tstore32(ws, wt[0], wt[1], fr, fq, RKT + ((size_t)((rowb >> 11) * 4 + (cb >> 6)) * 16 + ((rowb >> 7) & 15)) * 8192 + (size_t)(cb & 63) * 128 + (rowb & 127), 128); } }
            return; }
        if (mode == 4) {
#pragma unroll
            for (int ai = 0; ai < 2; ++ai)
#pragma unroll
                for (int mh = 0; mh < 2; ++mh)
#pragma unroll
                    for (int bj = 0; bj < 2; ++bj) { const int rowb = u.pm * 256 + ai * 128 + wr * 64 + mh * 32, cb = colt + wc * 32 + bj * 128;
                        tstore32(ws, pack8(acc[ai][bj][2 * mh][0], acc[ai][bj][2 * mh][1]), pack8(acc[ai][bj][2 * mh + 1][0], acc[ai][bj][2 * mh + 1][1]), fr, fq,
                                 RV + ((size_t)((rowb >> 11) * 4 + (cb >> 7)) * 16 + ((rowb >> 7) & 15)) * 16384 + (size_t)(cb & 127) * 128 + (rowb & 127), 128); }
            return; }
#pragma unroll
        for (int ai = 0; ai < 2; ++ai)
#pragma unroll
            for (int m = 0; m < 4; ++m) { const int row = row0 + ai * 128 + m * 16;
#pragma unroll
                for (int bj = 0; bj < 2; ++bj) { const int c = col0 + bj * 128; f32x4 v0 = acc[ai][bj][m][0], v1 = acc[ai][bj][m][1];
                    if (mode == 0) { v0 = v0 * sc; v1 = v1 * sc; }
                    else {
#pragma unroll
                        for (int e = 0; e < 4; ++e) { v0[e] = v0[e] * fsigmoid(v0[e]); v1[e] = v1[e] * fsigmoid(v1[e]); } }
                    *(v4u*)(base + (size_t)row * ldc + c) = pack8(v0, v1); } }
    }
};
__device__ __forceinline__ void u8x8_to_f32(const v2u w, f32x4& a, f32x4& b) {
    a = (f32x4){(float)(w.x & 255u), (float)((w.x >> 8) & 255u), (float)((w.x >> 16) & 255u), (float)(w.x >> 24)}; b = (f32x4){(float)(w.y & 255u), (float)((w.y >> 8) & 255u), (float)((w.y >> 16) & 255u), (float)(w.y >> 24)}; }
struct EpiGate {
    static constexpr bool PERM = true;
    unsigned char* GATES; const float* bmg; bf16 *FQ, *FK; int skip;
    __device__ __forceinline__ void operator()(const pg8::f32x4 (&acc)[2][2][4][2], const Unit& u, int wr, int wc, int fr, int fq) const {
        if (skip & 33) return;
        { const int l_ = lane_now(); fr = l_ & 15; fq = (l_ >> 4) & 3; }
        if (u.pn < 4) {
            bf16* base = u.pn < 2 ? FQ : FK; const float sc = (u.pn < 2 ? C2 : 1.f) * (1.f / WSCALE);
            const int r0 = u.pm * 256 + wr * 64 + fr, c0 = (u.pn & 1) * 256 + wc * 32 + 8 * fq;
#pragma unroll
            for (int ai = 0; ai < 2; ++ai)
#pragma unroll
                for (int m = 0; m < 4; ++m)
#pragma unroll
                    for (int bj = 0; bj < 2; ++bj) *(v4u*)(base + (size_t)(r0 + ai * 128 + m * 16) * 512 + c0 + bj * 128) = pack8(acc[ai][bj][m][0] * sc, acc[ai][bj][m][1] * sc);
            return; }
        float ck = -LOG2E / WSCALE, cb = -LOG2E, c254 = 254.f; asm volatile("" : "+s"(ck), "+s"(cb), "+s"(c254));
        typedef float f2 __attribute__((ext_vector_type(2)));
        const int row0 = u.pm * 256 + wr * 64 + fr, col0 = (u.pn - 4) * 256 + wc * 32 + 8 * fq;
        f32x4 bb[2][2];
#pragma unroll
        for (int bj = 0; bj < 2; ++bj) { bb[bj][0] = *(const f32x4*)(bmg + col0 + bj * 128) * cb; bb[bj][1] = *(const f32x4*)(bmg + col0 + bj * 128 + 4) * cb; }
#pragma unroll
        for (int ai = 0; ai < 2; ++ai)
#pragma unroll
            for (int m = 0; m < 4; ++m) { unsigned char* rowp = GATES + (size_t)(row0 + ai * 128 + m * 16) * 2048 + col0;
#pragma unroll
                for (int bj = 0; bj < 2; ++bj) { v2u w;
#pragma unroll
                    for (int n = 0; n < 2; ++n) { const f32x4 a = acc[ai][bj][m][n], b = bb[bj][n]; unsigned b4 = 0u;
#pragma unroll
                        for (int hh = 0; hh < 2; ++hh) { const f2 t = (f2){a[2 * hh], a[2 * hh + 1]} * ck + (f2){b[2 * hh], b[2 * hh + 1]};
                            f2 ex; ex.x = __builtin_amdgcn_exp2f(t.x); ex.y = __builtin_amdgcn_exp2f(t.y); const f2 den = ex + 1.0f;
                            f2 rc; rc.x = __builtin_amdgcn_rcpf(den.x); rc.y = __builtin_amdgcn_rcpf(den.y); const f2 x = rc * c254 + 0.5f;
                            if (hh == 0) { b4 = __builtin_amdgcn_cvt_pk_u8_f32(x.x, 0, b4); b4 = __builtin_amdgcn_cvt_pk_u8_f32(x.y, 1, b4); }
                            else { b4 = __builtin_amdgcn_cvt_pk_u8_f32(x.x, 2, b4); b4 = __builtin_amdgcn_cvt_pk_u8_f32(x.y, 3, b4); } }
                        if (n == 0) w.x = b4; else w.y = b4; }
                    *(v2u*)(rowp + bj * 128) = w; } }
    }
};
struct HookMerge {
    static constexpr bool ON = true; static constexpr int AT = 6;
    const unsigned char* GATES;
    __device__ __forceinline__ void operator()(pg8::f32x4 (&acc)[2][2][4][2], const Unit& u, int wr, int wc, int fr, int fq) const {
        asm volatile("" : "+v"(fr), "+v"(fq));
        const int row0 = u.pm * 256 + wr * 64 + fr, col0 = u.pn * 256 + wc * 32 + 8 * fq;
        v2u ga[2][4][2], gb[2][4][2];
#pragma unroll
        for (int ai = 0; ai < 2; ++ai)
#pragma unroll
            for (int m = 0; m < 4; ++m) { const unsigned char* gp = GATES + (size_t)(row0 + ai * 128 + m * 16) * 2048 + col0;
#pragma unroll
                for (int bj = 0; bj < 2; ++bj) { ga[ai][m][bj] = *(const v2u*)(gp + bj * 128); gb[ai][m][bj] = *(const v2u*)(gp + 1024 + bj * 128); } }
        __builtin_amdgcn_sched_barrier(0);
#pragma unroll
        for (int ai = 0; ai < 2; ++ai)
#pragma unroll
            for (int m = 0; m < 4; ++m)
#pragma unroll
                for (int bj = 0; bj < 2; ++bj) { f32x4 a0, a1, b0, b1; u8x8_to_f32(ga[ai][m][bj], a0, a1); u8x8_to_f32(gb[ai][m][bj], b0, b1);
#pragma unroll
                    for (int e2 = 0; e2 < 4; ++e2) { acc[ai][bj][m][0][e2] *= a0[e2] * __builtin_amdgcn_rcpf(fmaxf(b0[e2], 1e-30f)); acc[ai][bj][m][1][e2] *= a1[e2] * __builtin_amdgcn_rcpf(fmaxf(b1[e2], 1e-30f)); } }
        __builtin_amdgcn_sched_barrier(0);
    }
};
struct EpiMerge {
    static constexpr bool PERM = true;
    const unsigned char* GATES; bf16* MERGED;
    __device__ __forceinline__ void operator()(const pg8::f32x4 (&acc)[2][2][4][2], const Unit& u, int wr, int wc, int fr, int fq) const {
        asm volatile("" : "+v"(fr), "+v"(fq));
        const int row0 = u.pm * 256 + wr * 64 + fr, col0 = u.pn * 256 + wc * 32 + 8 * fq;
        v2u gg[2][4][2];
#pragma unroll
        for (int ai = 0; ai < 2; ++ai)
#pragma unroll
            for (int m = 0; m < 4; ++m)
#pragma unroll
                for (int bj = 0; bj < 2; ++bj) gg[ai][m][bj] = *(const v2u*)(GATES + (size_t)(row0 + ai * 128 + m * 16) * 2048 + 1024 + col0 + bj * 128);
        __builtin_amdgcn_sched_barrier(0);
#pragma unroll
        for (int ai = 0; ai < 2; ++ai)
#pragma unroll
            for (int m = 0; m < 4; ++m)
#pragma unroll
                for (int bj = 0; bj < 2; ++bj) { f32x4 g0, g1; u8x8_to_f32(gg[ai][m][bj], g0, g1);
#pragma unroll
                    for (int e2 = 0; e2 < 4; ++e2) { g0[e2] = fmaxf(g0[e2], 1e-30f) * (1.f / 254.f); g1[e2] = fmaxf(g1[e2], 1e-30f) * (1.f / 254.f); }
                    *(v4u*)(MERGED + (size_t)(row0 + ai * 128 + m * 16) * 1024 + col0 + bj * 128) = pack8(acc[ai][bj][m][0] * g0, acc[ai][bj][m][1] * g1); }
    }
};
struct EpiMO {
    static constexpr bool PERM = true;
    bf16* MO;
    __device__ __forceinline__ void operator()(const pg8::f32x4 (&acc)[2][2][4][2], const Unit& u, int wr, int wc, int fr, int fq) const {
        asm volatile("" : "+v"(fr), "+v"(fq));
        const int row0 = u.pm * 256 + wr * 64 + fr, col0 = u.pn * 256 + wc * 32 + 8 * fq;
#pragma unroll
        for (int ai = 0; ai < 2; ++ai)
#pragma unroll
            for (int m = 0; m < 4; ++m) { bf16* rowp = MO + (size_t)(row0 + ai * 128 + m * 16) * 1024 + col0;
#pragma unroll
                for (int bj = 0; bj < 2; ++bj) *(v4u*)(rowp + bj * 128) = pack8(acc[ai][bj][m][0], acc[ai][bj][m][1]); }
    }
};
struct EpiGU {
    static constexpr bool PERM = true;
    const float* bgu; const float* rsof; unsigned char* ACT;
    __device__ __forceinline__ void operator()(const pg8::f32x4 (&acc)[2][2][4][2], const Unit& u, int wr, int wc, int fr, int fq) const {
        { const int l_ = lane_now(); fr = l_ & 15; fq = (l_ >> 4) & 3; }
        float c7 = 7.f, cm7 = -7.f, ck = -1.702f * 1.4426950408889634f; asm volatile("" : "+s"(c7), "+s"(cm7), "+s"(ck));
        const int j0 = u.pn * 128 + wc * 32 + 8 * fq;
        const float* bb = bgu + (size_t)u.e * 2048 + 2 * j0;
        const f32x4 q0 = *(const f32x4*)(bb), q1 = *(const f32x4*)(bb + 4), q2 = *(const f32x4*)(bb + 8), q3 = *(const f32x4*)(bb + 12);
        const f32x4 bg0 = {q0[0], q0[2], q1[0], q1[2]}, bl0 = {q0[1], q0[3], q1[1], q1[3]}, bg1 = {q2[0], q2[2], q3[0], q3[2]}, bl1 = {q2[1], q2[3], q3[1], q3[3]};
        const int rl0 = wr * 64 + fr;
        float rsv[2][4];
#pragma unroll
        for (int ai = 0; ai < 2; ++ai)
#pragma unroll
            for (int m = 0; m < 4; ++m) rsv[ai][m] = rsof[(size_t)u.e * NT + u.rtl * 256 + rl0 + ai * 128 + m * 16];
        __builtin_amdgcn_sched_barrier(0);
#pragma unroll
        for (int ai = 0; ai < 2; ++ai)
#pragma unroll
            for (int m = 0; m < 4; ++m) { const int rl = rl0 + ai * 128 + m * 16; const float rs = rsv[ai][m] * (1.f / WSCALE);
                int wpk[2];
#pragma unroll
                for (int n = 0; n < 2; ++n) { const f32x4 ga = acc[ai][0][m][n], la = acc[ai][1][m][n]; const f32x4 bgv = n ? bg1 : bg0, blv = n ? bl1 : bl0; int w = 0;
#pragma unroll
                    for (int hh = 0; hh < 2; ++hh) { typedef float f2 __attribute__((ext_vector_type(2)));
                        f2 g = (f2){ga[2 * hh], ga[2 * hh + 1]} * rs + (f2){bgv[2 * hh], bgv[2 * hh + 1]}, l = (f2){la[2 * hh], la[2 * hh + 1]} * rs + (f2){blv[2 * hh], blv[2 * hh + 1]};
                        f2 a, b; a.x = fminf(g.x, c7); a.y = fminf(g.y, c7); b.x = __builtin_amdgcn_fmed3f(l.x, cm7, c7); b.y = __builtin_amdgcn_fmed3f(l.y, cm7, c7);
                        const f2 t = a * ck; f2 ex; ex.x = __builtin_amdgcn_exp2f(t.x); ex.y = __builtin_amdgcn_exp2f(t.y);
                        const f2 den = ex + 1.0f; f2 rc; rc.x = __builtin_amdgcn_rcpf(den.x); rc.y = __builtin_amdgcn_rcpf(den.y);
                        const f2 o = (a * rc) * (b + 1.0f);
                        if (hh == 0) w = __builtin_amdgcn_cvt_pk_fp8_f32(o.x, o.y, w, false); else w = __builtin_amdgcn_cvt_pk_fp8_f32(o.x, o.y, w, true); }
                    wpk[n] = w; }
                *(v2u*)(ACT + ((size_t)u.pm * 256 + rl) * 1024 + j0) = (v2u){(unsigned)wpk[0], (unsigned)wpk[1]}; }
    }
};
struct EpiDN {
    static constexpr bool PERM = true;
    const float* bdn; unsigned char* Y;
    __device__ __forceinline__ void operator()(const pg8::f32x4 (&acc)[2][2][4][2], const Unit& u, int wr, int wc, int fr, int fq) const {
        asm volatile("" : "+v"(fr), "+v"(fq));
        const int col0 = u.pn * 256 + wc * 32 + 8 * fq; const float* bb = bdn + (size_t)u.e * 1024 + col0;
        f32x4 bv[2][2];
#pragma unroll
        for (int bj = 0; bj < 2; ++bj) { bv[bj][0] = *(const f32x4*)(bb + bj * 128) * YSCALE; bv[bj][1] = *(const f32x4*)(bb + bj * 128 + 4) * YSCALE; }
        const int rl0 = wr * 64 + fr;
#pragma unroll
        for (int ai = 0; ai < 2; ++ai)
#pragma unroll
            for (int m = 0; m < 4; ++m) { unsigned char* rowp = Y + ((size_t)u.pm * 256 + rl0 + ai * 128 + m * 16) * 1024 + col0;
#pragma unroll
                for (int bj = 0; bj < 2; ++bj) *(v2u*)(rowp + bj * 128) = pack8_fp8(acc[ai][bj][m][0] * (YSCALE / WSCALE) + bv[bj][0], acc[ai][bj][m][1] * (YSCALE / WSCALE) + bv[bj][1]); }
    }
};
struct EpiPJ {
    static constexpr bool PERM = false;
    bf16* PJ;
    __device__ __forceinline__ void operator()(const pg8::f32x4 (&acc)[2][2][4][2], const Unit& u, int wr, int wc, int fr, int fq) const {
        asm volatile("" : "+v"(fr), "+v"(fq));
        const int row0 = u.pm * 256 + wr * 64 + fr, col0 = u.pn * 256 + wc * 32 + 4 * fq;
#pragma unroll
        for (int ai = 0; ai < 2; ++ai)
#pragma unroll
            for (int m = 0; m < 4; ++m) { const size_t off = (size_t)(row0 + ai * 128 + m * 16) * 1024 + col0;
#pragma unroll
                for (int bj = 0; bj < 2; ++bj)
#pragma unroll
                    for (int n = 0; n < 2; ++n) { const f32x4 v = acc[ai][bj][m][n]; v2u w; w.x = cvt_pk_bf16(v[0], v[1]); w.y = cvt_pk_bf16(v[2], v[3]); *(v2u*)(PJ + off + bj * 128 + n * 16) = w; } }
    }
};
struct EpiPG {
    static constexpr bool PERM = true;
    unsigned char* G8; const float* rstd2;
    __device__ __forceinline__ void operator()(const pg8::f32x4 (&acc)[2][2][4][2], const Unit& u, int wr, int wc, int fr, int fq) const {
        { const int l_ = lane_now(); fr = l_ & 15; fq = (l_ >> 4) & 3; }
        float ck = -LOG2E / WSCALE, c254 = 254.f; asm volatile("" : "+s"(ck), "+s"(c254));
        typedef float f2 __attribute__((ext_vector_type(2)));
        const int row0 = u.pm * 256 + wr * 64 + fr, col0 = u.pn * 256 + wc * 32 + 8 * fq;
        float rsv[2][4];
#pragma unroll
        for (int ai = 0; ai < 2; ++ai)
#pragma unroll
            for (int m = 0; m < 4; ++m) rsv[ai][m] = rstd2[row0 + ai * 128 + m * 16];
        __builtin_amdgcn_sched_barrier(0);
#pragma unroll
        for (int ai = 0; ai < 2; ++ai)
#pragma unroll
            for (int m = 0; m < 4; ++m) { const float rs = rsv[ai][m] * ck; unsigned char* rowp = G8 + (size_t)(row0 + ai * 128 + m * 16) * 1024 + col0;
#pragma unroll
                for (int bj = 0; bj < 2; ++bj) { v2u w;
#pragma unroll
                    for (int n = 0; n < 2; ++n) { const f32x4 a = acc[ai][bj][m][n]; unsigned b4 = 0u;
#pragma unroll
                        for (int hh = 0; hh < 2; ++hh) { const f2 t = (f2){a[2 * hh], a[2 * hh + 1]} * rs;
                            f2 ex; ex.x = __builtin_amdgcn_exp2f(t.x); ex.y = __builtin_amdgcn_exp2f(t.y); const f2 den = ex + 1.0f;
                            f2 rc; rc.x = __builtin_amdgcn_rcpf(den.x); rc.y = __builtin_amdgcn_rcpf(den.y); const f2 x = rc * c254 + 0.5f;
                            if (hh == 0) { b4 = __builtin_amdgcn_cvt_pk_u8_f32(x.x, 0, b4); b4 = __builtin_amdgcn_cvt_pk_u8_f32(x.y, 1, b4); }
                            else { b4 = __builtin_amdgcn_cvt_pk_u8_f32(x.x, 2, b4); b4 = __builtin_amdgcn_cvt_pk_u8_f32(x.y, 3, b4); } }
                        if (n == 0) w.x = b4; else w.y = b4; }
                    *(v2u*)(rowp + bj * 128) = w; } }
    }
};

__device__ __forceinline__ int moe_setup(Frame& F) {
    LAS int* cnt = (LAS int*)(F.lds + SCH_CNT); LAS int* P = (LAS int*)(F.lds + SCH_P); LAS int* rt2e = (LAS int*)(F.lds + SCH_RT2E);
    if (F.tid < NE) cnt[F.tid] = (int)__hip_atomic_load(((gu32*)(F.ap->ws + WS_CTL)) + CW_CNT + F.tid, RLX_AGENT);
    __syncthreads();
    if (F.tid == 0) { int s = 0; for (int e = 0; e < NE; ++e) { P[e] = s; s += (cnt[e] + 255) >> 8; } P[NE] = s; }
    __syncthreads();
    const int RT = __builtin_amdgcn_readfirstlane(P[NE]);
    for (int t = F.tid; t < RT && t < MAXRT; t += NWAVES * 64) { int e = 0;
#pragma unroll
        for (int k = 1; k <= NE; ++k) e += (P[k] <= t) ? 1 : 0;
        rt2e[t] = e; }
    __syncthreads();
    return RT < MAXRT ? RT : MAXRT;
}
struct MoeOrder {
    pg8::DenseOrder d; LAS const int* P; LAS const int* rt2e; LAS const unsigned* tab;
    const char* Abase; size_t tsA; const char* Bbase; size_t estride, tsB; bool gather;
    __device__ __forceinline__ bool next(int i, Unit& u) const {
        if (!d.tile(i, u.pm, u.pn)) return false;
        const int e = __builtin_amdgcn_readfirstlane(rt2e[u.pm]); u.e = e; u.rtl = u.pm - __builtin_amdgcn_readfirstlane(P[e]);
        u.A = gather ? Abase : Abase + (size_t)u.pm * tsA; u.B = Bbase + (size_t)e * estride + (size_t)u.pn * tsB; return true;
    }
    __device__ __forceinline__ const LAS unsigned char* table(int ui) const { return (const LAS unsigned char*)tab + ui * 1024; }
};

__device__ __forceinline__ void router_pass(Frame& F) {
    LAS float* L = (LAS float*)(F.lds + RING_OFF + F.wave * 2304);
    LAS int* hist = (LAS int*)(F.lds + RING_OFF + 32768); LAS int* hbase = hist + 32;
    if (F.tid < 64) hist[F.tid] = 0;
    __syncthreads();
    const float* X = (F.ap->in[0]); const bf16* MO = WSP(bf16, WS_MO); bf16* MOw = WSP(bf16, WS_MO); unsigned char* HB = WSP(unsigned char, WS_HB); const bf16* wrt = WSP(bf16, WS_WRT);
    const int lane = F.lane, r = lane & 15, q = lane >> 4, tok0 = (int)blockIdx.x * 128 + F.wave * 16, token = tok0 + r;
    pg8::f32x4 acc0 = {0.f, 0.f, 0.f, 0.f}, acc1 = {0.f, 0.f, 0.f, 0.f}; float ss = 0.f;
    const float* hrow = X + (size_t)token * DM + q * 8; const bf16* morow = MO + (size_t)token * DM + q * 8; const bf16* b0p = wrt + (size_t)r * 1024 + q * 8;
    f32x4 xa[2][2][2], ga[2][2][2]; v4u ma[2][2], wa[2][2][4];
#define RT_LOAD(buf, grp) do { _Pragma("unroll") for (int s_ = 0; s_ < 2; ++s_) { const int kk_ = (grp) * 2 + s_; \
        xa[buf][s_][0] = *(const f32x4*)(hrow + kk_ * 32); xa[buf][s_][1] = *(const f32x4*)(hrow + kk_ * 32 + 4); ma[buf][s_] = *(const v4u*)(morow + kk_ * 32); \
        ga[buf][s_][0] = *(const f32x4*)((F.ap->in[9]) + kk_ * 32 + q * 8); ga[buf][s_][1] = *(const f32x4*)((F.ap->in[9]) + kk_ * 32 + q * 8 + 4); \
        wa[buf][s_][0] = *(const v4u*)(b0p + kk_ * 32); wa[buf][s_][1] = *(const v4u*)(b0p + 16 * 1024 + kk_ * 32); wa[buf][s_][2] = *(const v4u*)(b0p + 32768 + kk_ * 32); wa[buf][s_][3] = *(const v4u*)(b0p + 32768 + 16 * 1024 + kk_ * 32); } } while (0)
#define RT_STEP(buf, grp) do { _Pragma("unroll") for (int s_ = 0; s_ < 2; ++s_) { const int kk_ = (grp) * 2 + s_; \
        f32x4 h0 = xa[buf][s_][0], h1 = xa[buf][s_][1]; { f32x4 m0, m1; unpack8(ma[buf][s_], m0, m1); h0 = h0 + m0; h1 = h1 + m1; } \
        ss += (h0[0] * h0[0] + h0[1] * h0[1]) + (h0[2] * h0[2] + h0[3] * h0[3]) + (h1[0] * h1[0] + h1[1] * h1[1]) + (h1[2] * h1[2] + h1[3] * h1[3]); \
        const f32x4 x0 = h0 * ga[buf][s_][0], x1 = h1 * ga[buf][s_][1]; \
        const v4u hi = pack8(x0, x1); f32x4 y0, y1; unpack8(hi, y0, y1); const v4u lo = pack8(x0 - y0, x1 - y1); \
        *(v2u*)(HB + (size_t)token * DM + kk_ * 32 + q * 8) = pack8_fp8(x0, x1); *(v4u*)(MOw + (size_t)token * DM + q * 8 + kk_ * 32) = pack8(h0, h1);     \
        const bf16x8 ah = __builtin_bit_cast(bf16x8, hi), al = __builtin_bit_cast(bf16x8, lo); \
        acc0 = __builtin_amdgcn_mfma_f32_16x16x32_bf16(ah, __builtin_bit_cast(bf16x8, wa[buf][s_][0]), acc0, 0, 0, 0); acc0 = __builtin_amdgcn_mfma_f32_16x16x32_bf16(al, __builtin_bit_cast(bf16x8, wa[buf][s_][0]), acc0, 0, 0, 0); \
        acc0 = __builtin_amdgcn_mfma_f32_16x16x32_bf16(ah, __builtin_bit_cast(bf16x8, wa[buf][s_][2]), acc0, 0, 0, 0); \
        acc1 = __builtin_amdgcn_mfma_f32_16x16x32_bf16(ah, __builtin_bit_cast(bf16x8, wa[buf][s_][1]), acc1, 0, 0, 0); acc1 = __builtin_amdgcn_mfma_f32_16x16x32_bf16(al, __builtin_bit_cast(bf16x8, wa[buf][s_][1]), acc1, 0, 0, 0); \
        acc1 = __builtin_amdgcn_mfma_f32_16x16x32_bf16(ah, __builtin_bit_cast(bf16x8, wa[buf][s_][3]), acc1, 0, 0, 0); } } while (0)
    RT_LOAD(0, 0);
#pragma unroll
    for (int gp = 0; gp < 16; gp += 2) {
        RT_LOAD(1, gp + 1); __builtin_amdgcn_sched_barrier(0); RT_STEP(0, gp); __builtin_amdgcn_sched_barrier(0);
        if (gp + 2 < 16) RT_LOAD(0, gp + 2);
        __builtin_amdgcn_sched_barrier(0); RT_STEP(1, gp + 1); __builtin_amdgcn_sched_barrier(0);
    }
#undef RT_LOAD
#undef RT_STEP
    ss = xor16_sum(ss); ss = xor32_sum(ss);
    const float rstd = 1.f / sqrtf(ss * (1.f / DM) + EPS);
#pragma unroll
    for (int i = 0; i < 4; ++i) { L[(4 * q + i) * 33 + r] = acc0[i]; L[(4 * q + i) * 33 + 16 + r] = acc1[i]; }
    LDS_WAIT(); asm volatile("" ::: "memory");
    int te0 = 0, te1 = 0, te2 = 0, te3 = 0, rk0 = 0, rk1 = 0, rk2 = 0, rk3 = 0; float w0 = 0.f, w1 = 0.f, w2 = 0.f, w3 = 0.f;
    if (lane < 16) {
        float v[32];
#pragma unroll
        for (int e = 0; e < 32; ++e) v[e] = L[lane * 33 + e] * rstd + (F.ap->in[11])[e];
        float tv[4]; int te[4];
#pragma unroll
        for (int k = 0; k < 4; ++k) { float best = v[0]; int bi = 0;
#pragma unroll
            for (int e = 1; e < 32; ++e) if (v[e] > best) { best = v[e]; bi = e; }
            tv[k] = best; te[k] = bi;
#pragma unroll
            for (int e = 0; e < 32; ++e) v[e] = (e == bi) ? -INFINITY : v[e]; }
        const float e1 = expf(tv[1] - tv[0]), e2 = expf(tv[2] - tv[0]), e3 = expf(tv[3] - tv[0]), inv = 1.f / (1.f + e1 + e2 + e3);
        w0 = inv; w1 = e1 * inv; w2 = e2 * inv; w3 = e3 * inv; te0 = te[0]; te1 = te[1]; te2 = te[2]; te3 = te[3];
        rk0 = __hip_atomic_fetch_add(hist + te0, 1, __ATOMIC_RELAXED, __HIP_MEMORY_SCOPE_WORKGROUP); rk1 = __hip_atomic_fetch_add(hist + te1, 1, __ATOMIC_RELAXED, __HIP_MEMORY_SCOPE_WORKGROUP);
        rk2 = __hip_atomic_fetch_add(hist + te2, 1, __ATOMIC_RELAXED, __HIP_MEMORY_SCOPE_WORKGROUP); rk3 = __hip_atomic_fetch_add(hist + te3, 1, __ATOMIC_RELAXED, __HIP_MEMORY_SCOPE_WORKGROUP);
    }
    __syncthreads();
    if (F.tid < NE) hbase[F.tid] = (int)__hip_atomic_fetch_add(((gu32*)(F.ap->ws + WS_CTL)) + CW_CNT + F.tid, (unsigned)hist[F.tid], RLX_AGENT);
    __syncthreads();
    if (lane < 16) {
        int* TOK = WSP(int, WS_TOK); float* RSOF = WSP(float, WS_RSOF); int* TOPE = WSP(int, WS_TOPE); float* TOPW = WSP(float, WS_TOPW); int* POS = WSP(int, WS_POS);
        const int p0 = hbase[te0] + rk0, p1 = hbase[te1] + rk1, p2 = hbase[te2] + rk2, p3 = hbase[te3] + rk3;
        TOK[(size_t)te0 * NT + p0] = token; TOK[(size_t)te1 * NT + p1] = token; TOK[(size_t)te2 * NT + p2] = token; TOK[(size_t)te3 * NT + p3] = token;
        RSOF[(size_t)te0 * NT + p0] = rstd; RSOF[(size_t)te1 * NT + p1] = rstd; RSOF[(size_t)te2 * NT + p2] = rstd; RSOF[(size_t)te3 * NT + p3] = rstd;
        *(int4*)(TOPE + (size_t)token * 4) = make_int4(te0, te1, te2, te3); *(float4*)(TOPW + (size_t)token * 4) = make_float4(w0, w1, w2, w3); *(int4*)(POS + (size_t)token * 4) = make_int4(p0, p1, p2, p3);
    }
    __syncthreads();
}
__device__ __forceinline__ void combine_pass(Frame& F) {
    LAS const int* P = (LAS const int*)(F.lds + SCH_P);
    const unsigned char* Y = WSP(unsigned char, WS_Y); const bf16* MO = WSP(bf16, WS_MO); unsigned char* HB2 = WSP(unsigned char, WS_HB2); float* RSTD2 = WSP(float, WS_RSTD2); bf16* H2B = WSP(bf16, WS_H2B);
    const int* TOPE = WSP(int, WS_TOPE); const float* TOPW = WSP(float, WS_TOPW); const int* POS = WSP(int, WS_POS);
    const int lane = F.lane, tok0 = (int)blockIdx.x * 128 + F.wave * 16;
    int4 te_n[2], tp_n[2]; float4 tw_n[2], tw_c[2]; v4u mc[2][2], mn[2][2]; v2u yc[2][4][2], yn[2][4][2];
#define CB_ROUTE(i) do { _Pragma("unroll") for (int t_ = 0; t_ < 2; ++t_) { te_n[t_] = *(const int4*)(TOPE + (size_t)(tok0 + (i) + t_) * 4); tw_n[t_] = *(const float4*)(TOPW + (size_t)(tok0 + (i) + t_) * 4); tp_n[t_] = *(const int4*)(POS + (size_t)(tok0 + (i) + t_) * 4); } } while (0)
#define CB_DATA(dm, dy, i) do { _Pragma("unroll") for (int t_ = 0; t_ < 2; ++t_) { \
        const size_t s0_ = (size_t)(P[te_n[t_].x] * 256 + tp_n[t_].x) * DM, s1_ = (size_t)(P[te_n[t_].y] * 256 + tp_n[t_].y) * DM, s2_ = (size_t)(P[te_n[t_].z] * 256 + tp_n[t_].z) * DM, s3_ = (size_t)(P[te_n[t_].w] * 256 + tp_n[t_].w) * DM; \
        _Pragma("unroll") for (int j = 0; j < 2; ++j) { const int c = 8 * lane + 512 * j; dm[t_][j] = *(const v4u*)(MO + (size_t)(tok0 + (i) + t_) * DM + c); \
            dy[t_][0][j] = *(const v2u*)(Y + s0_ + c); dy[t_][1][j] = *(const v2u*)(Y + s1_ + c); dy[t_][2][j] = *(const v2u*)(Y + s2_ + c); dy[t_][3][j] = *(const v2u*)(Y + s3_ + c); } } } while (0)
    CB_ROUTE(0); CB_DATA(mc, yc, 0); tw_c[0] = tw_n[0]; tw_c[1] = tw_n[1]; CB_ROUTE(2);
    for (int i = 0; i < 16; i += 2) {
        const float4 tw_x0 = tw_n[0], tw_x1 = tw_n[1];
        if (i + 2 < 16) CB_DATA(mn, yn, i + 2);
        if (i + 4 < 16) CB_ROUTE(i + 4);
        __builtin_amdgcn_sched_barrier(0);
#pragma unroll
        for (int t = 0; t < 2; ++t) { const int token = tok0 + i + t; f32x4 v[2][2]; float ss = 0.f; const float4 tw = tw_c[t] * (1.f / YSCALE);
#pragma unroll
            for (int j = 0; j < 2; ++j) { f32x4 a, b; unpack8(mc[t][j], a, b);
#pragma unroll
                for (int k = 0; k < 4; ++k) { const v2u y = yc[t][k][j]; const float w = k == 0 ? tw.x : k == 1 ? tw.y : k == 2 ? tw.z : tw.w;
                    const auto p0 = __builtin_amdgcn_cvt_pk_f32_fp8((int)y.x, false), p1 = __builtin_amdgcn_cvt_pk_f32_fp8((int)y.x, true), p2 = __builtin_amdgcn_cvt_pk_f32_fp8((int)y.y, false), p3 = __builtin_amdgcn_cvt_pk_f32_fp8((int)y.y, true);
                    a += w * (f32x4){p0[0], p0[1], p1[0], p1[1]}; b += w * (f32x4){p2[0], p2[1], p3[0], p3[1]}; }
                v[j][0] = a; v[j][1] = b;
                ss += ((a.x * a.x + a.y * a.y) + (a.z * a.z + a.w * a.w)) + ((b.x * b.x + b.y * b.y) + (b.z * b.z + b.w * b.w)); }
            const float rstd = 1.f / sqrtf(wave_sum(ss) * (1.f / DM) + EPS);
#pragma unroll
            for (int j = 0; j < 2; ++j) { const int c = 8 * lane + 512 * j; *(v4u*)(H2B + (size_t)token * DM + c) = pack8(v[j][0], v[j][1]);
                const f32x4 g0 = *(const f32x4*)((F.ap->in[16]) + c), g1 = *(const f32x4*)((F.ap->in[16]) + c + 4);
                *(v2u*)(HB2 + (size_t)token * DM + c) = pack8_fp8(v[j][0] * g0, v[j][1] * g1); }
            if (lane == 0) RSTD2[token] = rstd; }
        __builtin_amdgcn_sched_barrier(0);
#pragma unroll
        for (int t = 0; t < 2; ++t)
#pragma unroll
            for (int j = 0; j < 2; ++j) { mc[t][j] = mn[t][j];
#pragma unroll
                for (int k = 0; k < 4; ++k) yc[t][k][j] = yn[t][k][j]; }
        tw_c[0] = tw_x0; tw_c[1] = tw_x1;
    }
#undef CB_ROUTE
#undef CB_DATA
}
__device__ __forceinline__ void final_pass(Frame& F) {
    const bf16* PJ = WSP(bf16, WS_PJ); const bf16* H2B = WSP(bf16, WS_H2B); const unsigned char* G8 = WSP(unsigned char, WS_G8); const int lane = F.lane, tok0 = (int)blockIdx.x * 128 + F.wave * 16;
    v4u hc[2][2], hn[2][2], pc[2][2], pn[2][2]; v2u gc[2][2], gn[2][2];
#define FP_LOAD(hd, pd, gd, i) do { _Pragma("unroll") for (int t_ = 0; t_ < 2; ++t_) _Pragma("unroll") for (int j = 0; j < 2; ++j) { const size_t o_ = (size_t)(tok0 + (i) + t_) * DM + 8 * lane + 512 * j; \
        hd[t_][j] = *(const v4u*)(H2B + o_); pd[t_][j] = *(const v4u*)(PJ + o_); gd[t_][j] = *(const v2u*)(G8 + o_); } } while (0)
    FP_LOAD(hc, pc, gc, 0);
    for (int i = 0; i < 16; i += 2) {
        if (i + 2 < 16) FP_LOAD(hn, pn, gn, i + 2);
        __builtin_amdgcn_sched_barrier(0);
#pragma unroll
        for (int t = 0; t < 2; ++t) { f32x4 v[2][2]; float ss = 0.f;
#pragma unroll
            for (int j = 0; j < 2; ++j) { f32x4 a, b, pa, pb; unpack8(hc[t][j], a, b); unpack8(pc[t][j], pa, pb); const unsigned g0 = gc[t][j].x, g1 = gc[t][j].y;
                const f32x4 ga = {(float)(g0 & 255u), (float)((g0 >> 8) & 255u), (float)((g0 >> 16) & 255u), (float)(g0 >> 24)}, gb = {(float)(g1 & 255u), (float)((g1 >> 8) & 255u), (float)((g1 >> 16) & 255u), (float)(g1 >> 24)};
                a += (ga * (1.f / 254.f)) * pa; b += (gb * (1.f / 254.f)) * pb; v[j][0] = a; v[j][1] = b;
                ss += ((a.x * a.x + a.y * a.y) + (a.z * a.z + a.w * a.w)) + ((b.x * b.x + b.y * b.y) + (b.z * b.z + b.w * b.w)); }
            const float rstd = 1.f / sqrtf(wave_sum(ss) * (1.f / DM) + EPS); float* hr = (F.ap->out) + (size_t)(tok0 + i + t) * DM;
#pragma unroll
            for (int j = 0; j < 2; ++j) { const int c = 8 * lane + 512 * j; const f32x4 g0 = *(const f32x4*)((F.ap->in[19]) + c), g1 = *(const f32x4*)((F.ap->in[19]) + c + 4);
                *(f32x4*)(hr + c) = v[j][0] * rstd * g0; *(f32x4*)(hr + c + 4) = v[j][1] * rstd * g1; } }
        __builtin_amdgcn_sched_barrier(0);
#pragma unroll
        for (int t = 0; t < 2; ++t)
#pragma unroll
            for (int j = 0; j < 2; ++j) { hc[t][j] = hn[t][j]; pc[t][j] = pn[t][j]; gc[t][j] = gn[t][j]; }
    }
#undef FP_LOAD
}

struct PnOffOrder { pg8::DenseOrder d; int off;
    __device__ __forceinline__ bool next(int i, pg8::Unit& u) const { if (!d.next(i, u)) return false; u.pn += off; return true; }
    __device__ __forceinline__ const LAS unsigned char* table(int) const { return nullptr; } };
struct StrideOrder { int start, stride, n; const char* A; const char* B; size_t tsA, tsB;
    __device__ __forceinline__ bool next(int i, pg8::Unit& u) const { const int idx = start + i * stride; if (idx >= n) return false; u.pm = idx >> 2; u.pn = idx & 3; u.A = A + (size_t)u.pm * tsA; u.B = B + (size_t)u.pn * tsB; u.e = 0; u.rtl = 0; return true; }
    __device__ __forceinline__ const LAS unsigned char* table(int) const { return nullptr; } };
constexpr int N_PHASES = 11;

__global__ void __launch_bounds__(NWAVES * 64, 2) fwd(Args args) {
    extern __shared__ __attribute__((aligned(16))) unsigned char lds[];
    Frame F;
    F.lds = (LAS unsigned char*)lds;
    F.MISC = (volatile LAS unsigned*)(F.lds + MISC_OFF);
    F.tid = threadIdx.x; F.lane = F.tid & 63; F.wave = __builtin_amdgcn_readfirstlane(F.tid >> 6);
    F.G = gridDim.x; { const int bx = blockIdx.x; F.vcu = (F.G % 8 == 0) ? (bx % 8) * (F.G / 8) + bx / 8 : bx; }
    REARGS();
    for (int u = F.tid; u < 64; u += NWAVES * 64) ((LAS unsigned*)(F.lds + MISC_OFF))[u] = 0u;
    __syncthreads();
    const bool one = (F.ap->ph_hi - F.ap->ph_lo) > 1;
    XcdBarrier bar; bar.bar = (unsigned*)(((gu32*)(F.ap->ws + WS_CTL)) + CW_BAR); bar.x = 0; bar.st = nullptr;
    if (one) bar = xcd_barrier_post((unsigned*)(((gu32*)(F.ap->ws + WS_CTL)) + CW_BAR), F.MISC + 8, F.tid);
#ifdef ONLY_PHASE
    constexpr int lo = ONLY_PHASE, hi = ONLY_PHASE + 1;
#else
    const int lo = F.ap->ph_lo, hi = F.ap->ph_hi;
#endif
    int cid = (int)blockIdx.x;
#define IN(k) (lo <= (k) && (k) < hi)
#define RELANE() do { int l_ = lane_now(); asm volatile("" : "+v"(l_)); F.lane = l_; F.tid = F.wave * 64 + l_; REARGS(); asm volatile("" : "+s"(cid)); } while (0)
#define GBAR() do { RELANE(); xcd_barrier(bar, F.tid); } while (0)
#define SEAM(k) do { if (IN(k) && IN((k) + 1)) GBAR(); } while (0)
    const int rep_phase = F.ap->rep_phase, rep_mode = F.ap->rep_mode;
#define NREP(k) (((k) == rep_phase) ? 2 : 1)
    LAS unsigned char* ring = F.lds + RING_OFF;

    for (int rep = 0; rep < NREP(0); ++rep) { if (rep) GBAR(); if (IN(0)) { RELANE(); p0_prologue(F); } } SEAM(0);
    for (int rep = 0; rep < NREP(1); ++rep) { if (rep) GBAR(); if (IN(1)) { RELANE();
        if (cid < NBATCH * 8) cum_scan(F, cid);
        { pg8::Gemm g{1024, 1024, 1024}; PnOffOrder S; S.off = 4; S.d.init(NT / 256, 8, F.G, cid, WSP(bf16, WS_XN), (size_t)256 * 1024 * 2, WSP(bf16, WS_W1T), (size_t)256 * 1024 * 2);
          EpiIn E{WSP(bf16, WS_FQ), WSP(bf16, WS_FK), WSP(bf16, WS_FV), WSP(bf16, WS_RQ), WSP(bf16, WS_RK), WSP(bf16, WS_RV), WSP(bf16, WS_RGS), WSP(float, WS_ROT), WSP(bf16, WS_RKT), F.lds + TAB_OFF, (rep == 1 && rep_mode >= 7) ? (rep_mode == 7 ? 1 : rep_mode - 64) : 0};
          pg8::gemm_phase<EpiIn, PnOffOrder, true, false>(ring, g, S, E, F.wave); }
        { RELANE();
          pg8::Gemm g{1024, 1024, 1024}; pg8::DenseOrder S; S.init(NT / 256, 12, F.G, cid, WSP(unsigned char, WS_XN8), (size_t)256 * 1024, WSP(unsigned char, WS_WG8T), (size_t)256 * 1024);
          EpiGate E{WSP(unsigned char, WS_GATES), (F.ap->in[7]), WSP(bf16, WS_FQ), WSP(bf16, WS_FK), (rep == 1 && rep_mode >= 7) ? (rep_mode == 7 ? 1 : rep_mode - 64) : 0};
          pg8::gemm_phase<EpiGate, pg8::DenseOrder, true, false, 1>(ring, g, S, E, F.wave); }
    } } SEAM(1);
    for (int rep = 0; rep < NREP(2); ++rep) { if (rep) GBAR(); if (IN(2)) { RELANE();
        { static_assert(ret_body::LDS_BYTES <= RING_BYTES && attn_body::ATTN_LDS_BYTES <= RING_BYTES, "phase scratch inside the ring");
          volatile LAS int* qn = (volatile LAS int*)(F.MISC + 16);
          const attn_body::bf16* Q = (const attn_body::bf16*)WSP(bf16, WS_FQ); const attn_body::bf16* K = (const attn_body::bf16*)WSP(bf16, WS_FK); const attn_body::bf16* V = (const attn_body::bf16*)WSP(bf16, WS_FV);
          attn_body::bf16* O = (attn_body::bf16*)WSP(bf16, WS_BR);
          if (lane_now() + F.wave * 64 == 0) qn[0] = (int)__hip_atomic_fetch_add(((gu32*)(F.ap->ws + WS_CTL)) + CW_QUEUE + 64 * rep, 1u, RLX_AGENT);
          __syncthreads();
          for (int n = 0;; ++n) {
              const int item = __builtin_amdgcn_readfirstlane(qn[n & 1]);
              if (item >= 64 + 1024 + CONV_CHUNKS) break;
              int nxt_item = 0;
              if (lane_now() + F.wave * 64 == 0) nxt_item = (int)__hip_atomic_fetch_add(((gu32*)(F.ap->ws + WS_CTL)) + CW_QUEUE + 64 * rep, 1u, RLX_AGENT);
              if (item < 64) { const int bh4 = item;
                  ret_body::ret_unit(ring, bh4 >> 2, bh4 & 3, WSP(bf16, WS_RQ), WSP(bf16, WS_RK), WSP(bf16, WS_RV), WSP(bf16, WS_RKT), WSP(bf16, WS_RGS), WSP(bf16, WS_BR), F.wave, 0, 16, 0); }
              else { const int r = item - 64, cb = (int)(((long)r * CONV_CHUNKS) / (1024 + CONV_CHUNKS)), cn = (int)(((long)(r + 1) * CONV_CHUNKS) / (1024 + CONV_CHUNKS));
                  if (cn > cb) { RELANE(); conv_chunk(F, cb); }
                  else { const int k = r - cb, qb = 7 - (k >> 7), bh = k & 127;
                      attn_body::attn_unit<8>(bh >> 3, bh & 7, qb, Q, K, V, O, WSP(float, WS_CUM) + (size_t)bh * SEQ, (char*)lds + RING_OFF, F.wave); } }
              if (lane_now() + F.wave * 64 == 0) qn[(n + 1) & 1] = nxt_item;
              __syncthreads();
          } }
    } } SEAM(2);
    for (int rep = 0; rep < NREP(3); ++rep) { if (rep) GBAR(); if (IN(3)) { RELANE();
        pg8::Gemm g{1024, 1024, 1024}; pg8::DenseOrder S; S.init(NT / 256, 4, F.G, cid, WSP(bf16, WS_BR), (size_t)256 * 1024 * 2, WSP(bf16, WS_WBT), (size_t)256 * 1024 * 2);
        EpiMerge E{WSP(unsigned char, WS_GATES), WSP(bf16, WS_MERGED)}; HookMerge H{WSP(unsigned char, WS_GATES)};
        pg8::gemm_phase<EpiMerge, pg8::DenseOrder, true, false, 2, HookMerge>(ring, g, S, E, F.wave, H);
    } } SEAM(3);
    for (int rep = 0; rep < NREP(4); ++rep) { if (rep) GBAR(); if (IN(4)) { RELANE();
        pg8::Gemm g{1024, 1024, 1024}; pg8::DenseOrder S; S.init(NT / 256, 4, F.G, cid, WSP(bf16, WS_MERGED), (size_t)256 * 1024 * 2, WSP(bf16, WS_WOT), (size_t)256 * 1024 * 2);
        EpiMO E{WSP(bf16, WS_MO)}; pg8::gemm_phase<EpiMO, pg8::DenseOrder, true, false>(ring, g, S, E, F.wave);
    } } SEAM(4);
    for (int rep = 0; rep < NREP(5); ++rep) { if (rep) GBAR(); if (IN(5)) { RELANE(); router_pass(F); } } SEAM(5);
    for (int rep = 0; rep < NREP(6); ++rep) { if (rep) GBAR(); if (IN(6)) { RELANE();
        const int RT = moe_setup(F);
        MoeOrder S; S.d.init(RT, 8, F.G, cid, nullptr, 0, nullptr, 0); S.P = (LAS const int*)(F.lds + SCH_P); S.rt2e = (LAS const int*)(F.lds + SCH_RT2E); S.tab = (LAS const unsigned*)(F.lds + TAB_OFF);
        S.Abase = (const char*)WSP(unsigned char, WS_HB); S.tsA = 0; S.Bbase = (const char*)WSP(unsigned char, WS_WGUT); S.estride = (size_t)2048 * 1024; S.tsB = (size_t)256 * 1024; S.gather = true;
        { LAS const int* cnt = (LAS const int*)(F.lds + SCH_CNT); LAS unsigned* tab = (LAS unsigned*)(F.lds + TAB_OFF); const int* TOK = WSP(int, WS_TOK);
          int tokv[MAXUNITS / 2];
#pragma unroll
          for (int j = 0; j < MAXUNITS / 2; ++j) { const int ui = 2 * j + (F.tid >> 8), r = F.tid & 255; int pm, pn; tokv[j] = -1;
              if (S.d.tile(ui, pm, pn)) { const int e = S.rt2e[pm], pos = (pm - S.P[e]) * 256 + r; tokv[j] = pos < cnt[e] ? TOK[(size_t)e * NT + pos] : NT; } }
#pragma unroll
          for (int j = 0; j < MAXUNITS / 2; ++j) { const int ui = 2 * j + (F.tid >> 8), r = F.tid & 255; if (tokv[j] >= 0) tab[ui * 256 + r] = (unsigned)tokv[j] * 1024u; }
          __syncthreads(); }
        pg8::Gemm g{1024, 1024, 1024};
        EpiGU E{(F.ap->in[13]), WSP(float, WS_RSOF), WSP(unsigned char, WS_ACT)}; pg8::gemm_phase<EpiGU, MoeOrder, true, true, 1>(ring, g, S, E, F.wave);
    } } SEAM(6);
    for (int rep = 0; rep < NREP(7); ++rep) { if (rep) GBAR(); if (IN(7)) { RELANE();
        const int RT = moe_setup(F);
        MoeOrder S; S.d.init(RT, 4, F.G, cid, nullptr, 0, nullptr, 0); S.P = (LAS const int*)(F.lds + SCH_P); S.rt2e = (LAS const int*)(F.lds + SCH_RT2E); S.tab = (LAS const unsigned*)(F.lds + TAB_OFF);
        S.Abase = (const char*)WSP(unsigned char, WS_ACT); S.tsA = (size_t)256 * 1024; S.Bbase = (const char*)WSP(unsigned char, WS_WDT); S.estride = (size_t)1024 * 1024; S.tsB = (size_t)256 * 1024; S.gather = false;
        pg8::Gemm g{1024, 1024, 1024};
        EpiDN E{(F.ap->in[15]), WSP(unsigned char, WS_Y)}; pg8::gemm_phase<EpiDN, MoeOrder, true, false, 1>(ring, g, S, E, F.wave);
        { const int rem = (RT * 4) % F.G, nidle = F.G - rem; const bool tail = 2 * nidle >= F.G;
          if (!tail || cid >= rem) { RELANE(); pg8::Gemm g2{256, 256, 256}; StrideOrder S2; S2.start = tail ? cid - rem : cid; S2.stride = tail ? nidle : F.G; S2.n = (NT / 256) * 4; S2.A = (const char*)WSP(bf16, WS_PB); S2.tsA = (size_t)256 * 256 * 2; S2.B = (const char*)WSP(bf16, WS_WPPT); S2.tsB = (size_t)256 * 256 * 2;
              EpiPJ E2{WSP(bf16, WS_PJ)}; pg8::gemm_phase<EpiPJ, StrideOrder, true, false>(ring, g2, S2, E2, F.wave); } }
    } } SEAM(7);
    for (int rep = 0; rep < NREP(8); ++rep) { if (rep) GBAR(); if (IN(8)) { RELANE(); (void)moe_setup(F); combine_pass(F); } } SEAM(8);
    for (int rep = 0; rep < NREP(9); ++rep) { if (rep) GBAR(); if (IN(9)) { RELANE();
        { pg8::Gemm g{1024, 1024, 1024}; pg8::DenseOrder S; S.init(NT / 256, 4, F.G, cid, WSP(unsigned char, WS_HB2), (size_t)256 * 1024, WSP(unsigned char, WS_WPGT), (size_t)256 * 1024);
          EpiPG E{WSP(unsigned char, WS_G8), WSP(float, WS_RSTD2)}; pg8::gemm_phase<EpiPG, pg8::DenseOrder, true, false, 1>(ring, g, S, E, F.wave); }
    } } SEAM(9);
    if (IN(10)) { RELANE(); final_pass(F); }
#undef IN
#undef SEAM
}

extern "C" void kernel_launch(void* const* d_in, const int* in_sizes, int n_in, void* d_out, int out_size, void* d_ws, size_t ws_size, hipStream_t stream) {
    static int grid = 0;
    if (grid == 0) {
        if (n_in != 20 || in_sizes[0] != NT * DM || out_size != NT * DM || ws_size < WS_END) { fprintf(stderr, "kernel_launch: unexpected shapes / workspace (%zu < %zu); nothing launched\n", ws_size, (size_t)WS_END); grid = -1; return; }
        int dev = 0, cus = 0, per_cu = 0;
        if (hipGetDevice(&dev) != hipSuccess || hipDeviceGetAttribute(&cus, hipDeviceAttributeMultiprocessorCount, dev) != hipSuccess) { grid = -1; return; }
        if (hipFuncSetAttribute((const void*)fwd, hipFuncAttributeMaxDynamicSharedMemorySize, LDS_BYTES) != hipSuccess) { fprintf(stderr, "kernel_launch: hipFuncSetAttribute failed\n"); grid = -1; return; }
        if (hipOccupancyMaxActiveBlocksPerMultiprocessor(&per_cu, (const void*)fwd, NWAVES * 64, LDS_BYTES) != hipSuccess || per_cu < 1) { fprintf(stderr, "kernel_launch: occupancy query reports %d workgroups per CU\n", per_cu); }
        (void)hipGetLastError();
        grid = cus;
        if (grid != 256) { fprintf(stderr, "kernel_launch: built for 256 CUs, found %d; nothing launched\n", cus); grid = -1; return; }
    }
    if (grid < 0) return;
    if (hipMemsetAsync((char*)d_ws + WS_CTL, 0, CTL_ZERO_BYTES, stream) != hipSuccess) return;
    Args a; memset(&a, 0, sizeof a);
    for (int i = 0; i < 20; ++i) a.in[i] = (const float*)d_in[i];
    a.out = (float*)d_out; a.ws = (unsigned char*)d_ws;
#ifndef MK_SPLIT
    a.ph_lo = 0; a.ph_hi = N_PHASES;
#ifdef PROBE_PHASE
    a.rep_phase = PROBE_PHASE; a.rep_mode = PROBE_MODE;
#else
    a.rep_phase = -1; a.rep_mode = 0;
#endif
    hipLaunchKernelGGL(fwd, dim3(grid), dim3(NWAVES * 64), LDS_BYTES, stream, a);
#else
    for (int ph = 0; ph < N_PHASES; ++ph) { a.ph_lo = ph; a.ph_hi = ph + 1; hipLaunchKernelGGL(fwd, dim3(grid), dim3(NWAVES * 64), LDS_BYTES, stream, a); }
#endif
}
```

```cpp
#include <hip/hip_runtime.h>
#include <cstdio>
#include <cstdint>
#include <cstring>
#include <cmath>
__device__ __forceinline__ int lane_now() { int l; asm volatile("v_mbcnt_lo_u32_b32 %0, -1, 0\n\tv_mbcnt_hi_u32_b32 %0, -1, %0" : "=v"(l)); return l; }
namespace pg8 {
#define PG8_LAS __attribute__((address_space(3)))
typedef unsigned short bf16_t;
typedef short bf16x8 __attribute__((ext_vector_type(8)));
typedef float f32x4 __attribute__((ext_vector_type(4)));
typedef float f32x2 __attribute__((ext_vector_type(2)));
typedef unsigned u32x4 __attribute__((ext_vector_type(4)));
typedef unsigned u32x2 __attribute__((ext_vector_type(2)));
constexpr int BM = 256, BK = 64, HALF = 128, HTB = HALF * BK * 2  , STAGE_BYTES = 8 * HTB, NXCD = 8, WGM = 8;

__host__ __device__ __forceinline__ int lds_byte(int r, int c) { const int st = (r >> 4) * 2 + (c >> 5), rr = r & 15, cc = c & 31, ob = rr * 64 + cc * 2; return st * 1024 + (ob ^ (((ob >> 9) & 1) << 5)); }
__host__ __device__ __forceinline__ void stage_rc(int b, int& R, int& C) { const int st = b / 1024, sb = b % 1024, swz = sb ^ (((sb >> 9) & 1) << 5); R = (st >> 1) * 16 + swz / 64; C = (st & 1) * 32 + (swz % 64) / 2; }
__host__ __device__ __forceinline__ int perm32(int rho) { const int n = rho >> 4, i = rho & 15; return 8 * (i >> 2) + 4 * n + (i & 3); }

struct Unit { int pm, pn; const char* A; const char* B; int e, rtl; };
struct Gemm { int lda, ldb, K; };

struct DenseOrder {
    int nM, nN, nwg, G, c; const char* A; const char* B; size_t tsA, tsB;
    __device__ __forceinline__ void init(int nM_, int nN_, int G_, int c_, const void* A_, size_t tsA_, const void* B_, size_t tsB_) { nM = nM_; nN = nN_; nwg = nM * nN; G = G_; c = c_; A = (const char*)A_; B = (const char*)B_; tsA = tsA_; tsB = tsB_; }
    __device__ __forceinline__ bool tile(int i, int& pm, int& pn) const {
        const long L = (long)i * G + c; if (L >= nwg) return false;
        int wgid = (int)L; { const int q = nwg / NXCD, r = nwg % NXCD, xcd = wgid % NXCD, off = wgid / NXCD; wgid = (xcd < r ? xcd * (q + 1) : r * (q + 1) + (xcd - r) * q) + off; }
        const int nig = WGM * nN, gid = wgid / nig, fm = gid * WGM, gsz = (nM - fm) < WGM ? (nM - fm) : WGM;
        pm = fm + ((wgid % nig) % gsz); pn = (wgid % nig) / gsz; return true;
    }
    __device__ __forceinline__ bool next(int i, Unit& u) const { if (!tile(i, u.pm, u.pn)) return false; u.A = A + (size_t)u.pm * tsA; u.B = B + (size_t)u.pn * tsB; u.e = 0; u.rtl = 0; return true; }
    __device__ __forceinline__ const PG8_LAS unsigned char* table(int) const { return nullptr; }
};

__device__ __forceinline__ unsigned cvt_pk_bf16(float lo, float hi) { unsigned r; asm volatile("s_nop 0\n\tv_cvt_pk_bf16_f32 %0, %1, %2" : "=v"(r) : "v"(lo), "v"(hi)); return r; }
__device__ __forceinline__ float bflo(unsigned w) { return __uint_as_float(w << 16); }
__device__ __forceinline__ float bfhi(unsigned w) { return __uint_as_float(w & 0xffff0000u); }
__device__ __forceinline__ float fsigmoid(float x) { return __builtin_amdgcn_rcpf(1.0f + __builtin_amdgcn_exp2f(-1.4426950408889634f * x)); }

__device__ __forceinline__ const char* uni_ptr(const char* p) { const unsigned long long v = (unsigned long long)p; const unsigned lo = __builtin_amdgcn_readfirstlane((unsigned)v), hi = __builtin_amdgcn_readfirstlane((unsigned)(v >> 32)); return (const char*)(((unsigned long long)hi << 32) | lo); }
__device__ __forceinline__ void uni_unit(Unit& u) { u.pm = __builtin_amdgcn_readfirstlane(u.pm); u.pn = __builtin_amdgcn_readfirstlane(u.pn); u.e = __builtin_amdgcn_readfirstlane(u.e); u.rtl = __builtin_amdgcn_readfirstlane(u.rtl); u.A = uni_ptr(u.A); u.B = uni_ptr(u.B); }
struct NoHook { static constexpr bool ON = false; static constexpr int AT = -1; template <class A> __device__ __forceinline__ void operator()(A&, const Unit&, int, int, int, int) const {} };
template <class Epi, class Sched, bool ALIGN_EPI, bool GATHER, int ES = 2, class Hook = NoHook>
__device__ __forceinline__ void gemm_phase(PG8_LAS unsigned char* lds, const Gemm g, const Sched& S, const Epi& E, int wave, const Hook& H = Hook()) {
    int tid = wave * 64 + lane_now(); asm volatile("" : "+v"(tid));
    const int wid = __builtin_amdgcn_readfirstlane(tid >> 6), lane = tid & 63, wr = wid >> 2, wc = wid & 3, fr = lane & 15, fq = lane >> 4;
    const int K = g.K, nt = K * ES / (BK * 2);
    unsigned voffA[2], voffB[2];
#pragma unroll
    for (int i = 0; i < 2; ++i) { int R, C; stage_rc(tid * 16 + i * 8192, R, C); const int Rb = Epi::PERM ? ((R & ~31) + perm32(R & 31)) : R;
        voffA[i] = (unsigned)(R * g.lda * ES + C * 2); voffB[i] = (unsigned)(Rb * g.ldb * ES + C * 2); }
    const size_t kstep = (size_t)(BK * 2);
    const size_t hstepA = GATHER ? (size_t)0 : (size_t)HALF * g.lda * ES;
    const size_t hstepB = (size_t)HALF * g.ldb * ES;
    const unsigned ldsw = (unsigned)wid * 1024u;
    const int aoff = lds_byte(wr * 64 + fr, fq * 8), boff = lds_byte(wc * 32 + fr, fq * 8);
    unsigned vA[2][2], nvA[2][2];
#define PG8_ROWS(dst, uidx) do { int t_ = wave * 64 + lane_now(); asm volatile("" : "+v"(t_)); int R0_, C0_; stage_rc(t_ * 16, R0_, C0_); \
        const PG8_LAS unsigned char* _t = S.table(uidx) + (unsigned)R0_ * 4u; const unsigned c2_ = (unsigned)C0_ * 2u; _Pragma("unroll") for (int h = 0; h < 2; ++h) _Pragma("unroll") for (int i = 0; i < 2; ++i) \
        dst[h][i] = *(const PG8_LAS unsigned*)(_t + h * 512 + i * 256) + c2_; } while (0)
#define PG8_SA(b, h) (((b) * 2 + (h)) * HTB)
#define PG8_SB(b, h) ((4 + (b) * 2 + (h)) * HTB)
#define PG8_STAGE(bufoff, gbase, voff) do { const char* _gb = (const char*)(gbase); asm volatile("" : "+s"(_gb));     \
        _Pragma("unroll") for (int _i = 0; _i < 2; ++_i) { const unsigned _la = (unsigned)__builtin_amdgcn_readfirstlane((int)(unsigned)(uintptr_t)(lds + (bufoff) + ldsw + _i * 8192)); \
            asm volatile("s_mov_b32 m0, %2\n\ts_nop 0\n\tglobal_load_lds_dwordx4 %0, %1" :: "v"((voff)[_i]), "s"(_gb), "s"(_la) : "memory", "m0"); } } while (0)
#define PG8_STB(b, h, ptr) PG8_STAGE(PG8_SB(b, h), (ptr) + (h) * hstepB, voffB)
#define PG8_STA(b, h, ptr, nx) do { if constexpr (GATHER) { unsigned _v[2]; _v[0] = (nx) ? nvA[h][0] : vA[h][0]; _v[1] = (nx) ? nvA[h][1] : vA[h][1]; PG8_STAGE(PG8_SA(b, h), (ptr), _v); } \
        else { PG8_STAGE(PG8_SA(b, h), (ptr) + (h) * hstepA, voffA); } } while (0)
#define PG8_LDA(dst, b, h) do { _Pragma("unroll") for (int m = 0; m < 4; ++m) _Pragma("unroll") for (int k = 0; k < 2; ++k) dst[m][k] = *(const PG8_LAS bf16x8*)(lds + PG8_SA(b, h) + aoff + m * 2048 + k * 1024); } while (0)
#define PG8_LDB(dst, b, h) do { _Pragma("unroll") for (int n = 0; n < 2; ++n) _Pragma("unroll") for (int k = 0; k < 2; ++k) dst[n][k] = *(const PG8_LAS bf16x8*)(lds + PG8_SB(b, h) + boff + n * 2048 + k * 1024); } while (0)
#define PG8_MMA(ai, bj, At, Bt, Z) do { const f32x4 z4_ = {0.f, 0.f, 0.f, 0.f}; __builtin_amdgcn_s_setprio(1); _Pragma("unroll") for (int m = 0; m < 4; ++m) _Pragma("unroll") for (int n = 0; n < 2; ++n) { \
        if constexpr (ES == 2) { acc[ai][bj][m][n] = __builtin_amdgcn_mfma_f32_16x16x32_bf16(Bt[n][0], At[m][0], (Z) ? z4_ : acc[ai][bj][m][n], 0, 0, 0); acc[ai][bj][m][n] = __builtin_amdgcn_mfma_f32_16x16x32_bf16(Bt[n][1], At[m][1], acc[ai][bj][m][n], 0, 0, 0); } \
        else { typedef int v8i_ __attribute__((ext_vector_type(8))); const u32x4 b0_ = __builtin_bit_cast(u32x4, Bt[n][0]), b1_ = __builtin_bit_cast(u32x4, Bt[n][1]), a0_ = __builtin_bit_cast(u32x4, At[m][0]), a1_ = __builtin_bit_cast(u32x4, At[m][1]); \
            const v8i_ bv_ = {(int)b0_[0], (int)b0_[1], (int)b0_[2], (int)b0_[3], (int)b1_[0], (int)b1_[1], (int)b1_[2], (int)b1_[3]}, av_ = {(int)a0_[0], (int)a0_[1], (int)a0_[2], (int)a0_[3], (int)a1_[0], (int)a1_[1], (int)a1_[2], (int)a1_[3]}; \
            acc[ai][bj][m][n] = __builtin_amdgcn_mfma_scale_f32_16x16x128_f8f6f4(bv_, av_, (Z) ? z4_ : acc[ai][bj][m][n], 0, 0, 0, 0, 0, 0); } }     \
        __builtin_amdgcn_s_setprio(0); \
        _Pragma("unroll") for (int m = 0; m < 4; ++m) asm volatile("" : "+v"(acc[ai][bj][m][0]), "+v"(acc[ai][bj][m][1]));     \
        } while (0)
#define PG8_WAIT_V(n) asm volatile("s_waitcnt vmcnt(" #n ")" ::: "memory")
#define PG8_WAIT_L(n) asm volatile("s_waitcnt lgkmcnt(" #n ")" ::: "memory")
#define PG8_BAR __builtin_amdgcn_s_barrier()
#define PG8_SCHED __builtin_amdgcn_sched_barrier(0)
    Unit cur, nxt; int ui = 0;
    if (!S.next(0, cur)) return;
    uni_unit(cur);
    f32x4 acc[2][2][4][2];
    bf16x8 At[4][2], B0[2][2], B1[2][2];
    const char* cA = cur.A; const char* cB = cur.B;
    if constexpr (GATHER) { PG8_ROWS(vA, 0); }
    PG8_STB(0, 0, cB); PG8_STB(0, 1, cB); PG8_STA(0, 0, cA, false); PG8_STA(0, 1, cA, false);
    if (wr == 1) PG8_BAR;
    PG8_WAIT_V(2); PG8_BAR;
    PG8_STB(1, 0, cB + kstep); PG8_STA(1, 0, cA + kstep, false); PG8_STB(1, 1, cB + kstep);
    PG8_WAIT_V(6); PG8_BAR;
    for (;;) {
        const bool has_next = S.next(ui + 1, nxt);
        if (has_next) uni_unit(nxt);
        const char* nA = has_next ? nxt.A : cA; const char* nB = has_next ? nxt.B : cB;
#define PG8_KPAIR(t, LAST, ZERO) do { \
            const char* a1 = cA + (size_t)((t) + 1) * kstep; \
            const char* a2 = (LAST) ? nA : cA + (size_t)((t) + 2) * kstep; const char* b2 = (LAST) ? nB : cB + (size_t)((t) + 2) * kstep; \
            const char* a3 = a2 + kstep; const char* b3 = b2 + kstep; \
              \
            PG8_LDB(B0, 0, 0); PG8_LDB(B1, 0, 1); PG8_SCHED; PG8_LDA(At, 0, 0); PG8_STA(1, 1, a1, false); \
            PG8_WAIT_V(8); PG8_WAIT_L(0); PG8_BAR; PG8_MMA(0, 0, At, B0, ZERO); PG8_MMA(0, 1, At, B1, ZERO); PG8_BAR; PG8_SCHED; \
              \
            PG8_LDA(At, 0, 1); PG8_STB(0, 0, b2); PG8_STB(0, 1, b2); PG8_STA(0, 0, a2, LAST); \
            PG8_WAIT_V(8); PG8_WAIT_L(0); PG8_BAR; PG8_MMA(1, 0, At, B0, ZERO); PG8_MMA(1, 1, At, B1, ZERO); PG8_BAR; PG8_SCHED; \
              \
            PG8_LDB(B0, 1, 0); PG8_LDB(B1, 1, 1); PG8_SCHED; PG8_LDA(At, 1, 0); PG8_STA(0, 1, a2, LAST); \
            PG8_WAIT_V(8); PG8_WAIT_L(0); PG8_BAR; PG8_MMA(0, 0, At, B0, false); PG8_MMA(0, 1, At, B1, false); PG8_BAR; PG8_SCHED; \
              \
            PG8_LDA(At, 1, 1); PG8_STB(1, 0, b3); PG8_STB(1, 1, b3); PG8_STA(1, 0, a3, LAST); \
            PG8_WAIT_V(8); PG8_WAIT_L(0); PG8_BAR; PG8_MMA(1, 0, At, B0, false); PG8_MMA(1, 1, At, B1, false); PG8_BAR; PG8_SCHED; } while (0)
        PG8_KPAIR(0, false, true);
        _Pragma("nounroll") for (int t = 2; t < nt - 2; t += 2) { PG8_KPAIR(t, false, false); if constexpr (Hook::ON) { if (t == Hook::AT) H(acc, cur, wr, wc, fr, fq); } }
        if constexpr (GATHER) {
            if (has_next) { PG8_ROWS(nvA, ui + 1); }
            else {
#pragma unroll
                for (int h = 0; h < 2; ++h)
#pragma unroll
                    for (int i = 0; i < 2; ++i) nvA[h][i] = vA[h][i]; }
        }
        PG8_KPAIR(nt - 2, true, false);
#undef PG8_KPAIR
        if constexpr (ALIGN_EPI) { if (wr == 0) PG8_BAR; }
        E(acc, cur, wr, wc, fr, fq);
        if (!has_next) break;
        cur = nxt; cA = nA; cB = nB; ++ui;
        if constexpr (GATHER) {
#pragma unroll
            for (int h = 0; h < 2; ++h)
#pragma unroll
                for (int i = 0; i < 2; ++i) vA[h][i] = nvA[h][i];
        }
        if constexpr (ALIGN_EPI) { if (wr == 1) PG8_BAR; }
    }
    PG8_WAIT_V(0);
    if constexpr (!ALIGN_EPI) { if (wr == 0) PG8_BAR; }
    PG8_BAR;
#undef PG8_SA
#undef PG8_SB
#undef PG8_STAGE
#undef PG8_STB
#undef PG8_ROWS
#undef PG8_STA
#undef PG8_LDA
#undef PG8_LDB
#undef PG8_MMA
#undef PG8_WAIT_V
#undef PG8_WAIT_L
#undef PG8_BAR
#undef PG8_SCHED
}
}

constexpr int NWAVES = 8;
constexpr int NT = 32768, DM = 1024, SEQ = 2048, NBATCH = 16, INW = 3080, NE = 32, PLE = 256;
constexpr float EPS = 1e-6f;
constexpr float LOG2E = 1.4426950408889634f;
constexpr float C2 = 0.125f * 1.4426950408889634f;
constexpr int N1 = 5120;
constexpr int MAXRT = 576;
constexpr int MAXUNITS = 24;

constexpr size_t MiB = 1u << 20;
constexpr size_t WS_CTL = 0, CTL_ZERO_BYTES = 1 * MiB;
constexpr size_t WS_TOK = 2 * MiB;
constexpr size_t WS_RSOF = 6 * MiB;
constexpr size_t WS_TOPE = 10 * MiB;
constexpr size_t WS_TOPW = 10 * MiB + 512 * 1024;
constexpr size_t WS_POS = 11 * MiB;
constexpr size_t WS_LOGF = 12 * MiB;
constexpr size_t WS_CUM = 13 * MiB;
constexpr size_t WS_ROT = 14 * MiB;
constexpr size_t WS_RSTD2 = 14 * MiB + 512 * 1024;
constexpr size_t WS_WRT = 15 * MiB;
constexpr size_t WS_W1T = 16 * MiB;
constexpr size_t WS_WBT = 26 * MiB;
constexpr size_t WS_WOT = 28 * MiB;
constexpr size_t WS_WPGT = 30 * MiB;
constexpr size_t WS_WPPT = 32 * MiB;
constexpr size_t WS_WGUT = 34 * MiB;
constexpr size_t WS_WDT = 162 * MiB;
constexpr size_t WS_HB = 226 * MiB;
constexpr size_t WS_PB = 291 * MiB;
constexpr size_t WS_Z = 307 * MiB;
constexpr size_t WS_XN = WS_Z, WS_FQ = WS_Z + 64 * MiB, WS_FK = WS_Z + 96 * MiB, WS_FV = WS_Z + 128 * MiB, WS_RQ = WS_Z + 160 * MiB, WS_RK = WS_Z + 176 * MiB;
constexpr size_t WS_RV = WS_Z + 192 * MiB, WS_RGS = WS_Z + 224 * MiB, WS_GATES = WS_Z + 256 * MiB, WS_BR = WS_Z + 384 * MiB, WS_MERGED = WS_Z + 448 * MiB;
constexpr size_t WS_RKT = WS_Z + 512 * MiB;
constexpr size_t WS_XN8 = WS_Z + 528 * MiB;
constexpr size_t WS_WG8T = WS_W1T + 4 * MiB;
constexpr size_t WS_H2B = WS_Z + 448 * MiB;
constexpr size_t WS_MO = WS_Z + 512 * MiB;
constexpr size_t WS_ACT = WS_Z, WS_Y = WS_Z + 144 * MiB;
constexpr size_t WS_HB2 = WS_Z, WS_PJ = WS_Z + 384 * MiB, WS_G8 = WS_Z + 160 * MiB;
constexpr size_t WS_END = WS_Z + 576 * MiB;
constexpr int CW_BAR = 4096;
constexpr int CW_CNT = 8192;
constexpr int CW_QUEUE = 8256;
constexpr int CW_SSQ = 16384;
static_assert((CW_SSQ + NT) * 4 <= (int)CTL_ZERO_BYTES, "CTL words inside the memset region");

constexpr int RING_OFF = 0, RING_BYTES = 131072;
constexpr int TAB_OFF = RING_BYTES;
constexpr int SCH_OFF = TAB_OFF + MAXUNITS * 1024;
constexpr int SCH_CNT = SCH_OFF, SCH_P = SCH_OFF + 128, SCH_RT2E = SCH_OFF + 128 + 160;
constexpr int MISC_OFF = SCH_RT2E + MAXRT * 4;
constexpr int LDS_BYTES = 163840;
static_assert(MISC_OFF + 256 <= LDS_BYTES && (MISC_OFF % 16) == 0, "LDS map");

#define GAS __attribute__((address_space(1)))
#define LAS __attribute__((address_space(3)))
typedef unsigned short bf16;
typedef unsigned v4u __attribute__((ext_vector_type(4)));
typedef unsigned v2u __attribute__((ext_vector_type(2)));
typedef float f32x4 __attribute__((ext_vector_type(4)));
typedef short bf16x8 __attribute__((ext_vector_type(8)));
typedef GAS unsigned gu32;
#define RLX_AGENT __ATOMIC_RELAXED, __HIP_MEMORY_SCOPE_AGENT
#define LDS_WAIT() asm volatile("s_waitcnt lgkmcnt(0)" ::: "memory")
#define VM_WAIT() asm volatile("s_waitcnt vmcnt(0)" ::: "memory")
__device__ __forceinline__ unsigned f2bf(float f) { unsigned u = __builtin_bit_cast(unsigned, f); return (u + 0x7fffu + ((u >> 16) & 1u)) >> 16; }
__device__ __forceinline__ unsigned pk2(float lo, float hi) { return f2bf(lo) | (f2bf(hi) << 16); }
using pg8::bflo; using pg8::bfhi; using pg8::fsigmoid; using pg8::cvt_pk_bf16;
constexpr float WSCALE = 32.f;
constexpr float YSCALE = 8.f;
__device__ __forceinline__ float clamp_f8(float v) { return fminf(fmaxf(v, -448.f), 448.f); }
__device__ __forceinline__ v2u pack8_fp8(const f32x4 a, const f32x4 b) {
    int w0 = 0, w1 = 0;
    w0 = __builtin_amdgcn_cvt_pk_fp8_f32(clamp_f8(a[0]), clamp_f8(a[1]), w0, false); w0 = __builtin_amdgcn_cvt_pk_fp8_f32(clamp_f8(a[2]), clamp_f8(a[3]), w0, true);
    w1 = __builtin_amdgcn_cvt_pk_fp8_f32(clamp_f8(b[0]), clamp_f8(b[1]), w1, false); w1 = __builtin_amdgcn_cvt_pk_fp8_f32(clamp_f8(b[2]), clamp_f8(b[3]), w1, true);
    return (v2u){(unsigned)w0, (unsigned)w1}; }
#define DPP_F(v, ctrl) __int_as_float(__builtin_amdgcn_update_dpp(0, __float_as_int(v), (ctrl), 0xF, 0xF, false))
__device__ __forceinline__ float wave_sum(float v) {
    v += DPP_F(v, 0xB1); v += DPP_F(v, 0x4E); v += DPP_F(v, 0x141); v += DPP_F(v, 0x140);
    const int b = __float_as_int(v);
    return (__int_as_float(__builtin_amdgcn_readlane(b, 0)) + __int_as_float(__builtin_amdgcn_readlane(b, 16))) + (__int_as_float(__builtin_amdgcn_readlane(b, 32)) + __int_as_float(__builtin_amdgcn_readlane(b, 48)));
}
__device__ __forceinline__ float xor32_sum(float v) { auto rr = __builtin_amdgcn_permlane32_swap(__float_as_uint(v), __float_as_uint(v), false, false); return __uint_as_float(rr[0]) + __uint_as_float(rr[1]); }
__device__ __forceinline__ float xor16_sum(float v) { auto rr = __builtin_amdgcn_permlane16_swap(__float_as_uint(v), __float_as_uint(v), false, false); return __uint_as_float(rr[0]) + __uint_as_float(rr[1]); }

#define XB_TMO      128
#define XB_XCNT(j)  (256  + 64 * (j))
#define XB_XSUB(j)  (1280 + 64 * (j))
#define XB_XGEN(j)  (2304 + 64 * (j))
#define XB_TOP      3328
#define XB_TOPGEN   3392
#define XCD_BAR_WORDS 3456
#define XB_SPIN_CAP (1u << 20)

__device__ __forceinline__ unsigned xb_ld(unsigned* p)              { return __hip_atomic_load(p, __ATOMIC_RELAXED, __HIP_MEMORY_SCOPE_AGENT); }
__device__ __forceinline__ unsigned xb_add(unsigned* p, unsigned v) { return __hip_atomic_fetch_add(p, v, __ATOMIC_RELAXED, __HIP_MEMORY_SCOPE_AGENT); }
__device__ __forceinline__ unsigned xb_xcc_id() { return (unsigned)__builtin_amdgcn_s_getreg((3 << 11) | 20) & 0xFu; }
#define XB_SPIN(cond, bar) do { unsigned _sp = 0; while (cond) { __builtin_amdgcn_s_sleep(1); \
    if ((++_sp & 255u) == 0u) { if (xb_ld(&(bar)[XB_TMO])) break; if (_sp > XB_SPIN_CAP) { atomicAdd(&(bar)[XB_TMO], 1u); break; } } } } while (0)

struct XcdBarrier {
    unsigned* bar; unsigned x;
    volatile LAS unsigned* st;
};
__device__ __forceinline__ XcdBarrier xcd_barrier_post(unsigned* bar, volatile LAS unsigned* st, int tid) {
    XcdBarrier b; b.bar = bar; b.x = xb_xcc_id(); b.st = st;
    if (tid == 0) (void)xb_add(&bar[XB_XCNT(b.x)], 1u);
    return b;
}
__device__ __forceinline__ void xcd_barrier_complete(unsigned* bar, unsigned x, unsigned& nloc, unsigned& nx) {
    const unsigned G = gridDim.x * gridDim.y * gridDim.z;
    unsigned sum, cnt, mine, sp = 0u;
    for (;;) {
        sum = 0u; cnt = 0u; mine = 0u;
#pragma unroll
        for (unsigned j = 0; j < 16; ++j) { const unsigned c = xb_ld(&bar[XB_XCNT(j)]); sum += c; cnt += (c > 0u) ? 1u : 0u; mine = (j == x) ? c : mine; }
        if (sum == G) break;
        __builtin_amdgcn_s_sleep(1);
        if ((++sp & 255u) == 0u) { if (xb_ld(&bar[XB_TMO])) break; if (sp > XB_SPIN_CAP) { atomicAdd(&bar[XB_TMO], 1u); break; } }
    }
    nloc = mine > 0u ? mine : 1u; nx = cnt > 0u ? cnt : 1u;
}
__device__ __forceinline__ void xcd_barrier(const XcdBarrier& b, int tid) {
    asm volatile("s_waitcnt vmcnt(0)" ::: "memory");
    __syncthreads();
    if (tid == 0) {
        unsigned* bar = b.bar;
        __builtin_amdgcn_s_waitcnt(0);
        unsigned nloc = b.st[0], nx = b.st[1];
        if (nloc == 0u) { xcd_barrier_complete(bar, b.x, nloc, nx); b.st[0] = nloc; b.st[1] = nx; }
        const unsigned old = xb_add(&bar[XB_XSUB(b.x)], 1u);
        const unsigned gen = old / nloc;
        if (old + 1u == (gen + 1u) * nloc) {
            __builtin_amdgcn_fence(__ATOMIC_RELEASE, "agent");
            asm volatile("s_waitcnt vmcnt(0)" ::: "memory");
            const unsigned og = xb_add(&bar[XB_TOP], 1u);
            const unsigned tg = og / nx;
            if (og + 1u == (tg + 1u) * nx) xb_add(&bar[XB_TOPGEN], 1u);
            else XB_SPIN(xb_ld(&bar[XB_TOPGEN]) == tg, bar);
            __builtin_amdgcn_fence(__ATOMIC_ACQUIRE, "agent");
            xb_add(&bar[XB_XGEN(b.x)], 1u);
            asm volatile("s_waitcnt vmcnt(0)" ::: "memory");
        } else {
            XB_SPIN(xb_ld(&bar[XB_XGEN(b.x)]) == gen, bar);
            __builtin_amdgcn_fence(__ATOMIC_ACQUIRE, "agent");
            asm volatile("s_waitcnt vmcnt(0)" ::: "memory");
        }
    }
    __syncthreads();
}

struct Args { const float* in[20]; float* out; unsigned char* ws; int ph_lo, ph_hi, rep_phase, rep_mode; };
struct Frame {
    LAS unsigned char* lds;
    volatile LAS unsigned* MISC;
    int tid, lane, wave;
    int vcu, G;
    const __attribute__((address_space(4))) Args* ap;
};
#define REARGS() do { F.ap = (const __attribute__((address_space(4))) Args*)__builtin_amdgcn_kernarg_segment_ptr(); asm volatile("" : "+s"(F.ap)); } while (0)
#define WSP(T, off) ((T*)(F.ap->ws + (off)))

#include <hip/hip_bf16.h>
namespace attn_body {
using bf16=__hip_bfloat16;
using bf16x8=__attribute__((ext_vector_type(8)))short;
using s16x4=__attribute__((ext_vector_type(4)))short;
using f32x16=__attribute__((ext_vector_type(16)))float;
using u32x4=__attribute__((ext_vector_type(4)))unsigned;
constexpr int BATCH=16,NHEAD=8,SEQ=2048,D=64,DM=NHEAD*D,OPITCH=1024;
constexpr int NW=8,QBLK=32,QB=QBLK*NW,KVBLK=64,NQB=SEQ/QB;
constexpr int ATTN_PITCH=DM, ATTN_UNIT_ROWS=QB;
__device__ __forceinline__ int crow(int r,int hi){return (r&3)+8*(r>>2)+4*hi;}
#define SBAR() __builtin_amdgcn_sched_barrier(0)
__device__ __forceinline__ void cmask(f32x16&p0,f32x16&p1,int jb,int qrel,int hi){
  const float NEG=-INFINITY; int kb=64*jb+4*hi;
  #pragma unroll
  for(int r=0;r<16;++r){int kv=kb+(r&3)+8*(r>>2); if(kv>qrel)p0[r]=NEG; if(kv+32>qrel)p1[r]=NEG;}
}

constexpr int NSLOT=3, SLOTB=8192;
constexpr int LDS_K=0, LDS_V=NSLOT*SLOTB, LDS_WS=2*NSLOT*SLOTB, LDS_OST=LDS_WS+NW*64*4, LDS_KB=LDS_OST+NW*4096, LDS_BYTES=LDS_KB+SEQ*16;
constexpr float C2=0.125f*1.4426950408889634f;
__device__ __forceinline__ void glds16(const void*gsrc,unsigned lds_dst){unsigned keep;
  asm volatile("s_mov_b32 %0, m0\n\ts_mov_b32 m0, %2\n\ts_nop 0\n\tglobal_load_lds_dwordx4 %1, off\n\ts_mov_b32 m0, %0":"=&s"(keep):"v"(gsrc),"s"(lds_dst):"memory");}
__device__ __forceinline__ float max3f(float a,float b,float c){float r;asm("v_max3_f32 %0, %1, %2, %3":"=v"(r):"v"(a),"v"(b),"v"(c));return r;}
__device__ __forceinline__ float max2f(float a,float b){float r;asm("v_max_f32_e32 %0, %1, %2":"=v"(r):"v"(a),"v"(b));return r;}
__device__ __forceinline__ float fadd_s(float a,float b){float r;asm("v_add_f32_e32 %0, %1, %2":"=v"(r):"v"(a),"v"(b));return r;}
__device__ __forceinline__ float fsub_s(float a,float b){float r;asm("v_sub_f32_e32 %0, %1, %2":"=v"(r):"v"(a),"v"(b));return r;}
typedef float f32x2_t __attribute__((ext_vector_type(2))); typedef __bf16 bf16x2_t __attribute__((ext_vector_type(2)));
__device__ __forceinline__ unsigned cvtpk_s(float lo,float hi){f32x2_t v={lo,hi};bf16x2_t b=__builtin_convertvector(v,bf16x2_t);return __builtin_bit_cast(unsigned,b);}
#define WAIT_BAR(N) asm volatile("s_waitcnt vmcnt(" #N ") lgkmcnt(0)\n\ts_barrier":::"memory")

__device__ __forceinline__ void qkt(f32x16&p0,f32x16&p1,const char*Kslot,const bf16x8*qr,const bf16x8 qx,const bf16x8 kb0,const bf16x8 kb1,int r32,int hi){
  const f32x16 zc=f32x16{};
  const char*kb=Kslot+hi*1024+r32*16;
  #pragma unroll
  for(int d0=0;d0<4;++d0){
    const bf16x8 b0=*reinterpret_cast<const bf16x8*>(kb+d0*2048);
    const bf16x8 b1=*reinterpret_cast<const bf16x8*>(kb+d0*2048+512);
    if(d0==0){p0=__builtin_amdgcn_mfma_f32_32x32x16_bf16(b0,qr[0],zc,0,0,0);p1=__builtin_amdgcn_mfma_f32_32x32x16_bf16(b1,qr[0],zc,0,0,0);}
    else{p0=__builtin_amdgcn_mfma_f32_32x32x16_bf16(b0,qr[d0],p0,0,0,0);p1=__builtin_amdgcn_mfma_f32_32x32x16_bf16(b1,qr[d0],p1,0,0,0);}}
  p0=__builtin_amdgcn_mfma_f32_32x32x16_bf16(kb0,qx,p0,0,0,0);p1=__builtin_amdgcn_mfma_f32_32x32x16_bf16(kb1,qx,p1,0,0,0);
}
typedef __attribute__((address_space(3))) const char* lds_cptr;
typedef short v4i16_t __attribute__((ext_vector_type(4)));
__device__ __forceinline__ void kload8(bf16x8*kf,lds_cptr kp){
  kf[0]=*(const __attribute__((address_space(3))) bf16x8*)(kp);      kf[1]=*(const __attribute__((address_space(3))) bf16x8*)(kp+512);
  kf[2]=*(const __attribute__((address_space(3))) bf16x8*)(kp+2048); kf[3]=*(const __attribute__((address_space(3))) bf16x8*)(kp+2560);
  kf[4]=*(const __attribute__((address_space(3))) bf16x8*)(kp+4096); kf[5]=*(const __attribute__((address_space(3))) bf16x8*)(kp+4608);
  kf[6]=*(const __attribute__((address_space(3))) bf16x8*)(kp+6144); kf[7]=*(const __attribute__((address_space(3))) bf16x8*)(kp+6656);
}
__device__ __forceinline__ void kload2(bf16x8*kf,lds_cptr kp,int j){ kf[2*j]=*(const __attribute__((address_space(3))) bf16x8*)(kp+j*2048); kf[2*j+1]=*(const __attribute__((address_space(3))) bf16x8*)(kp+j*2048+512); }
__device__ __forceinline__ s16x4 vtr(lds_cptr p){ return __builtin_bit_cast(s16x4,__builtin_amdgcn_ds_read_tr16_b64_v4i16((__attribute__((address_space(3))) v4i16_t*)p)); }
__device__ __forceinline__ float rowmax(const f32x16&p0,const f32x16&p1){
  float a=max3f(p0[0],p0[1],p1[0]),b=max3f(p0[2],p0[3],p1[1]);a=max3f(a,p1[2],p1[3]);
  #pragma unroll
  for(int r=4;r<16;r+=4){a=max3f(a,p0[r],p0[r+1]);b=max3f(b,p0[r+2],p0[r+3]);a=max3f(a,p1[r],p1[r+1]);b=max3f(b,p1[r+2],p1[r+3]);}
  const float m=max2f(a,b);
  auto rr=__builtin_amdgcn_permlane32_swap(__float_as_uint(m),__float_as_uint(m),false,false);
  return max2f(__uint_as_float(rr[0]),__uint_as_float(rr[1]));
}
__device__ __forceinline__ void pv(f32x16*o,int vb,bf16x8 pa0,bf16x8 pa1,bf16x8 pa2,bf16x8 pa3){
  #pragma unroll
  for(int d0=0;d0<2;++d0){s16x4 lo[4],hi[4];
    #pragma unroll
    for(int ks=0;ks<4;++ks){
      asm volatile("ds_read_b64_tr_b16 %0,%1 offset:%c2":"=&v"(lo[ks]):"v"(vb),"i"(d0*4096+ks*1024):"memory");
      asm volatile("ds_read_b64_tr_b16 %0,%1 offset:%c2":"=&v"(hi[ks]):"v"(vb),"i"(d0*4096+ks*1024+512):"memory");}
    asm volatile("s_waitcnt lgkmcnt(0)":::"memory");SBAR();
    #define PK(k) (bf16x8){lo[k][0],lo[k][1],lo[k][2],lo[k][3],hi[k][0],hi[k][1],hi[k][2],hi[k][3]}
    o[d0]=__builtin_amdgcn_mfma_f32_32x32x16_bf16(pa0,PK(0),o[d0],0,0,0);
    o[d0]=__builtin_amdgcn_mfma_f32_32x32x16_bf16(pa1,PK(1),o[d0],0,0,0);
    o[d0]=__builtin_amdgcn_mfma_f32_32x32x16_bf16(pa2,PK(2),o[d0],0,0,0);
    o[d0]=__builtin_amdgcn_mfma_f32_32x32x16_bf16(pa3,PK(3),o[d0],0,0,0);
    #undef PK
  }
}

__device__ __forceinline__ void split3(float v,unsigned&a,unsigned&b,unsigned&c){ a=cvtpk_s(v,0.f)&0xffffu; const float r1=v-__uint_as_float(a<<16); b=cvtpk_s(r1,0.f)&0xffffu; const float r2=r1-__uint_as_float(b<<16); c=cvtpk_s(r2,0.f)&0xffffu; }
__device__ __forceinline__ bf16x8 make_qx(float m,int hi){ unsigned a,b,c; split3(m,a,b,c); u32x4 w={0x3F803F80u,0x3F80u|(a<<16),b|(c<<16),0u}; if(hi)w=(u32x4){0u,0u,0u,0u}; return __builtin_bit_cast(bf16x8,w); }
#ifndef ATTN_STORE16
#define ATTN_STORE16(p,v) (*(u32x4*)(p)=(v))
#endif
template<int THRL> __device__ __forceinline__ void attn_unit(int b,int h,int qb,const bf16*Q,const bf16*__restrict__ K,const bf16*__restrict__ V,bf16*O,const float*__restrict__ cum,char*shm,int wave){
  int tid=wave*64+lane_now(); asm volatile("":"+v"(tid));
  const int lane=tid&63,r32=lane&31,hi=lane>>5; const int wid=__builtin_amdgcn_readfirstlane(tid>>6);
  const long rowbase=(long)b*SEQ; const int q0=qb*QB;
  const bf16*Qw=Q+(rowbase+q0+wid*QBLK)*DM+h*D;
  const bf16*Kh=K+rowbase*DM+h*D,*Vh=V+rowbase*DM+h*D;
  const unsigned lds0=(unsigned)(uintptr_t)shm;
  float*wsf=(float*)(shm+LDS_WS)+wid*64;
  const bf16*ksrc=Kh+(long)lane*DM+wid*8;
  const bf16*vsrc=Vh+(long)(16*(wid&3)+(lane>>2))*DM+(wid>>2)*32+(lane&3)*8;
  const unsigned kdst=lds0+LDS_K+wid*1024, vdst=lds0+LDS_V+wid*1024;
  #define DMA_K(t,slot) glds16(ksrc+(long)(t)*KVBLK*DM,(unsigned)__builtin_amdgcn_readfirstlane(kdst+(slot)))
  #define DMA_V(t,slot) glds16(vsrc+(long)(t)*KVBLK*DM,(unsigned)__builtin_amdgcn_readfirstlane(vdst+(slot)))
  const int vb0=(int)(lds0+LDS_V)+((lane>>4)&1)*32+(lane&3)*8+(4*hi+((lane&15)>>2))*64;
  const char*Kbase=shm+LDS_K; bf16x8 kf[8];
  const lds_cptr shm3=(lds_cptr)shm; const lds_cptr kp0=shm3+LDS_K+hi*1024+r32*16; const lds_cptr vp0=shm3+LDS_V+((lane>>4)&1)*32+(lane&3)*8+(4*hi+((lane&15)>>2))*64;
  const int NT=(q0+QB)/KVBLK;
  const lds_cptr kbp=shm3+LDS_KB+r32*16;
  DMA_K(0,0);DMA_V(0,0);DMA_K(1,SLOTB);
  { const float cref=cum[q0+QB-1]; float cv[SEQ/(NW*64)];
    #pragma unroll
    for(int i=0;i<SEQ/(NW*64);++i){ const int kv=tid+i*NW*64; cv[i]=(kv<q0+QB)?cum[kv]:0.f; }
    #pragma unroll
    for(int i=0;i<SEQ/(NW*64);++i){ const int kv=tid+i*NW*64; if(kv<q0+QB){ unsigned a,bb,c; split3((cref-cv[i])*1.4426950408889634f,a,bb,c);
      *(__attribute__((address_space(3))) u32x4*)((__attribute__((address_space(3))) char*)shm3+LDS_KB+kv*16)=(u32x4){a|(bb<<16),c|0xBF800000u,0xBF80BF80u,0u}; } } }
  bf16x8 qr[4];
  #pragma unroll
  for(int d0=0;d0<4;++d0)qr[d0]=*reinterpret_cast<const bf16x8*>(&Qw[(long)r32*DM+d0*16+hi*8]);
  float mhat=0.f,l_reg=0.f;f32x16 o[2];o[0]=f32x16{};o[1]=f32x16{};bf16x8 qx=make_qx(0.f,hi);const f32x16 zc=f32x16{};
  const int qrel=wid*QBLK+r32;
  #define CMASK(P0,P1,t) do{int jb_=(t)-(NT-4); if(jb_>=0)cmask(P0,P1,jb_,qrel,hi);}while(0)
  bool resc=false;
  #define START(P0,P1) do{ const float rm=rowmax(P0,P1); resc=false; \
    { const float dl=rm; mhat=fadd_s(mhat,dl); \
      _Pragma("unroll") for(int r=0;r<16;++r){P0[r]=fsub_s(P0[r],dl);P1[r]=fsub_s(P1[r],dl);} \
      qx=make_qx(mhat,hi); } \
    _Pragma("unroll") for(int r=0;r<16;++r)P0[r]=__builtin_amdgcn_exp2f(P0[r]); }while(0)
  #define RESC() do{ if(resc){ asm volatile("s_waitcnt lgkmcnt(0)":::"memory"); \
      _Pragma("unroll") for(int d_=0;d_<2;++d_) _Pragma("unroll") for(int r=0;r<16;++r)o[d_][r]*=wsf[crow(r,hi)]; } }while(0)
  f32x16 pA0,pA1,pB0,pB1;
  int sl_prev=0,sl_cur=0,sl_next=SLOTB;
  #define ROT() do{sl_prev=sl_cur;sl_cur=sl_next;sl_next=(sl_next==(NSLOT-1)*SLOTB)?0:sl_next+SLOTB;}while(0)
  DMA_K(2,2*SLOTB);
  WAIT_BAR(3);
  qkt(pA0,pA1,Kbase,qr,qx,*(const __attribute__((address_space(3))) bf16x8*)(kbp),*(const __attribute__((address_space(3))) bf16x8*)(kbp+512),r32,hi);asm volatile("s_nop 15\n\ts_nop 7":"+v"(pA0),"+v"(pA1));CMASK(pA0,pA1,0);
  START(pA0,pA1);
  _Pragma("unroll") for(int r=0;r<16;++r)pA1[r]=__builtin_amdgcn_exp2f(pA1[r]);
  WAIT_BAR(0);
  DMA_K(3,0);DMA_V(1,SLOTB);
  ROT();
  kload8(kf,kp0+sl_cur);
  WAIT_BAR(2);
  s16x4 vlo[8],vhi[8]; u32x4 pw0,pw1,pw2,pw3;
  #define PKW(P,B) cvtpk_s(P[B],P[B+1])
  #define PAF(k) __builtin_bit_cast(bf16x8,pw##k)
  #define VFR(i) (bf16x8){vlo[i][0],vlo[i][1],vlo[i][2],vlo[i][3],vhi[i][0],vhi[i][1],vhi[i][2],vhi[i][3]}
  #define PIN(x) asm volatile("":"+v"(x))
  #define MX3(a,b,c) __builtin_fmaxf(__builtin_fmaxf((a),(b)),(c))
  #define GAPA(MF,A0,A1,A2,A3,W0,W1,PW) do{ MF; sacc+=A0; sacc+=A1; sacc+=A2; sacc+=A3; PIN(sacc); W0; W1; PIN(PW); SBAR(); }while(0)
  #define EX(v) __builtin_amdgcn_exp2f(v)
  #define GAPB(MF,X,B) do{ MF; X[B]=EX(X[B]); X[B+1]=EX(X[B+1]); X[B+2]=EX(X[B+2]); X[B+3]=EX(X[B+3]); PIN(X); SBAR(); }while(0)
  #define VRD(i) do{ vlo[i]=vtr(vp_+(((i)>>2)*4096+((i)&3)*1024)); vhi[i]=vtr(vp_+(((i)>>2)*4096+((i)&3)*1024+512)); }while(0)
  #define KRD(G,j) do{ if(G){ kload2(kf,kp0+sl_next,j); SBAR(); } }while(0)
  #define STEP(C0,C1,P0,P1,t,GK,GV,GL) do{ SBAR(); \
    const lds_cptr vp_=vp0+sl_prev; \
    const bf16x8 kb0_=*(const __attribute__((address_space(3))) bf16x8*)(kbp+(t)*1024), kb1_=*(const __attribute__((address_space(3))) bf16x8*)(kbp+(t)*1024+512); \
    VRD(0); SBAR(); float sacc=(P0[0]+P0[1]); \
    GAPA(C0=__builtin_amdgcn_mfma_f32_32x32x16_bf16(kf[0],qr[0],zc,0,0,0), P0[2],P0[3],P0[4],P0[5],     pw0[0]=PKW(P0,0), pw0[1]=PKW(P0,2), pw0); \
    VRD(4); SBAR(); GAPA(C1=__builtin_amdgcn_mfma_f32_32x32x16_bf16(kf[1],qr[0],zc,0,0,0), P0[6],P0[7],P0[8],P0[9],     pw0[2]=PKW(P0,4), pw0[3]=PKW(P0,6), pw0); \
    VRD(1); SBAR(); GAPA(C0=__builtin_amdgcn_mfma_f32_32x32x16_bf16(kf[2],qr[1],C0,0,0,0),   P0[10],P0[11],P0[12],P0[13], pw1[0]=PKW(P0,8), pw1[1]=PKW(P0,10), pw1); \
    VRD(5); SBAR(); GAPA(C1=__builtin_amdgcn_mfma_f32_32x32x16_bf16(kf[3],qr[1],C1,0,0,0),   P0[14],P0[15],P1[0],P1[1],   pw1[2]=PKW(P0,12),pw1[3]=PKW(P0,14), pw1); \
    VRD(2); SBAR(); GAPA(C0=__builtin_amdgcn_mfma_f32_32x32x16_bf16(kf[4],qr[2],C0,0,0,0),   P1[2],P1[3],P1[4],P1[5],     pw2[0]=PKW(P1,0), pw2[1]=PKW(P1,2), pw2); \
    VRD(6); SBAR(); GAPA(C1=__builtin_amdgcn_mfma_f32_32x32x16_bf16(kf[5],qr[2],C1,0,0,0),   P1[6],P1[7],P1[8],P1[9],     pw2[2]=PKW(P1,4), pw2[3]=PKW(P1,6), pw2); \
    VRD(3); SBAR(); GAPA(C0=__builtin_amdgcn_mfma_f32_32x32x16_bf16(kf[6],qr[3],C0,0,0,0),   P1[10],P1[11],P1[12],P1[13], pw3[0]=PKW(P1,8), pw3[1]=PKW(P1,10), pw3); \
    VRD(7); SBAR(); GAPA(C1=__builtin_amdgcn_mfma_f32_32x32x16_bf16(kf[7],qr[3],C1,0,0,0),   P1[14],P1[15],0.f,0.f,       pw3[2]=PKW(P1,12),pw3[3]=PKW(P1,14), pw3); \
    C0=__builtin_amdgcn_mfma_f32_32x32x16_bf16(kb0_,qx,C0,0,0,0); C1=__builtin_amdgcn_mfma_f32_32x32x16_bf16(kb1_,qx,C1,0,0,0); SBAR(); \
    l_reg+=sacc; \
    if(GK){DMA_K((t)+3,sl_cur);} if(GV){DMA_V((t)+1,sl_next);} \
    CMASK(C0,C1,t); \
    { float a=MX3(C0[0],C0[1],C1[0]),b=MX3(C0[2],C0[3],C1[1]); a=MX3(a,C1[2],C1[3]); \
      _Pragma("unroll") for(int r=4;r<16;r+=4){a=MX3(a,C0[r],C0[r+1]);b=MX3(b,C0[r+2],C0[r+3]);a=MX3(a,C1[r],C1[r+1]);b=MX3(b,C1[r+2],C1[r+3]);} \
      float rm=__builtin_fmaxf(a,b); { auto rr=__builtin_amdgcn_permlane32_swap(__float_as_uint(rm),__float_as_uint(rm),false,false); rm=__builtin_fmaxf(__uint_as_float(rr[0]),__uint_as_float(rr[1])); } \
      resc=false; \
      if(__builtin_expect(__any(rm>(float)THRL),0)){ const float dl=__builtin_fmaxf(rm,0.f); mhat+=dl; \
        _Pragma("unroll") for(int r=0;r<16;++r){C0[r]-=dl;C1[r]-=dl;} \
        qx=make_qx(mhat,hi); \
        const float f=__builtin_amdgcn_exp2f(-dl); l_reg*=f; if(hi==0)wsf[r32]=f; resc=true; } } \
    SBAR(); \
    GAPB(o[0]=__builtin_amdgcn_mfma_f32_32x32x16_bf16(PAF(0),VFR(0),o[0],0,0,0), C0,0); \
    GAPB(o[1]=__builtin_amdgcn_mfma_f32_32x32x16_bf16(PAF(0),VFR(4),o[1],0,0,0), C0,4); \
    KRD(GL,0); GAPB(o[0]=__builtin_amdgcn_mfma_f32_32x32x16_bf16(PAF(1),VFR(1),o[0],0,0,0), C0,8); \
    KRD(GL,1); GAPB(o[1]=__builtin_amdgcn_mfma_f32_32x32x16_bf16(PAF(1),VFR(5),o[1],0,0,0), C0,12); \
    KRD(GL,2); GAPB(o[0]=__builtin_amdgcn_mfma_f32_32x32x16_bf16(PAF(2),VFR(2),o[0],0,0,0), C1,0); \
    KRD(GL,3); GAPB(o[1]=__builtin_amdgcn_mfma_f32_32x32x16_bf16(PAF(2),VFR(6),o[1],0,0,0), C1,4); \
    GAPB(o[0]=__builtin_amdgcn_mfma_f32_32x32x16_bf16(PAF(3),VFR(3),o[0],0,0,0), C1,8); \
    GAPB(o[1]=__builtin_amdgcn_mfma_f32_32x32x16_bf16(PAF(3),VFR(7),o[1],0,0,0), C1,12); \
    }while(0)
  int t=1;
  #undef CMASK
  #define CMASK(P0,P1,t) do{}while(0)
  for(;t+5<NT;t+=2){
    STEP(pB0,pB1,pA0,pA1,t,true,true,true);     WAIT_BAR(2); RESC(); ROT();
    STEP(pA0,pA1,pB0,pB1,t+1,true,true,true);   WAIT_BAR(2); RESC(); ROT();
  }
  #undef CMASK
  #define CMASK(P0,P1,t) do{int jb_=(t)-(NT-4); if(jb_>=0)cmask(P0,P1,jb_,qrel,hi);}while(0)
  #define ENDW(tt) do{ if((tt)+3<NT){WAIT_BAR(2);} else if((tt)+2<NT){WAIT_BAR(1);} else {WAIT_BAR(0);} }while(0)
  for(;t+1<NT;t+=2){
    STEP(pB0,pB1,pA0,pA1,t,(t+3<NT),(t+1<NT),(t+1<NT));       ENDW(t);   RESC(); ROT();
    STEP(pA0,pA1,pB0,pB1,t+1,(t+4<NT),(t+2<NT),(t+2<NT));     ENDW(t+1); RESC(); ROT();
  }
  STEP(pB0,pB1,pA0,pA1,NT-1,false,false,false); RESC();
  { float sacc=pB0[0]+pB0[1]; _Pragma("unroll") for(int r=2;r<16;++r)sacc+=pB0[r]; _Pragma("unroll") for(int r=0;r<16;++r)sacc+=pB1[r]; l_reg+=sacc;
    pw0=(u32x4){PKW(pB0,0),PKW(pB0,2),PKW(pB0,4),PKW(pB0,6)};pw1=(u32x4){PKW(pB0,8),PKW(pB0,10),PKW(pB0,12),PKW(pB0,14)};pw2=(u32x4){PKW(pB1,0),PKW(pB1,2),PKW(pB1,4),PKW(pB1,6)};pw3=(u32x4){PKW(pB1,8),PKW(pB1,10),PKW(pB1,12),PKW(pB1,14)};
    SBAR(); pv(o,vb0+sl_cur,PAF(0),PAF(1),PAF(2),PAF(3)); }
  #undef PKW
  #undef PAF
  #undef VFR
  #undef PIN
  #undef MX3
  #undef GAPA
  #undef GAPB
  #undef EX
  #undef VRD
  #undef KRD
  #undef STEP
  #undef ENDW
  {auto rr=__builtin_amdgcn_permlane32_swap(__float_as_uint(l_reg),__float_as_uint(l_reg),false,false);l_reg=__uint_as_float(rr[0])+__uint_as_float(rr[1]);}
  if(hi==0)wsf[32+r32]=l_reg;asm volatile("s_waitcnt lgkmcnt(0)":::"memory");
  float rli[16];
  #pragma unroll
  for(int r=0;r<16;++r)rli[r]=__builtin_amdgcn_rcpf(wsf[32+crow(r,hi)]);
  bf16*Ow=O+(rowbase+q0+wid*QBLK)*OPITCH+h*D;
  { bf16*stg=(bf16*)(shm+LDS_OST)+wid*2048;
    #pragma unroll
    for(int r=0;r<16;++r){const int orow=crow(r,hi);
      #pragma unroll
      for(int d0=0;d0<2;++d0)stg[orow*64+d0*32+r32]=__float2bfloat16(o[d0][r]*rli[r]);}
    asm volatile("s_waitcnt lgkmcnt(0)":::"memory");
    #pragma unroll
    for(int i=0;i<4;++i){const int row=i*8+(lane>>3),ch=lane&7; const u32x4 v=*(const u32x4*)(stg+row*64+ch*8); ATTN_STORE16(Ow+(long)row*OPITCH+ch*8,v);} }
  asm volatile("s_waitcnt lgkmcnt(0)\n\ts_barrier":::"memory");
  #undef DMA_K
  #undef DMA_V
  #undef CMASK
  #undef START
  #undef RESC
  #undef ROT
}
constexpr int ATTN_LDS_BYTES=LDS_BYTES;
#undef SBAR
#undef WAIT_BAR
}

namespace ret_body {
constexpr int VT_P = 272, KT_P = 272, ST_P = 144, PW_P = 272;
constexpr int KC_P = 144;
constexpr int L_VT = 0, L_KT = L_VT + 128 * VT_P, L_ST = L_KT + 64 * KT_P, L_PW = L_ST + 128 * ST_P, PW_BYTES = 16 * PW_P, L_KC = L_PW + 8 * PW_BYTES, LDS_BYTES = L_KC + 128 * KC_P;
typedef short bf16x8 __attribute__((ext_vector_type(8)));
typedef float f32x4 __attribute__((ext_vector_type(4)));
#define dpp_f(v, ctrl) __int_as_float(__builtin_amdgcn_update_dpp(0, __float_as_int(v), (ctrl), 0xF, 0xF, false))
#define RB_MFMA(a, b, c) __builtin_amdgcn_mfma_f32_16x16x32_bf16(__builtin_bit_cast(bf16x8, a), __builtin_bit_cast(bf16x8, b), c, 0, 0, 0)
__device__ __forceinline__ void ret_unit(LAS unsigned char* L, int b, int h, const bf16* RQ, const bf16* RK, const bf16* RVT, const bf16* RKT, const bf16* RGS, bf16* BR, int wave, int c0 = 0, int c1 = SEQ / 128, int pf0 = 0) {
    int tid = wave * 64 + lane_now(); asm volatile("" : "+v"(tid));
    const int lane = tid & 63, w = __builtin_amdgcn_readfirstlane(tid >> 6), r = lane & 15, q = lane >> 4;
    const float lg2 = log1pf(-exp2f(-5.f - (float)h)) * LOG2E;
    const float cd = __builtin_amdgcn_exp2f(128.f * lg2);
    unsigned z0 = 0u; asm volatile("" : "+v"(z0));
    f32x4 S[4];
#pragma unroll
    for (int i = 0; i < 4; ++i) { const float zf = __uint_as_float(z0); S[i] = (f32x4){zf, zf, zf, zf}; }
    for (int i = tid * 16; i < 128 * ST_P; i += NWAVES * 64 * 16) *(LAS v4u*)(L + L_ST + i) = (v4u){z0, z0, z0, z0};
    LAS unsigned char* Pw = L + L_PW + w * PW_BYTES;
    v4u pv[4], pkt[2], pkc[2], pq[2];
    const int t16 = tid & 15, trow = tid >> 4;
#define RB_LOAD(cc) do { const size_t r0_ = (size_t)b * SEQ + (size_t)(cc) * 128; const size_t it_ = (size_t)((b * 4 + h) * 16 + (cc)); \
        _Pragma("unroll") for (int j = 0; j < 4; ++j) pv[j] = *(const v4u*)(RVT + it_ * 16384 + (size_t)(32 * j + trow) * 128 + 8 * t16); \
        _Pragma("unroll") for (int j = 0; j < 2; ++j) pkt[j] = *(const v4u*)(RKT + it_ * 8192 + (size_t)(32 * j + trow) * 128 + 8 * t16); \
        _Pragma("unroll") for (int j = 0; j < 2; ++j) pkc[j] = *(const v4u*)(RK + (r0_ + 64 * j + (tid >> 3)) * 256 + h * 64 + 8 * (tid & 7)); \
        _Pragma("unroll") for (int ks = 0; ks < 2; ++ks) pq[ks] = *(const v4u*)(RQ + (r0_ + 16 * w + r) * 256 + h * 64 + 32 * ks + 8 * q); } while (0)
    RB_LOAD(0);
    for (int c = 0; c < c1; ++c) {
        const int pf = pf0 | ((c < c0) ? 3 : 0);
        const size_t row0 = (size_t)b * SEQ + (size_t)c * 128;
        float lg2c = lg2; asm volatile("" : "+v"(lg2c));
        if (!(pf & 8)) {
#pragma unroll
        for (int j = 0; j < 4; ++j) *(LAS v4u*)(L + L_VT + (32 * j + trow) * VT_P + 16 * t16) = pv[j];
#pragma unroll
        for (int j = 0; j < 2; ++j) *(LAS v4u*)(L + L_KT + (32 * j + trow) * KT_P + 16 * t16) = pkt[j];
        if (!(pf & 2)) {
#pragma unroll
        for (int j = 0; j < 2; ++j) *(LAS v4u*)(L + L_KC + (64 * j + (tid >> 3)) * KC_P + 16 * (tid & 7)) = pkc[j];
        }
        }
        v4u qf[2]; qf[0] = pq[0]; qf[1] = pq[1];
        __syncthreads();
        const float fdec = __builtin_amdgcn_exp2f((float)(16 * w + 4 * q - r) * lg2c);
        const float g1 = __builtin_amdgcn_exp2f(lg2c), g2 = g1 * g1, g3 = g2 * g1; float gm16[8];
        { const float gi = __builtin_amdgcn_exp2f(-16.f * lg2c); gm16[0] = 1.f;
#pragma unroll
          for (int j = 1; j < 8; ++j) gm16[j] = gm16[j - 1] * gi; }
        if (!(pf & 2)) {
#pragma unroll
        for (int jh = 0; jh < 2; ++jh) {
        v4u kk0[4], kk1[4];
#pragma unroll
        for (int jj = 0; jj < 4; ++jj) { const int jb = 4 * jh + jj; if (jb <= w) { kk0[jj] = *(const LAS v4u*)(L + L_KC + (16 * jb + r) * KC_P + 16 * q); kk1[jj] = *(const LAS v4u*)(L + L_KC + (16 * jb + r) * KC_P + 64 + 16 * q); } }
        __builtin_amdgcn_sched_barrier(0);
#pragma unroll
        for (int jj = 0; jj < 4; ++jj) { const int jb = 4 * jh + jj;
            if (jb <= w) {
                const v4u k0 = kk0[jj], k1 = kk1[jj];
                f32x4 acc = (f32x4){0.f, 0.f, 0.f, 0.f};
                acc = RB_MFMA(qf[0], k0, acc); acc = RB_MFMA(qf[1], k1, acc);
                const float f0 = fdec * gm16[jb];
                acc[0] *= f0; acc[1] *= f0 * g1; acc[2] *= f0 * g2; acc[3] *= f0 * g3;
                if (jb == w) {
#pragma unroll
                    for (int e = 0; e < 4; ++e) acc[e] = (4 * q - r + e >= 0) ? acc[e] : 0.f; }
                const unsigned p01 = cvt_pk_bf16(acc[0], acc[1]), p23 = cvt_pk_bf16(acc[2], acc[3]);
                LAS unsigned char* pp = Pw + (4 * q) * PW_P + (16 * jb + r) * 2;
                *(LAS unsigned short*)(pp) = (unsigned short)p01; *(LAS unsigned short*)(pp + PW_P) = (unsigned short)(p01 >> 16);
                *(LAS unsigned short*)(pp + 2 * PW_P) = (unsigned short)p23; *(LAS unsigned short*)(pp + 3 * PW_P) = (unsigned short)(p23 >> 16);
            } else if (jb == w + 1 && (w & 1) == 0) {
                LAS unsigned char* pp = Pw + (4 * q) * PW_P + (16 * jb + r) * 2;
                *(LAS unsigned short*)(pp) = 0; *(LAS unsigned short*)(pp + PW_P) = 0; *(LAS unsigned short*)(pp + 2 * PW_P) = 0; *(LAS unsigned short*)(pp + 3 * PW_P) = 0;
            }
        }
        __builtin_amdgcn_sched_barrier(0); }
        }
        LDS_WAIT(); asm volatile("" ::: "memory");
        if (c + 1 < c1) RB_LOAD(c + 1);
        if (!(pf & 2)) {
        v4u pg[4];
        { const size_t grow_ = row0 + 16 * w + (lane >> 4);
#pragma unroll
          for (int i = 0; i < 4; ++i) pg[i] = *(const v4u*)(RGS + (grow_ + 4 * i) * 512 + h * 128 + 8 * (lane & 15)); }
        f32x4 oi[8];
#pragma unroll
        for (int d = 0; d < 8; ++d) oi[d] = (f32x4){0.f, 0.f, 0.f, 0.f};
#pragma unroll
        for (int ks = 0; ks < 4; ++ks) {
            if (2 * ks <= w && !(pf & 2)) { const v4u pa = *(const LAS v4u*)(Pw + r * PW_P + (32 * ks + 8 * q) * 2); v4u vb[8];
#pragma unroll
                for (int d = 0; d < 8; ++d) vb[d] = *(const LAS v4u*)(L + L_VT + (16 * d + r) * VT_P + (32 * ks + 8 * q) * 2);
                __builtin_amdgcn_sched_barrier(0);
#pragma unroll
                for (int d = 0; d < 8; ++d) oi[d] = RB_MFMA(pa, vb[d], oi[d]);
                __builtin_amdgcn_sched_barrier(0); }
        }
        { const float rfq = __builtin_amdgcn_exp2f((float)(16 * w + r + 1) * lg2);
#pragma unroll
          for (int ks = 0; ks < 2; ++ks) { v4u sb[8], qs;
#pragma unroll
            for (int wd = 0; wd < 4; ++wd) qs[wd] = cvt_pk_bf16(bflo(qf[ks][wd]) * rfq, bfhi(qf[ks][wd]) * rfq);
#pragma unroll
            for (int d = 0; d < 8; ++d) sb[d] = *(const LAS v4u*)(L + L_ST + (16 * d + r) * ST_P + (32 * ks + 8 * q) * 2);
            __builtin_amdgcn_sched_barrier(0);
#pragma unroll
            for (int d = 0; d < 8; ++d) oi[d] = RB_MFMA(qs, sb[d], oi[d]);
            __builtin_amdgcn_sched_barrier(0); } }
        float ss[4];
#pragma unroll
        for (int e = 0; e < 4; ++e) ss[e] = 0.f;
#pragma unroll
        for (int d = 0; d < 8; ++d)
#pragma unroll
            for (int e = 0; e < 4; ++e) ss[e] += oi[d][e] * oi[d][e];
#pragma unroll
        for (int e = 0; e < 4; ++e) { float s = ss[e]; s += dpp_f(s, 0xB1); s += dpp_f(s, 0x4E); s += dpp_f(s, 0x141); s += dpp_f(s, 0x140); ss[e] = 1.f / sqrtf(s * (1.f / 128.f) + EPS); }
#pragma unroll
        for (int d = 0; d < 8; ++d) { const unsigned p01 = cvt_pk_bf16(oi[d][0] * ss[0], oi[d][1] * ss[1]), p23 = cvt_pk_bf16(oi[d][2] * ss[2], oi[d][3] * ss[3]);
            LAS unsigned char* pp = Pw + (4 * q) * PW_P + (16 * d + r) * 2;
            *(LAS unsigned short*)(pp) = (unsigned short)p01; *(LAS unsigned short*)(pp + PW_P) = (unsigned short)(p01 >> 16);
            *(LAS unsigned short*)(pp + 2 * PW_P) = (unsigned short)p23; *(LAS unsigned short*)(pp + 3 * PW_P) = (unsigned short)(p23 >> 16); }
        LDS_WAIT(); asm volatile("" ::: "memory");
        { const int orow = lane >> 4, oc = lane & 15; const size_t grow = row0 + 16 * w + orow;
#pragma unroll
          for (int i = 0; i < 4; ++i) { const v4u ov = *(const LAS v4u*)(Pw + (orow + 4 * i) * PW_P + 16 * oc); const v4u gv = pg[i];
              v4u o;
#pragma unroll
              for (int wd = 0; wd < 4; ++wd) o[wd] = cvt_pk_bf16(bflo(ov[wd]) * bflo(gv[wd]), bfhi(ov[wd]) * bfhi(gv[wd]));
              if (!(pf & 1)) *(v4u*)(BR + (grow + 4 * i) * 1024 + 512 + h * 128 + 8 * oc) = o; } }
        }
        if (!(pf & 2)) __syncthreads();
#pragma unroll
        for (int i = 0; i < 4; ++i) S[i] = S[i] * cd;
        if (!(pf & 4))
#pragma unroll
        for (int ks = 0; ks < 4; ++ks) { const v4u vb = *(const LAS v4u*)(L + L_VT + (16 * w + r) * VT_P + (32 * ks + 8 * q) * 2); v4u ka[4];
#pragma unroll
            for (int i = 0; i < 4; ++i) ka[i] = *(const LAS v4u*)(L + L_KT + (16 * i + r) * KT_P + (32 * ks + 8 * q) * 2);
            __builtin_amdgcn_sched_barrier(0);
#pragma unroll
            for (int i = 0; i < 4; ++i) S[i] = RB_MFMA(ka[i], vb, S[i]);
            __builtin_amdgcn_sched_barrier(0); }
#pragma unroll
        for (int i = 0; i < 4; ++i) { v2u sv; sv.x = cvt_pk_bf16(S[i][0], S[i][1]); sv.y = cvt_pk_bf16(S[i][2], S[i][3]); *(LAS v2u*)(L + L_ST + (16 * w + r) * ST_P + (16 * i + 4 * q) * 2) = sv; }
        __syncthreads();
    }
}
#undef RB_MFMA
#undef dpp_f
#undef RB_LOAD
}

struct TrItem { const float* src; bf16* dst; int ldw, K, base, mul, gu, f8; };
__device__ __forceinline__ int tr_row(const TrItem& t, int n) { if (t.gu) { const int a = t.base + (n >> 1), b = n & 1; return 256 * (a >> 7) + 128 * b + (a & 127); } return t.base + t.mul * n; }
__device__ __forceinline__ void tr_load(const TrItem& t, f32x4 (&v)[8], int lane) {
    const float* p = t.src + (size_t)(lane >> 3) * t.ldw + 4 * (lane & 7);
#pragma unroll
    for (int i = 0; i < 8; ++i) v[i] = *(const GAS f32x4*)(p + (size_t)(8 * i) * t.ldw);
}
__device__ __forceinline__ void tr_store(const TrItem& t, const f32x4 (&v)[8], LAS float* scr, int lane) {
    { LAS float* w = scr + (lane >> 3) * 33 + 4 * (lane & 7);
#pragma unroll
      for (int i = 0; i < 8; ++i) { w[(8 * i) * 33 + 0] = v[i][0]; w[(8 * i) * 33 + 1] = v[i][1]; w[(8 * i) * 33 + 2] = v[i][2]; w[(8 * i) * 33 + 3] = v[i][3]; } }
    LDS_WAIT(); asm volatile("" ::: "memory");
    const int c = lane & 7;
#pragma unroll
    for (int j = 0; j < 4; ++j) { const int n = (lane >> 3) + 8 * j; const LAS float* s = scr + (8 * c) * 33 + n;
        if (t.f8) { const f32x4 a = {s[0 * 33] * WSCALE, s[1 * 33] * WSCALE, s[2 * 33] * WSCALE, s[3 * 33] * WSCALE}, b = {s[4 * 33] * WSCALE, s[5 * 33] * WSCALE, s[6 * 33] * WSCALE, s[7 * 33] * WSCALE};
            *(GAS v2u*)((unsigned char*)t.dst + (size_t)tr_row(t, n) * t.K + 8 * c) = pack8_fp8(a, b); }
        else { v4u o; o.x = cvt_pk_bf16(s[0 * 33], s[1 * 33]); o.y = cvt_pk_bf16(s[2 * 33], s[3 * 33]); o.z = cvt_pk_bf16(s[4 * 33], s[5 * 33]); o.w = cvt_pk_bf16(s[6 * 33], s[7 * 33]);
            *(GAS v4u*)(t.dst + (size_t)tr_row(t, n) * t.K + 8 * c) = o; } }
    LDS_WAIT(); asm volatile("" ::: "memory");
}
__device__ __forceinline__ void tr_store2(const TrItem& t0, const f32x4 (&v0)[8], const TrItem& t1, const f32x4 (&v1)[8], LAS float* s0, LAS float* s1, int lane) {
    { LAS float* w0 = s0 + (lane >> 3) * 33 + 4 * (lane & 7); LAS float* w1 = s1 + (lane >> 3) * 33 + 4 * (lane & 7);
#pragma unroll
      for (int i = 0; i < 8; ++i) { w0[(8 * i) * 33 + 0] = v0[i][0]; w0[(8 * i) * 33 + 1] = v0[i][1]; w0[(8 * i) * 33 + 2] = v0[i][2]; w0[(8 * i) * 33 + 3] = v0[i][3];
                                    w1[(8 * i) * 33 + 0] = v1[i][0]; w1[(8 * i) * 33 + 1] = v1[i][1]; w1[(8 * i) * 33 + 2] = v1[i][2]; w1[(8 * i) * 33 + 3] = v1[i][3]; } }
    LDS_WAIT(); asm volatile("" ::: "memory");
    const int c = lane & 7;
#pragma unroll
    for (int u = 0; u < 2; ++u) { const TrItem& t = u ? t1 : t0; const LAS float* sb = u ? s1 : s0;
#pragma unroll
        for (int j = 0; j < 4; ++j) { const int n = (lane >> 3) + 8 * j; const LAS float* s = sb + (8 * c) * 33 + n;
            if (t.f8 == 1) { const f32x4 a = {s[0 * 33] * WSCALE, s[1 * 33] * WSCALE, s[2 * 33] * WSCALE, s[3 * 33] * WSCALE}, b = {s[4 * 33] * WSCALE, s[5 * 33] * WSCALE, s[6 * 33] * WSCALE, s[7 * 33] * WSCALE};
                *(GAS v2u*)((unsigned char*)t.dst + (size_t)tr_row(t, n) * t.K + 8 * c) = pack8_fp8(a, b); }
            else { v4u o; o.x = cvt_pk_bf16(s[0 * 33], s[1 * 33]); o.y = cvt_pk_bf16(s[2 * 33], s[3 * 33]); o.z = cvt_pk_bf16(s[4 * 33], s[5 * 33]); o.w = cvt_pk_bf16(s[6 * 33], s[7 * 33]);
                *(GAS v4u*)(t.dst + (size_t)tr_row(t, n) * t.K + 8 * c) = o; } } }
    LDS_WAIT(); asm volatile("" ::: "memory");
}
constexpr int TR_IN = 96 * 16, TR_MG = 64 * 16, TR_BR = 2 * 32 * 8, TR_O = 32 * 16, TR_PG = 32 * 16, TR_PP = 32 * 4, TR_GU = 32 * 64 * 16, TR_DN = 32 * 32 * 16;
constexpr int TR_ITEMS = TR_IN + TR_MG + TR_BR + TR_O + TR_PG + TR_PP + TR_GU + TR_DN;
__device__ __forceinline__ TrItem tr_decode(Frame& F, int it) {
    TrItem t; t.mul = 1; t.gu = 0; t.f8 = 0; int r = it;
    if (r < TR_GU) { const int e = r >> 10, rr = r & 1023, kb = rr >> 6, blk = rr & 63;
        t.src = (F.ap->in[12]) + (size_t)e * 1024 * 2048 + (size_t)(64 * kb) * 2048 + 32 * blk; t.ldw = 2048; t.dst = (bf16*)(WSP(unsigned char, WS_WGUT) + (size_t)e * 2048 * 1024 + 64 * kb); t.K = 1024; t.base = 16 * blk; t.gu = 1; t.f8 = 1; return t; } r -= TR_GU;
    if (r < TR_DN) { const int e = r >> 9, rr = r & 511, kb = rr >> 5, blk = rr & 31;
        t.src = (F.ap->in[14]) + (size_t)e * 1024 * 1024 + (size_t)(64 * kb) * 1024 + 32 * blk; t.ldw = 1024; t.dst = (bf16*)(WSP(unsigned char, WS_WDT) + (size_t)e * 1024 * 1024 + 64 * kb); t.K = 1024; t.base = 32 * blk; t.f8 = 1; return t; } r -= TR_DN;
    if (r < TR_IN) { const int kb = r / 96, blk = r % 96; int s0;
        if (blk < 32) { s0 = 32 * blk; t.base = 32 * blk; t.f8 = 1; }
        else if (blk < 48) { s0 = 32 * blk; t.base = 32 * (blk - 32); }
        else if (blk < 64) { s0 = 2056 + 32 * (blk - 48); t.base = 1024 + 32 * (blk - 48); }
        else if (blk < 80) { s0 = 2568 + 32 * (blk - 64); t.base = 1536 + 32 * (blk - 64); }
        else { const int hb = (blk - 80) & 7, head = hb >> 1, half = hb & 1, isk = (blk >= 88); s0 = (isk ? 1800 : 1544) + head * 64 + half * 32; t.base = (isk ? 768 : 512) + head * 64 + half; t.mul = 2; }
        t.src = (F.ap->in[3]) + (size_t)(64 * kb) * INW + s0; t.ldw = INW; t.dst = t.f8 ? (bf16*)(WSP(unsigned char, WS_WG8T) + 64 * kb) : WSP(bf16, WS_W1T) + 64 * kb; t.K = 1024; return t; } r -= TR_IN;
    if (r < TR_MG) { const int kb = r >> 6, blk = r & 63; t.src = (F.ap->in[6]) + (size_t)(64 * kb) * 2048 + 32 * blk; t.ldw = 2048; t.dst = (bf16*)(WSP(unsigned char, WS_WG8T) + 64 * kb); t.K = 1024; t.base = 1024 + 32 * blk; t.f8 = 1; return t; } r -= TR_MG;
    if (r < TR_BR) { const int gsel = r >> 8, rr = r & 255, kb = rr >> 5, blk = rr & 31;
        t.src = (F.ap->in[5]) + (size_t)gsel * 512 * 1024 + (size_t)(64 * kb) * 1024 + 32 * blk; t.ldw = 1024; t.dst = WSP(bf16, WS_WBT) + gsel * 512 + 64 * kb; t.K = 1024; t.base = 32 * blk; return t; } r -= TR_BR;
    if (r < TR_O) { const int kb = r >> 5, blk = r & 31; t.src = (F.ap->in[8]) + (size_t)(64 * kb) * 1024 + 32 * blk; t.ldw = 1024; t.dst = WSP(bf16, WS_WOT) + 64 * kb; t.K = 1024; t.base = 32 * blk; return t; } r -= TR_O;
    if (r < TR_PG) { const int kb = r >> 5, blk = r & 31; t.src = (F.ap->in[17]) + (size_t)(64 * kb) * 1024 + 32 * blk; t.ldw = 1024; t.dst = (bf16*)(WSP(unsigned char, WS_WPGT) + 64 * kb); t.K = 1024; t.base = 32 * blk; t.f8 = 1; return t; } r -= TR_PG;
    { const int kb = r >> 5, blk = r & 31; t.src = (F.ap->in[18]) + (size_t)(64 * kb) * 1024 + 32 * blk; t.ldw = 1024; t.dst = WSP(bf16, WS_WPPT) + 64 * kb; t.K = 256; t.base = 32 * blk; return t; }
}

__device__ __forceinline__ void p0_row(Frame& F, int m, f32x4 (&v)[4], LAS const float* WFt, int lane, const f32x4 (&gq)[4], float bfl) {
    float s = 0.f;
#pragma unroll
    for (int j = 0; j < 4; ++j) s += (v[j].x * v[j].x + v[j].y * v[j].y) + (v[j].z * v[j].z + v[j].w * v[j].w);
    const float rstd = 1.f / sqrtf(wave_sum(s) * (1.f / DM) + EPS);
    GAS unsigned long long* o8 = (GAS unsigned long long*)(WSP(bf16, WS_XN) + (size_t)m * DM) + lane;
    GAS int* q8 = (GAS int*)(WSP(unsigned char, WS_XN8) + (size_t)m * DM) + lane;
#pragma unroll
    for (int j = 0; j < 4; ++j) { v[j] = v[j] * rstd * gq[j];
        o8[64 * j] = (unsigned long long)cvt_pk_bf16(v[j].x, v[j].y) | ((unsigned long long)cvt_pk_bf16(v[j].z, v[j].w) << 32);
        { int w = 0; w = __builtin_amdgcn_cvt_pk_fp8_f32(clamp_f8(v[j].x), clamp_f8(v[j].y), w, false); w = __builtin_amdgcn_cvt_pk_fp8_f32(clamp_f8(v[j].z), clamp_f8(v[j].w), w, true); q8[64 * j] = w; } }
    float fa[8];
#pragma unroll
    for (int c = 0; c < 8; ++c) { float a = 0.f;
#pragma unroll
        for (int j = 0; j < 4; ++j) { const f32x4 w = *(const LAS f32x4*)(WFt + c * 1024 + 256 * j + 4 * lane); a += (v[j].x * w.x + v[j].y * w.y) + (v[j].z * w.z + v[j].w * w.w); }
        fa[c] = wave_sum(a); }
    float z = fa[0];
#pragma unroll
    for (int c = 1; c < 8; ++c) z = (lane == c) ? fa[c] : z;
    if (lane < 8) { z += bfl; WSP(float, WS_LOGF)[(size_t)m * 8 + lane] = fminf(z, 0.f) - log1pf(expf(-fabsf(z))); }
}
__device__ __forceinline__ void p0_prologue(Frame& F) {
    LAS float* WFt = (LAS float*)(F.lds + RING_OFF);
    { f32x4 wv[2][2];
#pragma unroll
      for (int i = 0; i < 2; ++i) { const float* wp = (F.ap->in[3]) + (size_t)(F.tid + NWAVES * 64 * i) * INW + 1536; wv[i][0] = *(const GAS f32x4*)wp; wv[i][1] = *(const GAS f32x4*)(wp + 4); }
#pragma unroll
      for (int i = 0; i < 2; ++i) { const int k = F.tid + NWAVES * 64 * i;
#pragma unroll
          for (int c = 0; c < 8; ++c) WFt[c * 1024 + k] = wv[i][c >> 2][c & 3]; } }
    __syncthreads();
    const int gw = F.vcu * NWAVES + F.wave, NGW = F.G * NWAVES, lane = F.lane;
#ifndef P0_REP_ROWS
#define P0_REP_ROWS 1
#endif
#ifndef P0_REP_TR
#define P0_REP_TR 1
#endif
#ifndef P0_REP_ROWS
#define P0_REP_ROWS 1
#endif
#ifndef P0_REP_TR
#define P0_REP_TR 1
#endif
    for (int rep_ = 0; rep_ < P0_REP_ROWS; ++rep_)
    { f32x4 gq[4]; const float bfl = (F.ap->in[4])[lane & 7];
#pragma unroll
      for (int j = 0; j < 4; ++j) gq[j] = ((const GAS f32x4*)(F.ap->in[2]))[lane + 64 * j];
      f32x4 va[4], vb[4]; int m = gw;
      if (m < NT) {
#pragma unroll
          for (int j = 0; j < 4; ++j) va[j] = ((const GAS f32x4*)((F.ap->in[0]) + (size_t)m * DM))[lane + 64 * j]; }
      for (; m < NT; m += NGW) { const int m2 = m + NGW;
          if (m2 < NT) {
#pragma unroll
              for (int j = 0; j < 4; ++j) vb[j] = ((const GAS f32x4*)((F.ap->in[0]) + (size_t)m2 * DM))[lane + 64 * j]; }
          __builtin_amdgcn_sched_barrier(0);
          p0_row(F, m, va, WFt, lane, gq, bfl);
          __builtin_amdgcn_sched_barrier(0);
#pragma unroll
          for (int j = 0; j < 4; ++j) va[j] = vb[j];
      } }
    __syncthreads();
    for (int rep_ = 0; rep_ < P0_REP_TR; ++rep_)
    { LAS float* scr = (LAS float*)(F.lds + RING_OFF + F.wave * 8704);
      constexpr int TR_P0_END = TR_GU + TR_DN + TR_IN + TR_MG;
      int it = TR_GU + TR_DN + gw; f32x4 cur[8], nxt[8]; TrItem tc, tn;
      if (it < TR_P0_END) { tc = tr_decode(F, it); tr_load(tc, cur, lane); }
      while (it < TR_P0_END) {
          const int itn = it + NGW; const bool hn = itn < TR_P0_END;
          if (hn) { tn = tr_decode(F, itn); tr_load(tn, nxt, lane); }
          tr_store(tc, cur, scr, lane);
          if (hn) { tc = tn;
#pragma unroll
              for (int i = 0; i < 8; ++i) cur[i] = nxt[i]; }
          it = itn;
      } }
    const int gt = F.vcu * (NWAVES * 64) + F.tid, NGT = F.G * NWAVES * 64;
    { float* rot = WSP(float, WS_ROT);
      for (int i = gt; i < SEQ * 32; i += NGT) { const int pos = i >> 5, j = i & 31;
          const float inv = powf(10000.f, -(float)j / 32.f); const float ang = (float)pos * inv;
          double rev = (double)ang * 0.15915494309189535; rev -= floor(rev); const float fr = (float)rev;
          rot[i] = __builtin_amdgcn_cosf(fr); rot[SEQ * 32 + i] = __builtin_amdgcn_sinf(fr); } }
    { bf16* wrt = WSP(bf16, WS_WRT);
      for (int i = gt; i < 1024 * 32; i += NGT) { const int k = i >> 5, n = i & 31; const float v = (F.ap->in[10])[i]; const unsigned hi = f2bf(v); const float rem = v - __uint_as_float(hi << 16);
          wrt[n * 1024 + k] = (bf16)hi; wrt[32768 + n * 1024 + k] = (bf16)f2bf(rem); } }
    if (gt < 64) { GAS v4u* z = (GAS v4u*)(WSP(unsigned char, WS_HB) + (size_t)NT * DM); z[gt] = (v4u){0u, 0u, 0u, 0u}; }
}

constexpr int CONV_ITEMS = 64, CONV_TR_ITEMS = TR_ITEMS - TR_IN - TR_MG, CONV_TR_CHUNKS = CONV_TR_ITEMS / CONV_ITEMS, CONV_PB_CHUNKS = NT * PLE / 4 / 16384, CONV_CHUNKS = CONV_TR_CHUNKS + CONV_PB_CHUNKS;
static_assert(CONV_TR_ITEMS % CONV_ITEMS == 0 && (TR_GU + TR_DN) % CONV_ITEMS == 0 && (NT * PLE / 4) % 16384 == 0, "whole chunks");
__device__ __forceinline__ TrItem conv_decode(Frame& F, int ci) { return tr_decode(F, ci < TR_GU + TR_DN ? ci : ci + TR_IN + TR_MG); }
__device__ __forceinline__ void conv_chunk(Frame& F, int c) {
    int lane = lane_now(); asm volatile("" : "+v"(lane));
    if (c >= CONV_TR_CHUNKS) {
        const int j = c - CONV_TR_CHUNKS, t = F.wave * 64 + lane;
        const GAS f32x4* ps = (const GAS f32x4*)(F.ap->in[1]) + (size_t)j * 16384 + t; GAS unsigned long long* pd = (GAS unsigned long long*)WSP(bf16, WS_PB) + (size_t)j * 16384 + t;
        for (int b = 0; b < 4; ++b) { f32x4 v[8];
#pragma unroll
            for (int u = 0; u < 8; ++u) v[u] = ps[b * 4096 + u * 512];
#pragma unroll
            for (int u = 0; u < 8; ++u) pd[b * 4096 + u * 512] = (unsigned long long)cvt_pk_bf16(v[u].x, v[u].y) | ((unsigned long long)cvt_pk_bf16(v[u].z, v[u].w) << 32); }
        return; }
    LAS float* scr = (LAS float*)(F.lds + RING_OFF + F.wave * 17408); LAS float* scr1 = scr + 2176;
    static_assert(NWAVES * 17408 <= SCH_OFF - RING_OFF, "conversion scratch inside ring + table region");
    const int base = c * CONV_ITEMS + F.wave;
    f32x4 a0[8], a1[8], b0[8], b1[8], c0[8], c1[8]; TrItem ta0, ta1, tb0, tb1, tc0, tc1;
    constexpr int NPAIR = CONV_ITEMS / NWAVES / 2;
    ta0 = conv_decode(F, base); ta1 = conv_decode(F, base + NWAVES); tr_load(ta0, a0, lane); tr_load(ta1, a1, lane);
    tb0 = conv_decode(F, base + 2 * NWAVES); tb1 = conv_decode(F, base + 3 * NWAVES); tr_load(tb0, b0, lane); tr_load(tb1, b1, lane);
    tc0 = tb0; tc1 = tb1;
#pragma unroll
    for (int i = 0; i < 8; ++i) { c0[i] = b0[i]; c1[i] = b1[i]; }
    for (int k = 0; k < NPAIR; ++k) {
        if (k + 2 < NPAIR) { tc0 = conv_decode(F, base + NWAVES * (2 * k + 4)); tc1 = conv_decode(F, base + NWAVES * (2 * k + 5)); tr_load(tc0, c0, lane); tr_load(tc1, c1, lane); }
        __builtin_amdgcn_sched_barrier(0);
        tr_store2(ta0, a0, ta1, a1, scr, scr1, lane);
        __builtin_amdgcn_sched_barrier(0);
        ta0 = tb0; ta1 = tb1; tb0 = tc0; tb1 = tc1;
#pragma unroll
        for (int i = 0; i < 8; ++i) { a0[i] = b0[i]; a1[i] = b1[i]; b0[i] = c0[i]; b1[i] = c1[i]; }
    }
}

__device__ __forceinline__ void cum_scan(Frame& F, int bh) {
    const float* lf = WSP(float, WS_LOGF); float* cum = WSP(float, WS_CUM);
    const int b = bh >> 3, h = bh & 7, t0 = 4 * F.tid;
    double a0 = lf[((size_t)(b * SEQ + t0 + 0)) * 8 + h], a1 = lf[((size_t)(b * SEQ + t0 + 1)) * 8 + h], a2 = lf[((size_t)(b * SEQ + t0 + 2)) * 8 + h], a3 = lf[((size_t)(b * SEQ + t0 + 3)) * 8 + h];
    a1 += a0; a2 += a1; a3 += a2;
    LAS double* tot = (LAS double*)(F.lds + RING_OFF);
    tot[F.tid] = a3;
    __syncthreads();
    double ex = 0.0;
    for (int j = 0; j < 63; ++j) { const double v = tot[F.wave * 64 + j]; ex += (j < F.lane) ? v : 0.0; }
    if (F.lane == 63) tot[512 + F.wave] = ex + a3;
    __syncthreads();
    for (int w = 0; w < F.wave; ++w) ex += tot[512 + w];
    *(GAS f32x4*)(cum + (size_t)bh * SEQ + t0) = (f32x4){(float)(ex + a0), (float)(ex + a1), (float)(ex + a2), (float)(ex + a3)};
    __syncthreads();
}

typedef pg8::f32x4 (&AccRef)[2][2][4][2];
using pg8::Unit;
__device__ __forceinline__ v4u pack8(const f32x4 a, const f32x4 b) { v4u w; w.x = cvt_pk_bf16(a[0], a[1]); w.y = cvt_pk_bf16(a[2], a[3]); w.z = cvt_pk_bf16(b[0], b[1]); w.w = cvt_pk_bf16(b[2], b[3]); return w; }
__device__ __forceinline__ void unpack8(const v4u w, f32x4& a, f32x4& b) { a = (f32x4){bflo(w.x), bfhi(w.x), bflo(w.y), bfhi(w.y)}; b = (f32x4){bflo(w.z), bfhi(w.z), bflo(w.w), bfhi(w.w)}; }

__device__ __forceinline__ void tstore32(LAS unsigned char* scr, const v4u wa, const v4u wb, int fr, int fq, bf16* dst, int cstride) {
    LAS unsigned short* s2 = (LAS unsigned short*)scr;
#pragma unroll
    for (int e2 = 0; e2 < 4; ++e2) { const int col = 8 * fq + 2 * e2;
        s2[col * 40 + fr] = (unsigned short)(wa[e2] & 0xffffu); s2[(col + 1) * 40 + fr] = (unsigned short)(wa[e2] >> 16);
        s2[col * 40 + 16 + fr] = (unsigned short)(wb[e2] & 0xffffu); s2[(col + 1) * 40 + 16 + fr] = (unsigned short)(wb[e2] >> 16); }
    asm volatile("" ::: "memory");
    const int lane = fr + 16 * fq, cl = lane >> 1, part = lane & 1;
    const v4u r0 = *(const LAS v4u*)(scr + cl * 80 + part * 32), r1 = *(const LAS v4u*)(scr + cl * 80 + part * 32 + 16);
    asm volatile("" ::: "memory");
    bf16* d = dst + (size_t)cl * cstride + part * 16;
    *(v4u*)d = r0; *(v4u*)(d + 8) = r1;
}
struct EpiIn {
    static constexpr bool PERM = true;
    bf16 *FQ, *FK, *FV, *RQ, *RK, *RV, *RGS; const float* rot; bf16* RKT; LAS unsigned char* scr; int skip;
    __device__ __forceinline__ void operator()(const pg8::f32x4 (&acc)[2][2][4][2], const Unit& u, int wr, int wc, int fr, int fq) const {
        if (skip == 1) return;
        asm volatile("" : "+v"(fr), "+v"(fq));
        const int pn = u.pn; bf16* base; int ldc, colt, mode = 0; float sc = 1.f;
        if (skip) { const int cls = pn < 6 ? 1 : pn < 8 ? 2 : pn < 10 ? 4 : 8; if (skip & (cls << 1)) return; }
        if (pn < 2) { base = FQ; ldc = 512; colt = pn * 256; sc = C2; }
        else if (pn < 4) { base = FK; ldc = 512; colt = (pn - 2) * 256; }
        else if (pn < 6) { base = FV; ldc = 512; colt = (pn - 4) * 256; }
        else if (pn == 6) { base = RQ; ldc = 256; colt = 0; mode = 1; }
        else if (pn == 7) { base = RK; ldc = 256; colt = 0; mode = 1; sc = 0.125f; }
        else if (pn < 10) { base = RV; ldc = 512; colt = (pn - 8) * 256; mode = 4; }
        else { base = RGS; ldc = 512; colt = (pn - 10) * 256; mode = 2; }
        const int row0 = u.pm * 256 + wr * 64 + fr, col0 = colt + wc * 32 + 8 * fq;
        LAS unsigned char* ws = scr + (wr * 4 + wc) * 3072;
        if (mode == 1) {
            f32x4 cs[2][4], sn[2][4]; const int j = (col0 & 63) >> 1;
#pragma unroll
            for (int ai = 0; ai < 2; ++ai)
#pragma unroll
                for (int m = 0; m < 4; ++m) { const int pos = (row0 + ai * 128 + m * 16) & (SEQ - 1); cs[ai][m] = *(const f32x4*)(rot + pos * 32 + j); sn[ai][m] = *(const f32x4*)(rot + SEQ * 32 + pos * 32 + j); }
            __builtin_amdgcn_sched_barrier(0);
            float lg2b[2] = {0.f, 0.f};
            if (pn == 7) { lg2b[0] = log1pf(-exp2f(-5.f - (float)(wc >> 1))) * LOG2E; lg2b[1] = log1pf(-exp2f(-5.f - (float)((wc >> 1) + 2))) * LOG2E; }
#pragma unroll
            for (int ai = 0; ai < 2; ++ai)
#pragma unroll
                for (int mh = 0; mh < 2; ++mh)
#pragma unroll
                    for (int bj = 0; bj < 2; ++bj) { const int c = col0 + bj * 128; v4u wt[2];
#pragma unroll
                        for (int mm = 0; mm < 2; ++mm) { const int m = 2 * mh + mm, row = row0 + ai * 128 + m * 16; const f32x4 a = acc[ai][bj][m][0], b = acc[ai][bj][m][1], cv = cs[ai][m], sv = sn[ai][m];
                            const f32x4 v0 = {(a[0] * cv[0] - a[1] * sv[0]) * sc, (a[1] * cv[0] + a[0] * sv[0]) * sc, (a[2] * cv[1] - a[3] * sv[1]) * sc, (a[3] * cv[1] + a[2] * sv[1]) * sc};
                            const f32x4 v1 = {(b[0] * cv[2] - b[1] * sv[2]) * sc, (b[1] * cv[2] + b[0] * sv[2]) * sc, (b[2] * cv[3] - b[3] * sv[3]) * sc, (b[3] * cv[3] + b[2] * sv[3]) * sc};
                            *(v4u*)(base + (size_t)row * ldc + c) = pack8(v0, v1);
                            if (pn == 7) { const float dk = __builtin_amdgcn_exp2f((float)(127 - (row & 127)) * lg2b[bj]); wt[mm] = pack8(v0 * dk, v1 * dk); } }
                        if (pn == 7) {
                            const int rowb = u.pm * 256 + ai * 128 + wr * 64 + mh * 32, cb = wc * 32 + bj * 128;
                            tstore32(ws, wt[0], wt[1], fr, fq, RKT + ((size_t)((rowb >> 11) * 4 + (cb >> 6)) * 16 + ((rowb >> 7) & 15)) * 8192 + (size_t)(cb & 63) * 128 + (rowb & 127), 128); } }
            return; }
        if (mode == 4) {
#pragma unroll
            for (int ai = 0; ai < 2; ++ai)
#pragma unroll
                for (int mh = 0; mh < 2; ++mh)
#pragma unroll
                    for (int bj = 0; bj < 2; ++bj) { const int rowb = u.pm * 256 + ai * 128 + wr * 64 + mh * 32, cb = colt + wc * 32 + bj * 128;
                        tstore32(ws, pack8(acc[ai][bj][2 * mh][0], acc[ai][bj][2 * mh][1]), pack8(acc[ai][bj][2 * mh + 1][0], acc[ai][bj][2 * mh + 1][1]), fr, fq,
                                 RV + ((size_t)((rowb >> 11) * 4 + (cb >> 7)) * 16 + ((rowb >> 7) & 15)) * 16384 + (size_t)(cb & 127) * 128 + (rowb & 127), 128); }
            return; }
#pragma unroll
        for (int ai = 0; ai < 2; ++ai)
#pragma unroll
            for (int m = 0; m < 4; ++m) { const int row = row0 + ai * 128 + m * 16;
#pragma unroll
                for (int bj = 0; bj < 2; ++bj) { const int c = col0 + bj * 128; f32x4 v0 = acc[ai][bj][m][0], v1 = acc[ai][bj][m][1];
                    if (mode == 0) { v0 = v0 * sc; v1 = v1 * sc; }
                    else {
#pragma unroll
                        for (int e = 0; e < 4; ++e) { v0[e] = v0[e] * fsigmoid(v0[e]); v1[e] = v1[e] * fsigmoid(v1[e]); } }
                    *(v4u*)(base + (size_t)row * ldc + c) = pack8(v0, v1); } }
    }
};
__device__ __forceinline__ void u8x8_to_f32(const v2u w, f32x4& a, f32x4& b) {
    a = (f32x4){(float)(w.x & 255u), (float)((w.x >> 8) & 255u), (float)((w.x >> 16) & 255u), (float)(w.x >> 24)}; b = (f32x4){(float)(w.y & 255u), (float)((w.y >> 8) & 255u), (float)((w.y >> 16) & 255u), (float)(w.y >> 24)}; }
struct EpiGate {
    static constexpr bool PERM = true;
    unsigned char* GATES; const float* bmg; bf16 *FQ, *FK; int skip;
    __device__ __forceinline__ void operator()(const pg8::f32x4 (&acc)[2][2][4][2], const Unit& u, int wr, int wc, int fr, int fq) const {
        if (skip & 33) return;
        { const int l_ = lane_now(); fr = l_ & 15; fq = (l_ >> 4) & 3; }
        if (u.pn < 4) {
            bf16* base = u.pn < 2 ? FQ : FK; const float sc = (u.pn < 2 ? C2 : 1.f) * (1.f / WSCALE);
            const int r0 = u.pm * 256 + wr * 64 + fr, c0 = (u.pn & 1) * 256 + wc * 32 + 8 * fq;
#pragma unroll
            for (int ai = 0; ai < 2; ++ai)
#pragma unroll
                for (int m = 0; m < 4; ++m)
#pragma unroll
                    for (int bj = 0; bj < 2; ++bj) *(v4u*)(base + (size_t)(r0 + ai * 128 + m * 16) * 512 + c0 + bj * 128) = pack8(acc[ai][bj][m][0] * sc, acc[ai][bj][m][1] * sc);
            return; }
        float ck = -LOG2E / WSCALE, cb = -LOG2E, c254 = 254.f; asm volatile("" : "+s"(ck), "+s"(cb), "+s"(c254));
        typedef float f2 __attribute__((ext_vector_type(2)));
        const int row0 = u.pm * 256 + wr * 64 + fr, col0 = (u.pn - 4) * 256 + wc * 32 + 8 * fq;
        f32x4 bb[2][2];
#pragma unroll
        for (int bj = 0; bj < 2; ++bj) { bb[bj][0] = *(const f32x4*)(bmg + col0 + bj * 128) * cb; bb[bj][1] = *(const f32x4*)(bmg + col0 + bj * 128 + 4) * cb; }
#pragma unroll
        for (int ai = 0; ai < 2; ++ai)
#pragma unroll
            for (int m = 0; m < 4; ++m) { unsigned char* rowp = GATES + (size_t)(row0 + ai * 128 + m * 16) * 2048 + col0;
#pragma unroll
                for (int bj = 0; bj < 2; ++bj) { v2u w;
#pragma unroll
                    for (int n = 0; n < 2; ++n) { const f32x4 a = acc[ai][bj][m][n], b = bb[bj][n]; unsigned b4 = 0u;
#pragma unroll
                        for (int hh = 0; hh < 2; ++hh) { const f2 t = (f2){a[2 * hh], a[2 * hh + 1]} * ck + (f2){b[2 * hh], b[2 * hh + 1]};
                            f2 ex; ex.x = __builtin_amdgcn_exp2f(t.x); ex.y = __builtin_amdgcn_exp2f(t.y); const f2 den = ex + 1.0f;
                            f2 rc; rc.x = __builtin_amdgcn_rcpf(den.x); rc.y = __builtin_amdgcn_rcpf(den.y); const f2 x = rc * c254 + 0.5f;
                            if (hh == 0) { b4 = __builtin_amdgcn_cvt_pk_u8_f32(x.x, 0, b4); b4 = __builtin_amdgcn_cvt_pk_u8_f32(x.y, 1, b4); }
                            else { b4 = __builtin_amdgcn_cvt_pk_u8_f32(x.x, 2, b4); b4 = __builtin_amdgcn_cvt_pk_u8_f32(x.y, 3, b4); } }
                        if (n == 0) w.x = b4; else w.y = b4; }
                    *(v2u*)(rowp + bj * 128) = w; } }
    }
};
struct HookMerge {
    static constexpr bool ON = true; static constexpr int AT = 6;
    const unsigned char* GATES;
    __device__ __forceinline__ void operator()(pg8::f32x4 (&acc)[2][2][4][2], const Unit& u, int wr, int wc, int fr, int fq) const {
        asm volatile("" : "+v"(fr), "+v"(fq));
        const int row0 = u.pm * 256 + wr * 64 + fr, col0 = u.pn * 256 + wc * 32 + 8 * fq;
        v2u ga[2][4][2], gb[2][4][2];
#pragma unroll
        for (int ai = 0; ai < 2; ++ai)
#pragma unroll
            for (int m = 0; m < 4; ++m) { const unsigned char* gp = GATES + (size_t)(row0 + ai * 128 + m * 16) * 2048 + col0;
#pragma unroll
                for (int bj = 0; bj < 2; ++bj) { ga[ai][m][bj] = *(const v2u*)(gp + bj * 128); gb[ai][m][bj] = *(const v2u*)(gp + 1024 + bj * 128); } }
        __builtin_amdgcn_sched_barrier(0);
#pragma unroll
        for (int ai = 0; ai < 2; ++ai)
#pragma unroll
            for (int m = 0; m < 4; ++m)
#pragma unroll
                for (int bj = 0; bj < 2; ++bj) { f32x4 a0, a1, b0, b1; u8x8_to_f32(ga[ai][m][bj], a0, a1); u8x8_to_f32(gb[ai][m][bj], b0, b1);
#pragma unroll
                    for (int e2 = 0; e2 < 4; ++e2) { acc[ai][bj][m][0][e2] *= a0[e2] * __builtin_amdgcn_rcpf(fmaxf(b0[e2], 1e-30f)); acc[ai][bj][m][1][e2] *= a1[e2] * __builtin_amdgcn_rcpf(fmaxf(b1[e2], 1e-30f)); } }
        __builtin_amdgcn_sched_barrier(0);
    }
};
struct EpiMerge {
    static constexpr bool PERM = true;
    const unsigned char* GATES; bf16* MERGED;
    __device__ __forceinline__ void operator()(const pg8::f32x4 (&acc)[2][2][4][2], const Unit& u, int wr, int wc, int fr, int fq) const {
        asm volatile("" : "+v"(fr), "+v"(fq));
        const int row0 = u.pm * 256 + wr * 64 + fr, col0 = u.pn * 256 + wc * 32 + 8 * fq;
        v2u gg[2][4][2];
#pragma unroll
        for (int ai = 0; ai < 2; ++ai)
#pragma unroll
            for (int m = 0; m < 4; ++m)
#pragma unroll
                for (int bj = 0; bj < 2; ++bj) gg[ai][m][bj] = *(const v2u*)(GATES + (size_t)(row0 + ai * 128 + m * 16) * 2048 + 1024 + col0 + bj * 128);
        __builtin_amdgcn_sched_barrier(0);
#pragma unroll
        for (int ai = 0; ai < 2; ++ai)
#pragma unroll
            for (int m = 0; m < 4; ++m)
#pragma unroll
                for (int bj = 0; bj < 2; ++bj) { f32x4 g0, g1; u8x8_to_f32(gg[ai][m][bj], g0, g1);
#pragma unroll
                    for (int e2 = 0; e2 < 4; ++e2) { g0[e2] = fmaxf(g0[e2], 1e-30f) * (1.f / 254.f); g1[e2] = fmaxf(g1[e2], 1e-30f) * (1.f / 254.f); }
                    *(v4u*)(MERGED + (size_t)(row0 + ai * 128 + m * 16) * 1024 + col0 + bj * 128) = pack8(acc[ai][bj][m][0] * g0, acc[ai][bj][m][1] * g1); }
    }
};
struct EpiMO {
    static constexpr bool PERM = true;
    bf16* MO;
    __device__ __forceinline__ void operator()(const pg8::f32x4 (&acc)[2][2][4][2], const Unit& u, int wr, int wc, int fr, int fq) const {
        asm volatile("" : "+v"(fr), "+v"(fq));
        const int row0 = u.pm * 256 + wr * 64 + fr, col0 = u.pn * 256 + wc * 32 + 8 * fq;
#pragma unroll
        for (int ai = 0; ai < 2; ++ai)
#pragma unroll
            for (int m = 0; m < 4; ++m) { bf16* rowp = MO + (size_t)(row0 + ai * 128 + m * 16) * 1024 + col0;
#pragma unroll
                for (int bj = 0; bj < 2; ++bj) *(v4u*)(rowp + bj * 128) = pack8(acc[ai][bj][m][0], acc[ai][bj][m][1]); }
    }
};
struct EpiGU {
    static constexpr bool PERM = true;
    const float* bgu; const float* rsof; unsigned char* ACT;
    __device__ __forceinline__ void operator()(const pg8::f32x4 (&acc)[2][2][4][2], const Unit& u, int wr, int wc, int fr, int fq) const {
        { const int l_ = lane_now(); fr = l_ & 15; fq = (l_ >> 4) & 3; }
        float c7 = 7.f, cm7 = -7.f, ck = -1.702f * 1.4426950408889634f; asm volatile("" : "+s"(c7), "+s"(cm7), "+s"(ck));
        const int j0 = u.pn * 128 + wc * 32 + 8 * fq;
        const float* bb = bgu + (size_t)u.e * 2048 + 2 * j0;
        const f32x4 q0 = *(const f32x4*)(bb), q1 = *(const f32x4*)(bb + 4), q2 = *(const f32x4*)(bb + 8), q3 = *(const f32x4*)(bb + 12);
        const f32x4 bg0 = {q0[0], q0[2], q1[0], q1[2]}, bl0 = {q0[1], q0[3], q1[1], q1[3]}, bg1 = {q2[0], q2[2], q3[0], q3[2]}, bl1 = {q2[1], q2[3], q3[1], q3[3]};
        const int rl0 = wr * 64 + fr;
        float rsv[2][4];
#pragma unroll
        for (int ai = 0; ai < 2; ++ai)
#pragma unroll
            for (int m = 0; m < 4; ++m) rsv[ai][m] = rsof[(size_t)u.e * NT + u.rtl * 256 + rl0 + ai * 128 + m * 16];
        __builtin_amdgcn_sched_barrier(0);
#pragma unroll
        for (int ai = 0; ai < 2; ++ai)
#pragma unroll
            for (int m = 0; m < 4; ++m) { const int rl = rl0 + ai * 128 + m * 16; const float rs = rsv[ai][m] * (1.f / WSCALE);
                int wpk[2];
#pragma unroll
                for (int n = 0; n < 2; ++n) { const f32x4 ga = acc[ai][0][m][n], la = acc[ai][1][m][n]; const f32x4 bgv = n ? bg1 : bg0, blv = n ? bl1 : bl0; int w = 0;
#pragma unroll
                    for (int hh = 0; hh < 2; ++hh) { typedef float f2 __attribute__((ext_vector_type(2)));
                        f2 g = (f2){ga[2 * hh], ga[2 * hh + 1]} * rs + (f2){bgv[2 * hh], bgv[2 * hh + 1]}, l = (f2){la[2 * hh], la[2 * hh + 1]} * rs + (f2){blv[2 * hh], blv[2 * hh + 1]};
                        f2 a, b; a.x = fminf(g.x, c7); a.y = fminf(g.y, c7); b.x = __builtin_amdgcn_fmed3f(l.x, cm7, c7); b.y = __builtin_amdgcn_fmed3f(l.y, cm7, c7);
                        const f2 t = a * ck; f2 ex; ex.x = __builtin_amdgcn_exp2f(t.x); ex.y = __builtin_amdgcn_exp2f(t.y);
                        const f2 den = ex + 1.0f; f2 rc; rc.x = __builtin_amdgcn_rcpf(den.x); rc.y = __builtin_amdgcn_rcpf(den.y);
                        const f2 o = (a * rc) * (b + 1.0f);
                        if (hh == 0) w = __builtin_amdgcn_cvt_pk_fp8_f32(o.x, o.y, w, false); else w = __builtin_amdgcn_cvt_pk_fp8_f32(o.x, o.y, w, true); }
                    wpk[n] = w; }
                *(v2u*)(ACT + ((size_t)u.pm * 256 + rl) * 1024 + j0) = (v2u){(unsigned)wpk[0], (unsigned)wpk[1]}; }
    }
};
struct EpiDN {
    static constexpr bool PERM = true;
    const float* bdn; unsigned char* Y;
    __device__ __forceinline__ void operator()(const pg8::f32x4 (&acc)[2][2][4][2], const Unit& u, int wr, int wc, int fr, int fq) const {
        asm volatile("" : "+v"(fr), "+v"(fq));
        const int col0 = u.pn * 256 + wc * 32 + 8 * fq; const float* bb = bdn + (size_t)u.e * 1024 + col0;
        f32x4 bv[2][2];
#pragma unroll
        for (int bj = 0; bj < 2; ++bj) { bv[bj][0] = *(const f32x4*)(bb + bj * 128) * YSCALE; bv[bj][1] = *(const f32x4*)(bb + bj * 128 + 4) * YSCALE; }
        const int rl0 = wr * 64 + fr;
#pragma unroll
        for (int ai = 0; ai < 2; ++ai)
#pragma unroll
            for (int m = 0; m < 4; ++m) { unsigned char* rowp = Y + ((size_t)u.pm * 256 + rl0 + ai * 128 + m * 16) * 1024 + col0;
#pragma unroll
                for (int bj = 0; bj < 2; ++bj) *(v2u*)(rowp + bj * 128) = pack8_fp8(acc[ai][bj][m][0] * (YSCALE / WSCALE) + bv[bj][0], acc[ai][bj][m][1] * (YSCALE / WSCALE) + bv[bj][1]); }
    }
};
struct EpiPJ {
    static constexpr bool PERM = false;
    bf16* PJ;
    __device__ __forceinline__ void operator()(const pg8::f32x4 (&acc)[2][2][4][2], const Unit& u, int wr, int wc, int fr, int fq) const {
        asm volatile("" : "+v"(fr), "+v"(fq));
        const int row0 = u.pm * 256 + wr * 64 + fr, col0 = u.pn * 256 + wc * 32 + 4 * fq;
#pragma unroll
        for (int ai = 0; ai < 2; ++ai)
#pragma unroll
            for (int m = 0; m < 4; ++m) { const size_t off = (size_t)(row0 + ai * 128 + m * 16) * 1024 + col0;
#pragma unroll
                for (int bj = 0; bj < 2; ++bj)
#pragma unroll
                    for (int n = 0; n < 2; ++n) { const f32x4 v = acc[ai][bj][m][n]; v2u w; w.x = cvt_pk_bf16(v[0], v[1]); w.y = cvt_pk_bf16(v[2], v[3]); *(v2u*)(PJ + off + bj * 128 + n * 16) = w; } }
    }
};
struct EpiPG {
    static constexpr bool PERM = true;
    unsigned char* G8; const float* rstd2;
    __device__ __forceinline__ void operator()(const pg8::f32x4 (&acc)[2][2][4][2], const Unit& u, int wr, int wc, int fr, int fq) const {
        { const int l_ = lane_now(); fr = l_ & 15; fq = (l_ >> 4) & 3; }
        float ck = -LOG2E / WSCALE, c254 = 254.f; asm volatile("" : "+s"(ck), "+s"(c254));
        typedef float f2 __attribute__((ext_vector_type(2)));
        const int row0 = u.pm * 256 + wr * 64 + fr, col0 = u.pn * 256 + wc * 32 + 8 * fq;
        float rsv[2][4];
#pragma unroll
        for (int ai = 0; ai < 2; ++ai)
#pragma unroll
            for (int m = 0; m < 4; ++m) rsv[ai][m] = rstd2[row0 + ai * 128 + m * 16];
        __builtin_amdgcn_sched_barrier(0);
#pragma unroll
        for (int ai = 0; ai < 2; ++ai)
#pragma unroll
            for (int m = 0; m < 4; ++m) { const float rs = rsv[ai][m] * ck; unsigned char* rowp = G8 + (size_t)(row0 + ai * 128 + m * 16) * 1024 + col0;
#pragma unroll
                for (int bj = 0; bj < 2; ++bj) { v2u w;
#pragma unroll
                    for (int n = 0; n < 2; ++n) { const f32x4 a = acc[ai][bj][m][n]; unsigned b4 = 0u;
#pragma unroll
                        for (int hh = 0; hh < 2; ++hh) { const f2 t = (f2){a[2 * hh], a[2 * hh + 1]} * rs;
                            f2 ex; ex.x = __builtin_amdgcn_exp2f(t.x); ex.y = __builtin_amdgcn_exp2f(t.y); const f2 den = ex + 1.0f;
                            f2 rc; rc.x = __builtin_amdgcn_rcpf(den.x); rc.y = __builtin_amdgcn_rcpf(den.y); const f2 x = rc * c254 + 0.5f;
                            if (hh == 0) { b4 = __builtin_amdgcn_cvt_pk_u8_f32(x.x, 0, b4); b4 = __builtin_amdgcn_cvt_pk_u8_f32(x.y, 1, b4); }
                            else { b4 = __builtin_amdgcn_cvt_pk_u8_f32(x.x, 2, b4); b4 = __builtin_amdgcn_cvt_pk_u8_f32(x.y, 3, b4); } }
                        if (n == 0) w.x = b4; else w.y = b4; }
                    *(v2u*)(rowp + bj * 128) = w; } }
    }
};

__device__ __forceinline__ int moe_setup(Frame& F) {
    LAS int* cnt = (LAS int*)(F.lds + SCH_CNT); LAS int* P = (LAS int*)(F.lds + SCH_P); LAS int* rt2e = (LAS int*)(F.lds + SCH_RT2E);
    if (F.tid < NE) cnt[F.tid] = (int)__hip_atomic_load(((gu32*)(F.ap->ws + WS_CTL)) + CW_CNT + F.tid, RLX_AGENT);
    __syncthreads();
    if (F.tid == 0) { int s = 0; for (int e = 0; e < NE; ++e) { P[e] = s; s += (cnt[e] + 255) >> 8; } P[NE] = s; }
    __syncthreads();
    const int RT = __builtin_amdgcn_readfirstlane(P[NE]);
    for (int t = F.tid; t < RT && t < MAXRT; t += NWAVES * 64) { int e = 0;
#pragma unroll
        for (int k = 1; k <= NE; ++k) e += (P[k] <= t) ? 1 : 0;
        rt2e[t] = e; }
    __syncthreads();
    return RT < MAXRT ? RT : MAXRT;
}
struct MoeOrder {
    pg8::DenseOrder d; LAS const int* P; LAS const int* rt2e; LAS const unsigned* tab;
    const char* Abase; size_t tsA; const char* Bbase; size_t estride, tsB; bool gather;
    __device__ __forceinline__ bool next(int i, Unit& u) const {
        if (!d.tile(i, u.pm, u.pn)) return false;
        const int e = __builtin_amdgcn_readfirstlane(rt2e[u.pm]); u.e = e; u.rtl = u.pm - __builtin_amdgcn_readfirstlane(P[e]);
        u.A = gather ? Abase : Abase + (size_t)u.pm * tsA; u.B = Bbase + (size_t)e * estride + (size_t)u.pn * tsB; return true;
    }
    __device__ __forceinline__ const LAS unsigned char* table(int ui) const { return (const LAS unsigned char*)tab + ui * 1024; }
};

__device__ __forceinline__ void router_pass(Frame& F) {
    LAS float* L = (LAS float*)(F.lds + RING_OFF + F.wave * 2304);
    LAS int* hist = (LAS int*)(F.lds + RING_OFF + 32768); LAS int* hbase = hist + 32;
    if (F.tid < 64) hist[F.tid] = 0;
    __syncthreads();
    const float* X = (F.ap->in[0]); const bf16* MO = WSP(bf16, WS_MO); bf16* MOw = WSP(bf16, WS_MO); unsigned char* HB = WSP(unsigned char, WS_HB); const bf16* wrt = WSP(bf16, WS_WRT);
    const int lane = F.lane, r = lane & 15, q = lane >> 4, tok0 = (int)blockIdx.x * 128 + F.wave * 16, token = tok0 + r;
    pg8::f32x4 acc0 = {0.f, 0.f, 0.f, 0.f}, acc1 = {0.f, 0.f, 0.f, 0.f}; float ss = 0.f;
    const float* hrow = X + (size_t)token * DM + q * 8; const bf16* morow = MO + (size_t)token * DM + q * 8; const bf16* b0p = wrt + (size_t)r * 1024 + q * 8;
    f32x4 xa[2][2][2], ga[2][2][2]; v4u ma[2][2], wa[2][2][4];
#define RT_LOAD(buf, grp) do { _Pragma("unroll") for (int s_ = 0; s_ < 2; ++s_) { const int kk_ = (grp) * 2 + s_; \
        xa[buf][s_][0] = *(const f32x4*)(hrow + kk_ * 32); xa[buf][s_][1] = *(const f32x4*)(hrow + kk_ * 32 + 4); ma[buf][s_] = *(const v4u*)(morow + kk_ * 32); \
        ga[buf][s_][0] = *(const f32x4*)((F.ap->in[9]) + kk_ * 32 + q * 8); ga[buf][s_][1] = *(const f32x4*)((F.ap->in[9]) + kk_ * 32 + q * 8 + 4); \
        wa[buf][s_][0] = *(const v4u*)(b0p + kk_ * 32); wa[buf][s_][1] = *(const v4u*)(b0p + 16 * 1024 + kk_ * 32); wa[buf][s_][2] = *(const v4u*)(b0p + 32768 + kk_ * 32); wa[buf][s_][3] = *(const v4u*)(b0p + 32768 + 16 * 1024 + kk_ * 32); } } while (0)
#define RT_STEP(buf, grp) do { _Pragma("unroll") for (int s_ = 0; s_ < 2; ++s_) { const int kk_ = (grp) * 2 + s_; \
        f32x4 h0 = xa[buf][s_][0], h1 = xa[buf][s_][1]; { f32x4 m0, m1; unpack8(ma[buf][s_], m0, m1); h0 = h0 + m0; h1 = h1 + m1; } \
        ss += (h0[0] * h0[0] + h0[1] * h0[1]) + (h0[2] * h0[2] + h0[3] * h0[3]) + (h1[0] * h1[0] + h1[1] * h1[1]) + (h1[2] * h1[2] + h1[3] * h1[3]); \
        const f32x4 x0 = h0 * ga[buf][s_][0], x1 = h1 * ga[buf][s_][1]; \
        const v4u hi = pack8(x0, x1); f32x4 y0, y1; unpack8(hi, y0, y1); const v4u lo = pack8(x0 - y0, x1 - y1); \
        *(v2u*)(HB + (size_t)token * DM + kk_ * 32 + q * 8) = pack8_fp8(x0, x1); *(v4u*)(MOw + (size_t)token * DM + q * 8 + kk_ * 32) = pack8(h0, h1);     \
        const bf16x8 ah = __builtin_bit_cast(bf16x8, hi), al = __builtin_bit_cast(bf16x8, lo); \
        acc0 = __builtin_amdgcn_mfma_f32_16x16x32_bf16(ah, __builtin_bit_cast(bf16x8, wa[buf][s_][0]), acc0, 0, 0, 0); acc0 = __builtin_amdgcn_mfma_f32_16x16x32_bf16(al, __builtin_bit_cast(bf16x8, wa[buf][s_][0]), acc0, 0, 0, 0); \
        acc0 = __builtin_amdgcn_mfma_f32_16x16x32_bf16(ah, __builtin_bit_cast(bf16x8, wa[buf][s_][2]), acc0, 0, 0, 0); \
        acc1 = __builtin_amdgcn_mfma_f32_16x16x32_bf16(ah, __builtin_bit_cast(bf16x8, wa[buf][s_][1]), acc1, 0, 0, 0); acc1 = __builtin_amdgcn_mfma_f32_16x16x32_bf16(al, __builtin_bit_cast(bf16x8, wa[buf][s_][1]), acc1, 0, 0, 0); \
        acc1 = __builtin_amdgcn_mfma_f32_16x16x32_bf16(ah, __builtin_bit_cast(bf16x8, wa[buf][s_][3]), acc1, 0, 0, 0); } } while (0)
    RT_LOAD(0, 0);
#pragma unroll
    for (int gp = 0; gp < 16; gp += 2) {
        RT_LOAD(1, gp + 1); __builtin_amdgcn_sched_barrier(0); RT_STEP(0, gp); __builtin_amdgcn_sched_barrier(0);
        if (gp + 2 < 16) RT_LOAD(0, gp + 2);
        __builtin_amdgcn_sched_barrier(0); RT_STEP(1, gp + 1); __builtin_amdgcn_sched_barrier(0);
    }
#undef RT_LOAD
#undef RT_STEP
    ss = xor16_sum(ss); ss = xor32_sum(ss);
    const float rstd = 1.f / sqrtf(ss * (1.f / DM) + EPS);
#pragma unroll
    for (int i = 0; i < 4; ++i) { L[(4 * q + i) * 33 + r] = acc0[i]; L[(4 * q + i) * 33 + 16 + r] = acc1[i]; }
    LDS_WAIT(); asm volatile("" ::: "memory");
    int te0 = 0, te1 = 0, te2 = 0, te3 = 0, rk0 = 0, rk1 = 0, rk2 = 0, rk3 = 0; float w0 = 0.f, w1 = 0.f, w2 = 0.f, w3 = 0.f;
    if (lane < 16) {
        float v[32];
#pragma unroll
        for (int e = 0; e < 32; ++e) v[e] = L[lane * 33 + e] * rstd + (F.ap->in[11])[e];
        float tv[4]; int te[4];
#pragma unroll
        for (int k = 0; k < 4; ++k) { float best = v[0]; int bi = 0;
#pragma unroll
            for (int e = 1; e < 32; ++e) if (v[e] > best) { best = v[e]; bi = e; }
            tv[k] = best; te[k] = bi;
#pragma unroll
            for (int e = 0; e < 32; ++e) v[e] = (e == bi) ? -INFINITY : v[e]; }
        const float e1 = expf(tv[1] - tv[0]), e2 = expf(tv[2] - tv[0]), e3 = expf(tv[3] - tv[0]), inv = 1.f / (1.f + e1 + e2 + e3);
        w0 = inv; w1 = e1 * inv; w2 = e2 * inv; w3 = e3 * inv; te0 = te[0]; te1 = te[1]; te2 = te[2]; te3 = te[3];
        rk0 = __hip_atomic_fetch_add(hist + te0, 1, __ATOMIC_RELAXED, __HIP_MEMORY_SCOPE_WORKGROUP); rk1 = __hip_atomic_fetch_add(hist + te1, 1, __ATOMIC_RELAXED, __HIP_MEMORY_SCOPE_WORKGROUP);
        rk2 = __hip_atomic_fetch_add(hist + te2, 1, __ATOMIC_RELAXED, __HIP_MEMORY_SCOPE_WORKGROUP); rk3 = __hip_atomic_fetch_add(hist + te3, 1, __ATOMIC_RELAXED, __HIP_MEMORY_SCOPE_WORKGROUP);
    }
    __syncthreads();
    if (F.tid < NE) hbase[F.tid] = (int)__hip_atomic_fetch_add(((gu32*)(F.ap->ws + WS_CTL)) + CW_CNT + F.tid, (unsigned)hist[F.tid], RLX_AGENT);
    __syncthreads();
    if (lane < 16) {
        int* TOK = WSP(int, WS_TOK); float* RSOF = WSP(float, WS_RSOF); int* TOPE = WSP(int, WS_TOPE); float* TOPW = WSP(float, WS_TOPW); int* POS = WSP(int, WS_POS);
        const int p0 = hbase[te0] + rk0, p1 = hbase[te1] + rk1, p2 = hbase[te2] + rk2, p3 = hbase[te3] + rk3;
        TOK[(size_t)te0 * NT + p0] = token; TOK[(size_t)te1 * NT + p1] = token; TOK[(size_t)te2 * NT + p2] = token; TOK[(size_t)te3 * NT + p3] = token;
        RSOF[(size_t)te0 * NT + p0] = rstd; RSOF[(size_t)te1 * NT + p1] = rstd; RSOF[(size_t)te2 * NT + p2] = rstd; RSOF[(size_t)te3 * NT + p3] = rstd;
        *(int4*)(TOPE + (size_t)token * 4) = make_int4(te0, te1, te2, te3); *(float4*)(TOPW + (size_t)token * 4) = make_float4(w0, w1, w2, w3); *(int4*)(POS + (size_t)token * 4) = make_int4(p0, p1, p2, p3);
    }
    __syncthreads();
}
__device__ __forceinline__ void combine_pass(Frame& F) {
    LAS const int* P = (LAS const int*)(F.lds + SCH_P);
    const unsigned char* Y = WSP(unsigned char, WS_Y); const bf16* MO = WSP(bf16, WS_MO); unsigned char* HB2 = WSP(unsigned char, WS_HB2); float* RSTD2 = WSP(float, WS_RSTD2); bf16* H2B = WSP(bf16, WS_H2B);
    const int* TOPE = WSP(int, WS_TOPE); const float* TOPW = WSP(float, WS_TOPW); const int* POS = WSP(int, WS_POS);
    const int lane = F.lane, tok0 = (int)blockIdx.x * 128 + F.wave * 16;
    int4 te_n[2], tp_n[2]; float4 tw_n[2], tw_c[2]; v4u mc[2][2], mn[2][2]; v2u yc[2][4][2], yn[2][4][2];
#define CB_ROUTE(i) do { _Pragma("unroll") for (int t_ = 0; t_ < 2; ++t_) { te_n[t_] = *(const int4*)(TOPE + (size_t)(tok0 + (i) + t_) * 4); tw_n[t_] = *(const float4*)(TOPW + (size_t)(tok0 + (i) + t_) * 4); tp_n[t_] = *(const int4*)(POS + (size_t)(tok0 + (i) + t_) * 4); } } while (0)
#define CB_DATA(dm, dy, i) do { _Pragma("unroll") for (int t_ = 0; t_ < 2; ++t_) { \
        const size_t s0_ = (size_t)(P[te_n[t_].x] * 256 + tp_n[t_].x) * DM, s1_ = (size_t)(P[te_n[t_].y] * 256 + tp_n[t_].y) * DM, s2_ = (size_t)(P[te_n[t_].z] * 256 + tp_n[t_].z) * DM, s3_ = (size_t)(P[te_n[t_].w] * 256 + tp_n[t_].w) * DM; \
        _Pragma("unroll") for (int j = 0; j < 2; ++j) { const int c = 8 * lane + 512 * j; dm[t_][j] = *(const v4u*)(MO + (size_t)(tok0 + (i) + t_) * DM + c); \
            dy[t_][0][j] = *(const v2u*)(Y + s0_ + c); dy[t_][1][j] = *(const v2u*)(Y + s1_ + c); dy[t_][2][j] = *(const v2u*)(Y + s2_ + c); dy[t_][3][j] = *(const v2u*)(Y + s3_ + c); } } } while (0)
    CB_ROUTE(0); CB_DATA(mc, yc, 0); tw_c[0] = tw_n[0]; tw_c[1] = tw_n[1]; CB_ROUTE(2);
    for (int i = 0; i < 16; i += 2) {
        const float4 tw_x0 = tw_n[0], tw_x1 = tw_n[1];
        if (i + 2 < 16) CB_DATA(mn, yn, i + 2);
        if (i + 4 < 16) CB_ROUTE(i + 4);
        __builtin_amdgcn_sched_barrier(0);
#pragma unroll
        for (int t = 0; t < 2; ++t) { const int token = tok0 + i + t; f32x4 v[2][2]; float ss = 0.f; const float4 tw = tw_c[t] * (1.f / YSCALE);
#pragma unroll
            for (int j = 0; j < 2; ++j) { f32x4 a, b; unpack8(mc[t][j], a, b);
#pragma unroll
                for (int k = 0; k < 4; ++k) { const v2u y = yc[t][k][j]; const float w = k == 0 ? tw.x : k == 1 ? tw.y : k == 2 ? tw.z : tw.w;
                    const auto p0 = __builtin_amdgcn_cvt_pk_f32_fp8((int)y.x, false), p1 = __builtin_amdgcn_cvt_pk_f32_fp8((int)y.x, true), p2 = __builtin_amdgcn_cvt_pk_f32_fp8((int)y.y, false), p3 = __builtin_amdgcn_cvt_pk_f32_fp8((int)y.y, true);
                    a += w * (f32x4){p0[0], p0[1], p1[0], p1[1]}; b += w * (f32x4){p2[0], p2[1], p3[0], p3[1]}; }
                v[j][0] = a; v[j][1] = b;
                ss += ((a.x * a.x + a.y * a.y) + (a.z * a.z + a.w * a.w)) + ((b.x * b.x + b.y * b.y) + (b.z * b.z + b.w * b.w)); }
            const float rstd = 1.f / sqrtf(wave_sum(ss) * (1.f / DM) + EPS);
#pragma unroll
            for (int j = 0; j < 2; ++j) { const int c = 8 * lane + 512 * j; *(v4u*)(H2B + (size_t)token * DM + c) = pack8(v[j][0], v[j][1]);
                const f32x4 g0 = *(const f32x4*)((F.ap->in[16]) + c), g1 = *(const f32x4*)((F.ap->in[16]) + c + 4);
                *(v2u*)(HB2 + (size_t)token * DM + c) = pack8_fp8(v[j][0] * g0, v[j][1] * g1); }
            if (lane == 0) RSTD2[token] = rstd; }
        __builtin_amdgcn_sched_barrier(0);
#pragma unroll
        for (int t = 0; t < 2; ++t)
#pragma unroll
            for (int j = 0; j < 2; ++j) { mc[t][j] = mn[t][j];
#pragma unroll
                for (int k = 0; k < 4; ++k) yc[t][k][j] = yn[t][k][j]; }
        tw_c[0] = tw_x0; tw_c[1] = tw_x1;
    }
#undef CB_ROUTE
#undef CB_DATA
}
__device__ __forceinline__ void final_pass(Frame& F) {
    const bf16* PJ = WSP(bf16, WS_PJ); const bf16* H2B = WSP(bf16, WS_H2B); const unsigned char* G8 = WSP(unsigned char, WS_G8); const int lane = F.lane, tok0 = (int)blockIdx.x * 128 + F.wave * 16;
    v4u hc[2][2], hn[2][2], pc[2][2], pn[2][2]; v2u gc[2][2], gn[2][2];
#define FP_LOAD(hd, pd, gd, i) do { _Pragma("unroll") for (int t_ = 0; t_ < 2; ++t_) _Pragma("unroll") for (int j = 0; j < 2; ++j) { const size_t o_ = (size_t)(tok0 + (i) + t_) * DM + 8 * lane + 512 * j; \
        hd[t_][j] = *(const v4u*)(H2B + o_); pd[t_][j] = *(const v4u*)(PJ + o_); gd[t_][j] = *(const v2u*)(G8 + o_); } } while (0)
    FP_LOAD(hc, pc, gc, 0);
    for (int i = 0; i < 16; i += 2) {
        if (i + 2 < 16) FP_LOAD(hn, pn, gn, i + 2);
        __builtin_amdgcn_sched_barrier(0);
#pragma unroll
        for (int t = 0; t < 2; ++t) { f32x4 v[2][2]; float ss = 0.f;
#pragma unroll
            for (int j = 0; j < 2; ++j) { f32x4 a, b, pa, pb; unpack8(hc[t][j], a, b); unpack8(pc[t][j], pa, pb); const unsigned g0 = gc[t][j].x, g1 = gc[t][j].y;
                const f32x4 ga = {(float)(g0 & 255u), (float)((g0 >> 8) & 255u), (float)((g0 >> 16) & 255u), (float)(g0 >> 24)}, gb = {(float)(g1 & 255u), (float)((g1 >> 8) & 255u), (float)((g1 >> 16) & 255u), (float)(g1 >> 24)};
                a += (ga * (1.f / 254.f)) * pa; b += (gb * (1.f / 254.f)) * pb; v[j][0] = a; v[j][1] = b;
                ss += ((a.x * a.x + a.y * a.y) + (a.z * a.z + a.w * a.w)) + ((b.x * b.x + b.y * b.y) + (b.z * b.z + b.w * b.w)); }
            const float rstd = 1.f / sqrtf(wave_sum(ss) * (1.f / DM) + EPS); float* hr = (F.ap->out) + (size_t)(tok0 + i + t) * DM;
#pragma unroll
            for (int j = 0; j < 2; ++j) { const int c = 8 * lane + 512 * j; const f32x4 g0 = *(const f32x4*)((F.ap->in[19]) + c), g1 = *(const f32x4*)((F.ap->in[19]) + c + 4);
                *(f32x4*)(hr + c) = v[j][0] * rstd * g0; *(f32x4*)(hr + c + 4) = v[j][1] * rstd * g1; } }
        __builtin_amdgcn_sched_barrier(0);
#pragma unroll
        for (int t = 0; t < 2; ++t)
#pragma unroll
            for (int j = 0; j < 2; ++j) { hc[t][j] = hn[t][j]; pc[t][j] = pn[t][j]; gc[t][j] = gn[t][j]; }
    }
#undef FP_LOAD
}

struct PnOffOrder { pg8::DenseOrder d; int off;
    __device__ __forceinline__ bool next(int i, pg8::Unit& u) const { if (!d.next(i, u)) return false; u.pn += off; return true; }
    __device__ __forceinline__ const LAS unsigned char* table(int) const { return nullptr; } };
struct StrideOrder { int start, stride, n; const char* A; const char* B; size_t tsA, tsB;
    __device__ __forceinline__ bool next(int i, pg8::Unit& u) const { const int idx = start + i * stride; if (idx >= n) return false; u.pm = idx >> 2; u.pn = idx & 3; u.A = A + (size_t)u.pm * tsA; u.B = B + (size_t)u.pn * tsB; u.e = 0; u.rtl = 0; return true; }
    __device__ __forceinline__ const LAS unsigned char* table(int) const { return nullptr; } };
constexpr int N_PHASES = 11;

__global__ void __launch_bounds__(NWAVES * 64, 2) fwd(Args args) {
    extern __shared__ __attribute__((aligned(16))) unsigned char lds[];
    Frame F;
    F.lds = (LAS unsigned char*)lds;
    F.MISC = (volatile LAS unsigned*)(F.lds + MISC_OFF);
    F.tid = threadIdx.x; F.lane = F.tid & 63; F.wave = __builtin_amdgcn_readfirstlane(F.tid >> 6);
    F.G = gridDim.x; { const int bx = blockIdx.x; F.vcu = (F.G % 8 == 0) ? (bx % 8) * (F.G / 8) + bx / 8 : bx; }
    REARGS();
    for (int u = F.tid; u < 64; u += NWAVES * 64) ((LAS unsigned*)(F.lds + MISC_OFF))[u] = 0u;
    __syncthreads();
    const bool one = (F.ap->ph_hi - F.ap->ph_lo) > 1;
    XcdBarrier bar; bar.bar = (unsigned*)(((gu32*)(F.ap->ws + WS_CTL)) + CW_BAR); bar.x = 0; bar.st = nullptr;
    if (one) bar = xcd_barrier_post((unsigned*)(((gu32*)(F.ap->ws + WS_CTL)) + CW_BAR), F.MISC + 8, F.tid);
#ifdef ONLY_PHASE
    constexpr int lo = ONLY_PHASE, hi = ONLY_PHASE + 1;
#else
    const int lo = F.ap->ph_lo, hi = F.ap->ph_hi;
#endif
    int cid = (int)blockIdx.x;
#define IN(k) (lo <= (k) && (k) < hi)
#define RELANE() do { int l_ = lane_now(); asm volatile("" : "+v"(l_)); F.lane = l_; F.tid = F.wave * 64 + l_; REARGS(); asm volatile("" : "+s"(cid)); } while (0)
#define GBAR() do { RELANE(); xcd_barrier(bar, F.tid); } while (0)
#define SEAM(k) do { if (IN(k) && IN((k) + 1)) GBAR(); } while (0)
    const int rep_phase = F.ap->rep_phase, rep_mode = F.ap->rep_mode;
#define NREP(k) (((k) == rep_phase) ? 2 : 1)
    LAS unsigned char* ring = F.lds + RING_OFF;

    for (int rep = 0; rep < NREP(0); ++rep) { if (rep) GBAR(); if (IN(0)) { RELANE(); p0_prologue(F); } } SEAM(0);
    for (int rep = 0; rep < NREP(1); ++rep) { if (rep) GBAR(); if (IN(1)) { RELANE();
        if (cid < NBATCH * 8) cum_scan(F, cid);
        { pg8::Gemm g{1024, 1024, 1024}; PnOffOrder S; S.off = 4; S.d.init(NT / 256, 8, F.G, cid, WSP(bf16, WS_XN), (size_t)256 * 1024 * 2, WSP(bf16, WS_W1T), (size_t)256 * 1024 * 2);
          EpiIn E{WSP(bf16, WS_FQ), WSP(bf16, WS_FK), WSP(bf16, WS_FV), WSP(bf16, WS_RQ), WSP(bf16, WS_RK), WSP(bf16, WS_RV), WSP(bf16, WS_RGS), WSP(float, WS_ROT), WSP(bf16, WS_RKT), F.lds + TAB_OFF, (rep == 1 && rep_mode >= 7) ? (rep_mode == 7 ? 1 : rep_mode - 64) : 0};
          pg8::gemm_phase<EpiIn, PnOffOrder, true, false>(ring, g, S, E, F.wave); }
        { RELANE();
          pg8::Gemm g{1024, 1024, 1024}; pg8::DenseOrder S; S.init(NT / 256, 12, F.G, cid, WSP(unsigned char, WS_XN8), (size_t)256 * 1024, WSP(unsigned char, WS_WG8T), (size_t)256 * 1024);
          EpiGate E{WSP(unsigned char, WS_GATES), (F.ap->in[7]), WSP(bf16, WS_FQ), WSP(bf16, WS_FK), (rep == 1 && rep_mode >= 7) ? (rep_mode == 7 ? 1 : rep_mode - 64) : 0};
          pg8::gemm_phase<EpiGate, pg8::DenseOrder, true, false, 1>(ring, g, S, E, F.wave); }
    } } SEAM(1);
    for (int rep = 0; rep < NREP(2); ++rep) { if (rep) GBAR(); if (IN(2)) { RELANE();
        { static_assert(ret_body::LDS_BYTES <= RING_BYTES && attn_body::ATTN_LDS_BYTES <= RING_BYTES, "phase scratch inside the ring");
          volatile LAS int* qn = (volatile LAS int*)(F.MISC + 16);
          const attn_body::bf16* Q = (const attn_body::bf16*)WSP(bf16, WS_FQ); const attn_body::bf16* K = (const attn_body::bf16*)WSP(bf16, WS_FK); const attn_body::bf16* V = (const attn_body::bf16*)WSP(bf16, WS_FV);
          attn_body::bf16* O = (attn_body::bf16*)WSP(bf16, WS_BR);
          if (lane_now() + F.wave * 64 == 0) qn[0] = (int)__hip_atomic_fetch_add(((gu32*)(F.ap->ws + WS_CTL)) + CW_QUEUE + 64 * rep, 1u, RLX_AGENT);
          __syncthreads();
          for (int n = 0;; ++n) {
              const int item = __builtin_amdgcn_readfirstlane(qn[n & 1]);
              if (item >= 64 + 1024 + CONV_CHUNKS) break;
              int nxt_item = 0;
              if (lane_now() + F.wave * 64 == 0) nxt_item = (int)__hip_atomic_fetch_add(((gu32*)(F.ap->ws + WS_CTL)) + CW_QUEUE + 64 * rep, 1u, RLX_AGENT);
              if (item < 64) { const int bh4 = item;
                  ret_body::ret_unit(ring, bh4 >> 2, bh4 & 3, WSP(bf16, WS_RQ), WSP(bf16, WS_RK), WSP(bf16, WS_RV), WSP(bf16, WS_RKT), WSP(bf16, WS_RGS), WSP(bf16, WS_BR), F.wave, 0, 16, 0); }
              else { const int r = item - 64, cb = (int)(((long)r * CONV_CHUNKS) / (1024 + CONV_CHUNKS)), cn = (int)(((long)(r + 1) * CONV_CHUNKS) / (1024 + CONV_CHUNKS));
                  if (cn > cb) { RELANE(); conv_chunk(F, cb); }
                  else { const int k = r - cb, qb = 7 - (k >> 7), bh = k & 127;
                      attn_body::attn_unit<8>(bh >> 3, bh & 7, qb, Q, K, V, O, WSP(float, WS_CUM) + (size_t)bh * SEQ, (char*)lds + RING_OFF, F.wave); } }
              if (lane_now() + F.wave * 64 == 0) qn[(n + 1) & 1] = nxt_item;
              __syncthreads();
          } }
    } } SEAM(2);
    for (int rep = 0; rep < NREP(3); ++rep) { if (rep) GBAR(); if (IN(3)) { RELANE();
        pg8::Gemm g{1024, 1024, 1024}; pg8::DenseOrder S; S.init(NT / 256, 4, F.G, cid, WSP(bf16, WS_BR), (size_t)256 * 1024 * 2, WSP(bf16, WS_WBT), (size_t)256 * 1024 * 2);
        EpiMerge E{WSP(unsigned char, WS_GATES), WSP(bf16, WS_MERGED)}; HookMerge H{WSP(unsigned char, WS_GATES)};
        pg8::gemm_phase<EpiMerge, pg8::DenseOrder, true, false, 2, HookMerge>(ring, g, S, E, F.wave, H);
    } } SEAM(3);
    for (int rep = 0; rep < NREP(4); ++rep) { if (rep) GBAR(); if (IN(4)) { RELANE();
        pg8::Gemm g{1024, 1024, 1024}; pg8::DenseOrder S; S.init(NT / 256, 4, F.G, cid, WSP(bf16, WS_MERGED), (size_t)256 * 1024 * 2, WSP(bf16, WS_WOT), (size_t)256 * 1024 * 2);
        EpiMO E{WSP(bf16, WS_MO)}; pg8::gemm_phase<EpiMO, pg8::DenseOrder, true, false>(ring, g, S, E, F.wave);
    } } SEAM(4);
    for (int rep = 0; rep < NREP(5); ++rep) { if (rep) GBAR(); if (IN(5)) { RELANE(); router_pass(F); } } SEAM(5);
    for (int rep = 0; rep < NREP(6); ++rep) { if (rep) GBAR(); if (IN(6)) { RELANE();
        const int RT = moe_setup(F);
        MoeOrder S; S.d.init(RT, 8, F.G, cid, nullptr, 0, nullptr, 0); S.P = (LAS const int*)(F.lds + SCH_P); S.rt2e = (LAS const int*)(F.lds + SCH_RT2E); S.tab = (LAS const unsigned*)(F.lds + TAB_OFF);
        S.Abase = (const char*)WSP(unsigned char, WS_HB); S.tsA = 0; S.Bbase = (const char*)WSP(unsigned char, WS_WGUT); S.estride = (size_t)2048 * 1024; S.tsB = (size_t)256 * 1024; S.gather = true;
        { LAS const int* cnt = (LAS const int*)(F.lds + SCH_CNT); LAS unsigned* tab = (LAS unsigned*)(F.lds + TAB_OFF); const int* TOK = WSP(int, WS_TOK);
          int tokv[MAXUNITS / 2];
#pragma unroll
          for (int j = 0; j < MAXUNITS / 2; ++j) { const int ui = 2 * j + (F.tid >> 8), r = F.tid & 255; int pm, pn; tokv[j] = -1;
              if (S.d.tile(ui, pm, pn)) { const int e = S.rt2e[pm], pos = (pm - S.P[e]) * 256 + r; tokv[j] = pos < cnt[e] ? TOK[(size_t)e * NT + pos] : NT; } }
#pragma unroll
          for (int j = 0; j < MAXUNITS / 2; ++j) { const int ui = 2 * j + (F.tid >> 8), r = F.tid & 255; if (tokv[j] >= 0) tab[ui * 256 + r] = (unsigned)tokv[j] * 1024u; }
          __syncthreads(); }
        pg8::Gemm g{1024, 1024, 1024};
        EpiGU E{(F.ap->in[13]), WSP(float, WS_RSOF), WSP(unsigned char, WS_ACT)}; pg8::gemm_phase<EpiGU, MoeOrder, true, true, 1>(ring, g, S, E, F.wave);
    } } SEAM(6);
    for (int rep = 0; rep < NREP(7); ++rep) { if (rep) GBAR(); if (IN(7)) { RELANE();
        const int RT = moe_setup(F);
        MoeOrder S; S.d.init(RT, 4, F.G, cid, nullptr, 0, nullptr, 0); S.P = (LAS const int*)(F.lds + SCH_P); S.rt2e = (LAS const int*)(F.lds + SCH_RT2E); S.tab = (LAS const unsigned*)(F.lds + TAB_OFF);
        S.Abase = (const char*)WSP(unsigned char, WS_ACT); S.tsA = (size_t)256 * 1024; S.Bbase = (const char*)WSP(unsigned char, WS_WDT); S.estride = (size_t)1024 * 1024; S.tsB = (size_t)256 * 1024; S.gather = false;
        pg8::Gemm g{1024, 1024, 1024};
        EpiDN E{(F.ap->in[15]), WSP(unsigned char, WS_Y)}; pg8::gemm_phase<EpiDN, MoeOrder, true, false, 1>(ring, g, S, E, F.wave);
        { const int rem = (RT * 4) % F.G, nidle = F.G - rem; const bool tail = 2 * nidle >= F.G;
          if (!tail || cid >= rem) { RELANE(); pg8::Gemm g2{256, 256, 256}; StrideOrder S2; S2.start = tail ? cid - rem : cid; S2.stride = tail ? nidle : F.G; S2.n = (NT / 256) * 4; S2.A = (const char*)WSP(bf16, WS_PB); S2.tsA = (size_t)256 * 256 * 2; S2.B = (const char*)WSP(bf16, WS_WPPT); S2.tsB = (size_t)256 * 256 * 2;
              EpiPJ E2{WSP(bf16, WS_PJ)}; pg8::gemm_phase<EpiPJ, StrideOrder, true, false>(ring, g2, S2, E2, F.wave); } }
    } } SEAM(7);
    for (int rep = 0; rep < NREP(8); ++rep) { if (rep) GBAR(); if (IN(8)) { RELANE(); (void)moe_setup(F); combine_pass(F); } } SEAM(8);
    for (int rep = 0; rep < NREP(9); ++rep) { if (rep) GBAR(); if (IN(9)) { RELANE();
        { pg8::Gemm g{1024, 1024, 1024}; pg8::DenseOrder S; S.init(NT / 256, 4, F.G, cid, WSP(unsigned char, WS_HB2), (size_t)256 * 1024, WSP(unsigned char, WS_WPGT), (size_t)256 * 1024);
          EpiPG E{WSP(unsigned char, WS_G8), WSP(float, WS_RSTD2)}; pg8::gemm_phase<EpiPG, pg8::DenseOrder, true, false, 1>(ring, g, S, E, F.wave); }
    } } SEAM(9);
    if (IN(10)) { RELANE(); final_pass(F); }
#undef IN
#undef SEAM
}

extern "C" void kernel_launch(void* const* d_in, const int* in_sizes, int n_in, void* d_out, int out_size, void* d_ws, size_t ws_size, hipStream_t stream) {
    static int grid = 0;
    if (grid == 0) {
        if (n_in != 20 || in_sizes[0] != NT * DM || out_size != NT * DM || ws_size < WS_END) { fprintf(stderr, "kernel_launch: unexpected shapes / workspace (%zu < %zu); nothing launched\n", ws_size, (size_t)WS_END); grid = -1; return; }
        int dev = 0, cus = 0, per_cu = 0;
        if (hipGetDevice(&dev) != hipSuccess || hipDeviceGetAttribute(&cus, hipDeviceAttributeMultiprocessorCount, dev) != hipSuccess) { grid = -1; return; }
        if (hipFuncSetAttribute((const void*)fwd, hipFuncAttributeMaxDynamicSharedMemorySize, LDS_BYTES) != hipSuccess) { fprintf(stderr, "kernel_launch: hipFuncSetAttribute failed\n"); grid = -1; return; }
        if (hipOccupancyMaxActiveBlocksPerMultiprocessor(&per_cu, (const void*)fwd, NWAVES * 64, LDS_BYTES) != hipSuccess || per_cu < 1) { fprintf(stderr, "kernel_launch: occupancy query reports %d workgroups per CU\n", per_cu); }
        (void)hipGetLastError();
        grid = cus;
        if (grid != 256) { fprintf(stderr, "kernel_launch: built for 256 CUs, found %d; nothing launched\n", cus); grid = -1; return; }
    }
    if (grid < 0) return;
    if (hipMemsetAsync((char*)d_ws + WS_CTL, 0, CTL_ZERO_BYTES, stream) != hipSuccess) return;
    Args a; memset(&a, 0, sizeof a);
    for (int i = 0; i < 20; ++i) a.in[i] = (const float*)d_in[i];
    a.out = (float*)d_out; a.ws = (unsigned char*)d_ws;
#ifndef MK_SPLIT
    a.ph_lo = 0; a.ph_hi = N_PHASES;
#ifdef PROBE_PHASE
    a.rep_phase = PROBE_PHASE; a.rep_mode = PROBE_MODE;
#else
    a.rep_phase = -1; a.rep_mode = 0;
#endif
    hipLaunchKernelGGL(fwd, dim3(grid), dim3(NWAVES * 64), LDS_BYTES, stream, a);
#else
    for (int ph = 0; ph < N_PHASES; ++ph) { a.ph_lo = ph; a.ph_hi = ph + 1; hipLaunchKernelGGL(fwd, dim3(grid), dim3(NWAVES * 64), LDS_BYTES, stream, a); }
#endif
}
```

```cpp
#include <hip/hip_runtime.h>
#include <cstdio>
#include <cstdint>
#include <cstring>
#include <cmath>
__device__ __forceinline__ int lane_now() { int l; asm volatile("v_mbcnt_lo_u32_b32 %0, -1, 0\n\tv_mbcnt_hi_u32_b32 %0, -1, %0" : "=v"(l)); return l; }
namespace pg8 {
#define PG8_LAS __attribute__((address_space(3)))
typedef unsigned short bf16_t;
typedef short bf16x8 __attribute__((ext_vector_type(8)));
typedef float f32x4 __attribute__((ext_vector_type(4)));
typedef float f32x2 __attribute__((ext_vector_type(2)));
typedef unsigned u32x4 __attribute__((ext_vector_type(4)));
typedef unsigned u32x2 __attribute__((ext_vector_type(2)));
constexpr int BM = 256, BK = 64, HALF = 128, HTB = HALF * BK * 2  , STAGE_BYTES = 8 * HTB, NXCD = 8, WGM = 8;

__host__ __device__ __forceinline__ int lds_byte(int r, int c) { const int st = (r >> 4) * 2 + (c >> 5), rr = r & 15, cc = c & 31, ob = rr * 64 + cc * 2; return st * 1024 + (ob ^ (((ob >> 9) & 1) << 5)); }
__host__ __device__ __forceinline__ void stage_rc(int b, int& R, int& C) { const int st = b / 1024, sb = b % 1024, swz = sb ^ (((sb >> 9) & 1) << 5); R = (st >> 1) * 16 + swz / 64; C = (st & 1) * 32 + (swz % 64) / 2; }
__host__ __device__ __forceinline__ int perm32(int rho) { const int n = rho >> 4, i = rho & 15; return 8 * (i >> 2) + 4 * n + (i & 3); }

struct Unit { int pm, pn; const char* A; const char* B; int e, rtl; };
struct Gemm { int lda, ldb, K; };

struct DenseOrder {
    int nM, nN, nwg, G, c; const char* A; const char* B; size_t tsA, tsB;
    __device__ __forceinline__ void init(int nM_, int nN_, int G_, int c_, const void* A_, size_t tsA_, const void* B_, size_t tsB_) { nM = nM_; nN = nN_; nwg = nM * nN; G = G_; c = c_; A = (const char*)A_; B = (const char*)B_; tsA = tsA_; tsB = tsB_; }
    __device__ __forceinline__ bool tile(int i, int& pm, int& pn) const {
        const long L = (long)i * G + c; if (L >= nwg) return false;
        int wgid = (int)L; { const int q = nwg / NXCD, r = nwg % NXCD, xcd = wgid % NXCD, off = wgid / NXCD; wgid = (xcd < r ? xcd * (q + 1) : r * (q + 1) + (xcd - r) * q) + off; }
        const int nig = WGM * nN, gid = wgid / nig, fm = gid * WGM, gsz = (nM - fm) < WGM ? (nM - fm) : WGM;
        pm = fm + ((wgid % nig) % gsz); pn = (wgid % nig) / gsz; return true;
    }
    __device__ __forceinline__ bool next(int i, Unit& u) const { if (!tile(i, u.pm, u.pn)) return false; u.A = A + (size_t)u.pm * tsA; u.B = B + (size_t)u.pn * tsB; u.e = 0; u.rtl = 0; return true; }
    __device__ __forceinline__ const PG8_LAS unsigned char* table(int) const { return nullptr; }
};

__device__ __forceinline__ unsigned cvt_pk_bf16(float lo, float hi) { unsigned r; asm volatile("s_nop 0\n\tv_cvt_pk_bf16_f32 %0, %1, %2" : "=v"(r) : "v"(lo), "v"(hi)); return r; }
__device__ __forceinline__ float bflo(unsigned w) { return __uint_as_float(w << 16); }
__device__ __forceinline__ float bfhi(unsigned w) { return __uint_as_float(w & 0xffff0000u); }
__device__ __forceinline__ float fsigmoid(float x) { return __builtin_amdgcn_rcpf(1.0f + __builtin_amdgcn_exp2f(-1.4426950408889634f * x)); }

__device__ __forceinline__ const char* uni_ptr(const char* p) { const unsigned long long v = (unsigned long long)p; const unsigned lo = __builtin_amdgcn_readfirstlane((unsigned)v), hi = __builtin_amdgcn_readfirstlane((unsigned)(v >> 32)); return (const char*)(((unsigned long long)hi << 32) | lo); }
__device__ __forceinline__ void uni_unit(Unit& u) { u.pm = __builtin_amdgcn_readfirstlane(u.pm); u.pn = __builtin_amdgcn_readfirstlane(u.pn); u.e = __builtin_amdgcn_readfirstlane(u.e); u.rtl = __builtin_amdgcn_readfirstlane(u.rtl); u.A = uni_ptr(u.A); u.B = uni_ptr(u.B); }
struct NoHook { static constexpr bool ON = false; static constexpr int AT = -1; template <class A> __device__ __forceinline__ void operator()(A&, const Unit&, int, int, int, int) const {} };
template <class Epi, class Sched, bool ALIGN_EPI, bool GATHER, int ES = 2, class Hook = NoHook>
__device__ __forceinline__ void gemm_phase(PG8_LAS unsigned char* lds, const Gemm g, const Sched& S, const Epi& E, int wave, const Hook& H = Hook()) {
    int tid = wave * 64 + lane_now(); asm volatile("" : "+v"(tid));
    const int wid = __builtin_amdgcn_readfirstlane(tid >> 6), lane = tid & 63, wr = wid >> 2, wc = wid & 3, fr = lane & 15, fq = lane >> 4;
    const int K = g.K, nt = K * ES / (BK * 2);
    unsigned voffA[2], voffB[2];
#pragma unroll
    for (int i = 0; i < 2; ++i) { int R, C; stage_rc(tid * 16 + i * 8192, R, C); const int Rb = Epi::PERM ? ((R & ~31) + perm32(R & 31)) : R;
        voffA[i] = (unsigned)(R * g.lda * ES + C * 2); voffB[i] = (unsigned)(Rb * g.ldb * ES + C * 2); }
    const size_t kstep = (size_t)(BK * 2);
    const size_t hstepA = GATHER ? (size_t)0 : (size_t)HALF * g.lda * ES;
    const size_t hstepB = (size_t)HALF * g.ldb * ES;
    const unsigned ldsw = (unsigned)wid * 1024u;
    const int aoff = lds_byte(wr * 64 + fr, fq * 8), boff = lds_byte(wc * 32 + fr, fq * 8);
    unsigned vA[2][2], nvA[2][2];
#define PG8_ROWS(dst, uidx) do { int t_ = wave * 64 + lane_now(); asm volatile("" : "+v"(t_)); int R0_, C0_; stage_rc(t_ * 16, R0_, C0_); \
        const PG8_LAS unsigned char* _t = S.table(uidx) + (unsigned)R0_ * 4u; const unsigned c2_ = (unsigned)C0_ * 2u; _Pragma("unroll") for (int h = 0; h < 2; ++h) _Pragma("unroll") for (int i = 0; i < 2; ++i) \
        dst[h][i] = *(const PG8_LAS unsigned*)(_t + h * 512 + i * 256) + c2_; } while (0)
#define PG8_SA(b, h) (((b) * 2 + (h)) * HTB)
#define PG8_SB(b, h) ((4 + (b) * 2 + (h)) * HTB)
#define PG8_STAGE(bufoff, gbase, voff) do { const char* _gb = (const char*)(gbase); asm volatile("" : "+s"(_gb));     \
        _Pragma("unroll") for (int _i = 0; _i < 2; ++_i) { const unsigned _la = (unsigned)__builtin_amdgcn_readfirstlane((int)(unsigned)(uintptr_t)(lds + (bufoff) + ldsw + _i * 8192)); \
            asm volatile("s_mov_b32 m0, %2\n\ts_nop 0\n\tglobal_load_lds_dwordx4 %0, %1" :: "v"((voff)[_i]), "s"(_gb), "s"(_la) : "memory", "m0"); } } while (0)
#define PG8_STB(b, h, ptr) PG8_STAGE(PG8_SB(b, h), (ptr) + (h) * hstepB, voffB)
#define PG8_STA(b, h, ptr, nx) do { if constexpr (GATHER) { unsigned _v[2]; _v[0] = (nx) ? nvA[h][0] : vA[h][0]; _v[1] = (nx) ? nvA[h][1] : vA[h][1]; PG8_STAGE(PG8_SA(b, h), (ptr), _v); } \
        else { PG8_STAGE(PG8_SA(b, h), (ptr) + (h) * hstepA, voffA); } } while (0)
#define PG8_LDA(dst, b, h) do { _Pragma("unroll") for (int m = 0; m < 4; ++m) _Pragma("unroll") for (int k = 0; k < 2; ++k) dst[m][k] = *(const PG8_LAS bf16x8*)(lds + PG8_SA(b, h) + aoff + m * 2048 + k * 1024); } while (0)
#define PG8_LDB(dst, b, h) do { _Pragma("unroll") for (int n = 0; n < 2; ++n) _Pragma("unroll") for (int k = 0; k < 2; ++k) dst[n][k] = *(const PG8_LAS bf16x8*)(lds + PG8_SB(b, h) + boff + n * 2048 + k * 1024); } while (0)
#define PG8_MMA(ai, bj, At, Bt, Z) do { const f32x4 z4_ = {0.f, 0.f, 0.f, 0.f}; __builtin_amdgcn_s_setprio(1); _Pragma("unroll") for (int m = 0; m < 4; ++m) _Pragma("unroll") for (int n = 0; n < 2; ++n) { \
        if constexpr (ES == 2) { acc[ai][bj][m][n] = __builtin_amdgcn_mfma_f32_16x16x32_bf16(Bt[n][0], At[m][0], (Z) ? z4_ : acc[ai][bj][m][n], 0, 0, 0); acc[ai][bj][m][n] = __builtin_amdgcn_mfma_f32_16x16x32_bf16(Bt[n][1], At[m][1], acc[ai][bj][m][n], 0, 0, 0); } \
        else { typedef int v8i_ __attribute__((ext_vector_type(8))); const u32x4 b0_ = __builtin_bit_cast(u32x4, Bt[n][0]), b1_ = __builtin_bit_cast(u32x4, Bt[n][1]), a0_ = __builtin_bit_cast(u32x4, At[m][0]), a1_ = __builtin_bit_cast(u32x4, At[m][1]); \
            const v8i_ bv_ = {(int)b0_[0], (int)b0_[1], (int)b0_[2], (int)b0_[3], (int)b1_[0], (int)b1_[1], (int)b1_[2], (int)b1_[3]}, av_ = {(int)a0_[0], (int)a0_[1], (int)a0_[2], (int)a0_[3], (int)a1_[0], (int)a1_[1], (int)a1_[2], (int)a1_[3]}; \
            acc[ai][bj][m][n] = __builtin_amdgcn_mfma_scale_f32_16x16x128_f8f6f4(bv_, av_, (Z) ? z4_ : acc[ai][bj][m][n], 0, 0, 0, 0, 0, 0); } }     \
        __builtin_amdgcn_s_setprio(0); \
        _Pragma("unroll") for (int m = 0; m < 4; ++m) asm volatile("" : "+v"(acc[ai][bj][m][0]), "+v"(acc[ai][bj][m][1]));     \
        } while (0)
#define PG8_WAIT_V(n) asm volatile("s_waitcnt vmcnt(" #n ")" ::: "memory")
#define PG8_WAIT_L(n) asm volatile("s_waitcnt lgkmcnt(" #n ")" ::: "memory")
#define PG8_BAR __builtin_amdgcn_s_barrier()
#define PG8_SCHED __builtin_amdgcn_sched_barrier(0)
    Unit cur, nxt; int ui = 0;
    if (!S.next(0, cur)) return;
    uni_unit(cur);
    f32x4 acc[2][2][4][2];
    bf16x8 At[4][2], B0[2][2], B1[2][2];
    const char* cA = cur.A; const char* cB = cur.B;
    if constexpr (GATHER) { PG8_ROWS(vA, 0); }
    PG8_STB(0, 0, cB); PG8_STB(0, 1, cB); PG8_STA(0, 0, cA, false); PG8_STA(0, 1, cA, false);
    if (wr == 1) PG8_BAR;
    PG8_WAIT_V(2); PG8_BAR;
    PG8_STB(1, 0, cB + kstep); PG8_STA(1, 0, cA + kstep, false); PG8_STB(1, 1, cB + kstep);
    PG8_WAIT_V(6); PG8_BAR;
    for (;;) {
        const bool has_next = S.next(ui + 1, nxt);
        if (has_next) uni_unit(nxt);
        const char* nA = has_next ? nxt.A : cA; const char* nB = has_next ? nxt.B : cB;
#define PG8_KPAIR(t, LAST, ZERO) do { \
            const char* a1 = cA + (size_t)((t) + 1) * kstep; \
            const char* a2 = (LAST) ? nA : cA + (size_t)((t) + 2) * kstep; const char* b2 = (LAST) ? nB : cB + (size_t)((t) + 2) * kstep; \
            const char* a3 = a2 + kstep; const char* b3 = b2 + kstep; \
              \
            PG8_LDB(B0, 0, 0); PG8_LDB(B1, 0, 1); PG8_SCHED; PG8_LDA(At, 0, 0); PG8_STA(1, 1, a1, false); \
            PG8_WAIT_V(8); PG8_WAIT_L(0); PG8_BAR; PG8_MMA(0, 0, At, B0, ZERO); PG8_MMA(0, 1, At, B1, ZERO); PG8_BAR; PG8_SCHED; \
              \
            PG8_LDA(At, 0, 1); PG8_STB(0, 0, b2); PG8_STB(0, 1, b2); PG8_STA(0, 0, a2, LAST); \
            PG8_WAIT_V(8); PG8_WAIT_L(0); PG8_BAR; PG8_MMA(1, 0, At, B0, ZERO); PG8_MMA(1, 1, At, B1, ZERO); PG8_BAR; PG8_SCHED; \
              \
            PG8_LDB(B0, 1, 0); PG8_LDB(B1, 1, 1); PG8_SCHED; PG8_LDA(At, 1, 0); PG8_STA(0, 1, a2, LAST); \
            PG8_WAIT_V(8); PG8_WAIT_L(0); PG8_BAR; PG8_MMA(0, 0, At, B0, false); PG8_MMA(0, 1, At, B1, false); PG8_BAR; PG8_SCHED; \
              \
            PG8_LDA(At, 1, 1); PG8_STB(1, 0, b3); PG8_STB(1, 1, b3); PG8_STA(1, 0, a3, LAST); \
            PG8_WAIT_V(8); PG8_WAIT_L(0); PG8_BAR; PG8_MMA(1, 0, At, B0, false); PG8_MMA(1, 1, At, B1, false); PG8_BAR; PG8_SCHED; } while (0)
        PG8_KPAIR(0, false, true);
        _Pragma("nounroll") for (int t = 2; t < nt - 2; t += 2) { PG8_KPAIR(t, false, false); if constexpr (Hook::ON) { if (t == Hook::AT) H(acc, cur, wr, wc, fr, fq); } }
        if constexpr (GATHER) {
            if (has_next) { PG8_ROWS(nvA, ui + 1); }
            else {
#pragma unroll
                for (int h = 0; h < 2; ++h)
#pragma unroll
                    for (int i = 0; i < 2; ++i) nvA[h][i] = vA[h][i]; }
        }
        PG8_KPAIR(nt - 2, true, false);
#undef PG8_KPAIR
        if constexpr (ALIGN_EPI) { if (wr == 0) PG8_BAR; }
        E(acc, cur, wr, wc, fr, fq);
        if (!has_next) break;
        cur = nxt; cA = nA; cB = nB; ++ui;
        if constexpr (GATHER) {
#pragma unroll
            for (int h = 0; h < 2; ++h)
#pragma unroll
                for (int i = 0; i < 2; ++i) vA[h][i] = nvA[h][i];
        }
        if constexpr (ALIGN_EPI) { if (wr == 1) PG8_BAR; }
    }
    PG8_WAIT_V(0);
    if constexpr (!ALIGN_EPI) { if (wr == 0) PG8_BAR; }
    PG8_BAR;
#undef PG8_SA
#undef PG8_SB
#undef PG8_STAGE
#undef PG8_STB
#undef PG8_ROWS
#undef PG8_STA
#undef PG8_LDA
#undef PG8_LDB
#undef PG8_MMA
#undef PG8_WAIT_V
#undef PG8_WAIT_L
#undef PG8_BAR
#undef PG8_SCHED
}
}

constexpr int NWAVES = 8;
constexpr int NT = 32768, DM = 1024, SEQ = 2048, NBATCH = 16, INW = 3080, NE = 32, PLE = 256;
constexpr float EPS = 1e-6f;
constexpr float LOG2E = 1.4426950408889634f;
constexpr float C2 = 0.125f * 1.4426950408889634f;
constexpr int N1 = 5120;
constexpr int MAXRT = 576;
constexpr int MAXUNITS = 24;

constexpr size_t MiB = 1u << 20;
constexpr size_t WS_CTL = 0, CTL_ZERO_BYTES = 1 * MiB;
constexpr size_t WS_TOK = 2 * MiB;
constexpr size_t WS_RSOF = 6 * MiB;
constexpr size_t WS_TOPE = 10 * MiB;
constexpr size_t WS_TOPW = 10 * MiB + 512 * 1024;
constexpr size_t WS_POS = 11 * MiB;
constexpr size_t WS_LOGF = 12 * MiB;
constexpr size_t WS_CUM = 13 * MiB;
constexpr size_t WS_ROT = 14 * MiB;
constexpr size_t WS_RSTD2 = 14 * MiB + 512 * 1024;
constexpr size_t WS_WRT = 15 * MiB;
constexpr size_t WS_W1T = 16 * MiB;
constexpr size_t WS_WBT = 26 * MiB;
constexpr size_t WS_WOT = 28 * MiB;
constexpr size_t WS_WPGT = 30 * MiB;
constexpr size_t WS_WPPT = 32 * MiB;
constexpr size_t WS_WGUT = 34 * MiB;
constexpr size_t WS_WDT = 162 * MiB;
constexpr size_t WS_HB = 226 * MiB;
constexpr size_t WS_PB = 291 * MiB;
constexpr size_t WS_Z = 307 * MiB;
constexpr size_t WS_XN = WS_Z, WS_FQ = WS_Z + 64 * MiB, WS_FK = WS_Z + 96 * MiB, WS_FV = WS_Z + 128 * MiB, WS_RQ = WS_Z + 160 * MiB, WS_RK = WS_Z + 176 * MiB;
constexpr size_t WS_RV = WS_Z + 192 * MiB, WS_RGS = WS_Z + 224 * MiB, WS_GATES = WS_Z + 256 * MiB, WS_BR = WS_Z + 384 * MiB, WS_MERGED = WS_Z + 448 * MiB;
constexpr size_t WS_RKT = WS_Z + 512 * MiB;
constexpr size_t WS_XN8 = WS_Z + 528 * MiB;
constexpr size_t WS_WG8T = WS_W1T + 4 * MiB;
constexpr size_t WS_H2B = WS_Z + 448 * MiB;
constexpr size_t WS_MO = WS_Z + 512 * MiB;
constexpr size_t WS_ACT = WS_Z, WS_Y = WS_Z + 144 * MiB;
constexpr size_t WS_HB2 = WS_Z, WS_PJ = WS_Z + 384 * MiB, WS_G8 = WS_Z + 160 * MiB;
constexpr size_t WS_END = WS_Z + 576 * MiB;
constexpr int CW_BAR = 4096;
constexpr int CW_CNT = 8192;
constexpr int CW_QUEUE = 8256;
constexpr int CW_SSQ = 16384;
static_assert((CW_SSQ + NT) * 4 <= (int)CTL_ZERO_BYTES, "CTL words inside the memset region");

constexpr int RING_OFF = 0, RING_BYTES = 131072;
constexpr int TAB_OFF = RING_BYTES;
constexpr int SCH_OFF = TAB_OFF + MAXUNITS * 1024;
constexpr int SCH_CNT = SCH_OFF, SCH_P = SCH_OFF + 128, SCH_RT2E = SCH_OFF + 128 + 160;
constexpr int MISC_OFF = SCH_RT2E + MAXRT * 4;
constexpr int LDS_BYTES = 163840;
static_assert(MISC_OFF + 256 <= LDS_BYTES && (MISC_OFF % 16) == 0, "LDS map");

#define GAS __attribute__((address_space(1)))
#define LAS __attribute__((address_space(3)))
typedef unsigned short bf16;
typedef unsigned v4u __attribute__((ext_vector_type(4)));
typedef unsigned v2u __attribute__((ext_vector_type(2)));
typedef float f32x4 __attribute__((ext_vector_type(4)));
typedef short bf16x8 __attribute__((ext_vector_type(8)));
typedef GAS unsigned gu32;
#define RLX_AGENT __ATOMIC_RELAXED, __HIP_MEMORY_SCOPE_AGENT
#define LDS_WAIT() asm volatile("s_waitcnt lgkmcnt(0)" ::: "memory")
#define VM_WAIT() asm volatile("s_waitcnt vmcnt(0)" ::: "memory")
__device__ __forceinline__ unsigned f2bf(float f) { unsigned u = __builtin_bit_cast(unsigned, f); return (u + 0x7fffu + ((u >> 16) & 1u)) >> 16; }
__device__ __forceinline__ unsigned pk2(float lo, float hi) { return f2bf(lo) | (f2bf(hi) << 16); }
using pg8::bflo; using pg8::bfhi; using pg8::fsigmoid; using pg8::cvt_pk_bf16;
constexpr float WSCALE = 32.f;
constexpr float YSCALE = 8.f;
__device__ __forceinline__ float clamp_f8(float v) { return fminf(fmaxf(v, -448.f), 448.f); }
__device__ __forceinline__ v2u pack8_fp8(const f32x4 a, const f32x4 b) {
    int w0 = 0, w1 = 0;
    w0 = __builtin_amdgcn_cvt_pk_fp8_f32(clamp_f8(a[0]), clamp_f8(a[1]), w0, false); w0 = __builtin_amdgcn_cvt_pk_fp8_f32(clamp_f8(a[2]), clamp_f8(a[3]), w0, true);
    w1 = __builtin_amdgcn_cvt_pk_fp8_f32(clamp_f8(b[0]), clamp_f8(b[1]), w1, false); w1 = __builtin_amdgcn_cvt_pk_fp8_f32(clamp_f8(b[2]), clamp_f8(b[3]), w1, true);
    return (v2u){(unsigned)w0, (unsigned)w1}; }
#define DPP_F(v, ctrl) __int_as_float(__builtin_amdgcn_update_dpp(0, __float_as_int(v), (ctrl), 0xF, 0xF, false))
__device__ __forceinline__ float wave_sum(float v) {
    v += DPP_F(v, 0xB1); v += DPP_F(v, 0x4E); v += DPP_F(v, 0x141); v += DPP_F(v, 0x140);
    const int b = __float_as_int(v);
    return (__int_as_float(__builtin_amdgcn_readlane(b, 0)) + __int_as_float(__builtin_amdgcn_readlane(b, 16))) + (__int_as_float(__builtin_amdgcn_readlane(b, 32)) + __int_as_float(__builtin_amdgcn_readlane(b, 48)));
}
__device__ __forceinline__ float xor32_sum(float v) { auto rr = __builtin_amdgcn_permlane32_swap(__float_as_uint(v), __float_as_uint(v), false, false); return __uint_as_float(rr[0]) + __uint_as_float(rr[1]); }
__device__ __forceinline__ float xor16_sum(float v) { auto rr = __builtin_amdgcn_permlane16_swap(__float_as_uint(v), __float_as_uint(v), false, false); return __uint_as_float(rr[0]) + __uint_as_float(rr[1]); }

#define XB_TMO      128
#define XB_XCNT(j)  (256  + 64 * (j))
#define XB_XSUB(j)  (1280 + 64 * (j))
#define XB_XGEN(j)  (2304 + 64 * (j))
#define XB_TOP      3328
#define XB_TOPGEN   3392
#define XCD_BAR_WORDS 3456
#define XB_SPIN_CAP (1u << 20)

__device__ __forceinline__ unsigned xb_ld(unsigned* p)              { return __hip_atomic_load(p, __ATOMIC_RELAXED, __HIP_MEMORY_SCOPE_AGENT); }
__device__ __forceinline__ unsigned xb_add(unsigned* p, unsigned v) { return __hip_atomic_fetch_add(p, v, __ATOMIC_RELAXED, __HIP_MEMORY_SCOPE_AGENT); }
__device__ __forceinline__ unsigned xb_xcc_id() { return (unsigned)__builtin_amdgcn_s_getreg((3 << 11) | 20) & 0xFu; }
#define XB_SPIN(cond, bar) do { unsigned _sp = 0; while (cond) { __builtin_amdgcn_s_sleep(1); \
    if ((++_sp & 255u) == 0u) { if (xb_ld(&(bar)[XB_TMO])) break; if (_sp > XB_SPIN_CAP) { atomicAdd(&(bar)[XB_TMO], 1u); break; } } } } while (0)

struct XcdBarrier {
    unsigned* bar; unsigned x;
    volatile LAS unsigned* st;
};
__device__ __forceinline__ XcdBarrier xcd_barrier_post(unsigned* bar, volatile LAS unsigned* st, int tid) {
    XcdBarrier b; b.bar = bar; b.x = xb_xcc_id(); b.st = st;
    if (tid == 0) (void)xb_add(&bar[XB_XCNT(b.x)], 1u);
    return b;
}
__device__ __forceinline__ void xcd_barrier_complete(unsigned* bar, unsigned x, unsigned& nloc, unsigned& nx) {
    const unsigned G = gridDim.x * gridDim.y * gridDim.z;
    unsigned sum, cnt, mine, sp = 0u;
    for (;;) {
        sum = 0u; cnt = 0u; mine = 0u;
#pragma unroll
        for (unsigned j = 0; j < 16; ++j) { const unsigned c = xb_ld(&bar[XB_XCNT(j)]); sum += c; cnt += (c > 0u) ? 1u : 0u; mine = (j == x) ? c : mine; }
        if (sum == G) break;
        __builtin_amdgcn_s_sleep(1);
        if ((++sp & 255u) == 0u) { if (xb_ld(&bar[XB_TMO])) break; if (sp > XB_SPIN_CAP) { atomicAdd(&bar[XB_TMO], 1u); break; } }
    }
    nloc = mine > 0u ? mine : 1u; nx = cnt > 0u ? cnt : 1u;
}
__device__ __forceinline__ void xcd_barrier(const XcdBarrier& b, int tid) {
    asm volatile("s_waitcnt vmcnt(0)" ::: "memory");
    __syncthreads();
    if (tid == 0) {
        unsigned* bar = b.bar;
        __builtin_amdgcn_s_waitcnt(0);
        unsigned nloc = b.st[0], nx = b.st[1];
        if (nloc == 0u) { xcd_barrier_complete(bar, b.x, nloc, nx); b.st[0] = nloc; b.st[1] = nx; }
        const unsigned old = xb_add(&bar[XB_XSUB(b.x)], 1u);
        const unsigned gen = old / nloc;
        if (old + 1u == (gen + 1u) * nloc) {
            __builtin_amdgcn_fence(__ATOMIC_RELEASE, "agent");
            asm volatile("s_waitcnt vmcnt(0)" ::: "memory");
            const unsigned og = xb_add(&bar[XB_TOP], 1u);
            const unsigned tg = og / nx;
            if (og + 1u == (tg + 1u) * nx) xb_add(&bar[XB_TOPGEN], 1u);
            else XB_SPIN(xb_ld(&bar[XB_TOPGEN]) == tg, bar);
            __builtin_amdgcn_fence(__ATOMIC_ACQUIRE, "agent");
            xb_add(&bar[XB_XGEN(b.x)], 1u);
            asm volatile("s_waitcnt vmcnt(0)" ::: "memory");
        } else {
            XB_SPIN(xb_ld(&bar[XB_XGEN(b.x)]) == gen, bar);
            __builtin_amdgcn_fence(__ATOMIC_ACQUIRE, "agent");
            asm volatile("s_waitcnt vmcnt(0)" ::: "memory");
        }
    }
    __syncthreads();
}

struct Args { const float* in[20]; float* out; unsigned char* ws; int ph_lo, ph_hi, rep_phase, rep_mode; };
struct Frame {
    LAS unsigned char* lds;
    volatile LAS unsigned* MISC;
    int tid, lane, wave;
    int vcu, G;
    const __attribute__((address_space(4))) Args* ap;
};
#define REARGS() do { F.ap = (const __attribute__((address_space(4))) Args*)__builtin_amdgcn_kernarg_segment_ptr(); asm volatile("" : "+s"(F.ap)); } while (0)
#define WSP(T, off) ((T*)(F.ap->ws + (off)))

#include <hip/hip_bf16.h>
namespace attn_body {
using bf16=__hip_bfloat16;
using bf16x8=__attribute__((ext_vector_type(8)))short;
using s16x4=__attribute__((ext_vector_type(4)))short;
using f32x16=__attribute__((ext_vector_type(16)))float;
using u32x4=__attribute__((ext_vector_type(4)))unsigned;
constexpr int BATCH=16,NHEAD=8,SEQ=2048,D=64,DM=NHEAD*D,OPITCH=1024;
constexpr int NW=8,QBLK=32,QB=QBLK*NW,KVBLK=64,NQB=SEQ/QB;
constexpr int ATTN_PITCH=DM, ATTN_UNIT_ROWS=QB;
__device__ __forceinline__ int crow(int r,int hi){return (r&3)+8*(r>>2)+4*hi;}
#define SBAR() __builtin_amdgcn_sched_barrier(0)
__device__ __forceinline__ void cmask(f32x16&p0,f32x16&p1,int jb,int qrel,int hi){
  const float NEG=-INFINITY; int kb=64*jb+4*hi;
  #pragma unroll
  for(int r=0;r<16;++r){int kv=kb+(r&3)+8*(r>>2); if(kv>qrel)p0[r]=NEG; if(kv+32>qrel)p1[r]=NEG;}
}

constexpr int NSLOT=3, SLOTB=8192;
constexpr int LDS_K=0, LDS_V=NSLOT*SLOTB, LDS_WS=2*NSLOT*SLOTB, LDS_OST=LDS_WS+NW*64*4, LDS_KB=LDS_OST+NW*4096, LDS_BYTES=LDS_KB+SEQ*16;
constexpr float C2=0.125f*1.4426950408889634f;
__device__ __forceinline__ void glds16(const void*gsrc,unsigned lds_dst){unsigned keep;
  asm volatile("s_mov_b32 %0, m0\n\ts_mov_b32 m0, %2\n\ts_nop 0\n\tglobal_load_lds_dwordx4 %1, off\n\ts_mov_b32 m0, %0":"=&s"(keep):"v"(gsrc),"s"(lds_dst):"memory");}
__device__ __forceinline__ float max3f(float a,float b,float c){float r;asm("v_max3_f32 %0, %1, %2, %3":"=v"(r):"v"(a),"v"(b),"v"(c));return r;}
__device__ __forceinline__ float max2f(float a,float b){float r;asm("v_max_f32_e32 %0, %1, %2":"=v"(r):"v"(a),"v"(b));return r;}
__device__ __forceinline__ float fadd_s(float a,float b){float r;asm("v_add_f32_e32 %0, %1, %2":"=v"(r):"v"(a),"v"(b));return r;}
__device__ __forceinline__ float fsub_s(float a,float b){float r;asm("v_sub_f32_e32 %0, %1, %2":"=v"(r):"v"(a),"v"(b));return r;}
typedef float f32x2_t __attribute__((ext_vector_type(2))); typedef __bf16 bf16x2_t __attribute__((ext_vector_type(2)));
__device__ __forceinline__ unsigned cvtpk_s(float lo,float hi){f32x2_t v={lo,hi};bf16x2_t b=__builtin_convertvector(v,bf16x2_t);return __builtin_bit_cast(unsigned,b);}
#define WAIT_BAR(N) asm volatile("s_waitcnt vmcnt(" #N ") lgkmcnt(0)\n\ts_barrier":::"memory")

__device__ __forceinline__ void qkt(f32x16&p0,f32x16&p1,const char*Kslot,const bf16x8*qr,const bf16x8 qx,const bf16x8 kb0,const bf16x8 kb1,int r32,int hi){
  const f32x16 zc=f32x16{};
  const char*kb=Kslot+hi*1024+r32*16;
  #pragma unroll
  for(int d0=0;d0<4;++d0){
    const bf16x8 b0=*reinterpret_cast<const bf16x8*>(kb+d0*2048);
    const bf16x8 b1=*reinterpret_cast<const bf16x8*>(kb+d0*2048+512);
    if(d0==0){p0=__builtin_amdgcn_mfma_f32_32x32x16_bf16(b0,qr[0],zc,0,0,0);p1=__builtin_amdgcn_mfma_f32_32x32x16_bf16(b1,qr[0],zc,0,0,0);}
    else{p0=__builtin_amdgcn_mfma_f32_32x32x16_bf16(b0,qr[d0],p0,0,0,0);p1=__builtin_amdgcn_mfma_f32_32x32x16_bf16(b1,qr[d0],p1,0,0,0);}}
  p0=__builtin_amdgcn_mfma_f32_32x32x16_bf16(kb0,qx,p0,0,0,0);p1=__builtin_amdgcn_mfma_f32_32x32x16_bf16(kb1,qx,p1,0,0,0);
}
typedef __attribute__((address_space(3))) const char* lds_cptr;
typedef short v4i16_t __attribute__((ext_vector_type(4)));
__device__ __forceinline__ void kload8(bf16x8*kf,lds_cptr kp){
  kf[0]=*(const __attribute__((address_space(3))) bf16x8*)(kp);      kf[1]=*(const __attribute__((address_space(3))) bf16x8*)(kp+512);
  kf[2]=*(const __attribute__((address_space(3))) bf16x8*)(kp+2048); kf[3]=*(const __attribute__((address_space(3))) bf16x8*)(kp+2560);
  kf[4]=*(const __attribute__((address_space(3))) bf16x8*)(kp+4096); kf[5]=*(const __attribute__((address_space(3))) bf16x8*)(kp+4608);
  kf[6]=*(const __attribute__((address_space(3))) bf16x8*)(kp+6144); kf[7]=*(const __attribute__((address_space(3))) bf16x8*)(kp+6656);
}
__device__ __forceinline__ void kload2(bf16x8*kf,lds_cptr kp,int j){ kf[2*j]=*(const __attribute__((address_space(3))) bf16x8*)(kp+j*2048); kf[2*j+1]=*(const __attribute__((address_space(3))) bf16x8*)(kp+j*2048+512); }
__device__ __forceinline__ s16x4 vtr(lds_cptr p){ return __builtin_bit_cast(s16x4,__builtin_amdgcn_ds_read_tr16_b64_v4i16((__attribute__((address_space(3))) v4i16_t*)p)); }
__device__ __forceinline__ float rowmax(const f32x16&p0,const f32x16&p1){
  float a=max3f(p0[0],p0[1],p1[0]),b=max3f(p0[2],p0[3],p1[1]);a=max3f(a,p1[2],p1[3]);
  #pragma unroll
  for(int r=4;r<16;r+=4){a=max3f(a,p0[r],p0[r+1]);b=max3f(b,p0[r+2],p0[r+3]);a=max3f(a,p1[r],p1[r+1]);b=max3f(b,p1[r+2],p1[r+3]);}
  const float m=max2f(a,b);
  auto rr=__builtin_amdgcn_permlane32_swap(__float_as_uint(m),__float_as_uint(m),false,false);
  return max2f(__uint_as_float(rr[0]),__uint_as_float(rr[1]));
}
__device__ __forceinline__ void pv(f32x16*o,int vb,bf16x8 pa0,bf16x8 pa1,bf16x8 pa2,bf16x8 pa3){
  #pragma unroll
  for(int d0=0;d0<2;++d0){s16x4 lo[4],hi[4];
    #pragma unroll
    for(int ks=0;ks<4;++ks){
      asm volatile("ds_read_b64_tr_b16 %0,%1 offset:%c2":"=&v"(lo[ks]):"v"(vb),"i"(d0*4096+ks*1024):"memory");
      asm volatile("ds_read_b64_tr_b16 %0,%1 offset:%c2":"=&v"(hi[ks]):"v"(vb),"i"(d0*4096+ks*1024+512):"memory");}
    asm volatile("s_waitcnt lgkmcnt(0)":::"memory");SBAR();
    #define PK(k) (bf16x8){lo[k][0],lo[k][1],lo[k][2],lo[k][3],hi[k][0],hi[k][1],hi[k][2],hi[k][3]}
    o[d0]=__builtin_amdgcn_mfma_f32_32x32x16_bf16(pa0,PK(0),o[d0],0,0,0);
    o[d0]=__builtin_amdgcn_mfma_f32_32x32x16_bf16(pa1,PK(1),o[d0],0,0,0);
    o[d0]=__builtin_amdgcn_mfma_f32_32x32x16_bf16(pa2,PK(2),o[d0],0,0,0);
    o[d0]=__builtin_amdgcn_mfma_f32_32x32x16_bf16(pa3,PK(3),o[d0],0,0,0);
    #undef PK
  }
}

__device__ __forceinline__ void split3(float v,unsigned&a,unsigned&b,unsigned&c){ a=cvtpk_s(v,0.f)&0xffffu; const float r1=v-__uint_as_float(a<<16); b=cvtpk_s(r1,0.f)&0xffffu; const float r2=r1-__uint_as_float(b<<16); c=cvtpk_s(r2,0.f)&0xffffu; }
__device__ __forceinline__ bf16x8 make_qx(float m,int hi){ unsigned a,b,c; split3(m,a,b,c); u32x4 w={0x3F803F80u,0x3F80u|(a<<16),b|(c<<16),0u}; if(hi)w=(u32x4){0u,0u,0u,0u}; return __builtin_bit_cast(bf16x8,w); }
#ifndef ATTN_STORE16
#define ATTN_STORE16(p,v) (*(u32x4*)(p)=(v))
#endif
template<int THRL> __device__ __forceinline__ void attn_unit(int b,int h,int qb,const bf16*Q,const bf16*__restrict__ K,const bf16*__restrict__ V,bf16*O,const float*__restrict__ cum,char*shm,int wave){
  int tid=wave*64+lane_now(); asm volatile("":"+v"(tid));
  const int lane=tid&63,r32=lane&31,hi=lane>>5; const int wid=__builtin_amdgcn_readfirstlane(tid>>6);
  const long rowbase=(long)b*SEQ; const int q0=qb*QB;
  const bf16*Qw=Q+(rowbase+q0+wid*QBLK)*DM+h*D;
  const bf16*Kh=K+rowbase*DM+h*D,*Vh=V+rowbase*DM+h*D;
  const unsigned lds0=(unsigned)(uintptr_t)shm;
  float*wsf=(float*)(shm+LDS_WS)+wid*64;
  const bf16*ksrc=Kh+(long)lane*DM+wid*8;
  const bf16*vsrc=Vh+(long)(16*(wid&3)+(lane>>2))*DM+(wid>>2)*32+(lane&3)*8;
  const unsigned kdst=lds0+LDS_K+wid*1024, vdst=lds0+LDS_V+wid*1024;
  #define DMA_K(t,slot) glds16(ksrc+(long)(t)*KVBLK*DM,(unsigned)__builtin_amdgcn_readfirstlane(kdst+(slot)))
  #define DMA_V(t,slot) glds16(vsrc+(long)(t)*KVBLK*DM,(unsigned)__builtin_amdgcn_readfirstlane(vdst+(slot)))
  const int vb0=(int)(lds0+LDS_V)+((lane>>4)&1)*32+(lane&3)*8+(4*hi+((lane&15)>>2))*64;
  const char*Kbase=shm+LDS_K; bf16x8 kf[8];
  const lds_cptr shm3=(lds_cptr)shm; const lds_cptr kp0=shm3+LDS_K+hi*1024+r32*16; const lds_cptr vp0=shm3+LDS_V+((lane>>4)&1)*32+(lane&3)*8+(4*hi+((lane&15)>>2))*64;
  const int NT=(q0+QB)/KVBLK;
  const lds_cptr kbp=shm3+LDS_KB+r32*16;
  DMA_K(0,0);DMA_V(0,0);DMA_K(1,SLOTB);
  { const float cref=cum[q0+QB-1]; float cv[SEQ/(NW*64)];
    #pragma unroll
    for(int i=0;i<SEQ/(NW*64);++i){ const int kv=tid+i*NW*64; cv[i]=(kv<q0+QB)?cum[kv]:0.f; }
    #pragma unroll
    for(int i=0;i<SEQ/(NW*64);++i){ const int kv=tid+i*NW*64; if(kv<q0+QB){ unsigned a,bb,c; split3((cref-cv[i])*1.4426950408889634f,a,bb,c);
      *(__attribute__((address_space(3))) u32x4*)((__attribute__((address_space(3))) char*)shm3+LDS_KB+kv*16)=(u32x4){a|(bb<<16),c|0xBF800000u,0xBF80BF80u,0u}; } } }
  bf16x8 qr[4];
  #pragma unroll
  for(int d0=0;d0<4;++d0)qr[d0]=*reinterpret_cast<const bf16x8*>(&Qw[(long)r32*DM+d0*16+hi*8]);
  float mhat=0.f,l_reg=0.f;f32x16 o[2];o[0]=f32x16{};o[1]=f32x16{};bf16x8 qx=make_qx(0.f,hi);const f32x16 zc=f32x16{};
  const int qrel=wid*QBLK+r32;
  #define CMASK(P0,P1,t) do{int jb_=(t)-(NT-4); if(jb_>=0)cmask(P0,P1,jb_,qrel,hi);}while(0)
  bool resc=false;
  #define START(P0,P1) do{ const float rm=rowmax(P0,P1); resc=false; \
    { const float dl=rm; mhat=fadd_s(mhat,dl); \
      _Pragma("unroll") for(int r=0;r<16;++r){P0[r]=fsub_s(P0[r],dl);P1[r]=fsub_s(P1[r],dl);} \
      qx=make_qx(mhat,hi); } \
    _Pragma("unroll") for(int r=0;r<16;++r)P0[r]=__builtin_amdgcn_exp2f(P0[r]); }while(0)
  #define RESC() do{ if(resc){ asm volatile("s_waitcnt lgkmcnt(0)":::"memory"); \
      _Pragma("unroll") for(int d_=0;d_<2;++d_) _Pragma("unroll") for(int r=0;r<16;++r)o[d_][r]*=wsf[crow(r,hi)]; } }while(0)
  f32x16 pA0,pA1,pB0,pB1;
  int sl_prev=0,sl_cur=0,sl_next=SLOTB;
  #define ROT() do{sl_prev=sl_cur;sl_cur=sl_next;sl_next=(sl_next==(NSLOT-1)*SLOTB)?0:sl_next+SLOTB;}while(0)
  DMA_K(2,2*SLOTB);
  WAIT_BAR(3);
  qkt(pA0,pA1,Kbase,qr,qx,*(const __attribute__((address_space(3))) bf16x8*)(kbp),*(const __attribute__((address_space(3))) bf16x8*)(kbp+512),r32,hi);asm volatile("s_nop 15\n\ts_nop 7":"+v"(pA0),"+v"(pA1));CMASK(pA0,pA1,0);
  START(pA0,pA1);
  _Pragma("unroll") for(int r=0;r<16;++r)pA1[r]=__builtin_amdgcn_exp2f(pA1[r]);
  WAIT_BAR(0);
  DMA_K(3,0);DMA_V(1,SLOTB);
  ROT();
  kload8(kf,kp0+sl_cur);
  WAIT_BAR(2);
  s16x4 vlo[8],vhi[8]; u32x4 pw0,pw1,pw2,pw3;
  #define PKW(P,B) cvtpk_s(P[B],P[B+1])
  #define PAF(k) __builtin_bit_cast(bf16x8,pw##k)
  #define VFR(i) (bf16x8){vlo[i][0],vlo[i][1],vlo[i][2],vlo[i][3],vhi[i][0],vhi[i][1],vhi[i][2],vhi[i][3]}
  #define PIN(x) asm volatile("":"+v"(x))
  #define MX3(a,b,c) __builtin_fmaxf(__builtin_fmaxf((a),(b)),(c))
  #define GAPA(MF,A0,A1,A2,A3,W0,W1,PW) do{ MF; sacc+=A0; sacc+=A1; sacc+=A2; sacc+=A3; PIN(sacc); W0; W1; PIN(PW); SBAR(); }while(0)
  #define EX(v) __builtin_amdgcn_exp2f(v)
  #define GAPB(MF,X,B) do{ MF; X[B]=EX(X[B]); X[B+1]=EX(X[B+1]); X[B+2]=EX(X[B+2]); X[B+3]=EX(X[B+3]); PIN(X); SBAR(); }while(0)
  #define VRD(i) do{ vlo[i]=vtr(vp_+(((i)>>2)*4096+((i)&3)*1024)); vhi[i]=vtr(vp_+(((i)>>2)*4096+((i)&3)*1024+512)); }while(0)
  #define KRD(G,j) do{ if(G){ kload2(kf,kp0+sl_next,j); SBAR(); } }while(0)
  #define STEP(C0,C1,P0,P1,t,GK,GV,GL) do{ SBAR(); \
    const lds_cptr vp_=vp0+sl_prev; \
    const bf16x8 kb0_=*(const __attribute__((address_space(3))) bf16x8*)(kbp+(t)*1024), kb1_=*(const __attribute__((address_space(3))) bf16x8*)(kbp+(t)*1024+512); \
    VRD(0); SBAR(); float sacc=(P0[0]+P0[1]); \
    GAPA(C0=__builtin_amdgcn_mfma_f32_32x32x16_bf16(kf[0],qr[0],zc,0,0,0), P0[2],P0[3],P0[4],P0[5],     pw0[0]=PKW(P0,0), pw0[1]=PKW(P0,2), pw0); \
    VRD(4); SBAR(); GAPA(C1=__builtin_amdgcn_mfma_f32_32x32x16_bf16(kf[1],qr[0],zc,0,0,0), P0[6],P0[7],P0[8],P0[9],     pw0[2]=PKW(P0,4), pw0[3]=PKW(P0,6), pw0); \
    VRD(1); SBAR(); GAPA(C0=__builtin_amdgcn_mfma_f32_32x32x16_bf16(kf[2],qr[1],C0,0,0,0),   P0[10],P0[11],P0[12],P0[13], pw1[0]=PKW(P0,8), pw1[1]=PKW(P0,10), pw1); \
    VRD(5); SBAR(); GAPA(C1=__builtin_amdgcn_mfma_f32_32x32x16_bf16(kf[3],qr[1],C1,0,0,0),   P0[14],P0[15],P1[0],P1[1],   pw1[2]=PKW(P0,12),pw1[3]=PKW(P0,14), pw1); \
    VRD(2); SBAR(); GAPA(C0=__builtin_amdgcn_mfma_f32_32x32x16_bf16(kf[4],qr[2],C0,0,0,0),   P1[2],P1[3],P1[4],P1[5],     pw2[0]=PKW(P1,0), pw2[1]=PKW(P1,2), pw2); \
    VRD(6); SBAR(); GAPA(C1=__builtin_amdgcn_mfma_f32_32x32x16_bf16(kf[5],qr[2],C1,0,0,0),   P1[6],P1[7],P1[8],P1[9],     pw2[2]=PKW(P1,4), pw2[3]=PKW(P1,6), pw2); \
    VRD(3); SBAR(); GAPA(C0=__builtin_amdgcn_mfma_f32_32x32x16_bf16(kf[6],qr[3],C0,0,0,0),   P1[10],P1[11],P1[12],P1[13], pw3[0]=PKW(P1,8), pw3[1]=PKW(P1,10), pw3); \
    VRD(7); SBAR(); GAPA(C1=__builtin_amdgcn_mfma_f32_32x32x16_bf16(kf[7],qr[3],C1,0,0,0),   P1[14],P1[15],0.f,0.f,       pw3[2]=PKW(P1,12),pw3[3]=PKW(P1,14), pw3); \
    C0=__builtin_amdgcn_mfma_f32_32x32x16_bf16(kb0_,qx,C0,0,0,0); C1=__builtin_amdgcn_mfma_f32_32x32x16_bf16(kb1_,qx,C1,0,0,0); SBAR(); \
    l_reg+=sacc; \
    if(GK){DMA_K((t)+3,sl_cur);} if(GV){DMA_V((t)+1,sl_next);} \
    CMASK(C0,C1,t); \
    { float a=MX3(C0[0],C0[1],C1[0]),b=MX3(C0[2],C0[3],C1[1]); a=MX3(a,C1[2],C1[3]); \
      _Pragma("unroll") for(int r=4;r<16;r+=4){a=MX3(a,C0[r],C0[r+1]);b=MX3(b,C0[r+2],C0[r+3]);a=MX3(a,C1[r],C1[r+1]);b=MX3(b,C1[r+2],C1[r+3]);} \
      float rm=__builtin_fmaxf(a,b); { auto rr=__builtin_amdgcn_permlane32_swap(__float_as_uint(rm),__float_as_uint(rm),false,false); rm=__builtin_fmaxf(__uint_as_float(rr[0]),__uint_as_float(rr[1])); } \
      resc=false; \
      if(__builtin_expect(__any(rm>(float)THRL),0)){ const float dl=__builtin_fmaxf(rm,0.f); mhat+=dl; \
        _Pragma("unroll") for(int r=0;r<16;++r){C0[r]-=dl;C1[r]-=dl;} \
        qx=make_qx(mhat,hi); \
        const float f=__builtin_amdgcn_exp2f(-dl); l_reg*=f; if(hi==0)wsf[r32]=f; resc=true; } } \
    SBAR(); \
    GAPB(o[0]=__builtin_amdgcn_mfma_f32_32x32x16_bf16(PAF(0),VFR(0),o[0],0,0,0), C0,0); \
    GAPB(o[1]=__builtin_amdgcn_mfma_f32_32x32x16_bf16(PAF(0),VFR(4),o[1],0,0,0), C0,4); \
    KRD(GL,0); GAPB(o[0]=__builtin_amdgcn_mfma_f32_32x32x16_bf16(PAF(1),VFR(1),o[0],0,0,0), C0,8); \
    KRD(GL,1); GAPB(o[1]=__builtin_amdgcn_mfma_f32_32x32x16_bf16(PAF(1),VFR(5),o[1],0,0,0), C0,12); \
    KRD(GL,2); GAPB(o[0]=__builtin_amdgcn_mfma_f32_32x32x16_bf16(PAF(2),VFR(2),o[0],0,0,0), C1,0); \
    KRD(GL,3); GAPB(o[1]=__builtin_amdgcn_mfma_f32_32x32x16_bf16(PAF(2),VFR(6),o[1],0,0,0), C1,4); \
    GAPB(o[0]=__builtin_amdgcn_mfma_f32_32x32x16_bf16(PAF(3),VFR(3),o[0],0,0,0), C1,8); \
    GAPB(o[1]=__builtin_amdgcn_mfma_f32_32x32x16_bf16(PAF(3),VFR(7),o[1],0,0,0), C1,12); \
    }while(0)
  int t=1;
  #undef CMASK
  #define CMASK(P0,P1,t) do{}while(0)
  for(;t+5<NT;t+=2){
    STEP(pB0,pB1,pA0,pA1,t,true,true,true);     WAIT_BAR(2); RESC(); ROT();
    STEP(pA0,pA1,pB0,pB1,t+1,true,true,true);   WAIT_BAR(2); RESC(); ROT();
  }
  #undef CMASK
  #define CMASK(P0,P1,t) do{int jb_=(t)-(NT-4); if(jb_>=0)cmask(P0,P1,jb_,qrel,hi);}while(0)
  #define ENDW(tt) do{ if((tt)+3<NT){WAIT_BAR(2);} else if((tt)+2<NT){WAIT_BAR(1);} else {WAIT_BAR(0);} }while(0)
  for(;t+1<NT;t+=2){
    STEP(pB0,pB1,pA0,pA1,t,(t+3<NT),(t+1<NT),(t+1<NT));       ENDW(t);   RESC(); ROT();
    STEP(pA0,pA1,pB0,pB1,t+1,(t+4<NT),(t+2<NT),(t+2<NT));     ENDW(t+1); RESC(); ROT();
  }
  STEP(pB0,pB1,pA0,pA1,NT-1,false,false,false); RESC();
  { float sacc=pB0[0]+pB0[1]; _Pragma("unroll") for(int r=2;r<16;++r)sacc+=pB0[r]; _Pragma("unroll") for(int r=0;r<16;++r)sacc+=pB1[r]; l_reg+=sacc;
    pw0=(u32x4){PKW(pB0,0),PKW(pB0,2),PKW(pB0,4),PKW(pB0,6)};pw1=(u32x4){PKW(pB0,8),PKW(pB0,10),PKW(pB0,12),PKW(pB0,14)};pw2=(u32x4){PKW(pB1,0),PKW(pB1,2),PKW(pB1,4),PKW(pB1,6)};pw3=(u32x4){PKW(pB1,8),PKW(pB1,10),PKW(pB1,12),PKW(pB1,14)};
    SBAR(); pv(o,vb0+sl_cur,PAF(0),PAF(1),PAF(2),PAF(3)); }
  #undef PKW
  #undef PAF
  #undef VFR
  #undef PIN
  #undef MX3
  #undef GAPA
  #undef GAPB
  #undef EX
  #undef VRD
  #undef KRD
  #undef STEP
  #undef ENDW
  {auto rr=__builtin_amdgcn_permlane32_swap(__float_as_uint(l_reg),__float_as_uint(l_reg),false,false);l_reg=__uint_as_float(rr[0])+__uint_as_float(rr[1]);}
  if(hi==0)wsf[32+r32]=l_reg;asm volatile("s_waitcnt lgkmcnt(0)":::"memory");
  float rli[16];
  #pragma unroll
  for(int r=0;r<16;++r)rli[r]=__builtin_amdgcn_rcpf(wsf[32+crow(r,hi)]);
  bf16*Ow=O+(rowbase+q0+wid*QBLK)*OPITCH+h*D;
  { bf16*stg=(bf16*)(shm+LDS_OST)+wid*2048;
    #pragma unroll
    for(int r=0;r<16;++r){const int orow=crow(r,hi);
      #pragma unroll
      for(int d0=0;d0<2;++d0)stg[orow*64+d0*32+r32]=__float2bfloat16(o[d0][r]*rli[r]);}
    asm volatile("s_waitcnt lgkmcnt(0)":::"memory");
    #pragma unroll
    for(int i=0;i<4;++i){const int row=i*8+(lane>>3),ch=lane&7; const u32x4 v=*(const u32x4*)(stg+row*64+ch*8); ATTN_STORE16(Ow+(long)row*OPITCH+ch*8,v);} }
  asm volatile("s_waitcnt lgkmcnt(0)\n\ts_barrier":::"memory");
  #undef DMA_K
  #undef DMA_V
  #undef CMASK
  #undef START
  #undef RESC
  #undef ROT
}
constexpr int ATTN_LDS_BYTES=LDS_BYTES;
#undef SBAR
#undef WAIT_BAR
}

namespace ret_body {
constexpr int VT_P = 272, KT_P = 272, ST_P = 144, PW_P = 272;
constexpr int KC_P = 144;
constexpr int L_VT = 0, L_KT = L_VT + 128 * VT_P, L_ST = L_KT + 64 * KT_P, L_PW = L_ST + 128 * ST_P, PW_BYTES = 16 * PW_P, L_KC = L_PW + 8 * PW_BYTES, LDS_BYTES = L_KC + 128 * KC_P;
typedef short bf16x8 __attribute__((ext_vector_type(8)));
typedef float f32x4 __attribute__((ext_vector_type(4)));
#define dpp_f(v, ctrl) __int_as_float(__builtin_amdgcn_update_dpp(0, __float_as_int(v), (ctrl), 0xF, 0xF, false))
#define RB_MFMA(a, b, c) __builtin_amdgcn_mfma_f32_16x16x32_bf16(__builtin_bit_cast(bf16x8, a), __builtin_bit_cast(bf16x8, b), c, 0, 0, 0)
__device__ __forceinline__ void ret_unit(LAS unsigned char* L, int b, int h, const bf16* RQ, const bf16* RK, const bf16* RVT, const bf16* RKT, const bf16* RGS, bf16* BR, int wave, int c0 = 0, int c1 = SEQ / 128, int pf0 = 0) {
    int tid = wave * 64 + lane_now(); asm volatile("" : "+v"(tid));
    const int lane = tid & 63, w = __builtin_amdgcn_readfirstlane(tid >> 6), r = lane & 15, q = lane >> 4;
    const float lg2 = log1pf(-exp2f(-5.f - (float)h)) * LOG2E;
    const float cd = __builtin_amdgcn_exp2f(128.f * lg2);
    unsigned z0 = 0u; asm volatile("" : "+v"(z0));
    f32x4 S[4];
#pragma unroll
    for (int i = 0; i < 4; ++i) { const float zf = __uint_as_float(z0); S[i] = (f32x4){zf, zf, zf, zf}; }
    for (int i = tid * 16; i < 128 * ST_P; i += NWAVES * 64 * 16) *(LAS v4u*)(L + L_ST + i) = (v4u){z0, z0, z0, z0};
    LAS unsigned char* Pw = L + L_PW + w * PW_BYTES;
    v4u pv[4], pkt[2], pkc[2], pq[2];
    const int t16 = tid & 15, trow = tid >> 4;
#define RB_LOAD(cc) do { const size_t r0_ = (size_t)b * SEQ + (size_t)(cc) * 128; const size_t it_ = (size_t)((b * 4 + h) * 16 + (cc)); \
        _Pragma("unroll") for (int j = 0; j < 4; ++j) pv[j] = *(const v4u*)(RVT + it_ * 16384 + (size_t)(32 * j + trow) * 128 + 8 * t16); \
        _Pragma("unroll") for (int j = 0; j < 2; ++j) pkt[j] = *(const v4u*)(RKT + it_ * 8192 + (size_t)(32 * j + trow) * 128 + 8 * t16); \
        _Pragma("unroll") for (int j = 0; j < 2; ++j) pkc[j] = *(const v4u*)(RK + (r0_ + 64 * j + (tid >> 3)) * 256 + h * 64 + 8 * (tid & 7)); \
        _Pragma("unroll") for (int ks = 0; ks < 2; ++ks) pq[ks] = *(const v4u*)(RQ + (r0_ + 16 * w + r) * 256 + h * 64 + 32 * ks + 8 * q); } while (0)
    RB_LOAD(0);
    for (int c = 0; c < c1; ++c) {
        const int pf = pf0 | ((c < c0) ? 3 : 0);
        const size_t row0 = (size_t)b * SEQ + (size_t)c * 128;
        float lg2c = lg2; asm volatile("" : "+v"(lg2c));
        if (!(pf & 8)) {
#pragma unroll
        for (int j = 0; j < 4; ++j) *(LAS v4u*)(L + L_VT + (32 * j + trow) * VT_P + 16 * t16) = pv[j];
#pragma unroll
        for (int j = 0; j < 2; ++j) *(LAS v4u*)(L + L_KT + (32 * j + trow) * KT_P + 16 * t16) = pkt[j];
        if (!(pf & 2)) {
#pragma unroll
        for (int j = 0; j < 2; ++j) *(LAS v4u*)(L + L_KC + (64 * j + (tid >> 3)) * KC_P + 16 * (tid & 7)) = pkc[j];
        }
        }
        v4u qf[2]; qf[0] = pq[0]; qf[1] = pq[1];
        __syncthreads();
        const float fdec = __builtin_amdgcn_exp2f((float)(16 * w + 4 * q - r) * lg2c);
        const float g1 = __builtin_amdgcn_exp2f(lg2c), g2 = g1 * g1, g3 = g2 * g1; float gm16[8];
        { const float gi = __builtin_amdgcn_exp2f(-16.f * lg2c); gm16[0] = 1.f;
#pragma unroll
          for (int j = 1; j < 8; ++j) gm16[j] = gm16[j - 1] * gi; }
        if (!(pf & 2)) {
#pragma unroll
        for (int jh = 0; jh < 2; ++jh) {
        v4u kk0[4], kk1[4];
#pragma unroll
        for (int jj = 0; jj < 4; ++jj) { const int jb = 4 * jh + jj; if (jb <= w) { kk0[jj] = *(const LAS v4u*)(L + L_KC + (16 * jb + r) * KC_P + 16 * q); kk1[jj] = *(const LAS v4u*)(L + L_KC + (16 * jb + r) * KC_P + 64 + 16 * q); } }
        __builtin_amdgcn_sched_barrier(0);
#pragma unroll
        for (int jj = 0; jj < 4; ++jj) { const int jb = 4 * jh + jj;
            if (jb <= w) {
                const v4u k0 = kk0[jj], k1 = kk1[jj];
                f32x4 acc = (f32x4){0.f, 0.f, 0.f, 0.f};
                acc = RB_MFMA(qf[0], k0, acc); acc = RB_MFMA(qf[1], k1, acc);
                const float f0 = fdec * gm16[jb];
                acc[0] *= f0; acc[1] *= f0 * g1; acc[2] *= f0 * g2; acc[3] *= f0 * g3;
                if (jb == w) {
#pragma unroll
                    for (int e = 0; e < 4; ++e) acc[e] = (4 * q - r + e >= 0) ? acc[e] : 0.f; }
                const unsigned p01 = cvt_pk_bf16(acc[0], acc[1]), p23 = cvt_pk_bf16(acc[2], acc[3]);
                LAS unsigned char* pp = Pw + (4 * q) * PW_P + (16 * jb + r) * 2;
                *(LAS unsigned short*)(pp) = (unsigned short)p01; *(LAS unsigned short*)(pp + PW_P) = (unsigned short)(p01 >> 16);
                *(LAS unsigned short*)(pp + 2 * PW_P) = (unsigned short)p23; *(LAS unsigned short*)(pp + 3 * PW_P) = (unsigned short)(p23 >> 16);
            } else if (jb == w + 1 && (w & 1) == 0) {
                LAS unsigned char* pp = Pw + (4 * q) * PW_P + (16 * jb + r) * 2;
                *(LAS unsigned short*)(pp) = 0; *(LAS unsigned short*)(pp + PW_P) = 0; *(LAS unsigned short*)(pp + 2 * PW_P) = 0; *(LAS unsigned short*)(pp + 3 * PW_P) = 0;
            }
        }
        __builtin_amdgcn_sched_barrier(0); }
        }
        LDS_WAIT(); asm volatile("" ::: "memory");
        if (c + 1 < c1) RB_LOAD(c + 1);
        if (!(pf & 2)) {
        v4u pg[4];
        { const size_t grow_ = row0 + 16 * w + (lane >> 4);
#pragma unroll
          for (int i = 0; i < 4; ++i) pg[i] = *(const v4u*)(RGS + (grow_ + 4 * i) * 512 + h * 128 + 8 * (lane & 15)); }
        f32x4 oi[8];
#pragma unroll
        for (int d = 0; d < 8; ++d) oi[d] = (f32x4){0.f, 0.f, 0.f, 0.f};
#pragma unroll
        for (int ks = 0; ks < 4; ++ks) {
            if (2 * ks <= w && !(pf & 2)) { const v4u pa = *(const LAS v4u*)(Pw + r * PW_P + (32 * ks + 8 * q) * 2); v4u vb[8];
#pragma unroll
                for (int d = 0; d < 8; ++d) vb[d] = *(const LAS v4u*)(L + L_VT + (16 * d + r) * VT_P + (32 * ks + 8 * q) * 2);
                __builtin_amdgcn_sched_barrier(0);
#pragma unroll
                for (int d = 0; d < 8; ++d) oi[d] = RB_MFMA(pa, vb[d], oi[d]);
                __builtin_amdgcn_sched_barrier(0); }
        }
        { const float rfq = __builtin_amdgcn_exp2f((float)(16 * w + r + 1) * lg2);
#pragma unroll
          for (int ks = 0; ks < 2; ++ks) { v4u sb[8], qs;
#pragma unroll
            for (int wd = 0; wd < 4; ++wd) qs[wd] = cvt_pk_bf16(bflo(qf[ks][wd]) * rfq, bfhi(qf[ks][wd]) * rfq);
#pragma unroll
            for (int d = 0; d < 8; ++d) sb[d] = *(const LAS v4u*)(L + L_ST + (16 * d + r) * ST_P + (32 * ks + 8 * q) * 2);
            __builtin_amdgcn_sched_barrier(0);
#pragma unroll
            for (int d = 0; d < 8; ++d) oi[d] = RB_MFMA(qs, sb[d], oi[d]);
            __builtin_amdgcn_sched_barrier(0); } }
        float ss[4];
#pragma unroll
        for (int e = 0; e < 4; ++e) ss[e] = 0.f;
#pragma unroll
        for (int d = 0; d < 8; ++d)
#pragma unroll
            for (int e = 0; e < 4; ++e) ss[e] += oi[d][e] * oi[d][e];
#pragma unroll
        for (int e = 0; e < 4; ++e) { float s = ss[e]; s += dpp_f(s, 0xB1); s += dpp_f(s, 0x4E); s += dpp_f(s, 0x141); s += dpp_f(s, 0x140); ss[e] = 1.f / sqrtf(s * (1.f / 128.f) + EPS); }
#pragma unroll
        for (int d = 0; d < 8; ++d) { const unsigned p01 = cvt_pk_bf16(oi[d][0] * ss[0], oi[d][1] * ss[1]), p23 = cvt_pk_bf16(oi[d][2] * ss[2], oi[d][3] * ss[3]);
            LAS unsigned char* pp = Pw + (4 * q) * PW_P + (16 * d + r) * 2;
            *(LAS unsigned short*)(pp) = (unsigned short)p01; *(LAS unsigned short*)(pp + PW_P) = (unsigned short)(p01 >> 16);
            *(LAS unsigned short*)(pp + 2 * PW_P) = (unsigned short)p23; *(LAS unsigned short*)(pp + 3 * PW_P) = (unsigned short)(p23 >> 16); }
        LDS_WAIT(); asm volatile("" ::: "memory");
        { const int orow = lane >> 4, oc = lane & 15; const size_t grow = row0 + 16 * w + orow;
#pragma unroll
          for (int i = 0; i < 4; ++i) { const v4u ov = *(const LAS v4u*)(Pw + (orow + 4 * i) * PW_P + 16 * oc); const v4u gv = pg[i];
              v4u o;
#pragma unroll
              for (int wd = 0; wd < 4; ++wd) o[wd] = cvt_pk_bf16(bflo(ov[wd]) * bflo(gv[wd]), bfhi(ov[wd]) * bfhi(gv[wd]));
              if (!(pf & 1)) *(v4u*)(BR + (grow + 4 * i) * 1024 + 512 + h * 128 + 8 * oc) = o; } }
        }
        if (!(pf & 2)) __syncthreads();
#pragma unroll
        for (int i = 0; i < 4; ++i) S[i] = S[i] * cd;
        if (!(pf & 4))
#pragma unroll
        for (int ks = 0; ks < 4; ++ks) { const v4u vb = *(const LAS v4u*)(L + L_VT + (16 * w + r) * VT_P + (32 * ks + 8 * q) * 2); v4u ka[4];
#pragma unroll
            for (int i = 0; i < 4; ++i) ka[i] = *(const LAS v4u*)(L + L_KT + (16 * i + r) * KT_P + (32 * ks + 8 * q) * 2);
            __builtin_amdgcn_sched_barrier(0);
#pragma unroll
            for (int i = 0; i < 4; ++i) S[i] = RB_MFMA(ka[i], vb, S[i]);
            __builtin_amdgcn_sched_barrier(0); }
#pragma unroll
        for (int i = 0; i < 4; ++i) { v2u sv; sv.x = cvt_pk_bf16(S[i][0], S[i][1]); sv.y = cvt_pk_bf16(S[i][2], S[i][3]); *(LAS v2u*)(L + L_ST + (16 * w + r) * ST_P + (16 * i + 4 * q) * 2) = sv; }
        __syncthreads();
    }
}
#undef RB_MFMA
#undef dpp_f
#undef RB_LOAD
}

struct TrItem { const float* src; bf16* dst; int ldw, K, base, mul, gu, f8; };
__device__ __forceinline__ int tr_row(const TrItem& t, int n) { if (t.gu) { const int a = t.base + (n >> 1), b = n & 1; return 256 * (a >> 7) + 128 * b + (a & 127); } return t.base + t.mul * n; }
__device__ __forceinline__ void tr_load(const TrItem& t, f32x4 (&v)[8], int lane) {
    const float* p = t.src + (size_t)(lane >> 3) * t.ldw + 4 * (lane & 7);
#pragma unroll
    for (int i = 0; i < 8; ++i) v[i] = *(const GAS f32x4*)(p + (size_t)(8 * i) * t.ldw);
}
__device__ __forceinline__ void tr_store(const TrItem& t, const f32x4 (&v)[8], LAS float* scr, int lane) {
    { LAS float* w = scr + (lane >> 3) * 33 + 4 * (lane & 7);
#pragma unroll
      for (int i = 0; i < 8; ++i) { w[(8 * i) * 33 + 0] = v[i][0]; w[(8 * i) * 33 + 1] = v[i][1]; w[(8 * i) * 33 + 2] = v[i][2]; w[(8 * i) * 33 + 3] = v[i][3]; } }
    LDS_WAIT(); asm volatile("" ::: "memory");
    const int c = lane & 7;
#pragma unroll
    for (int j = 0; j < 4; ++j) { const int n = (lane >> 3) + 8 * j; const LAS float* s = scr + (8 * c) * 33 + n;
        if (t.f8) { const f32x4 a = {s[0 * 33] * WSCALE, s[1 * 33] * WSCALE, s[2 * 33] * WSCALE, s[3 * 33] * WSCALE}, b = {s[4 * 33] * WSCALE, s[5 * 33] * WSCALE, s[6 * 33] * WSCALE, s[7 * 33] * WSCALE};
            *(GAS v2u*)((unsigned char*)t.dst + (size_t)tr_row(t, n) * t.K + 8 * c) = pack8_fp8(a, b); }
        else { v4u o; o.x = cvt_pk_bf16(s[0 * 33], s[1 * 33]); o.y = cvt_pk_bf16(s[2 * 33], s[3 * 33]); o.z = cvt_pk_bf16(s[4 * 33], s[5 * 33]); o.w = cvt_pk_bf16(s[6 * 33], s[7 * 33]);
            *(GAS v4u*)(t.dst + (size_t)tr_row(t, n) * t.K + 8 * c) = o; } }
    LDS_WAIT(); asm volatile("" ::: "memory");
}
__device__ __forceinline__ void tr_store2(const TrItem& t0, const f32x4 (&v0)[8], const TrItem& t1, const f32x4 (&v1)[8], LAS float* s0, LAS float* s1, int lane) {
    { LAS float* w0 = s0 + (lane >> 3) * 33 + 4 * (lane & 7); LAS float* w1 = s1 + (lane >> 3) * 33 + 4 * (lane & 7);
#pragma unroll
      for (int i = 0; i < 8; ++i) { w0[(8 * i) * 33 + 0] = v0[i][0]; w0[(8 * i) * 33 + 1] = v0[i][1]; w0[(8 * i) * 33 + 2] = v0[i][2]; w0[(8 * i) * 33 + 3] = v0[i][3];
                                    w1[(8 * i) * 33 + 0] = v1[i][0]; w1[(8 * i) * 33 + 1] = v1[i][1]; w1[(8 * i) * 33 + 2] = v1[i][2]; w1[(8 * i) * 33 + 3] = v1[i][3]; } }
    LDS_WAIT(); asm volatile("" ::: "memory");
    const int c = lane & 7;
#pragma unroll
    for (int u = 0; u < 2; ++u) { const TrItem& t = u ? t1 : t0; const LAS float* sb = u ? s1 : s0;
#pragma unroll
        for (int j = 0; j < 4; ++j) { const int n = (lane >> 3) + 8 * j; const LAS float* s = sb + (8 * c) * 33 + n;
            if (t.f8 == 1) { const f32x4 a = {s[0 * 33] * WSCALE, s[1 * 33] * WSCALE, s[2 * 33] * WSCALE, s[3 * 33] * WSCALE}, b = {s[4 * 33] * WSCALE, s[5 * 33] * WSCALE, s[6 * 33] * WSCALE, s[7 * 33] * WSCALE};
                *(GAS v2u*)((unsigned char*)t.dst + (size_t)tr_row(t, n) * t.K + 8 * c) = pack8_fp8(a, b); }
            else { v4u o; o.x = cvt_pk_bf16(s[0 * 33], s[1 * 33]); o.y = cvt_pk_bf16(s[2 * 33], s[3 * 33]); o.z = cvt_pk_bf16(s[4 * 33], s[5 * 33]); o.w = cvt_pk_bf16(s[6 * 33], s[7 * 33]);
                *(GAS v4u*)(t.dst + (size_t)tr_row(t, n) * t.K + 8 * c) = o; } } }
    LDS_WAIT(); asm volatile("" ::: "memory");
}
constexpr int TR_IN = 96 * 16, TR_MG = 64 * 16, TR_BR = 2 * 32 * 8, TR_O = 32 * 16, TR_PG = 32 * 16, TR_PP = 32 * 4, TR_GU = 32 * 64 * 16, TR_DN = 32 * 32 * 16;
constexpr int TR_ITEMS = TR_IN + TR_MG + TR_BR + TR_O + TR_PG + TR_PP + TR_GU + TR_DN;
__device__ __forceinline__ TrItem tr_decode(Frame& F, int it) {
    TrItem t; t.mul = 1; t.gu = 0; t.f8 = 0; int r = it;
    if (r < TR_GU) { const int e = r >> 10, rr = r & 1023, kb = rr >> 6, blk = rr & 63;
        t.src = (F.ap->in[12]) + (size_t)e * 1024 * 2048 + (size_t)(64 * kb) * 2048 + 32 * blk; t.ldw = 2048; t.dst = (bf16*)(WSP(unsigned char, WS_WGUT) + (size_t)e * 2048 * 1024 + 64 * kb); t.K = 1024; t.base = 16 * blk; t.gu = 1; t.f8 = 1; return t; } r -= TR_GU;
    if (r < TR_DN) { const int e = r >> 9, rr = r & 511, kb = rr >> 5, blk = rr & 31;
        t.src = (F.ap->in[14]) + (size_t)e * 1024 * 1024 + (size_t)(64 * kb) * 1024 + 32 * blk; t.ldw = 1024; t.dst = (bf16*)(WSP(unsigned char, WS_WDT) + (size_t)e * 1024 * 1024 + 64 * kb); t.K = 1024; t.base = 32 * blk; t.f8 = 1; return t; } r -= TR_DN;
    if (r < TR_IN) { const int kb = r / 96, blk = r % 96; int s0;
        if (blk < 32) { s0 = 32 * blk; t.base = 32 * blk; t.f8 = 1; }
        else if (blk < 48) { s0 = 32 * blk; t.base = 32 * (blk - 32); }
        else if (blk < 64) { s0 = 2056 + 32 * (blk - 48); t.base = 1024 + 32 * (blk - 48); }
        else if (blk < 80) { s0 = 2568 + 32 * (blk - 64); t.base = 1536 + 32 * (blk - 64); }
        else { const int hb = (blk - 80) & 7, head = hb >> 1, half = hb & 1, isk = (blk >= 88); s0 = (isk ? 1800 : 1544) + head * 64 + half * 32; t.base = (isk ? 768 : 512) + head * 64 + half; t.mul = 2; }
        t.src = (F.ap->in[3]) + (size_t)(64 * kb) * INW + s0; t.ldw = INW; t.dst = t.f8 ? (bf16*)(WSP(unsigned char, WS_WG8T) + 64 * kb) : WSP(bf16, WS_W1T) + 64 * kb; t.K = 1024; return t; } r -= TR_IN;
    if (r < TR_MG) { const int kb = r >> 6, blk = r & 63; t.src = (F.ap->in[6]) + (size_t)(64 * kb) * 2048 + 32 * blk; t.ldw = 2048; t.dst = (bf16*)(WSP(unsigned char, WS_WG8T) + 64 * kb); t.K = 1024; t.base = 1024 + 32 * blk; t.f8 = 1; return t; } r -= TR_MG;
    if (r < TR_BR) { const int gsel = r >> 8, rr = r & 255, kb = rr >> 5, blk = rr & 31;
        t.src = (F.ap->in[5]) + (size_t)gsel * 512 * 1024 + (size_t)(64 * kb) * 1024 + 32 * blk; t.ldw = 1024; t.dst = WSP(bf16, WS_WBT) + gsel * 512 + 64 * kb; t.K = 1024; t.base = 32 * blk; return t; } r -= TR_BR;
    if (r < TR_O) { const int kb = r >> 5, blk = r & 31; t.src = (F.ap->in[8]) + (size_t)(64 * kb) * 1024 + 32 * blk; t.ldw = 1024; t.dst = WSP(bf16, WS_WOT) + 64 * kb; t.K = 1024; t.base = 32 * blk; return t; } r -= TR_O;
    if (r < TR_PG) { const int kb = r >> 5, blk = r & 31; t.src = (F.ap->in[17]) + (size_t)(64 * kb) * 1024 + 32 * blk; t.ldw = 1024; t.dst = (bf16*)(WSP(unsigned char, WS_WPGT) + 64 * kb); t.K = 1024; t.base = 32 * blk; t.f8 = 1; return t; } r -= TR_PG;
    { const int kb = r >> 5, blk = r & 31; t.src = (F.ap->in[18]) + (size_t)(64 * kb) * 1024 + 32 * blk; t.ldw = 1024; t.dst = WSP(bf16, WS_WPPT) + 64 * kb; t.K = 256; t.base = 32 * blk; return t; }
}

__device__ __forceinline__ void p0_row(Frame& F, int m, f32x4 (&v)[4], LAS const float* WFt, int lane, const f32x4 (&gq)[4], float bfl) {
    float s = 0.f;
#pragma unroll
    for (int j = 0; j < 4; ++j) s += (v[j].x * v[j].x + v[j].y * v[j].y) + (v[j].z * v[j].z + v[j].w * v[j].w);
    const float rstd = 1.f / sqrtf(wave_sum(s) * (1.f / DM) + EPS);
    GAS unsigned long long* o8 = (GAS unsigned long long*)(WSP(bf16, WS_XN) + (size_t)m * DM) + lane;
    GAS int* q8 = (GAS int*)(WSP(unsigned char, WS_XN8) + (size_t)m * DM) + lane;
#pragma unroll
    for (int j = 0; j < 4; ++j) { v[j] = v[j] * rstd * gq[j];
        o8[64 * j] = (unsigned long long)cvt_pk_bf16(v[j].x, v[j].y) | ((unsigned long long)cvt_pk_bf16(v[j].z, v[j].w) << 32);
        { int w = 0; w = __builtin_amdgcn_cvt_pk_fp8_f32(clamp_f8(v[j].x), clamp_f8(v[j].y), w, false); w = __builtin_amdgcn_cvt_pk_fp8_f32(clamp_f8(v[j].z), clamp_f8(v[j].w), w, true); q8[64 * j] = w; } }
    float fa[8];
#pragma unroll
    for (int c = 0; c < 8; ++c) { float a = 0.f;
#pragma unroll
        for (int j = 0; j < 4; ++j) { const f32x4 w = *(const LAS f32x4*)(WFt + c * 1024 + 256 * j + 4 * lane); a += (v[j].x * w.x + v[j].y * w.y) + (v[j].z * w.z + v[j].w * w.w); }
        fa[c] = wave_sum(a); }
    float z = fa[0];
#pragma unroll
    for (int c = 1; c < 8; ++c) z = (lane == c) ? fa[c] : z;
    if (lane < 8) { z += bfl; WSP(float, WS_LOGF)[(size_t)m * 8 + lane] = fminf(z, 0.f) - log1pf(expf(-fabsf(z))); }
}
__device__ __forceinline__ void p0_prologue(Frame& F) {
    LAS float* WFt = (LAS float*)(F.lds + RING_OFF);
    { f32x4 wv[2][2];
#pragma unroll
      for (int i = 0; i < 2; ++i) { const float* wp = (F.ap->in[3]) + (size_t)(F.tid + NWAVES * 64 * i) * INW + 1536; wv[i][0] = *(const GAS f32x4*)wp; wv[i][1] = *(const GAS f32x4*)(wp + 4); }
#pragma unroll
      for (int i = 0; i < 2; ++i) { const int k = F.tid + NWAVES * 64 * i;
#pragma unroll
          for (int c = 0; c < 8; ++c) WFt[c * 1024 + k] = wv[i][c >> 2][c & 3]; } }
    __syncthreads();
    const int gw = F.vcu * NWAVES + F.wave, NGW = F.G * NWAVES, lane = F.lane;
#ifndef P0_REP_ROWS
#define P0_REP_ROWS 1
#endif
#ifndef P0_REP_TR
#define P0_REP_TR 1
#endif
#ifndef P0_REP_ROWS
#define P0_REP_ROWS 1
#endif
#ifndef P0_REP_TR
#define P0_REP_TR 1
#endif
    for (int rep_ = 0; rep_ < P0_REP_ROWS; ++rep_)
    { f32x4 gq[4]; const float bfl = (F.ap->in[4])[lane & 7];
#pragma unroll
      for (int j = 0; j < 4; ++j) gq[j] = ((const GAS f32x4*)(F.ap->in[2]))[lane + 64 * j];
      f32x4 va[4], vb[4], vc[4], vd[4]; int m = gw;
#define P0_LD(V, mm) do { if ((mm) < NT) { _Pragma("unroll") for (int j = 0; j < 4; ++j) V[j] = ((const GAS f32x4*)((F.ap->in[0]) + (size_t)(mm) * DM))[lane + 64 * j]; } } while (0)
#define P0_ROW(V, mm) do { __builtin_amdgcn_sched_barrier(0); if ((mm) < NT) p0_row(F, (mm), V, WFt, lane, gq, bfl); __builtin_amdgcn_sched_barrier(0); } while (0)
      P0_LD(va, m); P0_LD(vb, m + NGW); P0_LD(vc, m + 2 * NGW);
      for (; m < NT; m += 4 * NGW) {
          P0_LD(vd, m + 3 * NGW); P0_ROW(va, m);
          P0_LD(va, m + 4 * NGW); P0_ROW(vb, m + NGW);
          P0_LD(vb, m + 5 * NGW); P0_ROW(vc, m + 2 * NGW);
          P0_LD(vc, m + 6 * NGW); P0_ROW(vd, m + 3 * NGW);
      }
#undef P0_LD
#undef P0_ROW
    }
    __syncthreads();
    for (int rep_ = 0; rep_ < P0_REP_TR; ++rep_)
    { LAS float* scr = (LAS float*)(F.lds + RING_OFF + F.wave * 8704);
      constexpr int TR_P0_END = TR_GU + TR_DN + TR_IN + TR_MG;
      int it = TR_GU + TR_DN + gw; f32x4 cur[8], nxt[8]; TrItem tc, tn;
      if (it < TR_P0_END) { tc = tr_decode(F, it); tr_load(tc, cur, lane); }
      while (it < TR_P0_END) {
          const int itn = it + NGW; const bool hn = itn < TR_P0_END;
          if (hn) { tn = tr_decode(F, itn); tr_load(tn, nxt, lane); }
          tr_store(tc, cur, scr, lane);
          if (hn) { tc = tn;
#pragma unroll
              for (int i = 0; i < 8; ++i) cur[i] = nxt[i]; }
          it = itn;
      } }
    const int gt = F.vcu * (NWAVES * 64) + F.tid, NGT = F.G * NWAVES * 64;
    { float* rot = WSP(float, WS_ROT);
      for (int i = gt; i < SEQ * 32; i += NGT) { const int pos = i >> 5, j = i & 31;
          const float inv = powf(10000.f, -(float)j / 32.f); const float ang = (float)pos * inv;
          double rev = (double)ang * 0.15915494309189535; rev -= floor(rev); const float fr = (float)rev;
          rot[i] = __builtin_amdgcn_cosf(fr); rot[SEQ * 32 + i] = __builtin_amdgcn_sinf(fr); } }
    { bf16* wrt = WSP(bf16, WS_WRT);
      for (int i = gt; i < 1024 * 32; i += NGT) { const int k = i >> 5, n = i & 31; const float v = (F.ap->in[10])[i]; const unsigned hi = f2bf(v); const float rem = v - __uint_as_float(hi << 16);
          wrt[n * 1024 + k] = (bf16)hi; wrt[32768 + n * 1024 + k] = (bf16)f2bf(rem); } }
    if (gt < 64) { GAS v4u* z = (GAS v4u*)(WSP(unsigned char, WS_HB) + (size_t)NT * DM); z[gt] = (v4u){0u, 0u, 0u, 0u}; }
}

template <int F8, int GU>
__device__ __forceinline__ void tr_store2t(const TrItem& t0, const f32x4 (&v0)[8], const TrItem& t1, const f32x4 (&v1)[8], LAS float* s0, LAS float* s1, int lane) {
    { LAS float* w0 = s0 + (lane >> 3) * 33 + 4 * (lane & 7); LAS float* w1 = s1 + (lane >> 3) * 33 + 4 * (lane & 7);
#pragma unroll
      for (int i = 0; i < 8; ++i) { w0[(8 * i) * 33 + 0] = v0[i][0]; w0[(8 * i) * 33 + 1] = v0[i][1]; w0[(8 * i) * 33 + 2] = v0[i][2]; w0[(8 * i) * 33 + 3] = v0[i][3];
                                    w1[(8 * i) * 33 + 0] = v1[i][0]; w1[(8 * i) * 33 + 1] = v1[i][1]; w1[(8 * i) * 33 + 2] = v1[i][2]; w1[(8 * i) * 33 + 3] = v1[i][3]; } }
    LDS_WAIT(); asm volatile("" ::: "memory");
    const int c = lane & 7; float r[2][4][8];
#pragma unroll
    for (int u = 0; u < 2; ++u) { const LAS float* sb = (u ? s1 : s0) + (8 * c) * 33 + (lane >> 3);
#pragma unroll
        for (int j = 0; j < 4; ++j)
#pragma unroll
            for (int k = 0; k < 8; ++k) r[u][j][k] = sb[k * 33 + 8 * j]; }
    LDS_WAIT(); asm volatile("" ::: "memory");
#pragma unroll
    for (int u = 0; u < 2; ++u) { const TrItem& t = u ? t1 : t0;
#pragma unroll
        for (int j = 0; j < 4; ++j) { const int n = (lane >> 3) + 8 * j; int row;
            if (GU) { const int a = t.base + (n >> 1), b = n & 1; row = 256 * (a >> 7) + 128 * b + (a & 127); } else row = t.base + n;
            if (F8) { const f32x4 a = {r[u][j][0] * WSCALE, r[u][j][1] * WSCALE, r[u][j][2] * WSCALE, r[u][j][3] * WSCALE}, b = {r[u][j][4] * WSCALE, r[u][j][5] * WSCALE, r[u][j][6] * WSCALE, r[u][j][7] * WSCALE};
                *(GAS v2u*)((unsigned char*)t.dst + (size_t)row * t.K + 8 * c) = pack8_fp8(a, b); }
            else { v4u o; o.x = cvt_pk_bf16(r[u][j][0], r[u][j][1]); o.y = cvt_pk_bf16(r[u][j][2], r[u][j][3]); o.z = cvt_pk_bf16(r[u][j][4], r[u][j][5]); o.w = cvt_pk_bf16(r[u][j][6], r[u][j][7]);
                *(GAS v4u*)(t.dst + (size_t)row * t.K + 8 * c) = o; } } }
}
constexpr int CONV_ITEMS = 64, CONV_TR_ITEMS = TR_ITEMS - TR_IN - TR_MG, CONV_TR_CHUNKS = CONV_TR_ITEMS / CONV_ITEMS, CONV_PB_CHUNKS = NT * PLE / 4 / 16384, CONV_CHUNKS = CONV_TR_CHUNKS + CONV_PB_CHUNKS;
static_assert(CONV_TR_ITEMS % CONV_ITEMS == 0 && (TR_GU + TR_DN) % CONV_ITEMS == 0 && (NT * PLE / 4) % 16384 == 0, "whole chunks");
__device__ __forceinline__ TrItem conv_decode(Frame& F, int ci) { return tr_decode(F, ci < TR_GU + TR_DN ? ci : ci + TR_IN + TR_MG); }
template <int F8, int GU>
__device__ __forceinline__ void conv_body(Frame& F, int c, int lane) {
    LAS float* scr = (LAS float*)(F.lds + RING_OFF + F.wave * 17408); LAS float* scr1 = scr + 2176;
    static_assert(NWAVES * 17408 <= SCH_OFF - RING_OFF, "conversion scratch inside ring + table region");
    static_assert(CONV_ITEMS / NWAVES / 2 == 4, "four pairs per wave, written out below");
    const int base = c * CONV_ITEMS + F.wave;
    f32x4 a0[8], a1[8], b0[8], b1[8], c0[8], c1[8]; TrItem ta0, ta1, tb0, tb1, tc0, tc1;
#define CV_LD(X, pi) do { t##X##0 = conv_decode(F, base + NWAVES * (2 * (pi))); t##X##1 = conv_decode(F, base + NWAVES * (2 * (pi) + 1)); tr_load(t##X##0, X##0, lane); tr_load(t##X##1, X##1, lane); } while (0)
#define CV_ST(X) do { __builtin_amdgcn_sched_barrier(0); tr_store2t<F8, GU>(t##X##0, X##0, t##X##1, X##1, scr, scr1, lane); __builtin_amdgcn_sched_barrier(0); } while (0)
    CV_LD(a, 0); CV_LD(b, 1);
    CV_LD(c, 2); CV_ST(a);
    CV_LD(a, 3); CV_ST(b);
    CV_ST(c);
    CV_ST(a);
#undef CV_LD
#undef CV_ST
}

__device__ __forceinline__ void conv_chunk(Frame& F, int c) {
    int lane = lane_now(); asm volatile("" : "+v"(lane));
    if (c >= CONV_TR_CHUNKS) {
        const int j = c - CONV_TR_CHUNKS, t = F.wave * 64 + lane;
        const GAS f32x4* ps = (const GAS f32x4*)(F.ap->in[1]) + (size_t)j * 16384 + t; GAS unsigned long long* pd = (GAS unsigned long long*)WSP(bf16, WS_PB) + (size_t)j * 16384 + t;
        for (int b = 0; b < 4; ++b) { f32x4 v[8];
#pragma unroll
            for (int u = 0; u < 8; ++u) v[u] = ps[b * 4096 + u * 512];
#pragma unroll
            for (int u = 0; u < 8; ++u) pd[b * 4096 + u * 512] = (unsigned long long)cvt_pk_bf16(v[u].x, v[u].y) | ((unsigned long long)cvt_pk_bf16(v[u].z, v[u].w) << 32); }
        return; }
    const int ci0 = c * CONV_ITEMS;
    if (ci0 < TR_GU) conv_body<1, 1>(F, c, lane);
    else if (ci0 < TR_GU + TR_DN) conv_body<1, 0>(F, c, lane);
    else if (ci0 < TR_GU + TR_DN + TR_BR + TR_O) conv_body<0, 0>(F, c, lane);
    else if (ci0 < TR_GU + TR_DN + TR_BR + TR_O + TR_PG) conv_body<1, 0>(F, c, lane);
    else conv_body<0, 0>(F, c, lane);
}

__device__ __forceinline__ void cum_scan(Frame& F, int bh) {
    const float* lf = WSP(float, WS_LOGF); float* cum = WSP(float, WS_CUM);
    const int b = bh >> 3, h = bh & 7, t0 = 4 * F.tid;
    double a0 = lf[((size_t)(b * SEQ + t0 + 0)) * 8 + h], a1 = lf[((size_t)(b * SEQ + t0 + 1)) * 8 + h], a2 = lf[((size_t)(b * SEQ + t0 + 2)) * 8 + h], a3 = lf[((size_t)(b * SEQ + t0 + 3)) * 8 + h];
    a1 += a0; a2 += a1; a3 += a2;
    LAS double* tot = (LAS double*)(F.lds + RING_OFF);
    tot[F.tid] = a3;
    __syncthreads();
    double ex = 0.0;
    for (int j = 0; j < 63; ++j) { const double v = tot[F.wave * 64 + j]; ex += (j < F.lane) ? v : 0.0; }
    if (F.lane == 63) tot[512 + F.wave] = ex + a3;
    __syncthreads();
    for (int w = 0; w < F.wave; ++w) ex += tot[512 + w];
    *(GAS f32x4*)(cum + (size_t)bh * SEQ + t0) = (f32x4){(float)(ex + a0), (float)(ex + a1), (float)(ex + a2), (float)(ex + a3)};
    __syncthreads();
}

typedef pg8::f32x4 (&AccRef)[2][2][4][2];
using pg8::Unit;
__device__ __forceinline__ v4u pack8(const f32x4 a, const f32x4 b) { v4u w; w.x = cvt_pk_bf16(a[0], a[1]); w.y = cvt_pk_bf16(a[2], a[3]); w.z = cvt_pk_bf16(b[0], b[1]); w.w = cvt_pk_bf16(b[2], b[3]); return w; }
__device__ __forceinline__ void unpack8(const v4u w, f32x4& a, f32x4& b) { a = (f32x4){bflo(w.x), bfhi(w.x), bflo(w.y), bfhi(w.y)}; b = (f32x4){bflo(w.z), bfhi(w.z), bflo(w.w), bfhi(w.w)}; }

__device__ __forceinline__ void tstore32(LAS unsigned char* scr, const v4u wa, const v4u wb, int fr, int fq, bf16* dst, int cstride) {
    LAS unsigned short* s2 = (LAS unsigned short*)scr;
#pragma unroll
    for (int e2 = 0; e2 < 4; ++e2) { const int col = 8 * fq + 2 * e2;
        s2[col * 40 + fr] = (unsigned short)(wa[e2] & 0xffffu); s2[(col + 1) * 40 + fr] = (unsigned short)(wa[e2] >> 16);
        s2[col * 40 + 16 + fr] = (unsigned short)(wb[e2] & 0xffffu); s2[(col + 1) * 40 + 16 + fr] = (unsigned short)(wb[e2] >> 16); }
    asm volatile("" ::: "memory");
    const int lane = fr + 16 * fq, cl = lane >> 1, part = lane & 1;
    const v4u r0 = *(const LAS v4u*)(scr + cl * 80 + part * 32), r1 = *(const LAS v4u*)(scr + cl * 80 + part * 32 + 16);
    asm volatile("" ::: "memory");
    bf16* d = dst + (size_t)cl * cstride + part * 16;
    *(v4u*)d = r0; *(v4u*)(d + 8) = r1;
}
struct EpiIn {
    static constexpr bool PERM = true;
    bf16 *FQ, *FK, *FV, *RQ, *RK, *RV, *RGS; const float* rot; bf16* RKT; LAS unsigned char* scr; int skip;
    __device__ __forceinline__ void operator()(const pg8::f32x4 (&acc)[2][2][4][2], const Unit& u, int wr, int wc, int fr, int fq) const {
        if (skip == 1) return;
        asm volatile("" : "+v"(fr), "+v"(fq));
        const int pn = u.pn; bf16* base; int ldc, colt, mode = 0; float sc = 1.f;
        if (skip) { const int cls = pn < 6 ? 1 : pn < 8 ? 2 : pn < 10 ? 4 : 8; if (skip & (cls << 1)) return; }
        if (pn < 2) { base = FQ; ldc = 512; colt = pn * 256; sc = C2; }
        else if (pn < 4) { base = FK; ldc = 512; colt = (pn - 2) * 256; }
        else if (pn < 6) { base = FV; ldc = 512; colt = (pn - 4) * 256; }
        else if (pn == 6) { base = RQ; ldc = 256; colt = 0; mode = 1; }
        else if (pn == 7) { base = RK; ldc = 256; colt = 0; mode = 1; sc = 0.125f; }
        else if (pn < 10) { base = RV; ldc = 512; colt = (pn - 8) * 256; mode = 4; }
        else { base = RGS; ldc = 512; colt = (pn - 10) * 256; mode = 2; }
        const int row0 = u.pm * 256 + wr * 64 + fr, col0 = colt + wc * 32 + 8 * fq;
        LAS unsigned char* ws = scr + (wr * 4 + wc) * 3072;
        if (mode == 1) {
            f32x4 cs[2][4], sn[2][4]; const int j = (col0 & 63) >> 1;
#pragma unroll
            for (int ai = 0; ai < 2; ++ai)
#pragma unroll
                for (int m = 0; m < 4; ++m) { const int pos = (row0 + ai * 128 + m * 16) & (SEQ - 1); cs[ai][m] = *(const f32x4*)(rot + pos * 32 + j); sn[ai][m] = *(const f32x4*)(rot + SEQ * 32 + pos * 32 + j); }
            __builtin_amdgcn_sched_barrier(0);
            float lg2b[2] = {0.f, 0.f};
            if (pn == 7) { lg2b[0] = log1pf(-exp2f(-5.f - (float)(wc >> 1))) * LOG2E; lg2b[1] = log1pf(-exp2f(-5.f - (float)((wc >> 1) + 2))) * LOG2E; }
#pragma unroll
            for (int ai = 0; ai < 2; ++ai)
#pragma unroll
                for (int mh = 0; mh < 2; ++mh)
#pragma unroll
                    for (int bj = 0; bj < 2; ++bj) { const int c = col0 + bj * 128; v4u wt[2];
#pragma unroll
                        for (int mm = 0; mm < 2; ++mm) { const int m = 2 * mh + mm, row = row0 + ai * 128 + m * 16; const f32x4 a = acc[ai][bj][m][0], b = acc[ai][bj][m][1], cv = cs[ai][m], sv = sn[ai][m];
                            const f32x4 v0 = {(a[0] * cv[0] - a[1] * sv[0]) * sc, (a[1] * cv[0] + a[0] * sv[0]) * sc, (a[2] * cv[1] - a[3] * sv[1]) * sc, (a[3] * cv[1] + a[2] * sv[1]) * sc};
                            const f32x4 v1 = {(b[0] * cv[2] - b[1] * sv[2]) * sc, (b[1] * cv[2] + b[0] * sv[2]) * sc, (b[2] * cv[3] - b[3] * sv[3]) * sc, (b[3] * cv[3] + b[2] * sv[3]) * sc};
                            *(v4u*)(base + (size_t)row * ldc + c) = pack8(v0, v1);
                            if (pn == 7) { const float dk = __builtin_amdgcn_exp2f((float)(127 - (row & 127)) * lg2b[bj]); wt[mm] = pack8(v0 * dk, v1 * dk); } }
                        if (pn == 7) {
                            const int rowb = u.pm * 256 + ai * 128 + wr * 64 + mh * 32, cb = wc * 32 + bj * 128;
                            tstore32(ws, wt[0], wt[1], fr, fq, RKT + ((size_t)((rowb >> 11) * 4 + (cb >> 6)) * 16 + ((rowb >> 7) & 15)) * 8192 + (size_t)(cb & 63) * 128 + (rowb & 127), 128); } }
            return; }
        if (mode == 4) {
#pragma unroll
            for (int ai = 0; ai < 2; ++ai)
#pragma unroll
                for (int mh = 0; mh < 2; ++mh)
#pragma unroll
                    for (int bj = 0; bj < 2; ++bj) { const int rowb = u.pm * 256 + ai * 128 + wr * 64 + mh * 32, cb = colt + wc * 32 + bj * 128;
                        tstore32(ws, pack8(acc[ai][bj][2 * mh][0], acc[ai][bj][2 * mh][1]), pack8(acc[ai][bj][2 * mh + 1][0], acc[ai][bj][2 * mh + 1][1]), fr, fq,
                                 RV + ((size_t)((rowb >> 11) * 4 + (cb >> 7)) * 16 + ((rowb >> 7) & 15)) * 16384 + (size_t)(cb & 127) * 128 + (rowb & 127), 128); }
            return; }
#pragma unroll
        for (int ai = 0; ai < 2; ++ai)
#pragma unroll
            for (int m = 0; m < 4; ++m) { const int row = row0 + ai * 128 + m * 16;
#pragma unroll
                for (int bj = 0; bj < 2; ++bj) { const int c = col0 + bj * 128; f32x4 v0 = acc[ai][bj][m][0], v1 = acc[ai][bj][m][1];
                    if (mode == 0) { v0 = v0 * sc; v1 = v1 * sc; }
                    else {
#pragma unroll
                        for (int e = 0; e < 4; ++e) { v0[e] = v0[e] * fsigmoid(v0[e]); v1[e] = v1[e] * fsigmoid(v1[e]); } }
                    *(v4u*)(base + (size_t)row * ldc + c) = pack8(v0, v1); } }
    }
};
__device__ __forceinline__ void u8x8_to_f32(const v2u w, f32x4& a, f32x4& b) {
    a = (f32x4){(float)(w.x & 255u), (float)((w.x >> 8) & 255u), (float)((w.x >> 16) & 255u), (float)(w.x >> 24)}; b = (f32x4){(float)(w.y & 255u), (float)((w.y >> 8) & 255u), (float)((w.y >> 16) & 255u), (float)(w.y >> 24)}; }
struct EpiGate {
    static constexpr bool PERM = true;
    unsigned char* GATES; const float* bmg; bf16 *FQ, *FK; int skip;
    __device__ __forceinline__ void operator()(const pg8::f32x4 (&acc)[2][2][4][2], const Unit& u, int wr, int wc, int fr, int fq) const {
        if (skip & 33) return;
        { const int l_ = lane_now(); fr = l_ & 15; fq = (l_ >> 4) & 3; }
        if (u.pn < 4) {
            bf16* base = u.pn < 2 ? FQ : FK; const float sc = (u.pn < 2 ? C2 : 1.f) * (1.f / WSCALE);
            const int r0 = u.pm * 256 + wr * 64 + fr, c0 = (u.pn & 1) * 256 + wc * 32 + 8 * fq;
#pragma unroll
            for (int ai = 0; ai < 2; ++ai)
#pragma unroll
                for (int m = 0; m < 4; ++m)
#pragma unroll
                    for (int bj = 0; bj < 2; ++bj) *(v4u*)(base + (size_t)(r0 + ai * 128 + m * 16) * 512 + c0 + bj * 128) = pack8(acc[ai][bj][m][0] * sc, acc[ai][bj][m][1] * sc);
            return; }
        float ck = -LOG2E / WSCALE, cb = -LOG2E, c254 = 254.f; asm volatile("" : "+s"(ck), "+s"(cb), "+s"(c254));
        typedef float f2 __attribute__((ext_vector_type(2)));
        const int row0 = u.pm * 256 + wr * 64 + fr, col0 = (u.pn - 4) * 256 + wc * 32 + 8 * fq;
        f32x4 bb[2][2];
#pragma unroll
        for (int bj = 0; bj < 2; ++bj) { bb[bj][0] = *(const f32x4*)(bmg + col0 + bj * 128) * cb; bb[bj][1] = *(const f32x4*)(bmg + col0 + bj * 128 + 4) * cb; }
#pragma unroll
        for (int ai = 0; ai < 2; ++ai)
#pragma unroll
            for (int m = 0; m < 4; ++m) { unsigned char* rowp = GATES + (size_t)(row0 + ai * 128 + m * 16) * 2048 + col0;
#pragma unroll
                for (int bj = 0; bj < 2; ++bj) { v2u w;
#pragma unroll
                    for (int n = 0; n < 2; ++n) { const f32x4 a = acc[ai][bj][m][n], b = bb[bj][n]; unsigned b4 = 0u;
#pragma unroll
                        for (int hh = 0; hh < 2; ++hh) { const f2 t = (f2){a[2 * hh], a[2 * hh + 1]} * ck + (f2){b[2 * hh], b[2 * hh + 1]};
                            f2 ex; ex.x = __builtin_amdgcn_exp2f(t.x); ex.y = __builtin_amdgcn_exp2f(t.y); const f2 den = ex + 1.0f;
                            f2 rc; rc.x = __builtin_amdgcn_rcpf(den.x); rc.y = __builtin_amdgcn_rcpf(den.y); const f2 x = rc * c254 + 0.5f;
                            if (hh == 0) { b4 = __builtin_amdgcn_cvt_pk_u8_f32(x.x, 0, b4); b4 = __builtin_amdgcn_cvt_pk_u8_f32(x.y, 1, b4); }
                            else { b4 = __builtin_amdgcn_cvt_pk_u8_f32(x.x, 2, b4); b4 = __builtin_amdgcn_cvt_pk_u8_f32(x.y, 3, b4); } }
                        if (n == 0) w.x = b4; else w.y = b4; }
                    *(v2u*)(rowp + bj * 128) = w; } }
    }
};
struct HookMerge {
    static constexpr bool ON = true; static constexpr int AT = 6;
    const unsigned char* GATES;
    __device__ __forceinline__ void operator()(pg8::f32x4 (&acc)[2][2][4][2], const Unit& u, int wr, int wc, int fr, int fq) const {
        asm volatile("" : "+v"(fr), "+v"(fq));
        const int row0 = u.pm * 256 + wr * 64 + fr, col0 = u.pn * 256 + wc * 32 + 8 * fq;
        v2u ga[2][4][2], gb[2][4][2];
#pragma unroll
        for (int ai = 0; ai < 2; ++ai)
#pragma unroll
            for (int m = 0; m < 4; ++m) { const unsigned char* gp = GATES + (size_t)(row0 + ai * 128 + m * 16) * 2048 + col0;
#pragma unroll
                for (int bj = 0; bj < 2; ++bj) { ga[ai][m][bj] = *(const v2u*)(gp + bj * 128); gb[ai][m][bj] = *(const v2u*)(gp + 1024 + bj * 128); } }
        __builtin_amdgcn_sched_barrier(0);
#pragma unroll
        for (int ai = 0; ai < 2; ++ai)
#pragma unroll
            for (int m = 0; m < 4; ++m)
#pragma unroll
                for (int bj = 0; bj < 2; ++bj) { f32x4 a0, a1, b0, b1; u8x8_to_f32(ga[ai][m][bj], a0, a1); u8x8_to_f32(gb[ai][m][bj], b0, b1);
#pragma unroll
                    for (int e2 = 0; e2 < 4; ++e2) { acc[ai][bj][m][0][e2] *= a0[e2] * __builtin_amdgcn_rcpf(fmaxf(b0[e2], 1e-30f)); acc[ai][bj][m][1][e2] *= a1[e2] * __builtin_amdgcn_rcpf(fmaxf(b1[e2], 1e-30f)); } }
        __builtin_amdgcn_sched_barrier(0);
    }
};
struct EpiMerge {
    static constexpr bool PERM = true;
    const unsigned char* GATES; bf16* MERGED;
    __device__ __forceinline__ void operator()(const pg8::f32x4 (&acc)[2][2][4][2], const Unit& u, int wr, int wc, int fr, int fq) const {
        asm volatile("" : "+v"(fr), "+v"(fq));
        const int row0 = u.pm * 256 + wr * 64 + fr, col0 = u.pn * 256 + wc * 32 + 8 * fq;
        v2u gg[2][4][2];
#pragma unroll
        for (int ai = 0; ai < 2; ++ai)
#pragma unroll
            for (int m = 0; m < 4; ++m)
#pragma unroll
                for (int bj = 0; bj < 2; ++bj) gg[ai][m][bj] = *(const v2u*)(GATES + (size_t)(row0 + ai * 128 + m * 16) * 2048 + 1024 + col0 + bj * 128);
        __builtin_amdgcn_sched_barrier(0);
#pragma unroll
        for (int ai = 0; ai < 2; ++ai)
#pragma unroll
            for (int m = 0; m < 4; ++m)
#pragma unroll
                for (int bj = 0; bj < 2; ++bj) { f32x4 g0, g1; u8x8_to_f32(gg[ai][m][bj], g0, g1);
#pragma unroll
                    for (int e2 = 0; e2 < 4; ++e2) { g0[e2] = fmaxf(g0[e2], 1e-30f) * (1.f / 254.f); g1[e2] = fmaxf(g1[e2], 1e-30f) * (1.f / 254.f); }
                    *(v4u*)(MERGED + (size_t)(row0 + ai * 128 + m * 16) * 1024 + col0 + bj * 128) = pack8(acc[ai][bj][m][0] * g0, acc[ai][bj][m][1] * g1); }
    }
};
struct EpiMO {
    static constexpr bool PERM = true;
    bf16* MO;
    __device__ __forceinline__ void operator()(const pg8::f32x4 (&acc)[2][2][4][2], const Unit& u, int wr, int wc, int fr, int fq) const {
        asm volatile("" : "+v"(fr), "+v"(fq));
        const int row0 = u.pm * 256 + wr * 64 + fr, col0 = u.pn * 256 + wc * 32 + 8 * fq;
#pragma unroll
        for (int ai = 0; ai < 2; ++ai)
#pragma unroll
            for (int m = 0; m < 4; ++m) { bf16* rowp = MO + (size_t)(row0 + ai * 128 + m * 16) * 1024 + col0;
#pragma unroll
                for (int bj = 0; bj < 2; ++bj) *(v4u*)(rowp + bj * 128) = pack8(acc[ai][bj][m][0], acc[ai][bj][m][1]); }
    }
};
struct EpiGU {
    static constexpr bool PERM = true;
    const float* bgu; const float* rsof; unsigned char* ACT;
    __device__ __forceinline__ void operator()(const pg8::f32x4 (&acc)[2][2][4][2], const Unit& u, int wr, int wc, int fr, int fq) const {
        { const int l_ = lane_now(); fr = l_ & 15; fq = (l_ >> 4) & 3; }
        float c7 = 7.f, cm7 = -7.f, ck = -1.702f * 1.4426950408889634f; asm volatile("" : "+s"(c7), "+s"(cm7), "+s"(ck));
        const int j0 = u.pn * 128 + wc * 32 + 8 * fq;
        const float* bb = bgu + (size_t)u.e * 2048 + 2 * j0;
        const f32x4 q0 = *(const f32x4*)(bb), q1 = *(const f32x4*)(bb + 4), q2 = *(const f32x4*)(bb + 8), q3 = *(const f32x4*)(bb + 12);
        const f32x4 bg0 = {q0[0], q0[2], q1[0], q1[2]}, bl0 = {q0[1], q0[3], q1[1], q1[3]}, bg1 = {q2[0], q2[2], q3[0], q3[2]}, bl1 = {q2[1], q2[3], q3[1], q3[3]};
        const int rl0 = wr * 64 + fr;
        float rsv[2][4];
#pragma unroll
        for (int ai = 0; ai < 2; ++ai)
#pragma unroll
            for (int m = 0; m < 4; ++m) rsv[ai][m] = rsof[(size_t)u.e * NT + u.rtl * 256 + rl0 + ai * 128 + m * 16];
        __builtin_amdgcn_sched_barrier(0);
#pragma unroll
        for (int ai = 0; ai < 2; ++ai)
#pragma unroll
            for (int m = 0; m < 4; ++m) { const int rl = rl0 + ai * 128 + m * 16; const float rs = rsv[ai][m] * (1.f / WSCALE);
                int wpk[2];
#pragma unroll
                for (int n = 0; n < 2; ++n) { const f32x4 ga = acc[ai][0][m][n], la = acc[ai][1][m][n]; const f32x4 bgv = n ? bg1 : bg0, blv = n ? bl1 : bl0; int w = 0;
#pragma unroll
                    for (int hh = 0; hh < 2; ++hh) { typedef float f2 __attribute__((ext_vector_type(2)));
                        f2 g = (f2){ga[2 * hh], ga[2 * hh + 1]} * rs + (f2){bgv[2 * hh], bgv[2 * hh + 1]}, l = (f2){la[2 * hh], la[2 * hh + 1]} * rs + (f2){blv[2 * hh], blv[2 * hh + 1]};
                        f2 a, b; a.x = fminf(g.x, c7); a.y = fminf(g.y, c7); b.x = __builtin_amdgcn_fmed3f(l.x, cm7, c7); b.y = __builtin_amdgcn_fmed3f(l.y, cm7, c7);
                        const f2 t = a * ck; f2 ex; ex.x = __builtin_amdgcn_exp2f(t.x); ex.y = __builtin_amdgcn_exp2f(t.y);
                        const f2 den = ex + 1.0f; f2 rc; rc.x = __builtin_amdgcn_rcpf(den.x); rc.y = __builtin_amdgcn_rcpf(den.y);
                        const f2 o = (a * rc) * (b + 1.0f);
                        if (hh == 0) w = __builtin_amdgcn_cvt_pk_fp8_f32(o.x, o.y, w, false); else w = __builtin_amdgcn_cvt_pk_fp8_f32(o.x, o.y, w, true); }
                    wpk[n] = w; }
                *(v2u*)(ACT + ((size_t)u.pm * 256 + rl) * 1024 + j0) = (v2u){(unsigned)wpk[0], (unsigned)wpk[1]}; }
    }
};
struct EpiDN {
    static constexpr bool PERM = true;
    const float* bdn; unsigned char* Y;
    __device__ __forceinline__ void operator()(const pg8::f32x4 (&acc)[2][2][4][2], const Unit& u, int wr, int wc, int fr, int fq) const {
        asm volatile("" : "+v"(fr), "+v"(fq));
        const int col0 = u.pn * 256 + wc * 32 + 8 * fq; const float* bb = bdn + (size_t)u.e * 1024 + col0;
        f32x4 bv[2][2];
#pragma unroll
        for (int bj = 0; bj < 2; ++bj) { bv[bj][0] = *(const f32x4*)(bb + bj * 128) * YSCALE; bv[bj][1] = *(const f32x4*)(bb + bj * 128 + 4) * YSCALE; }
        const int rl0 = wr * 64 + fr;
#pragma unroll
        for (int ai = 0; ai < 2; ++ai)
#pragma unroll
            for (int m = 0; m < 4; ++m) { unsigned char* rowp = Y + ((size_t)u.pm * 256 + rl0 + ai * 128 + m * 16) * 1024 + col0;
#pragma unroll
                for (int bj = 0; bj < 2; ++bj) *(v2u*)(rowp + bj * 128) = pack8_fp8(acc[ai][bj][m][0] * (YSCALE / WSCALE) + bv[bj][0], acc[ai][bj][m][1] * (YSCALE / WSCALE) + bv[bj][1]); }
    }
};
struct EpiPJ {
    static constexpr bool PERM = false;
    bf16* PJ;
    __device__ __forceinline__ void operator()(const pg8::f32x4 (&acc)[2][2][4][2], const Unit& u, int wr, int wc, int fr, int fq) const {
        asm volatile("" : "+v"(fr), "+v"(fq));
        const int row0 = u.pm * 256 + wr * 64 + fr, col0 = u.pn * 256 + wc * 32 + 4 * fq;
#pragma unroll
        for (int ai = 0; ai < 2; ++ai)
#pragma unroll
            for (int m = 0; m < 4; ++m) { const size_t off = (size_t)(row0 + ai * 128 + m * 16) * 1024 + col0;
#pragma unroll
                for (int bj = 0; bj < 2; ++bj)
#pragma unroll
                    for (int n = 0; n < 2; ++n) { const f32x4 v = acc[ai][bj][m][n]; v2u w; w.x = cvt_pk_bf16(v[0], v[1]); w.y = cvt_pk_bf16(v[2], v[3]); *(v2u*)(PJ + off + bj * 128 + n * 16) = w; } }
    }
};
struct EpiPG {
    static constexpr bool PERM = true;
    unsigned char* G8; const float* rstd2;
    __device__ __forceinline__ void operator()(const pg8::f32x4 (&acc)[2][2][4][2], const Unit& u, int wr, int wc, int fr, int fq) const {
        { const int l_ = lane_now(); fr = l_ & 15; fq = (l_ >> 4) & 3; }
        float ck = -LOG2E / WSCALE, c254 = 254.f; asm volatile("" : "+s"(ck), "+s"(c254));
        typedef float f2 __attribute__((ext_vector_type(2)));
        const int row0 = u.pm * 256 + wr * 64 + fr, col0 = u.pn * 256 + wc * 32 + 8 * fq;
        float rsv[2][4];
#pragma unroll
        for (int ai = 0; ai < 2; ++ai)
#pragma unroll
            for (int m = 0; m < 4; ++m) rsv[ai][m] = rstd2[row0 + ai * 128 + m * 16];
        __builtin_amdgcn_sched_barrier(0);
#pragma unroll
        for (int ai = 0; ai < 2; ++ai)
#pragma unroll
            for (int m = 0; m < 4; ++m) { const float rs = rsv[ai][m] * ck; unsigned char* rowp = G8 + (size_t)(row0 + ai * 128 + m * 16) * 1024 + col0;
#pragma unroll
                for (int bj = 0; bj < 2; ++bj) { v2u w;
#pragma unroll
                    for (int n = 0; n < 2; ++n) { const f32x4 a = acc[ai][bj][m][n]; unsigned b4 = 0u;
#pragma unroll
                        for (int hh = 0; hh < 2; ++hh) { const f2 t = (f2){a[2 * hh], a[2 * hh + 1]} * rs;
                            f2 ex; ex.x = __builtin_amdgcn_exp2f(t.x); ex.y = __builtin_amdgcn_exp2f(t.y); const f2 den = ex + 1.0f;
                            f2 rc; rc.x = __builtin_amdgcn_rcpf(den.x); rc.y = __builtin_amdgcn_rcpf(den.y); const f2 x = rc * c254 + 0.5f;
                            if (hh == 0) { b4 = __builtin_amdgcn_cvt_pk_u8_f32(x.x, 0, b4); b4 = __builtin_amdgcn_cvt_pk_u8_f32(x.y, 1, b4); }
                            else { b4 = __builtin_amdgcn_cvt_pk_u8_f32(x.x, 2, b4); b4 = __builtin_amdgcn_cvt_pk_u8_f32(x.y, 3, b4); } }
                        if (n == 0) w.x = b4; else w.y = b4; }
                    *(v2u*)(rowp + bj * 128) = w; } }
    }
};

__device__ __forceinline__ int moe_setup(Frame& F) {
    LAS int* cnt = (LAS int*)(F.lds + SCH_CNT); LAS int* P = (LAS int*)(F.lds + SCH_P); LAS int* rt2e = (LAS int*)(F.lds + SCH_RT2E);
    if (F.tid < NE) cnt[F.tid] = (int)__hip_atomic_load(((gu32*)(F.ap->ws + WS_CTL)) + CW_CNT + F.tid, RLX_AGENT);
    __syncthreads();
    if (F.tid == 0) { int s = 0; for (int e = 0; e < NE; ++e) { P[e] = s; s += (cnt[e] + 255) >> 8; } P[NE] = s; }
    __syncthreads();
    const int RT = __builtin_amdgcn_readfirstlane(P[NE]);
    for (int t = F.tid; t < RT && t < MAXRT; t += NWAVES * 64) { int e = 0;
#pragma unroll
        for (int k = 1; k <= NE; ++k) e += (P[k] <= t) ? 1 : 0;
        rt2e[t] = e; }
    __syncthreads();
    return RT < MAXRT ? RT : MAXRT;
}
struct MoeOrder {
    pg8::DenseOrder d; LAS const int* P; LAS const int* rt2e; LAS const unsigned* tab;
    const char* Abase; size_t tsA; const char* Bbase; size_t estride, tsB; bool gather;
    __device__ __forceinline__ bool next(int i, Unit& u) const {
        if (!d.tile(i, u.pm, u.pn)) return false;
        const int e = __builtin_amdgcn_readfirstlane(rt2e[u.pm]); u.e = e; u.rtl = u.pm - __builtin_amdgcn_readfirstlane(P[e]);
        u.A = gather ? Abase : Abase + (size_t)u.pm * tsA; u.B = Bbase + (size_t)e * estride + (size_t)u.pn * tsB; return true;
    }
    __device__ __forceinline__ const LAS unsigned char* table(int ui) const { return (const LAS unsigned char*)tab + ui * 1024; }
};

__device__ __forceinline__ void router_pass(Frame& F) {
    LAS float* L = (LAS float*)(F.lds + RING_OFF + F.wave * 2304);
    LAS int* hist = (LAS int*)(F.lds + RING_OFF + 32768); LAS int* hbase = hist + 32;
    if (F.tid < 64) hist[F.tid] = 0;
    __syncthreads();
    const float* X = (F.ap->in[0]); const bf16* MO = WSP(bf16, WS_MO); bf16* MOw = WSP(bf16, WS_MO); unsigned char* HB = WSP(unsigned char, WS_HB); const bf16* wrt = WSP(bf16, WS_WRT);
    const int lane = F.lane, r = lane & 15, q = lane >> 4, tok0 = (int)blockIdx.x * 128 + F.wave * 16, token = tok0 + r;
    pg8::f32x4 acc0 = {0.f, 0.f, 0.f, 0.f}, acc1 = {0.f, 0.f, 0.f, 0.f}; float ss = 0.f;
    const float* hrow = X + (size_t)token * DM + q * 8; const bf16* morow = MO + (size_t)token * DM + q * 8; const bf16* b0p = wrt + (size_t)r * 1024 + q * 8;
    f32x4 xa[2][2][2], ga[2][2][2]; v4u ma[2][2], wa[2][2][4];
#define RT_LOAD(buf, grp) do { _Pragma("unroll") for (int s_ = 0; s_ < 2; ++s_) { const int kk_ = (grp) * 2 + s_; \
        xa[buf][s_][0] = *(const f32x4*)(hrow + kk_ * 32); xa[buf][s_][1] = *(const f32x4*)(hrow + kk_ * 32 + 4); ma[buf][s_] = *(const v4u*)(morow + kk_ * 32); \
        ga[buf][s_][0] = *(const f32x4*)((F.ap->in[9]) + kk_ * 32 + q * 8); ga[buf][s_][1] = *(const f32x4*)((F.ap->in[9]) + kk_ * 32 + q * 8 + 4); \
        wa[buf][s_][0] = *(const v4u*)(b0p + kk_ * 32); wa[buf][s_][1] = *(const v4u*)(b0p + 16 * 1024 + kk_ * 32); wa[buf][s_][2] = *(const v4u*)(b0p + 32768 + kk_ * 32); wa[buf][s_][3] = *(const v4u*)(b0p + 32768 + 16 * 1024 + kk_ * 32); } } while (0)
#define RT_STEP(buf, grp) do { _Pragma("unroll") for (int s_ = 0; s_ < 2; ++s_) { const int kk_ = (grp) * 2 + s_; \
        f32x4 h0 = xa[buf][s_][0], h1 = xa[buf][s_][1]; { f32x4 m0, m1; unpack8(ma[buf][s_], m0, m1); h0 = h0 + m0; h1 = h1 + m1; } \
        ss += (h0[0] * h0[0] + h0[1] * h0[1]) + (h0[2] * h0[2] + h0[3] * h0[3]) + (h1[0] * h1[0] + h1[1] * h1[1]) + (h1[2] * h1[2] + h1[3] * h1[3]); \
        const f32x4 x0 = h0 * ga[buf][s_][0], x1 = h1 * ga[buf][s_][1]; \
        const v4u hi = pack8(x0, x1); f32x4 y0, y1; unpack8(hi, y0, y1); const v4u lo = pack8(x0 - y0, x1 - y1); \
        *(v2u*)(HB + (size_t)token * DM + kk_ * 32 + q * 8) = pack8_fp8(x0, x1); *(v4u*)(MOw + (size_t)token * DM + q * 8 + kk_ * 32) = pack8(h0, h1);     \
        const bf16x8 ah = __builtin_bit_cast(bf16x8, hi), al = __builtin_bit_cast(bf16x8, lo); \
        acc0 = __builtin_amdgcn_mfma_f32_16x16x32_bf16(ah, __builtin_bit_cast(bf16x8, wa[buf][s_][0]), acc0, 0, 0, 0); acc0 = __builtin_amdgcn_mfma_f32_16x16x32_bf16(al, __builtin_bit_cast(bf16x8, wa[buf][s_][0]), acc0, 0, 0, 0); \
        acc0 = __builtin_amdgcn_mfma_f32_16x16x32_bf16(ah, __builtin_bit_cast(bf16x8, wa[buf][s_][2]), acc0, 0, 0, 0); \
        acc1 = __builtin_amdgcn_mfma_f32_16x16x32_bf16(ah, __builtin_bit_cast(bf16x8, wa[buf][s_][1]), acc1, 0, 0, 0); acc1 = __builtin_amdgcn_mfma_f32_16x16x32_bf16(al, __builtin_bit_cast(bf16x8, wa[buf][s_][1]), acc1, 0, 0, 0); \
        acc1 = __builtin_amdgcn_mfma_f32_16x16x32_bf16(ah, __builtin_bit_cast(bf16x8, wa[buf][s_][3]), acc1, 0, 0, 0); } } while (0)
    RT_LOAD(0, 0);
#pragma unroll
    for (int gp = 0; gp < 16; gp += 2) {
        RT_LOAD(1, gp + 1); __builtin_amdgcn_sched_barrier(0); RT_STEP(0, gp); __builtin_amdgcn_sched_barrier(0);
        if (gp + 2 < 16) RT_LOAD(0, gp + 2);
        __builtin_amdgcn_sched_barrier(0); RT_STEP(1, gp + 1); __builtin_amdgcn_sched_barrier(0);
    }
#undef RT_LOAD
#undef RT_STEP
    ss = xor16_sum(ss); ss = xor32_sum(ss);
    const float rstd = 1.f / sqrtf(ss * (1.f / DM) + EPS);
#pragma unroll
    for (int i = 0; i < 4; ++i) { L[(4 * q + i) * 33 + r] = acc0[i]; L[(4 * q + i) * 33 + 16 + r] = acc1[i]; }
    LDS_WAIT(); asm volatile("" ::: "memory");
    int te0 = 0, te1 = 0, te2 = 0, te3 = 0, rk0 = 0, rk1 = 0, rk2 = 0, rk3 = 0; float w0 = 0.f, w1 = 0.f, w2 = 0.f, w3 = 0.f;
    if (lane < 16) {
        float v[32];
#pragma unroll
        for (int e = 0; e < 32; ++e) v[e] = L[lane * 33 + e] * rstd + (F.ap->in[11])[e];
        float tv[4]; int te[4];
#pragma unroll
        for (int k = 0; k < 4; ++k) { float best = v[0]; int bi = 0;
#pragma unroll
            for (int e = 1; e < 32; ++e) if (v[e] > best) { best = v[e]; bi = e; }
            tv[k] = best; te[k] = bi;
#pragma unroll
            for (int e = 0; e < 32; ++e) v[e] = (e == bi) ? -INFINITY : v[e]; }
        const float e1 = expf(tv[1] - tv[0]), e2 = expf(tv[2] - tv[0]), e3 = expf(tv[3] - tv[0]), inv = 1.f / (1.f + e1 + e2 + e3);
        w0 = inv; w1 = e1 * inv; w2 = e2 * inv; w3 = e3 * inv; te0 = te[0]; te1 = te[1]; te2 = te[2]; te3 = te[3];
        rk0 = __hip_atomic_fetch_add(hist + te0, 1, __ATOMIC_RELAXED, __HIP_MEMORY_SCOPE_WORKGROUP); rk1 = __hip_atomic_fetch_add(hist + te1, 1, __ATOMIC_RELAXED, __HIP_MEMORY_SCOPE_WORKGROUP);
        rk2 = __hip_atomic_fetch_add(hist + te2, 1, __ATOMIC_RELAXED, __HIP_MEMORY_SCOPE_WORKGROUP); rk3 = __hip_atomic_fetch_add(hist + te3, 1, __ATOMIC_RELAXED, __HIP_MEMORY_SCOPE_WORKGROUP);
    }
    __syncthreads();
    if (F.tid < NE) hbase[F.tid] = (int)__hip_atomic_fetch_add(((gu32*)(F.ap->ws + WS_CTL)) + CW_CNT + F.tid, (unsigned)hist[F.tid], RLX_AGENT);
    __syncthreads();
    if (lane < 16) {
        int* TOK = WSP(int, WS_TOK); float* RSOF = WSP(float, WS_RSOF); int* TOPE = WSP(int, WS_TOPE); float* TOPW = WSP(float, WS_TOPW); int* POS = WSP(int, WS_POS);
        const int p0 = hbase[te0] + rk0, p1 = hbase[te1] + rk1, p2 = hbase[te2] + rk2, p3 = hbase[te3] + rk3;
        TOK[(size_t)te0 * NT + p0] = token; TOK[(size_t)te1 * NT + p1] = token; TOK[(size_t)te2 * NT + p2] = token; TOK[(size_t)te3 * NT + p3] = token;
        RSOF[(size_t)te0 * NT + p0] = rstd; RSOF[(size_t)te1 * NT + p1] = rstd; RSOF[(size_t)te2 * NT + p2] = rstd; RSOF[(size_t)te3 * NT + p3] = rstd;
        *(int4*)(TOPE + (size_t)token * 4) = make_int4(te0, te1, te2, te3); *(float4*)(TOPW + (size_t)token * 4) = make_float4(w0, w1, w2, w3); *(int4*)(POS + (size_t)token * 4) = make_int4(p0, p1, p2, p3);
    }
    __syncthreads();
}
__device__ __forceinline__ void combine_pass(Frame& F) {
    LAS const int* P = (LAS const int*)(F.lds + SCH_P);
    const unsigned char* Y = WSP(unsigned char, WS_Y); const bf16* MO = WSP(bf16, WS_MO); unsigned char* HB2 = WSP(unsigned char, WS_HB2); float* RSTD2 = WSP(float, WS_RSTD2); bf16* H2B = WSP(bf16, WS_H2B);
    const int* TOPE = WSP(int, WS_TOPE); const float* TOPW = WSP(float, WS_TOPW); const int* POS = WSP(int, WS_POS);
    const int lane = F.lane, tok0 = (int)blockIdx.x * 128 + F.wave * 16;
    int4 te_n[2], tp_n[2]; float4 tw_n[2], tw_c[2]; v4u mc[2][2], mn[2][2]; v2u yc[2][4][2], yn[2][4][2];
#define CB_ROUTE(i) do { _Pragma("unroll") for (int t_ = 0; t_ < 2; ++t_) { te_n[t_] = *(const int4*)(TOPE + (size_t)(tok0 + (i) + t_) * 4); tw_n[t_] = *(const float4*)(TOPW + (size_t)(tok0 + (i) + t_) * 4); tp_n[t_] = *(const int4*)(POS + (size_t)(tok0 + (i) + t_) * 4); } } while (0)
#define CB_DATA(dm, dy, i) do { _Pragma("unroll") for (int t_ = 0; t_ < 2; ++t_) { \
        const size_t s0_ = (size_t)(P[te_n[t_].x] * 256 + tp_n[t_].x) * DM, s1_ = (size_t)(P[te_n[t_].y] * 256 + tp_n[t_].y) * DM, s2_ = (size_t)(P[te_n[t_].z] * 256 + tp_n[t_].z) * DM, s3_ = (size_t)(P[te_n[t_].w] * 256 + tp_n[t_].w) * DM; \
        _Pragma("unroll") for (int j = 0; j < 2; ++j) { const int c = 8 * lane + 512 * j; dm[t_][j] = *(const v4u*)(MO + (size_t)(tok0 + (i) + t_) * DM + c); \
            dy[t_][0][j] = *(const v2u*)(Y + s0_ + c); dy[t_][1][j] = *(const v2u*)(Y + s1_ + c); dy[t_][2][j] = *(const v2u*)(Y + s2_ + c); dy[t_][3][j] = *(const v2u*)(Y + s3_ + c); } } } while (0)
    f32x4 gq[2][2];
#pragma unroll
    for (int j = 0; j < 2; ++j) { gq[j][0] = *(const f32x4*)((F.ap->in[16]) + 8 * lane + 512 * j); gq[j][1] = *(const f32x4*)((F.ap->in[16]) + 8 * lane + 512 * j + 4); }
    CB_ROUTE(0); CB_DATA(mc, yc, 0); tw_c[0] = tw_n[0]; tw_c[1] = tw_n[1]; CB_ROUTE(2);
    for (int i = 0; i < 16; i += 2) {
        const float4 tw_x0 = tw_n[0], tw_x1 = tw_n[1];
        if (i + 2 < 16) CB_DATA(mn, yn, i + 2);
        if (i + 4 < 16) CB_ROUTE(i + 4);
        __builtin_amdgcn_sched_barrier(0);
#pragma unroll
        for (int t = 0; t < 2; ++t) { const int token = tok0 + i + t; f32x4 v[2][2]; float ss = 0.f; const float4 tw = tw_c[t] * (1.f / YSCALE);
#pragma unroll
            for (int j = 0; j < 2; ++j) { f32x4 a, b; unpack8(mc[t][j], a, b);
#pragma unroll
                for (int k = 0; k < 4; ++k) { const v2u y = yc[t][k][j]; const float w = k == 0 ? tw.x : k == 1 ? tw.y : k == 2 ? tw.z : tw.w;
                    const auto p0 = __builtin_amdgcn_cvt_pk_f32_fp8((int)y.x, false), p1 = __builtin_amdgcn_cvt_pk_f32_fp8((int)y.x, true), p2 = __builtin_amdgcn_cvt_pk_f32_fp8((int)y.y, false), p3 = __builtin_amdgcn_cvt_pk_f32_fp8((int)y.y, true);
                    a += w * (f32x4){p0[0], p0[1], p1[0], p1[1]}; b += w * (f32x4){p2[0], p2[1], p3[0], p3[1]}; }
                v[j][0] = a; v[j][1] = b;
                ss += ((a.x * a.x + a.y * a.y) + (a.z * a.z + a.w * a.w)) + ((b.x * b.x + b.y * b.y) + (b.z * b.z + b.w * b.w)); }
            const float rstd = 1.f / sqrtf(wave_sum(ss) * (1.f / DM) + EPS);
#pragma unroll
            for (int j = 0; j < 2; ++j) { const int c = 8 * lane + 512 * j; *(v4u*)(H2B + (size_t)token * DM + c) = pack8(v[j][0], v[j][1]);
                const f32x4 g0 = gq[j][0], g1 = gq[j][1];
                *(v2u*)(HB2 + (size_t)token * DM + c) = pack8_fp8(v[j][0] * g0, v[j][1] * g1); }
            if (lane == 0) RSTD2[token] = rstd; }
        __builtin_amdgcn_sched_barrier(0);
#pragma unroll
        for (int t = 0; t < 2; ++t)
#pragma unroll
            for (int j = 0; j < 2; ++j) { mc[t][j] = mn[t][j];
#pragma unroll
                for (int k = 0; k < 4; ++k) yc[t][k][j] = yn[t][k][j]; }
        tw_c[0] = tw_x0; tw_c[1] = tw_x1;
    }
#undef CB_ROUTE
#undef CB_DATA
}
__device__ __forceinline__ void final_pass(Frame& F) {
    const bf16* PJ = WSP(bf16, WS_PJ); const bf16* H2B = WSP(bf16, WS_H2B); const unsigned char* G8 = WSP(unsigned char, WS_G8); const int lane = F.lane, tok0 = (int)blockIdx.x * 128 + F.wave * 16;
    v4u hc[2][2], hn[2][2], pc[2][2], pn[2][2]; v2u gc[2][2], gn[2][2];
#define FP_LOAD(hd, pd, gd, i) do { _Pragma("unroll") for (int t_ = 0; t_ < 2; ++t_) _Pragma("unroll") for (int j = 0; j < 2; ++j) { const size_t o_ = (size_t)(tok0 + (i) + t_) * DM + 8 * lane + 512 * j; \
        hd[t_][j] = *(const v4u*)(H2B + o_); pd[t_][j] = *(const v4u*)(PJ + o_); gd[t_][j] = *(const v2u*)(G8 + o_); } } while (0)
    f32x4 gf[2][2];
#pragma unroll
    for (int j = 0; j < 2; ++j) { gf[j][0] = *(const f32x4*)((F.ap->in[19]) + 8 * lane + 512 * j); gf[j][1] = *(const f32x4*)((F.ap->in[19]) + 8 * lane + 512 * j + 4); }
    FP_LOAD(hc, pc, gc, 0);
    for (int i = 0; i < 16; i += 2) {
        if (i + 2 < 16) FP_LOAD(hn, pn, gn, i + 2);
        __builtin_amdgcn_sched_barrier(0);
#pragma unroll
        for (int t = 0; t < 2; ++t) { f32x4 v[2][2]; float ss = 0.f;
#pragma unroll
            for (int j = 0; j < 2; ++j) { f32x4 a, b, pa, pb; unpack8(hc[t][j], a, b); unpack8(pc[t][j], pa, pb); const unsigned g0 = gc[t][j].x, g1 = gc[t][j].y;
                const f32x4 ga = {(float)(g0 & 255u), (float)((g0 >> 8) & 255u), (float)((g0 >> 16) & 255u), (float)(g0 >> 24)}, gb = {(float)(g1 & 255u), (float)((g1 >> 8) & 255u), (float)((g1 >> 16) & 255u), (float)(g1 >> 24)};
                a += (ga * (1.f / 254.f)) * pa; b += (gb * (1.f / 254.f)) * pb; v[j][0] = a; v[j][1] = b;
                ss += ((a.x * a.x + a.y * a.y) + (a.z * a.z + a.w * a.w)) + ((b.x * b.x + b.y * b.y) + (b.z * b.z + b.w * b.w)); }
            const float rstd = 1.f / sqrtf(wave_sum(ss) * (1.f / DM) + EPS); float* hr = (F.ap->out) + (size_t)(tok0 + i + t) * DM;
#pragma unroll
            for (int j = 0; j < 2; ++j) { const int c = 8 * lane + 512 * j; const f32x4 g0 = gf[j][0], g1 = gf[j][1];
                *(f32x4*)(hr + c) = v[j][0] * rstd * g0; *(f32x4*)(hr + c + 4) = v[j][1] * rstd * g1; } }
        __builtin_amdgcn_sched_barrier(0);
#pragma unroll
        for (int t = 0; t < 2; ++t)
#pragma unroll
            for (int j = 0; j < 2; ++j) { hc[t][j] = hn[t][j]; pc[t][j] = pn[t][j]; gc[t][j] = gn[t][j]; }
    }
#undef FP_LOAD
}

struct PnOffOrder { pg8::DenseOrder d; int off;
    __device__ __forceinline__ bool next(int i, pg8::Unit& u) const { if (!d.next(i, u)) return false; u.pn += off; return true; }
    __device__ __forceinline__ const LAS unsigned char* table(int) const { return nullptr; } };
struct StrideOrder { int start, stride, n; const char* A; const char* B; size_t tsA, tsB;
    __device__ __forceinline__ bool next(int i, pg8::Unit& u) const { const int idx = start + i * stride; if (idx >= n) return false; u.pm = idx >> 2; u.pn = idx & 3; u.A = A + (size_t)u.pm * tsA; u.B = B + (size_t)u.pn * tsB; u.e = 0; u.rtl = 0; return true; }
    __device__ __forceinline__ const LAS unsigned char* table(int) const { return nullptr; } };
constexpr int N_PHASES = 11;

__global__ void __launch_bounds__(NWAVES * 64, 2) fwd(Args args) {
    extern __shared__ __attribute__((aligned(16))) unsigned char lds[];
    Frame F;
    F.lds = (LAS unsigned char*)lds;
    F.MISC = (volatile LAS unsigned*)(F.lds + MISC_OFF);
    F.tid = threadIdx.x; F.lane = F.tid & 63; F.wave = __builtin_amdgcn_readfirstlane(F.tid >> 6);
    F.G = gridDim.x; { const int bx = blockIdx.x; F.vcu = (F.G % 8 == 0) ? (bx % 8) * (F.G / 8) + bx / 8 : bx; }
    REARGS();
    for (int u = F.tid; u < 64; u += NWAVES * 64) ((LAS unsigned*)(F.lds + MISC_OFF))[u] = 0u;
    __syncthreads();
    const bool one = (F.ap->ph_hi - F.ap->ph_lo) > 1;
    XcdBarrier bar; bar.bar = (unsigned*)(((gu32*)(F.ap->ws + WS_CTL)) + CW_BAR); bar.x = 0; bar.st = nullptr;
    if (one) bar = xcd_barrier_post((unsigned*)(((gu32*)(F.ap->ws + WS_CTL)) + CW_BAR), F.MISC + 8, F.tid);
#ifdef ONLY_PHASE
    constexpr int lo = ONLY_PHASE, hi = ONLY_PHASE + 1;
#else
    const int lo = F.ap->ph_lo, hi = F.ap->ph_hi;
#endif
    int cid = (int)blockIdx.x;
#define IN(k) (lo <= (k) && (k) < hi)
#define RELANE() do { int l_ = lane_now(); asm volatile("" : "+v"(l_)); F.lane = l_; F.tid = F.wave * 64 + l_; REARGS(); asm volatile("" : "+s"(cid)); } while (0)
#define GBAR() do { RELANE(); xcd_barrier(bar, F.tid); } while (0)
#define SEAM(k) do { if (IN(k) && IN((k) + 1)) GBAR(); } while (0)
    const int rep_phase = F.ap->rep_phase, rep_mode = F.ap->rep_mode;
#define NREP(k) (((k) == rep_phase) ? 2 : 1)
    LAS unsigned char* ring = F.lds + RING_OFF;

    for (int rep = 0; rep < NREP(0); ++rep) { if (rep) GBAR(); if (IN(0)) { RELANE(); p0_prologue(F); } } SEAM(0);
    for (int rep = 0; rep < NREP(1); ++rep) { if (rep) GBAR(); if (IN(1)) { RELANE();
        if (cid < NBATCH * 8) cum_scan(F, cid);
        { pg8::Gemm g{1024, 1024, 1024}; PnOffOrder S; S.off = 4; S.d.init(NT / 256, 8, F.G, cid, WSP(bf16, WS_XN), (size_t)256 * 1024 * 2, WSP(bf16, WS_W1T), (size_t)256 * 1024 * 2);
          EpiIn E{WSP(bf16, WS_FQ), WSP(bf16, WS_FK), WSP(bf16, WS_FV), WSP(bf16, WS_RQ), WSP(bf16, WS_RK), WSP(bf16, WS_RV), WSP(bf16, WS_RGS), WSP(float, WS_ROT), WSP(bf16, WS_RKT), F.lds + TAB_OFF, (rep == 1 && rep_mode >= 7) ? (rep_mode == 7 ? 1 : rep_mode - 64) : 0};
          pg8::gemm_phase<EpiIn, PnOffOrder, true, false>(ring, g, S, E, F.wave); }
        { RELANE();
          pg8::Gemm g{1024, 1024, 1024}; pg8::DenseOrder S; S.init(NT / 256, 12, F.G, cid, WSP(unsigned char, WS_XN8), (size_t)256 * 1024, WSP(unsigned char, WS_WG8T), (size_t)256 * 1024);
          EpiGate E{WSP(unsigned char, WS_GATES), (F.ap->in[7]), WSP(bf16, WS_FQ), WSP(bf16, WS_FK), (rep == 1 && rep_mode >= 7) ? (rep_mode == 7 ? 1 : rep_mode - 64) : 0};
          pg8::gemm_phase<EpiGate, pg8::DenseOrder, true, false, 1>(ring, g, S, E, F.wave); }
    } } SEAM(1);
    for (int rep = 0; rep < NREP(2); ++rep) { if (rep) GBAR(); if (IN(2)) { RELANE();
        { static_assert(ret_body::LDS_BYTES <= RING_BYTES && attn_body::ATTN_LDS_BYTES <= RING_BYTES, "phase scratch inside the ring");
          volatile LAS int* qn = (volatile LAS int*)(F.MISC + 16);
          const attn_body::bf16* Q = (const attn_body::bf16*)WSP(bf16, WS_FQ); const attn_body::bf16* K = (const attn_body::bf16*)WSP(bf16, WS_FK); const attn_body::bf16* V = (const attn_body::bf16*)WSP(bf16, WS_FV);
          attn_body::bf16* O = (attn_body::bf16*)WSP(bf16, WS_BR);
          if (lane_now() + F.wave * 64 == 0) qn[0] = (int)__hip_atomic_fetch_add(((gu32*)(F.ap->ws + WS_CTL)) + CW_QUEUE + 64 * rep, 1u, RLX_AGENT);
          __syncthreads();
          for (int n = 0;; ++n) {
              const int item = __builtin_amdgcn_readfirstlane(qn[n & 1]);
              if (item >= 64 + 1024 + CONV_CHUNKS) break;
              int nxt_item = 0;
              if (lane_now() + F.wave * 64 == 0) nxt_item = (int)__hip_atomic_fetch_add(((gu32*)(F.ap->ws + WS_CTL)) + CW_QUEUE + 64 * rep, 1u, RLX_AGENT);
              if (item < 64) { const int bh4 = item;
                  ret_body::ret_unit(ring, bh4 >> 2, bh4 & 3, WSP(bf16, WS_RQ), WSP(bf16, WS_RK), WSP(bf16, WS_RV), WSP(bf16, WS_RKT), WSP(bf16, WS_RGS), WSP(bf16, WS_BR), F.wave, 0, 16, 0); }
              else { const int r = item - 64, cb = (int)(((long)r * CONV_CHUNKS) / (1024 + CONV_CHUNKS)), cn = (int)(((long)(r + 1) * CONV_CHUNKS) / (1024 + CONV_CHUNKS));
                  if (cn > cb) { RELANE(); conv_chunk(F, cb); }
                  else { const int k = r - cb, qb = 7 - (k >> 7), bh = k & 127;
                      attn_body::attn_unit<8>(bh >> 3, bh & 7, qb, Q, K, V, O, WSP(float, WS_CUM) + (size_t)bh * SEQ, (char*)lds + RING_OFF, F.wave); } }
              if (lane_now() + F.wave * 64 == 0) qn[(n + 1) & 1] = nxt_item;
              __syncthreads();
          } }
    } } SEAM(2);
    for (int rep = 0; rep < NREP(3); ++rep) { if (rep) GBAR(); if (IN(3)) { RELANE();
        pg8::Gemm g{1024, 1024, 1024}; pg8::DenseOrder S; S.init(NT / 256, 4, F.G, cid, WSP(bf16, WS_BR), (size_t)256 * 1024 * 2, WSP(bf16, WS_WBT), (size_t)256 * 1024 * 2);
        EpiMerge E{WSP(unsigned char, WS_GATES), WSP(bf16, WS_MERGED)}; HookMerge H{WSP(unsigned char, WS_GATES)};
        pg8::gemm_phase<EpiMerge, pg8::DenseOrder, true, false, 2, HookMerge>(ring, g, S, E, F.wave, H);
    } } SEAM(3);
    for (int rep = 0; rep < NREP(4); ++rep) { if (rep) GBAR(); if (IN(4)) { RELANE();
        pg8::Gemm g{1024, 1024, 1024}; pg8::DenseOrder S; S.init(NT / 256, 4, F.G, cid, WSP(bf16, WS_MERGED), (size_t)256 * 1024 * 2, WSP(bf16, WS_WOT), (size_t)256 * 1024 * 2);
        EpiMO E{WSP(bf16, WS_MO)}; pg8::gemm_phase<EpiMO, pg8::DenseOrder, true, false>(ring, g, S, E, F.wave);
    } } SEAM(4);
    for (int rep = 0; rep < NREP(5); ++rep) { if (rep) GBAR(); if (IN(5)) { RELANE(); router_pass(F); } } SEAM(5);
    int moe_rt = -1;
    for (int rep = 0; rep < NREP(6); ++rep) { if (rep) GBAR(); if (IN(6)) { RELANE();
        const int RT = moe_rt = moe_setup(F);
        MoeOrder S; S.d.init(RT, 8, F.G, cid, nullptr, 0, nullptr, 0); S.P = (LAS const int*)(F.lds + SCH_P); S.rt2e = (LAS const int*)(F.lds + SCH_RT2E); S.tab = (LAS const unsigned*)(F.lds + TAB_OFF);
        S.Abase = (const char*)WSP(unsigned char, WS_HB); S.tsA = 0; S.Bbase = (const char*)WSP(unsigned char, WS_WGUT); S.estride = (size_t)2048 * 1024; S.tsB = (size_t)256 * 1024; S.gather = true;
        { LAS const int* cnt = (LAS const int*)(F.lds + SCH_CNT); LAS unsigned* tab = (LAS unsigned*)(F.lds + TAB_OFF); const int* TOK = WSP(int, WS_TOK);
          int tokv[MAXUNITS / 2];
#pragma unroll
          for (int j = 0; j < MAXUNITS / 2; ++j) { const int ui = 2 * j + (F.tid >> 8), r = F.tid & 255; int pm, pn; tokv[j] = -1;
              if (S.d.tile(ui, pm, pn)) { const int e = S.rt2e[pm], pos = (pm - S.P[e]) * 256 + r; tokv[j] = pos < cnt[e] ? TOK[(size_t)e * NT + pos] : NT; } }
#pragma unroll
          for (int j = 0; j < MAXUNITS / 2; ++j) { const int ui = 2 * j + (F.tid >> 8), r = F.tid & 255; if (tokv[j] >= 0) tab[ui * 256 + r] = (unsigned)tokv[j] * 1024u; }
          __syncthreads(); }
        pg8::Gemm g{1024, 1024, 1024};
        EpiGU E{(F.ap->in[13]), WSP(float, WS_RSOF), WSP(unsigned char, WS_ACT)}; pg8::gemm_phase<EpiGU, MoeOrder, true, true, 1>(ring, g, S, E, F.wave);
    } } SEAM(6);
    for (int rep = 0; rep < NREP(7); ++rep) { if (rep) GBAR(); if (IN(7)) { RELANE();
        const int RT = moe_rt >= 0 ? moe_rt : (moe_rt = moe_setup(F));
        MoeOrder S; S.d.init(RT, 4, F.G, cid, nullptr, 0, nullptr, 0); S.P = (LAS const int*)(F.lds + SCH_P); S.rt2e = (LAS const int*)(F.lds + SCH_RT2E); S.tab = (LAS const unsigned*)(F.lds + TAB_OFF);
        S.Abase = (const char*)WSP(unsigned char, WS_ACT); S.tsA = (size_t)256 * 1024; S.Bbase = (const char*)WSP(unsigned char, WS_WDT); S.estride = (size_t)1024 * 1024; S.tsB = (size_t)256 * 1024; S.gather = false;
        pg8::Gemm g{1024, 1024, 1024};
        EpiDN E{(F.ap->in[15]), WSP(unsigned char, WS_Y)}; pg8::gemm_phase<EpiDN, MoeOrder, true, false, 1>(ring, g, S, E, F.wave);
        { const int rem = (RT * 4) % F.G, nidle = F.G - rem; const bool tail = 2 * nidle >= F.G;
          if (!tail || cid >= rem) { RELANE(); pg8::Gemm g2{256, 256, 256}; StrideOrder S2; S2.start = tail ? cid - rem : cid; S2.stride = tail ? nidle : F.G; S2.n = (NT / 256) * 4; S2.A = (const char*)WSP(bf16, WS_PB); S2.tsA = (size_t)256 * 256 * 2; S2.B = (const char*)WSP(bf16, WS_WPPT); S2.tsB = (size_t)256 * 256 * 2;
              EpiPJ E2{WSP(bf16, WS_PJ)}; pg8::gemm_phase<EpiPJ, StrideOrder, true, false>(ring, g2, S2, E2, F.wave); } }
    } } SEAM(7);
    for (int rep = 0; rep < NREP(8); ++rep) { if (rep) GBAR(); if (IN(8)) { RELANE(); if (moe_rt < 0) moe_rt = moe_setup(F); combine_pass(F); } } SEAM(8);
    for (int rep = 0; rep < NREP(9); ++rep) { if (rep) GBAR(); if (IN(9)) { RELANE();
        { pg8::Gemm g{1024, 1024, 1024}; pg8::DenseOrder S; S.init(NT / 256, 4, F.G, cid, WSP(unsigned char, WS_HB2), (size_t)256 * 1024, WSP(unsigned char, WS_WPGT), (size_t)256 * 1024);
          EpiPG E{WSP(unsigned char, WS_G8), WSP(float, WS_RSTD2)}; pg8::gemm_phase<EpiPG, pg8::DenseOrder, true, false, 1>(ring, g, S, E, F.wave); }
    } } SEAM(9);
    if (IN(10)) { RELANE(); final_pass(F); }
#undef IN
#undef SEAM
}

extern "C" void kernel_launch(void* const* d_in, const int* in_sizes, int n_in, void* d_out, int out_size, void* d_ws, size_t ws_size, hipStream_t stream) {
    static int grid = 0;
    if (grid == 0) {
        if (n_in != 20 || in_sizes[0] != NT * DM || out_size != NT * DM || ws_size < WS_END) { fprintf(stderr, "kernel_launch: unexpected shapes / workspace (%zu < %zu); nothing launched\n", ws_size, (size_t)WS_END); grid = -1; return; }
        int dev = 0, cus = 0, per_cu = 0;
        if (hipGetDevice(&dev) != hipSuccess || hipDeviceGetAttribute(&cus, hipDeviceAttributeMultiprocessorCount, dev) != hipSuccess) { grid = -1; return; }
        if (hipFuncSetAttribute((const void*)fwd, hipFuncAttributeMaxDynamicSharedMemorySize, LDS_BYTES) != hipSuccess) { fprintf(stderr, "kernel_launch: hipFuncSetAttribute failed\n"); grid = -1; return; }
        if (hipOccupancyMaxActiveBlocksPerMultiprocessor(&per_cu, (const void*)fwd, NWAVES * 64, LDS_BYTES) != hipSuccess || per_cu < 1) { fprintf(stderr, "kernel_launch: occupancy query reports %d workgroups per CU\n", per_cu); }
        (void)hipGetLastError();
        grid = cus;
        if (grid != 256) { fprintf(stderr, "kernel_launch: built for 256 CUs, found %d; nothing launched\n", cus); grid = -1; return; }
    }
    if (grid < 0) return;
    if (hipMemsetAsync((char*)d_ws + WS_CTL, 0, CTL_ZERO_BYTES, stream) != hipSuccess) return;
    Args a; memset(&a, 0, sizeof a);
    for (int i = 0; i < 20; ++i) a.in[i] = (const float*)d_in[i];
    a.out = (float*)d_out; a.ws = (unsigned char*)d_ws;
#ifndef MK_SPLIT
    a.ph_lo = 0; a.ph_hi = N_PHASES;
#ifdef PROBE_PHASE
    a.rep_phase = PROBE_PHASE; a.rep_mode = PROBE_MODE;
#else
    a.rep_phase = -1; a.rep_mode = 0;
#endif
    hipLaunchKernelGGL(fwd, dim3(grid), dim3(NWAVES * 64), LDS_BYTES, stream, a);
#else
    for (int ph = 0; ph < N_PHASES; ++ph) { a.ph_lo = ph; a.ph_hi = ph + 1; hipLaunchKernelGGL(fwd, dim3(grid), dim3(NWAVES * 64), LDS_BYTES, stream, a); }
#endif
}
```
